# Optimizing an MI355X kernel written in HIP

```python
import math
import jax, jax.numpy as jnp
from jax import lax
import numpy as np

D_MODEL = 2048
BATCH = 4
SEQ = 2048
DEPTH = 4

MEM_LEN = 256
A_HEAD_DIM = 128
A_HEADS = D_MODEL // 256
A_KV_HEADS = A_HEADS // 4
A_GROUP = A_HEADS // A_KV_HEADS
WINDOW = 128
BLOCK = 128
N_BUCKETS = 32
MAX_DISTANCE = 128
B_HEADS = D_MODEL // 512
B_KEY_DIM = 64
B_VAL_DIM = 128
GATE_RANK = 16
GATE_TAU = 16.0
GLA_CHUNK = 16
C_WIDTH = D_MODEL // 4
C_BLOCKS = 4
C_BLOCK_DIM = C_WIDTH // C_BLOCKS
CONV_WIDTH = 4
CONV_LEFT = 2
LRU_C = 8.0
X_HEADS = 4
X_HEAD_DIM = D_MODEL // X_HEADS
D_FF = 4 * D_MODEL
EPS = 1e-6
NEG_INF = -1e30

A_Q = A_HEADS * A_HEAD_DIM
A_KV = A_KV_HEADS * A_HEAD_DIM
B_QK = B_HEADS * B_KEY_DIM
B_V = B_HEADS * B_VAL_DIM
SPLIT_SIZES = (A_Q, A_KV, A_KV, B_QK, B_QK, B_V, B_V, GATE_RANK, GATE_RANK, C_WIDTH, C_WIDTH)
D_IN = sum(SPLIT_SIZES)
D_MIX = A_Q + B_V + C_WIDTH

kernel_name = 'hymba_style_parallel_hybrid_encoder'


def rmsnorm(x, g):
    xf = x.astype(jnp.float32)
    y = xf * lax.rsqrt(jnp.mean(jnp.square(xf), axis=-1, keepdims=True) + EPS)
    return (y * g.astype(jnp.float32)).astype(x.dtype)


def t5_bucket(rel):
    nb = N_BUCKETS // 2
    max_exact = nb // 2
    ret = jnp.where(rel > 0, nb, 0)
    n = jnp.abs(rel)
    nf = jnp.maximum(n, 1).astype(jnp.float32)
    large = max_exact + (jnp.log(nf / max_exact) / math.log(MAX_DISTANCE / max_exact)
                         * (nb - max_exact)).astype(jnp.int32)
    large = jnp.minimum(large, nb - 1)
    return ret + jnp.where(n < max_exact, n, large)


def windowed_gqa(q, k, v, rel_table, sink):
    bsz, seq = q.shape[:2]
    nblk = seq // BLOCK
    qb = q.reshape(bsz, nblk, BLOCK, A_KV_HEADS, A_GROUP, A_HEAD_DIM)

    def band(t):
        tp = jnp.pad(t, ((0, 0), (BLOCK, BLOCK), (0, 0), (0, 0)))
        tp = tp.reshape(bsz, nblk + 2, BLOCK, A_KV_HEADS, A_HEAD_DIM)
        return jnp.concatenate([tp[:, :-2], tp[:, 1:-1], tp[:, 2:]], axis=2)

    kb, vb = band(k), band(v)
    s = jnp.einsum('bnqhgd,bnkhd->bnhgqk', qb, kb).astype(jnp.float32) * (A_HEAD_DIM ** -0.5)
    qi = jnp.arange(BLOCK)[:, None]
    kj = jnp.arange(3 * BLOCK)[None, :]
    rel = kj - BLOCK - qi
    bias = rel_table.astype(jnp.float32)[t5_bucket(rel)]
    bias = jnp.transpose(bias, (2, 0, 1)).reshape(A_KV_HEADS, A_GROUP, BLOCK, 3 * BLOCK)
    kpos = jnp.arange(nblk)[:, None] * BLOCK + jnp.arange(3 * BLOCK)[None, :] - BLOCK
    valid = (jnp.abs(rel) <= WINDOW)[None] & ((kpos >= 0) & (kpos < seq))[:, None, :]
    s = jnp.where(valid[None, :, None, None], s + bias, NEG_INF)
    sink_col = jnp.broadcast_to(sink.astype(jnp.float32).reshape(A_KV_HEADS, A_GROUP, 1, 1),
                                s.shape[:-1] + (1,))
    p = jax.nn.softmax(jnp.concatenate([s, sink_col], axis=-1), axis=-1)[..., :-1]
    o = jnp.einsum('bnhgqk,bnkhd->bnqhgd', p.astype(v.dtype), vb)
    return o.reshape(bsz, seq, A_Q)


def gla_chunked(q, k, v, log_a, inclusive):
    bsz, nh, seq, dk = q.shape
    dv = v.shape[-1]
    nc = seq // GLA_CHUNK
    q = q.reshape(bsz, nh, nc, GLA_CHUNK, dk)
    k = k.reshape(bsz, nh, nc, GLA_CHUNK, dk)
    log_a = log_a.reshape(bsz, nh, nc, GLA_CHUNK, dk)
    v = v.reshape(bsz, nh, nc, GLA_CHUNK, dv)
    b = jnp.cumsum(log_a, axis=3)
    idx = jnp.arange(GLA_CHUNK)
    mask = (idx[:, None] >= idx[None, :]) if inclusive else (idx[:, None] > idx[None, :])
    m3 = mask[:, :, None]
    diff = b[:, :, :, :, None, :] - b[:, :, :, None, :, :]
    decay = jnp.where(m3, jnp.exp(jnp.where(m3, diff, 0.0)), 0.0)
    attn = jnp.einsum('bhnid,bhnjd,bhnijd->bhnij', q, k, decay)
    o = jnp.einsum('bhnij,bhnjd->bhnid', attn, v)
    b_last = b[:, :, :, -1, :]
    u = jnp.einsum('bhncd,bhnce->bhnde', k * jnp.exp(b_last[:, :, :, None, :] - b), v)

    def step(state, xs):
        dec, un = xs
        return dec[..., None] * state + un, state

    s0 = jnp.zeros((bsz, nh, dk, dv), jnp.float32)
    _, s_prev = lax.scan(step, s0, (jnp.moveaxis(jnp.exp(b_last), 2, 0), jnp.moveaxis(u, 2, 0)))
    s_prev = jnp.moveaxis(s_prev, 0, 2)
    o = o + jnp.einsum('bhncd,bhnde->bhnce', q * jnp.exp(b), s_prev)
    return o.reshape(bsz, nh, seq, dv)


def gla_mixer(q, k, v, g, zf, zb, w2f, b2f, w2b, b2b, gn):
    bsz, seq = q.shape[:2]
    f32 = jnp.float32

    def heads(t, d):
        return t.astype(f32).reshape(bsz, seq, B_HEADS, d).transpose(0, 2, 1, 3)

    qh = heads(q, B_KEY_DIM) * (B_KEY_DIM ** -0.5)
    kh = heads(k, B_KEY_DIM)
    vh = heads(v, B_VAL_DIM)
    la_f = heads(jax.nn.log_sigmoid(zf.astype(f32) @ w2f.astype(f32) + b2f.astype(f32)) / GATE_TAU, B_KEY_DIM)
    la_b = heads(jax.nn.log_sigmoid(zb.astype(f32) @ w2b.astype(f32) + b2b.astype(f32)) / GATE_TAU, B_KEY_DIM)
    o_f = gla_chunked(qh, kh, vh, la_f, True)
    flip = lambda t: jnp.flip(t, axis=2)
    o_b = flip(gla_chunked(flip(qh), flip(kh), flip(vh), flip(la_b), False))
    o = o_f + o_b
    o = o * lax.rsqrt(jnp.mean(jnp.square(o), axis=-1, keepdims=True) + EPS)
    o = o.transpose(0, 2, 1, 3).reshape(bsz, seq, B_V) * gn.astype(f32)
    return (o * jax.nn.silu(g.astype(f32))).astype(q.dtype)


def linear_scan(a, u, reverse):
    def combine(l, r):
        return (l[0] * r[0], r[0] * l[1] + r[1])
    _, h = lax.associative_scan(combine, (a, u), reverse=reverse, axis=1)
    return h


def rglru_mixer(xc, y, conv_w, conv_b, w_a, b_a, w_x, b_x, lam):
    bsz, seq, _ = xc.shape
    f32 = jnp.float32
    xp = jnp.pad(xc, ((0, 0), (CONV_LEFT, CONV_WIDTH - 1 - CONV_LEFT), (0, 0)))
    xconv = sum(xp[:, j:j + seq] * conv_w[j] for j in range(CONV_WIDTH)) + conv_b
    xf = xconv.astype(f32)
    xblk = xf.reshape(bsz, seq, C_BLOCKS, C_BLOCK_DIM)
    r = jax.nn.sigmoid(jnp.einsum('btgi,sgij->sbtgj', xblk, w_a.astype(f32)).reshape(2, bsz, seq, C_WIDTH)
                       + b_a.astype(f32)[:, None, None])
    i = jax.nn.sigmoid(jnp.einsum('btgi,sgij->sbtgj', xblk, w_x.astype(f32)).reshape(2, bsz, seq, C_WIDTH)
                       + b_x.astype(f32)[:, None, None])
    log_a = -LRU_C * r * jax.nn.softplus(-lam.astype(f32))[:, None, None]
    a = jnp.exp(log_a)
    u = jnp.sqrt(-jnp.expm1(2.0 * log_a)) * (i * xf[None])
    h = linear_scan(a[0], u[0], False) + linear_scan(a[1], u[1], True)
    return (h * jax.nn.gelu(y.astype(f32))).astype(xc.dtype)


def cross_attention(xn, memn, wq, wk, wv, wo):
    bsz, seq, _ = xn.shape
    mlen = memn.shape[1]
    q = (xn @ wq).reshape(bsz, seq, X_HEADS, X_HEAD_DIM)
    k = (memn @ wk).reshape(bsz, mlen, X_HEADS, X_HEAD_DIM)
    v = (memn @ wv).reshape(bsz, mlen, X_HEADS, X_HEAD_DIM)
    s = jnp.einsum('bthd,bmhd->bhtm', q, k).astype(jnp.float32) * (X_HEAD_DIM ** -0.5)
    p = jax.nn.softmax(s, axis=-1)
    o = jnp.einsum('bhtm,bmhd->bthd', p.astype(v.dtype), v).reshape(bsz, seq, D_MODEL)
    return o @ wo


def setup_inputs(seed: int = 0) -> dict:
    key = jax.random.key(seed)
    ks = jax.random.split(key, 32)
    f32 = jnp.float32
    L = DEPTH

    def nrm(k, shape, scale):
        return jax.random.normal(k, shape, f32) * scale

    def gain(k, shape):
        return 1.0 + 0.05 * jax.random.normal(k, shape, f32)

    a_init = jax.random.uniform(ks[17], (L, 2, C_WIDTH), f32, 0.9, 0.999) ** (1.0 / LRU_C)
    lru_lambda = jnp.log(a_init) - jnp.log1p(-a_init)
    return {
        'x': nrm(ks[0], (BATCH, SEQ, D_MODEL), 1.0),
        'mem': nrm(ks[1], (BATCH, MEM_LEN, D_MODEL), 1.0),
        'rel_bias': nrm(ks[2], (N_BUCKETS, A_HEADS), 0.5),
        'w_in': nrm(ks[3], (L, D_MODEL, D_IN), D_MODEL ** -0.5),
        'w_out': nrm(ks[4], (L, D_MIX, D_MODEL), D_MIX ** -0.5),
        'attn_sink': nrm(ks[5], (L, A_HEADS), 0.5),
        'gla_w2_f': nrm(ks[6], (L, GATE_RANK, B_QK), GATE_RANK ** -0.5),
        'gla_b2_f': nrm(ks[7], (L, B_QK), 0.1),
        'gla_w2_b': nrm(ks[8], (L, GATE_RANK, B_QK), GATE_RANK ** -0.5),
        'gla_b2_b': nrm(ks[9], (L, B_QK), 0.1),
        'gla_norm': gain(ks[10], (L, B_V)),
        'conv_w': nrm(ks[11], (L, CONV_WIDTH, C_WIDTH), CONV_WIDTH ** -0.5),
        'conv_b': nrm(ks[12], (L, C_WIDTH), 0.02),
        'lru_wa': nrm(ks[13], (L, 2, C_BLOCKS, C_BLOCK_DIM, C_BLOCK_DIM), C_BLOCK_DIM ** -0.5),
        'lru_ba': nrm(ks[14], (L, 2, C_WIDTH), 0.1),
        'lru_wx': nrm(ks[15], (L, 2, C_BLOCKS, C_BLOCK_DIM, C_BLOCK_DIM), C_BLOCK_DIM ** -0.5),
        'lru_bx': nrm(ks[16], (L, 2, C_WIDTH), 0.1),
        'lru_lambda': lru_lambda,
        'xq': nrm(ks[18], (L, D_MODEL, D_MODEL), D_MODEL ** -0.5),
        'xk': nrm(ks[19], (L, D_MODEL, D_MODEL), D_MODEL ** -0.5),
        'xv': nrm(ks[20], (L, D_MODEL, D_MODEL), D_MODEL ** -0.5),
        'xo': nrm(ks[21], (L, D_MODEL, D_MODEL), D_MODEL ** -0.5),
        'w_up': nrm(ks[22], (L, D_MODEL, D_FF), D_MODEL ** -0.5),
        'w_down': nrm(ks[23], (L, D_FF, D_MODEL), D_FF ** -0.5),
        'norm_mix_pre': gain(ks[24], (L, D_MODEL)),
        'norm_mix_post': gain(ks[25], (L, D_MODEL)),
        'norm_mem': gain(ks[26], (L, D_MODEL)),
        'norm_x_pre': gain(ks[27], (L, D_MODEL)),
        'norm_x_post': gain(ks[28], (L, D_MODEL)),
        'norm_ff_pre': gain(ks[29], (L, D_MODEL)),
        'norm_ff_post': gain(ks[30], (L, D_MODEL)),
    }


def reference(x, mem, rel_bias, w_in, w_out, attn_sink, gla_w2_f, gla_b2_f, gla_w2_b, gla_b2_b,
              gla_norm, conv_w, conv_b, lru_wa, lru_ba, lru_wx, lru_bx, lru_lambda,
              xq, xk, xv, xo, w_up, w_down, norm_mix_pre, norm_mix_post, norm_mem,
              norm_x_pre, norm_x_post, norm_ff_pre, norm_ff_post):
    bsz, seq, _ = x.shape
    offsets = np.cumsum(SPLIT_SIZES)[:-1].tolist()
    for l in range(DEPTH):
        h = rmsnorm(x, norm_mix_pre[l])
        aq, ak, av, bq, bk, bv, bg, zf, zb, cx, cy = jnp.split(h @ w_in[l], offsets, axis=-1)
        oa = windowed_gqa(aq.reshape(bsz, seq, A_HEADS, A_HEAD_DIM),
                          ak.reshape(bsz, seq, A_KV_HEADS, A_HEAD_DIM),
                          av.reshape(bsz, seq, A_KV_HEADS, A_HEAD_DIM),
                          rel_bias, attn_sink[l])
        ob = gla_mixer(bq, bk, bv, bg, zf, zb, gla_w2_f[l], gla_b2_f[l], gla_w2_b[l], gla_b2_b[l], gla_norm[l])
        oc = rglru_mixer(cx, cy, conv_w[l], conv_b[l], lru_wa[l], lru_ba[l], lru_wx[l], lru_bx[l], lru_lambda[l])
        mixed = jnp.concatenate([oa, ob.astype(oa.dtype), oc.astype(oa.dtype)], axis=-1) @ w_out[l]
        x = x + rmsnorm(mixed, norm_mix_post[l])
        h = rmsnorm(x, norm_x_pre[l])
        memn = rmsnorm(mem, norm_mem[l])
        x = x + rmsnorm(cross_attention(h, memn, xq[l], xk[l], xv[l], xo[l]), norm_x_post[l])
        h = rmsnorm(x, norm_ff_pre[l])
        ff = jnp.square(jax.nn.relu(h @ w_up[l])) @ w_down[l]
        x = x + rmsnorm(ff, norm_ff_post[l])
    return x
```

```cpp
#include <hip/hip_runtime.h>
#include <cstdint>
#include <cstdio>

namespace pg8 {
#define PG8_LAS __attribute__((address_space(3)))
typedef unsigned short bf16_t;
typedef short bf16x8 __attribute__((ext_vector_type(8)));
typedef float f32x4 __attribute__((ext_vector_type(4)));
typedef unsigned u32x4 __attribute__((ext_vector_type(4)));
constexpr int BM = 256, BK = 64, HALF = 128, HTB = HALF * BK * 2  , STAGE_BYTES = 8 * HTB, NXCD = 8, WGM = 8;

__host__ __device__ __forceinline__ int lds_byte(int r, int c) { const int st = (r >> 4) * 2 + (c >> 5), rr = r & 15, cc = c & 31, ob = rr * 64 + cc * 2; return st * 1024 + (ob ^ (((ob >> 9) & 1) << 5)); }
__host__ __device__ __forceinline__ void stage_rc(int b, int& R, int& C) { const int st = b / 1024, sb = b % 1024, swz = sb ^ (((sb >> 9) & 1) << 5); R = (st >> 1) * 16 + swz / 64; C = (st & 1) * 32 + (swz % 64) / 2; }
__host__ __device__ __forceinline__ int perm32(int rho) { const int n = rho >> 4, i = rho & 15; return 8 * (i >> 2) + 4 * n + (i & 3); }

struct Unit { int pm, pn, om, on, kind; };
struct Gemm { const bf16_t* A; const bf16_t* Bt; int M, N, K; };

struct StaticOrder {
    int nM, nN, nwg, G, c;
    __host__ __device__ void init(int M, int N, int G_, int c_) { nM = M / BM; nN = N / BM; nwg = nM * nN; G = G_; c = c_; }
    __host__ __device__ bool next(int i, Unit& u) const {
        const long L = (long)i * G + c; if (L >= nwg) return false;
        int wgid = (int)L; { const int q = nwg / NXCD, r = nwg % NXCD, xcd = wgid % NXCD, off = wgid / NXCD; wgid = (xcd < r ? xcd * (q + 1) : r * (q + 1) + (xcd - r) * q) + off; }
        const int nig = WGM * nN, gid = wgid / nig, fm = gid * WGM, gsz = (nM - fm) < WGM ? (nM - fm) : WGM;
        u.pm = fm + ((wgid % nig) % gsz); u.pn = (wgid % nig) / gsz; u.om = u.pm; u.on = u.pn; u.kind = 0; return true;
    }
    __device__ __forceinline__ void a_ready(const Unit&) const {}
    __device__ __forceinline__ void done(const Unit&) const {}
};
struct KvOrder {
    int G, c, NL, l0, memn_p0, memn_ps, xk_p0, xv_p0, w_ps;
    __host__ __device__ bool next(int i, Unit& u) const {
        const long L = (long)i * G + c; if (L >= (long)NL * 64) return false;
        const int l = (int)L / 64, r = (int)L % 64;
        if (r < 32) { const int pm = r & 3, pn = r >> 2; u.kind = 0; u.pm = memn_p0 + l * memn_ps + pm; u.pn = xk_p0 + l * w_ps + pn; u.om = (l0 + l) * 4 + pm; u.on = pn; }
        else { const int q = r - 32, pm = q & 7, pn = q >> 3; u.kind = 1; u.pm = xv_p0 + l * w_ps + pm; u.pn = memn_p0 + l * memn_ps + pn; u.om = (l0 + l) * 8 + pm; u.on = pn; }
        return true;
    }
    __device__ __forceinline__ void a_ready(const Unit&) const {}
    __device__ __forceinline__ void done(const Unit&) const {}
};

__device__ __forceinline__ unsigned cvt_pk_bf16(float lo, float hi) { unsigned r; asm volatile("v_cvt_pk_bf16_f32 %0, %1, %2" : "=v"(r) : "v"(lo), "v"(hi)); return r; }

template <int ACT  > struct EpiBf16 {
    static constexpr bool PERM = true, AFTER_DRAIN = false;
    bf16_t* O; int ldc; bf16_t* O1; int ldc1;
    __device__ __forceinline__ void operator()(const f32x4 (&acc)[2][2][4][2], const Unit& u, int wr, int wc, int fr, int fq) const {
        bf16_t* base = u.kind ? O1 : O; const int ld = u.kind ? ldc1 : ldc;
        const int row0 = u.om * BM + wr * 64 + fr, col0 = u.on * BM + wc * 32 + 8 * fq;
#pragma unroll
        for (int ai = 0; ai < 2; ++ai)
#pragma unroll
            for (int m = 0; m < 4; ++m) { bf16_t* rowp = base + (size_t)(row0 + ai * HALF + m * 16) * ld + col0;
#pragma unroll
                for (int bj = 0; bj < 2; ++bj) { f32x4 v0 = acc[ai][bj][m][0], v1 = acc[ai][bj][m][1];
                    if (ACT == 1) {
#pragma unroll
                        for (int j = 0; j < 4; ++j) { const float a = fmaxf(v0[j], 0.f), b = fmaxf(v1[j], 0.f); v0[j] = a * a; v1[j] = b * b; } }
                    u32x4 w; w.x = cvt_pk_bf16(v0[0], v0[1]); w.y = cvt_pk_bf16(v0[2], v0[3]); w.z = cvt_pk_bf16(v1[0], v1[1]); w.w = cvt_pk_bf16(v1[2], v1[3]);
                    *(u32x4*)(rowp + bj * HALF) = w; } }
    }
};
struct EpiF32 {
    static constexpr bool PERM = false, AFTER_DRAIN = false;
    float* C; int ldc;
    __device__ __forceinline__ void operator()(const f32x4 (&acc)[2][2][4][2], const Unit& u, int wr, int wc, int fr, int fq) const {
        const int row0 = u.om * BM + wr * 64 + fr, col0 = u.on * BM + wc * 32 + 4 * fq;
#pragma unroll
        for (int ai = 0; ai < 2; ++ai)
#pragma unroll
            for (int m = 0; m < 4; ++m) { float* rowp = C + (size_t)(row0 + ai * HALF + m * 16) * ldc + col0;
#pragma unroll
                for (int bj = 0; bj < 2; ++bj)
#pragma unroll
                    for (int n = 0; n < 2; ++n) *(f32x4*)(rowp + bj * HALF + n * 16) = acc[ai][bj][m][n]; }
    }
};

template <class Epi, class Sched, bool ALIGN_EPI = false, bool SP2 = false>
__device__ __forceinline__ void gemm_phase(PG8_LAS unsigned char* lds, const Gemm g, const Sched& S, const Epi& E) {
    int tid_ = threadIdx.x; asm volatile("" : "+v"(tid_));
    const int tid = tid_, wid = __builtin_amdgcn_readfirstlane(tid >> 6), lane = tid & 63, wr = wid >> 2, wc = wid & 3, fr = lane & 15, fq = lane >> 4;
    const int K = g.K, nt = K / BK;
    unsigned voffA[2], voffB[2];
#pragma unroll
    for (int i = 0; i < 2; ++i) { int R, C; stage_rc(tid * 16 + i * 8192, R, C); const int Rb = Epi::PERM ? ((R & ~31) + perm32(R & 31)) : R;
        voffA[i] = (unsigned)(R * K + C) * 2u; voffB[i] = (unsigned)(Rb * K + C) * 2u; }
    const size_t kstep = (size_t)(BK * 2);
    const size_t hstep = (size_t)HALF * K * 2;
    const size_t tstep = 2 * hstep;
    const unsigned ldsw = (unsigned)wid * 1024u;
    const int aoff = lds_byte(wr * 64 + fr, fq * 8), boff = lds_byte(wc * 32 + fr, fq * 8);
#define PG8_SA(b, h) (((b) * 2 + (h)) * HTB)
#define PG8_SB(b, h) ((4 + (b) * 2 + (h)) * HTB)
#define PG8_STAGE(bufoff, gbase, voff) do { _Pragma("unroll") for (int _i = 0; _i < 2; ++_i) \
        __builtin_amdgcn_global_load_lds((const unsigned*)((const char*)(gbase) + (voff)[_i]), (PG8_LAS unsigned*)(lds + (bufoff) + ldsw + _i * 8192), 16, 0, 0); } while (0)
#define PG8_LDA(dst, b, h) do { _Pragma("unroll") for (int m = 0; m < 4; ++m) _Pragma("unroll") for (int k = 0; k < 2; ++k) dst[m][k] = *(const PG8_LAS bf16x8*)(lds + PG8_SA(b, h) + aoff + m * 2048 + k * 1024); } while (0)
#define PG8_LDB(dst, b, h) do { _Pragma("unroll") for (int n = 0; n < 2; ++n) _Pragma("unroll") for (int k = 0; k < 2; ++k) dst[n][k] = *(const PG8_LAS bf16x8*)(lds + PG8_SB(b, h) + boff + n * 2048 + k * 1024); } while (0)
#define PG8_MMA(ai, bj, At, Bt) do { __builtin_amdgcn_s_setprio(1); _Pragma("unroll") for (int m = 0; m < 4; ++m) _Pragma("unroll") for (int n = 0; n < 2; ++n) _Pragma("unroll") for (int k = 0; k < 2; ++k) \
        acc[ai][bj][m][n] = __builtin_amdgcn_mfma_f32_16x16x32_bf16(Bt[n][k], At[m][k], acc[ai][bj][m][n], 0, 0, 0); __builtin_amdgcn_s_setprio(0); } while (0)
#define PG8_WAIT_V(n) asm volatile("s_waitcnt vmcnt(" #n ")" ::: "memory")
#define PG8_WAIT_L(n) asm volatile("s_waitcnt lgkmcnt(" #n ")" ::: "memory")
#define PG8_BAR __builtin_amdgcn_s_barrier()
#define PG8_SCHED __builtin_amdgcn_sched_barrier(0)
    Unit cur, nxt; int ui = 0;
    if (!S.next(0, cur)) return;
    f32x4 acc[2][2][4][2];
#pragma unroll
    for (int a = 0; a < 2; ++a)
#pragma unroll
        for (int b = 0; b < 2; ++b)
#pragma unroll
            for (int m = 0; m < 4; ++m)
#pragma unroll
                for (int n = 0; n < 2; ++n) acc[a][b][m][n] = (f32x4){0.f, 0.f, 0.f, 0.f};
    bf16x8 At[4][2], B0[2][2], B1[2][2];
    const char* cA = (const char*)g.A + (size_t)cur.pm * tstep; const char* cB = (const char*)g.Bt + (size_t)cur.pn * tstep;
    S.a_ready(cur);
    if constexpr (SP2) {
        PG8_STAGE(PG8_SB(0, 0), cB, voffB); PG8_STAGE(PG8_SB(0, 1), cB + hstep, voffB); PG8_STAGE(PG8_SA(0, 0), cA, voffA); PG8_STAGE(PG8_SA(0, 1), cA + hstep, voffA);
        if (wr == 1) PG8_BAR;
        PG8_WAIT_V(2); PG8_BAR;
        PG8_STAGE(PG8_SB(1, 0), cB + kstep, voffB); PG8_STAGE(PG8_SA(1, 0), cA + kstep, voffA); PG8_STAGE(PG8_SB(1, 1), cB + hstep + kstep, voffB);
        PG8_WAIT_V(6); PG8_BAR;
    } else {
        PG8_STAGE(PG8_SB(0, 0), cB, voffB); PG8_STAGE(PG8_SA(0, 0), cA, voffA); PG8_STAGE(PG8_SB(0, 1), cB + hstep, voffB); PG8_STAGE(PG8_SA(0, 1), cA + hstep, voffA);
        if (wr == 1) PG8_BAR;
        PG8_WAIT_V(4); PG8_BAR;
        PG8_STAGE(PG8_SB(1, 0), cB + kstep, voffB); PG8_STAGE(PG8_SA(1, 0), cA + kstep, voffA); PG8_STAGE(PG8_SB(1, 1), cB + hstep + kstep, voffB);
        PG8_WAIT_V(6); PG8_BAR;
    }
    for (;;) {
        const bool has_next = S.next(ui + 1, nxt);
        const char* nA = has_next ? (const char*)g.A + (size_t)nxt.pm * tstep : cA; const char* nB = has_next ? (const char*)g.Bt + (size_t)nxt.pn * tstep : cB;
        for (int t = 0; t < nt; t += 2) {
            const bool last = (t == nt - 2);
            const char* a1 = cA + (size_t)(t + 1) * kstep;
            const char* a2 = last ? nA : cA + (size_t)(t + 2) * kstep; const char* b2 = last ? nB : cB + (size_t)(t + 2) * kstep;
            const char* a3 = a2 + kstep; const char* b3 = b2 + kstep;
            if (last && has_next) S.a_ready(nxt);
            if constexpr (SP2) {
            PG8_LDB(B0, 0, 0); PG8_LDB(B1, 0, 1); PG8_SCHED; PG8_LDA(At, 0, 0); PG8_STAGE(PG8_SA(1, 1), a1 + hstep, voffA);
            PG8_WAIT_V(8); PG8_WAIT_L(0); PG8_BAR; PG8_MMA(0, 0, At, B0); PG8_MMA(0, 1, At, B1); PG8_BAR; PG8_SCHED;
            PG8_LDA(At, 0, 1); PG8_STAGE(PG8_SB(0, 0), b2, voffB); PG8_STAGE(PG8_SB(0, 1), b2 + hstep, voffB); PG8_STAGE(PG8_SA(0, 0), a2, voffA);
            PG8_WAIT_V(8); PG8_WAIT_L(0); PG8_BAR; PG8_MMA(1, 0, At, B0); PG8_MMA(1, 1, At, B1); PG8_BAR; PG8_SCHED;
            PG8_LDB(B0, 1, 0); PG8_LDB(B1, 1, 1); PG8_SCHED; PG8_LDA(At, 1, 0); PG8_STAGE(PG8_SA(0, 1), a2 + hstep, voffA);
            PG8_WAIT_V(8); PG8_WAIT_L(0); PG8_BAR; PG8_MMA(0, 0, At, B0); PG8_MMA(0, 1, At, B1); PG8_BAR; PG8_SCHED;
            PG8_LDA(At, 1, 1); PG8_STAGE(PG8_SB(1, 0), b3, voffB); PG8_STAGE(PG8_SB(1, 1), b3 + hstep, voffB); PG8_STAGE(PG8_SA(1, 0), a3, voffA);
            PG8_WAIT_V(8); PG8_WAIT_L(0); PG8_BAR; PG8_MMA(1, 0, At, B0); PG8_MMA(1, 1, At, B1); PG8_BAR; PG8_SCHED;
            } else {
            PG8_LDB(B0, 0, 0); PG8_SCHED; PG8_LDA(At, 0, 0); PG8_STAGE(PG8_SA(1, 1), a1 + hstep, voffA);
            PG8_WAIT_L(8); PG8_BAR; PG8_WAIT_L(0); PG8_MMA(0, 0, At, B0); PG8_BAR; PG8_SCHED;
            PG8_LDB(B1, 0, 1); PG8_STAGE(PG8_SB(0, 0), b2, voffB);
            PG8_BAR; PG8_WAIT_L(0); PG8_MMA(0, 1, At, B1); PG8_BAR;
            PG8_LDA(At, 0, 1); PG8_STAGE(PG8_SA(0, 0), a2, voffA);
            PG8_BAR; PG8_WAIT_L(0); PG8_MMA(1, 0, At, B0); PG8_BAR; PG8_SCHED;
            PG8_STAGE(PG8_SB(0, 1), b2 + hstep, voffB);
            PG8_WAIT_V(6); PG8_BAR; PG8_MMA(1, 1, At, B1); PG8_BAR;
            PG8_LDB(B0, 1, 0); PG8_SCHED; PG8_LDA(At, 1, 0); PG8_STAGE(PG8_SA(0, 1), a2 + hstep, voffA);
            PG8_WAIT_L(8); PG8_BAR; PG8_WAIT_L(0); PG8_MMA(0, 0, At, B0); PG8_BAR; PG8_SCHED;
            PG8_LDB(B1, 1, 1); PG8_STAGE(PG8_SB(1, 0), b3, voffB);
            PG8_BAR; PG8_WAIT_L(0); PG8_MMA(0, 1, At, B1); PG8_BAR;
            PG8_LDA(At, 1, 1); PG8_STAGE(PG8_SA(1, 0), a3, voffA);
            PG8_BAR; PG8_WAIT_L(0); PG8_MMA(1, 0, At, B0); PG8_BAR; PG8_SCHED;
            PG8_STAGE(PG8_SB(1, 1), b3 + hstep, voffB);
            PG8_WAIT_V(6); PG8_BAR; PG8_MMA(1, 1, At, B1); PG8_BAR;
            }
        }
        if constexpr (ALIGN_EPI) { if (wr == 0) PG8_BAR; }
        if constexpr (!Epi::AFTER_DRAIN) { E(acc, cur, wr, wc, fr, fq); S.done(cur); }
        if (!has_next) break;
#pragma unroll
        for (int a = 0; a < 2; ++a)
#pragma unroll
            for (int b = 0; b < 2; ++b)
#pragma unroll
                for (int m = 0; m < 4; ++m)
#pragma unroll
                    for (int n = 0; n < 2; ++n) acc[a][b][m][n] = (f32x4){0.f, 0.f, 0.f, 0.f};
        cur = nxt; cA = nA; cB = nB; ++ui;
        if constexpr (ALIGN_EPI) { if (wr == 1) PG8_BAR; }
    }
    PG8_WAIT_V(0);
    if constexpr (!ALIGN_EPI) { if (wr == 0) PG8_BAR; }
    PG8_BAR;
    if constexpr (Epi::AFTER_DRAIN) { E.fused(acc, cur, wr, wc, fr, fq, lds, wid, lane); S.done(cur); }
#undef PG8_SA
#undef PG8_SB
#undef PG8_STAGE
#undef PG8_LDA
#undef PG8_LDB
#undef PG8_MMA
#undef PG8_WAIT_V
#undef PG8_WAIT_L
#undef PG8_BAR
#undef PG8_SCHED
}
}

constexpr int D = 2048, BATCH = 4, SEQ = 2048, DEPTH = 4, M = BATCH * SEQ, MEM_LEN = 256, MM = BATCH * MEM_LEN;
constexpr int DIN = 4128, DFF = 8192;
constexpr int O_AQ = 0, O_AK = 1024, O_AV = 1280, O_BQ = 1536, O_BK = 1792, O_BV = 2048, O_BG = 2560, O_ZF = 3072, O_ZB = 3088, O_CX = 3104, O_CY = 3616;
constexpr int NPB = 4096;
constexpr int PB_CX = 3072, PB_CY = 3584;
constexpr float EPS = 1e-6f;
constexpr int NWAVES = 8, NTHREADS = 512;

#ifndef NWL
#define NWL 1
#endif
constexpr size_t MiB = 1u << 20;
constexpr size_t WS_CTL = 0, CTL_ZERO_BYTES = 1 * MiB;
constexpr size_t WS_W = 1 * MiB, WL_BYTES = 121 * MiB;
constexpr size_t WL_IN = 0, WL_OUT = 16 * MiB, WL_XQ = 24 * MiB, WL_XK = 32 * MiB, WL_XV = 40 * MiB, WL_XO = 48 * MiB, WL_UP = 56 * MiB, WL_DOWN = 88 * MiB, WL_Z = 120 * MiB, WL_LRUG = 120 * MiB + 256 * 1024;
constexpr size_t WS_XN = WS_W + NWL * WL_BYTES;
constexpr size_t WS_MEMN = WS_XN + 32 * MiB;
constexpr size_t WS_KX = WS_MEMN + 16 * MiB;
constexpr size_t WS_VT = WS_KX + 16 * MiB;
constexpr size_t WS_Y = WS_VT + 16 * MiB;
constexpr size_t WS_Z = WS_Y + 64 * MiB;
constexpr size_t WS_BIG = WS_Z + 1 * MiB;
constexpr size_t WS_PB = WS_BIG;
constexpr size_t WS_MIX = WS_BIG + 64 * MiB;
constexpr size_t WS_GLAU = WS_BIG + 96 * MiB;
constexpr size_t WS_MISC = WS_BIG + 128 * MiB;
constexpr size_t WS_H = WS_BIG;
constexpr size_t WS_Q = WS_BIG, WS_O = WS_BIG + 32 * MiB;
constexpr size_t WS_END = WS_BIG + 136 * MiB;
constexpr int CW_TMO = 0, CW_BAR = 4096;

constexpr int RING_OFF = 0, RING_BYTES = 131072, SCR_BYTES = 143360;
constexpr int LDSCTL_OFF = SCR_BYTES, MISC_OFF = LDSCTL_OFF + 320;
constexpr int LDS_BYTES = 147456;

#define GAS __attribute__((address_space(1)))
#define LAS __attribute__((address_space(3)))
typedef unsigned short bf16;
typedef unsigned v4u __attribute__((ext_vector_type(4)));
typedef unsigned v2u __attribute__((ext_vector_type(2)));
typedef float f32x4 __attribute__((ext_vector_type(4)));
typedef short bf16x8 __attribute__((ext_vector_type(8)));
typedef short s16x4 __attribute__((ext_vector_type(4)));
#define LDS_WAIT() asm volatile("s_waitcnt lgkmcnt(0)" ::: "memory")
#define VM_WAIT() asm volatile("s_waitcnt vmcnt(0)" ::: "memory")
__device__ __forceinline__ unsigned f2bf(float f) { unsigned u = __builtin_bit_cast(unsigned, f); return (u + 0x7fffu + ((u >> 16) & 1u)) >> 16; }
__device__ __forceinline__ unsigned pk2(float lo, float hi) { return f2bf(lo) | (f2bf(hi) << 16); }
__device__ __forceinline__ float bf2f(unsigned short b) { return __builtin_bit_cast(float, (unsigned)b << 16); }
__device__ __forceinline__ float wave_sum(float v) {
#pragma unroll
    for (int o = 1; o < 64; o <<= 1) v += __shfl_xor(v, o);
    return v;
}
__device__ __forceinline__ float wave_max(float v) {
#pragma unroll
    for (int o = 1; o < 64; o <<= 1) v = fmaxf(v, __shfl_xor(v, o));
    return v;
}
__device__ __forceinline__ float sigmoidf_(float x) { return 1.f / (1.f + expf(-x)); }
__device__ __forceinline__ float softplusf_(float x) { return fmaxf(x, 0.f) + log1pf(expf(-fabsf(x))); }
__device__ __forceinline__ float gelu_tanh(float x) { return 0.5f * x * (1.f + tanhf(0.7978845608028654f * (x + 0.044715f * x * x * x))); }
__device__ __forceinline__ int t5_bucket(int rel) {
    const int ret = rel > 0 ? 16 : 0; const int n = rel < 0 ? -rel : rel;
    if (n < 8) return ret + n;
    int k = 0; while (k < 7 && (64 << (k + 1)) <= n * n) ++k;
    return ret + 8 + k;
}

struct Frame {
    LAS unsigned char* lds;
    int tid, lane, wave, G, bx;
};

__device__ __forceinline__ void p0_transpose_item(const float* W, int K, int N, int c0, bf16* WT, int r0, int nblk, LAS float* scr, int item, int lane) {
    const int kb = item / nblk, nb = item % nblk, k0 = 64 * kb, n0 = 32 * nb;
#pragma unroll 8
    for (int i = 0; i < 32; ++i) { const int kk = 2 * i + (lane >> 5); scr[kk * 33 + (lane & 31)] = W[(size_t)(k0 + kk) * N + c0 + n0 + (lane & 31)]; }
    LDS_WAIT(); asm volatile("" ::: "memory");
    const int c = lane & 7;
#pragma unroll
    for (int j = 0; j < 4; ++j) { const int n = (lane >> 3) + 8 * j; const LAS float* s = scr + (8 * c) * 33 + n;
        v4u o; o.x = pk2(s[0 * 33], s[1 * 33]); o.y = pk2(s[2 * 33], s[3 * 33]); o.z = pk2(s[4 * 33], s[5 * 33]); o.w = pk2(s[6 * 33], s[7 * 33]);
        *(GAS v4u*)(WT + (size_t)(r0 + n0 + n) * K + k0 + 8 * c) = o; }
    LDS_WAIT(); asm volatile("" ::: "memory");
}
struct ConvSeg { const float* W; int K, N, c0, ncols; bf16* WT; int r0; };
__device__ __forceinline__ int seg_items(const ConvSeg& s) { return (s.K / 64) * (s.ncols / 32); }

__device__ __forceinline__ void norm_row(int lane, const float* src, const float* g, bf16* xn, float* copy_dst) {
    const GAS f32x4* xr = (const GAS f32x4*)src + lane; const GAS f32x4* gr = (const GAS f32x4*)g + lane;
    f32x4 v[8]; float s = 0.f;
#pragma unroll
    for (int j = 0; j < 8; ++j) { v[j] = xr[64 * j]; s += (v[j].x * v[j].x + v[j].y * v[j].y) + (v[j].z * v[j].z + v[j].w * v[j].w); }
    const float r = rsqrtf(wave_sum(s) * (1.f / D) + EPS);
    GAS v2u* o8 = (GAS v2u*)xn + lane;
#pragma unroll
    for (int j = 0; j < 8; ++j) { const f32x4 gg = gr[64 * j]; v2u w; w.x = pk2(v[j].x * r * gg.x, v[j].y * r * gg.y); w.y = pk2(v[j].z * r * gg.z, v[j].w * r * gg.w); o8[64 * j] = w;
        if (copy_dst) ((GAS f32x4*)copy_dst + lane)[64 * j] = v[j]; }
}
__device__ __forceinline__ void resid_norm_row(int lane, float* x, const float* y, const float* g1, const float* g2, bf16* xn) {
    const GAS f32x4* yr = (const GAS f32x4*)y + lane; GAS f32x4* xr = (GAS f32x4*)x + lane;
    const GAS f32x4* g1r = (const GAS f32x4*)g1 + lane;
    f32x4 v[8]; float s = 0.f;
#pragma unroll
    for (int j = 0; j < 8; ++j) { v[j] = yr[64 * j]; s += (v[j].x * v[j].x + v[j].y * v[j].y) + (v[j].z * v[j].z + v[j].w * v[j].w); }
    const float r = rsqrtf(wave_sum(s) * (1.f / D) + EPS);
    float s2 = 0.f;
#pragma unroll
    for (int j = 0; j < 8; ++j) { const f32x4 gg = g1r[64 * j]; const f32x4 xo = xr[64 * j];
        v[j].x = xo.x + v[j].x * r * gg.x; v[j].y = xo.y + v[j].y * r * gg.y; v[j].z = xo.z + v[j].z * r * gg.z; v[j].w = xo.w + v[j].w * r * gg.w;
        xr[64 * j] = v[j]; s2 += (v[j].x * v[j].x + v[j].y * v[j].y) + (v[j].z * v[j].z + v[j].w * v[j].w); }
    if (g2) {
        const float r2 = rsqrtf(wave_sum(s2) * (1.f / D) + EPS);
        const GAS f32x4* g2r = (const GAS f32x4*)g2 + lane; GAS v2u* o8 = (GAS v2u*)xn + lane;
#pragma unroll
        for (int j = 0; j < 8; ++j) { const f32x4 gg = g2r[64 * j]; v2u w; w.x = pk2(v[j].x * r2 * gg.x, v[j].y * r2 * gg.y); w.y = pk2(v[j].z * r2 * gg.z, v[j].w * r2 * gg.w); o8[64 * j] = w; }
    }
}
__device__ __forceinline__ void zgemm(const Frame& F, const bf16* XN, const bf16* WZ, float* Z) {
    const int lane = F.lane, g = lane >> 4, c = lane & 15;
    for (int tile = F.wave * F.G + F.bx; tile < (M / 16) * 2; tile += NWAVES * F.G) {
        const int rt = tile >> 1, ct = tile & 1;
        const bf16* ap = XN + (size_t)(rt * 16 + c) * D + g * 8;
        const bf16* bp = WZ + (size_t)(ct * 16 + c) * D + g * 8;
        f32x4 acc = {0.f, 0.f, 0.f, 0.f};
#pragma unroll 8
        for (int ks = 0; ks < D / 32; ++ks) { const bf16x8 a = *(const GAS bf16x8*)(ap + ks * 32); const bf16x8 b = *(const GAS bf16x8*)(bp + ks * 32); acc = __builtin_amdgcn_mfma_f32_16x16x32_bf16(a, b, acc, 0, 0, 0); }
#pragma unroll
        for (int r = 0; r < 4; ++r) Z[(size_t)(rt * 16 + 4 * g + r) * 32 + ct * 16 + c] = acc[r];
    }
}

constexpr size_t MISC_DEC = 3 * MiB;
constexpr int GL_Z = 0, GL_TF = 8192, GL_TB = 10240, GL_VI = 12288, GL_A = 29696, GL_B = 38912, GL_P = 48128, GL_SI = 57344, GL_OF = 74752;
__device__ __forceinline__ bf16x8 tr_frag(LAS unsigned char* p, int stride4) {
    const s16x4 lo = __builtin_amdgcn_ds_read_tr16_b64_v4i16((LAS s16x4*)p);
    const s16x4 hi = __builtin_amdgcn_ds_read_tr16_b64_v4i16((LAS s16x4*)(p + stride4));
    return __builtin_shufflevector(lo, hi, 0, 1, 2, 3, 4, 5, 6, 7);
}
__device__ __forceinline__ void gla_gates(const Frame& F, const float* __restrict__ Zrow, const float* __restrict__ w2f, const float* __restrict__ b2f, const float* __restrict__ w2b, const float* __restrict__ b2b,
                                          int h, float (&cf)[8], float (&cb)[8], float& totf, float& totb) {
    LAS float* ZS = (LAS float*)(F.lds + GL_Z); LAS float* TF = (LAS float*)(F.lds + GL_TF); LAS float* TB = (LAS float*)(F.lds + GL_TB);
    const int tid = F.tid, k = tid & 63, tg = F.wave;
    ((LAS f32x4*)ZS)[tid] = ((const GAS f32x4*)Zrow)[tid];
    float wf[16], wb[16];
#pragma unroll
    for (int r = 0; r < 16; ++r) { wf[r] = w2f[r * 256 + h * 64 + k]; wb[r] = w2b[r * 256 + h * 64 + k]; }
    const float bfv = b2f[h * 64 + k], bbv = b2b[h * 64 + k];
    __syncthreads();
#pragma unroll
    for (int i = 0; i < 8; ++i) { const int t = tg * 8 + i; float af = bfv, ab = bbv;
#pragma unroll
        for (int r = 0; r < 16; ++r) { af += ZS[t * 32 + r] * wf[r]; ab += ZS[t * 32 + 16 + r] * wb[r]; }
        cf[i] = -softplusf_(-af) * 0.0625f; cb[i] = -softplusf_(-ab) * 0.0625f; }
#pragma unroll
    for (int i = 1; i < 8; ++i) cf[i] += cf[i - 1];
#pragma unroll
    for (int i = 6; i >= 0; --i) cb[i] += cb[i + 1];
    TF[tg * 64 + k] = cf[7]; TB[tg * 64 + k] = cb[0];
    __syncthreads();
    float ef = 0.f, eb = 0.f; totf = 0.f; totb = 0.f;
#pragma unroll
    for (int g2 = 0; g2 < 8; ++g2) { const float a = TF[g2 * 64 + k], bq = TB[g2 * 64 + k]; totf += a; totb += bq; ef += (g2 < tg) ? a : 0.f; eb += (g2 > tg) ? bq : 0.f; }
#pragma unroll
    for (int i = 0; i < 8; ++i) { cf[i] += ef; cb[i] += eb; }
}
__device__ __forceinline__ void gla_stage_v(const Frame& F, const bf16* __restrict__ PB, size_t m0, int h) {
    LAS unsigned char* VI = F.lds + GL_VI;
#pragma unroll
    for (int i = 0; i < 2; ++i) { const int ch = F.tid + NTHREADS * i, row = ch >> 4, col = ch & 15;
        *(LAS v4u*)(VI + row * 272 + col * 16) = *(const GAS v4u*)(PB + (m0 + row) * NPB + O_BV + h * 128 + col * 8); }
}
__device__ __forceinline__ void gla_u_phase(const Frame& F, const bf16* __restrict__ PB, const float* __restrict__ Z, const float* __restrict__ w2f, const float* __restrict__ b2f,
                                            const float* __restrict__ w2b, const float* __restrict__ b2b, float* __restrict__ U, float* __restrict__ DEC) {
    const int tid = F.tid, lane = F.lane, g = lane >> 4, c = lane & 15, w = F.wave, k = tid & 63, tg = F.wave;
    LAS unsigned char* VI = F.lds + GL_VI;
    for (int unit = F.bx; unit < BATCH * 4 * 32; unit += F.G) {
        const int b = unit >> 7, h = (unit >> 5) & 3, n = unit & 31;
        const size_t m0 = (size_t)b * SEQ + n * 64;
        __syncthreads();
        float cf[8], cb[8], totf, totb;
        gla_gates(F, Z + m0 * 32, w2f, b2f, w2b, b2b, h, cf, cb, totf, totb);
#pragma unroll
        for (int i = 0; i < 8; ++i) { const int t = tg * 8 + i; const float kk = bf2f(PB[(m0 + t) * NPB + O_BK + h * 64 + k]);
            *(LAS unsigned short*)(F.lds + GL_A + t * 144 + k * 2) = (unsigned short)f2bf(kk * __expf(totf - cf[i]));
            *(LAS unsigned short*)(F.lds + GL_B + t * 144 + k * 2) = (unsigned short)f2bf(kk * __expf(totb - cb[i])); }
        const size_t ub = (size_t)(b * 4 + h) * 32 + n;
        if (tg == 0) { DEC[ub * 64 + k] = __expf(totf); DEC[(ub + 512) * 64 + k] = __expf(totb); }
        gla_stage_v(F, PB, m0, h);
        __syncthreads();
        bf16x8 vf[2];
#pragma unroll
        for (int ts = 0; ts < 2; ++ts) vf[ts] = tr_frag(VI + (32 * ts + 8 * g + (c >> 2)) * 272 + (16 * w + 4 * (c & 3)) * 2, 4 * 272);
#pragma unroll
        for (int d = 0; d < 2; ++d) {
            LAS unsigned char* KS = F.lds + (d ? GL_B : GL_A);
            float* Ud = U + (ub + (size_t)d * 512) * 8192;
#pragma unroll
            for (int kt = 0; kt < 4; ++kt) {
                f32x4 acc = {0.f, 0.f, 0.f, 0.f};
#pragma unroll
                for (int ts = 0; ts < 2; ++ts) { const bf16x8 af = tr_frag(KS + (32 * ts + 8 * g + (c >> 2)) * 144 + (16 * kt + 4 * (c & 3)) * 2, 4 * 144);
                    acc = __builtin_amdgcn_mfma_f32_16x16x32_bf16(af, vf[ts], acc, 0, 0, 0); }
#pragma unroll
                for (int r = 0; r < 4; ++r) Ud[(16 * kt + 4 * g + r) * 128 + 16 * w + c] = acc[r];
            }
        }
    }
}
__device__ __forceinline__ void gla_state_phase(const Frame& F, float* __restrict__ U, const float* __restrict__ DEC) {
    const int id = F.bx * NTHREADS + F.tid;
    if (id < 32 * 64 * 32) {
        const int seq = id >> 11, k = (id >> 5) & 63, e4 = id & 31, d = seq >> 4;
        const int bh = seq & 15;
        f32x4 S = {0.f, 0.f, 0.f, 0.f};
#pragma unroll 4
        for (int st = 0; st < 32; ++st) { const int n = d ? 31 - st : st; const size_t idx = (size_t)d * 512 + bh * 32 + n;
            GAS f32x4* p = (GAS f32x4*)(U + idx * 8192 + k * 128) + e4; const float dec = DEC[idx * 64 + k];
            const f32x4 u = *p; *p = S; S = S * dec + u; }
    }
}
__device__ __forceinline__ void gla_o_phase(const Frame& F, const bf16* __restrict__ PB, const float* __restrict__ Z, const float* __restrict__ w2f, const float* __restrict__ b2f,
                                            const float* __restrict__ w2b, const float* __restrict__ b2b, const float* __restrict__ U, const float* __restrict__ gn, bf16* __restrict__ MIX) {
    const int tid = F.tid, lane = F.lane, g = lane >> 4, c = lane & 15, w = F.wave, k = tid & 63, tg = F.wave;
    LAS unsigned char* VI = F.lds + GL_VI; LAS unsigned char* QI = F.lds + GL_A; LAS unsigned char* KI = F.lds + GL_B; LAS unsigned char* PI = F.lds + GL_P; LAS unsigned char* SI = F.lds + GL_SI;
    LAS float* OF = (LAS float*)(F.lds + GL_OF);
    for (int unit = F.bx; unit < BATCH * 4 * 32; unit += F.G) {
        const int b = unit >> 7, h = (unit >> 5) & 3, n = unit & 31;
        const size_t m0 = (size_t)b * SEQ + n * 64;
        __syncthreads();
        float cf[8], cb[8], totf, totb;
        gla_gates(F, Z + m0 * 32, w2f, b2f, w2b, b2b, h, cf, cb, totf, totb);
        float qv[8], kv[8];
#pragma unroll
        for (int i = 0; i < 8; ++i) { const int t = tg * 8 + i; qv[i] = bf2f(PB[(m0 + t) * NPB + O_BQ + h * 64 + k]) * 0.125f; kv[i] = bf2f(PB[(m0 + t) * NPB + O_BK + h * 64 + k]); }
        gla_stage_v(F, PB, m0, h);
        const size_t ub = (size_t)(b * 4 + h) * 32 + n;
        f32x4 acc[4];
#pragma unroll
        for (int tt = 0; tt < 4; ++tt) acc[tt] = (f32x4){0.f, 0.f, 0.f, 0.f};
#pragma unroll
        for (int d = 0; d < 2; ++d) {
            __syncthreads();
#pragma unroll
            for (int i = 0; i < 8; ++i) { const int t = tg * 8 + i; const float cc = d ? cb[i] : cf[i];
                *(LAS unsigned short*)(QI + t * 144 + k * 2) = (unsigned short)f2bf(qv[i] * __expf(cc));
                *(LAS unsigned short*)(KI + t * 144 + k * 2) = (unsigned short)f2bf(kv[i] * __expf(-cc)); }
            {   const float* Sd = U + (ub + (size_t)d * 512) * 8192; const int row = tid >> 3, c16 = (tid & 7) * 16;
                const GAS f32x4* sp = (const GAS f32x4*)(Sd + row * 128 + c16);
                const f32x4 s0 = sp[0], s1 = sp[1], s2 = sp[2], s3 = sp[3];
                v4u o0, o1; o0.x = pk2(s0.x, s0.y); o0.y = pk2(s0.z, s0.w); o0.z = pk2(s1.x, s1.y); o0.w = pk2(s1.z, s1.w); o1.x = pk2(s2.x, s2.y); o1.y = pk2(s2.z, s2.w); o1.z = pk2(s3.x, s3.y); o1.w = pk2(s3.z, s3.w);
                *(LAS v4u*)(SI + row * 272 + c16 * 2) = o0; *(LAS v4u*)(SI + row * 272 + c16 * 2 + 16) = o1; }
            __syncthreads();
#pragma unroll
            for (int q2 = 0; q2 < 2; ++q2) {
                const int id = 2 * w + q2, tt = id >> 2, jt = id & 3;
                f32x4 p = {0.f, 0.f, 0.f, 0.f};
#pragma unroll
                for (int ks = 0; ks < 2; ++ks) { const bf16x8 a = *(const LAS bf16x8*)(QI + (16 * tt + c) * 144 + ks * 64 + g * 16), bb = *(const LAS bf16x8*)(KI + (16 * jt + c) * 144 + ks * 64 + g * 16);
                    p = __builtin_amdgcn_mfma_f32_16x16x32_bf16(a, bb, p, 0, 0, 0); }
#pragma unroll
                for (int r = 0; r < 4; ++r) { const int t = 16 * tt + 4 * g + r, j = 16 * jt + c; const bool keep = d ? (j > t) : (j <= t);
                    *(LAS unsigned short*)(PI + t * 144 + j * 2) = (unsigned short)f2bf(keep ? p[r] : 0.f); }
            }
            __syncthreads();
            bf16x8 vf[2], sf[2];
#pragma unroll
            for (int s2 = 0; s2 < 2; ++s2) { vf[s2] = tr_frag(VI + (32 * s2 + 8 * g + (c >> 2)) * 272 + (16 * w + 4 * (c & 3)) * 2, 4 * 272);
                sf[s2] = tr_frag(SI + (32 * s2 + 8 * g + (c >> 2)) * 272 + (16 * w + 4 * (c & 3)) * 2, 4 * 272); }
#pragma unroll
            for (int tt = 0; tt < 4; ++tt)
#pragma unroll
                for (int s2 = 0; s2 < 2; ++s2) { const bf16x8 pa = *(const LAS bf16x8*)(PI + (16 * tt + c) * 144 + s2 * 64 + g * 16), qa = *(const LAS bf16x8*)(QI + (16 * tt + c) * 144 + s2 * 64 + g * 16);
                    acc[tt] = __builtin_amdgcn_mfma_f32_16x16x32_bf16(pa, vf[s2], acc[tt], 0, 0, 0);
                    acc[tt] = __builtin_amdgcn_mfma_f32_16x16x32_bf16(qa, sf[s2], acc[tt], 0, 0, 0); }
        }
#pragma unroll
        for (int tt = 0; tt < 4; ++tt)
#pragma unroll
            for (int r = 0; r < 4; ++r) OF[(16 * tt + 4 * g + r) * 132 + 16 * w + c] = acc[tt][r];
        __syncthreads();
        {   const int t = tid >> 3, c16 = (tid & 7) * 16;
            float o[16]; float ss = 0.f;
#pragma unroll
            for (int e = 0; e < 16; ++e) { o[e] = OF[t * 132 + c16 + e]; ss += o[e] * o[e]; }
            ss += __shfl_xor(ss, 1); ss += __shfl_xor(ss, 2); ss += __shfl_xor(ss, 4);
            const float rs = rsqrtf(ss * (1.f / 128.f) + EPS);
            const v4u g0 = *(const GAS v4u*)(PB + (m0 + t) * NPB + O_BG + h * 128 + c16), g1 = *(const GAS v4u*)(PB + (m0 + t) * NPB + O_BG + h * 128 + c16 + 8);
            const unsigned gg[8] = {g0.x, g0.y, g0.z, g0.w, g1.x, g1.y, g1.z, g1.w};
            unsigned oo[8];
#pragma unroll
            for (int e = 0; e < 8; ++e) { const float ga = bf2f((unsigned short)(gg[e] & 0xffffu)), gb = bf2f((unsigned short)(gg[e] >> 16));
                oo[e] = pk2(o[2 * e] * rs * gn[h * 128 + c16 + 2 * e] * (ga * sigmoidf_(ga)), o[2 * e + 1] * rs * gn[h * 128 + c16 + 2 * e + 1] * (gb * sigmoidf_(gb))); }
            v4u o0, o1; o0.x = oo[0]; o0.y = oo[1]; o0.z = oo[2]; o0.w = oo[3]; o1.x = oo[4]; o1.y = oo[5]; o1.z = oo[6]; o1.w = oo[7];
            *(GAS v4u*)(MIX + (m0 + t) * D + 1024 + h * 128 + c16) = o0; *(GAS v4u*)(MIX + (m0 + t) * D + 1024 + h * 128 + c16 + 8) = o1;
        }
    }
}
constexpr int LRU_LD = 132;
constexpr size_t MISC_CAR_A = 0, MISC_CAR_H = 1 * MiB, MISC_CIN = 2 * MiB;
template <bool FINAL>
__device__ __forceinline__ void lru_phase(const Frame& F, const bf16* __restrict__ PB, const bf16* __restrict__ LRUG, const float* __restrict__ cw, const float* __restrict__ cb,
                                          const float* __restrict__ ba, const float* __restrict__ bx, const float* __restrict__ lam, float* __restrict__ CAR_A, float* __restrict__ CAR_H,
                                          const float* __restrict__ CIN, bf16* __restrict__ MIX) {
    LAS float* XF = (LAS float*)(F.lds);
    LAS float* AS = (LAS float*)(F.lds + 33792);
    LAS float* US = (LAS float*)(F.lds + 2 * 33792);
    LAS unsigned char* XB = F.lds + 3 * 33792;
    const int tid = F.tid, lane = F.lane, g4 = lane >> 4, c = lane & 15, w = F.wave;
    for (int unit = F.bx; unit < BATCH * 32 * 4; unit += F.G) {
        const int b = unit >> 7, n = (unit >> 2) & 31, g = unit & 3, t0 = n * 64;
        __syncthreads();
        {
            const int ch2 = tid & 63, tb = (tid >> 6) * 8, ch = g * 128 + 2 * ch2;
            float w0[4], w1[4];
#pragma unroll
            for (int j = 0; j < 4; ++j) { w0[j] = cw[j * 512 + ch]; w1[j] = cw[j * 512 + ch + 1]; }
            const float b0 = cb[ch], b1 = cb[ch + 1];
            float x0[11], x1[11];
#pragma unroll
            for (int i = 0; i < 11; ++i) { const int t = t0 + tb - 2 + i; unsigned v = 0u; if (t >= 0 && t < SEQ) v = *(const GAS unsigned*)(PB + (size_t)(b * SEQ + t) * NPB + PB_CX + ch);
                x0[i] = bf2f((unsigned short)(v & 0xffffu)); x1[i] = bf2f((unsigned short)(v >> 16)); }
#pragma unroll
            for (int r = 0; r < 8; ++r) { float y0 = b0, y1 = b1;
#pragma unroll
                for (int j = 0; j < 4; ++j) { y0 += x0[r + j] * w0[j]; y1 += x1[r + j] * w1[j]; }
                XF[(tb + r) * LRU_LD + 2 * ch2] = y0; XF[(tb + r) * LRU_LD + 2 * ch2 + 1] = y1;
                *(LAS unsigned*)(XB + (tb + r) * 272 + ch2 * 4) = pk2(y0, y1); }
        }
        __syncthreads();
#pragma unroll
        for (int s = 0; s < 2; ++s) {
            {
                const int j = 16 * w + c, chj = g * 128 + j;
                const bf16* wap = LRUG + ((size_t)((s * 2 + 0) * 4 + g) * 128 + j) * 128 + g4 * 8;
                const bf16* wxp = LRUG + ((size_t)((s * 2 + 1) * 4 + g) * 128 + j) * 128 + g4 * 8;
                bf16x8 waf[4], wxf[4];
#pragma unroll
                for (int ks = 0; ks < 4; ++ks) { waf[ks] = *(const GAS bf16x8*)(wap + ks * 32); wxf[ks] = *(const GAS bf16x8*)(wxp + ks * 32); }
                const float bav = ba[s * 512 + chj], bxv = bx[s * 512 + chj], sp = softplusf_(-lam[s * 512 + chj]);
                LAS float* U = s == 0 ? US : XF;
#pragma unroll
                for (int tt = 0; tt < 4; ++tt) {
                    f32x4 ga = {0.f, 0.f, 0.f, 0.f}, gx = {0.f, 0.f, 0.f, 0.f};
#pragma unroll
                    for (int ks = 0; ks < 4; ++ks) { const bf16x8 xf = *(const LAS bf16x8*)(XB + (16 * tt + c) * 272 + ks * 64 + g4 * 16);
                        ga = __builtin_amdgcn_mfma_f32_16x16x32_bf16(xf, waf[ks], ga, 0, 0, 0); gx = __builtin_amdgcn_mfma_f32_16x16x32_bf16(xf, wxf[ks], gx, 0, 0, 0); }
#pragma unroll
                    for (int r = 0; r < 4; ++r) { const int t = 16 * tt + 4 * g4 + r;
                        const float rg = sigmoidf_(ga[r] + bav), ig = sigmoidf_(gx[r] + bxv);
                        const float la = -8.f * rg * sp, a = __expf(la);
                        const float xv = XF[t * LRU_LD + j];
                        AS[t * LRU_LD + j] = a; U[t * LRU_LD + j] = sqrtf(-expm1f(2.f * la)) * (ig * xv); }
                }
            }
            __syncthreads();
            if (tid < 128) {
                LAS float* U = s == 0 ? US : XF;
                const size_t ci = ((size_t)((s * BATCH + b) * 32 + n)) * 512 + g * 128 + tid;
                float h = FINAL ? CIN[ci] : 0.f, ap = 1.f;
#pragma unroll 8
                for (int st = 0; st < 64; ++st) { const int t = s ? 63 - st : st; const float a = AS[t * LRU_LD + tid], u = U[t * LRU_LD + tid]; h = a * h + u; ap *= a;
                    if (FINAL) { if (s == 0) US[t * LRU_LD + tid] = h; else US[t * LRU_LD + tid] += h; } }
                if (!FINAL) { CAR_A[ci] = ap; CAR_H[ci] = h; }
            }
            __syncthreads();
        }
        if (FINAL) {
            const int t = tid >> 3, c16 = (tid & 7) * 16;
            const size_t m = (size_t)b * SEQ + t0 + t;
            const v4u y0 = *(const GAS v4u*)(PB + m * NPB + PB_CY + g * 128 + c16), y1 = *(const GAS v4u*)(PB + m * NPB + PB_CY + g * 128 + c16 + 8);
            const unsigned yy[8] = {y0.x, y0.y, y0.z, y0.w, y1.x, y1.y, y1.z, y1.w};
            unsigned oo[8];
#pragma unroll
            for (int e = 0; e < 8; ++e) { const float ya = bf2f((unsigned short)(yy[e] & 0xffffu)), yb = bf2f((unsigned short)(yy[e] >> 16));
                oo[e] = pk2(US[t * LRU_LD + c16 + 2 * e] * gelu_tanh(ya), US[t * LRU_LD + c16 + 2 * e + 1] * gelu_tanh(yb)); }
            v4u o0, o1; o0.x = oo[0]; o0.y = oo[1]; o0.z = oo[2]; o0.w = oo[3]; o1.x = oo[4]; o1.y = oo[5]; o1.z = oo[6]; o1.w = oo[7];
            *(GAS v4u*)(MIX + m * D + 1536 + g * 128 + c16) = o0; *(GAS v4u*)(MIX + m * D + 1536 + g * 128 + c16 + 8) = o1;
        }
    }
}
__device__ __forceinline__ void lru_carry_phase(const Frame& F, const float* __restrict__ CAR_A, const float* __restrict__ CAR_H, float* __restrict__ CIN) {
    const int id = F.bx * NTHREADS + F.tid;
    if (id < 2 * BATCH * 512) {
        const int s = id >> 11, b = (id >> 9) & 3, ch = id & 511;
        float h = 0.f;
        for (int st = 0; st < 32; ++st) { const int n = s ? 31 - st : st; const size_t ci = ((size_t)((s * BATCH + b) * 32 + n)) * 512 + ch;
            CIN[ci] = h; h = CAR_A[ci] * h + CAR_H[ci]; }
    }
}
__device__ __forceinline__ void wattn_phase(const Frame& F, const bf16* __restrict__ PB, const float* __restrict__ rel_bias, const float* __restrict__ sink, bf16* __restrict__ MIX) {
    LAS unsigned char* KS = F.lds;
    LAS float* btab = (LAS float*)(F.lds + 400 * 272);
    const int lane = F.lane, g = lane >> 4, c = lane & 15, w = F.wave, tid = F.tid;
    for (int unit = F.bx; unit < BATCH * 8 * (SEQ / 128); unit += F.G) {
        const int b = unit >> 7, hq = (unit >> 4) & 7, qb = unit & 15, hkv = hq >> 2;
        const int q0 = qb * 128;
        __syncthreads();
        for (int ch = tid; ch < 400 * 16; ch += NTHREADS) { const int i = ch >> 4, col = ch & 15; int j = q0 - 128 + i; j = j < 0 ? 0 : (j > SEQ - 1 ? SEQ - 1 : j);
            const v4u v = *(const GAS v4u*)(PB + (size_t)(b * SEQ + j) * NPB + O_AK + hkv * 128 + col * 8);
            *(LAS v4u*)(KS + i * 272 + col * 16) = v; }
        if (tid < 304) { const int rel = tid - 143; btab[tid] = (rel >= -128 && rel <= 128) ? rel_bias[t5_bucket(rel) * 8 + hq] : 0.f; }
        __syncthreads();
        f32x4 S[18];
#pragma unroll
        for (int kt = 0; kt < 18; ++kt) S[kt] = (f32x4){0.f, 0.f, 0.f, 0.f};
        const bf16* qrow = PB + (size_t)(b * SEQ + q0 + 16 * w + c) * NPB + O_AQ + hq * 128 + g * 8;
#pragma unroll
        for (int ks = 0; ks < 4; ++ks) {
            const bf16x8 qf = *(const GAS bf16x8*)(qrow + ks * 32);
#pragma unroll
            for (int kt = 0; kt < 18; ++kt) { const bf16x8 kf = *(const LAS bf16x8*)(KS + (16 * w + 16 * kt + c) * 272 + ks * 64 + g * 16); S[kt] = __builtin_amdgcn_mfma_f32_16x16x32_bf16(kf, qf, S[kt], 0, 0, 0);
                if (kt == 8 || kt == 17) __builtin_amdgcn_sched_barrier(0); }
        }
        const float snk = sink[hq];
        float mx = snk;
#pragma unroll
        for (int kt = 0; kt < 18; ++kt)
#pragma unroll
            for (int r = 0; r < 4; ++r) {
                const int rel = 16 * kt + 4 * g + r - 128 - c;
                const int j = q0 + 16 * w + c + rel;
                const bool ok = (rel >= -128) && (rel <= 128) && (j >= 0) && (j < SEQ);
                const float bias = btab[(4 * g - c + 15) + 16 * kt + r];
                const float s = ok ? S[kt][r] * 0.08838834764831845f + bias : -1e30f;
                S[kt][r] = s; mx = fmaxf(mx, s);
                if (r == 3 && (kt & 1)) __builtin_amdgcn_sched_barrier(0);
            }
        mx = fmaxf(mx, __shfl_xor(mx, 16)); mx = fmaxf(mx, __shfl_xor(mx, 32));
        float sum = 0.f;
#pragma unroll
        for (int kt = 0; kt < 18; ++kt)
#pragma unroll
            for (int r = 0; r < 4; ++r) { const float p = (S[kt][r] > -1e29f) ? __builtin_amdgcn_exp2f((S[kt][r] - mx) * 1.4426950408889634f) : 0.f; S[kt][r] = p; sum += p; }
        sum += __shfl_xor(sum, 16); sum += __shfl_xor(sum, 32);
        sum += __builtin_amdgcn_exp2f((snk - mx) * 1.4426950408889634f);
        const float inv = 1.f / sum;
        bf16x8 pf[9];
#pragma unroll
        for (int s = 0; s < 9; ++s) { v4u t; t.x = pk2(S[2 * s][0] * inv, S[2 * s][1] * inv); t.y = pk2(S[2 * s][2] * inv, S[2 * s][3] * inv); t.z = pk2(S[2 * s + 1][0] * inv, S[2 * s + 1][1] * inv); t.w = pk2(S[2 * s + 1][2] * inv, S[2 * s + 1][3] * inv);
            pf[s] = __builtin_bit_cast(bf16x8, t); }
        __syncthreads();
        for (int ch = tid; ch < 400 * 16; ch += NTHREADS) { const int i = ch >> 4, col = ch & 15; int j = q0 - 128 + i; j = j < 0 ? 0 : (j > SEQ - 1 ? SEQ - 1 : j);
            const v4u v = *(const GAS v4u*)(PB + (size_t)(b * SEQ + j) * NPB + O_AV + hkv * 128 + col * 8);
            *(LAS v4u*)(KS + i * 272 + col * 16) = v; }
        __syncthreads();
        for (int dt = 0; dt < 8; ++dt) {
            f32x4 acc = {0.f, 0.f, 0.f, 0.f};
#pragma unroll
            for (int s = 0; s < 9; ++s) {
                LAS unsigned char* vp = KS + (16 * w + 32 * s + 4 * g + (c >> 2)) * 272 + (16 * dt + 4 * (c & 3)) * 2;
                const s16x4 lo = __builtin_amdgcn_ds_read_tr16_b64_v4i16((LAS s16x4*)vp);
                const s16x4 hi = __builtin_amdgcn_ds_read_tr16_b64_v4i16((LAS s16x4*)(vp + 16 * 272));
                const bf16x8 vf = __builtin_shufflevector(lo, hi, 0, 1, 2, 3, 4, 5, 6, 7);
                acc = __builtin_amdgcn_mfma_f32_16x16x32_bf16(vf, pf[s], acc, 0, 0, 0);
            }
            v2u o; o.x = pk2(acc[0], acc[1]); o.y = pk2(acc[2], acc[3]);
            *(GAS v2u*)(MIX + (size_t)(b * SEQ + q0 + 16 * w + c) * D + hq * 128 + dt * 16 + 4 * g) = o;
        }
    }
}
__device__ __forceinline__ void xattn_phase(const Frame& F, const bf16* __restrict__ Q, const bf16* __restrict__ KX, const bf16* __restrict__ VT, bf16* __restrict__ O) {
    LAS unsigned char* KS = F.lds;
    const int lane = F.lane, g = lane >> 4, c = lane & 15, w = F.wave, tid = F.tid;
    for (int unit = F.bx; unit < BATCH * 4 * (SEQ / 128); unit += F.G) {
        const int b = unit >> 6, h = (unit >> 4) & 3, qb = unit & 15;
        const int m0 = b * SEQ + qb * 128 + w * 16;
        f32x4 S[16];
#pragma unroll
        for (int kt = 0; kt < 16; ++kt) S[kt] = (f32x4){0.f, 0.f, 0.f, 0.f};
        const bf16* qrow = Q + (size_t)(m0 + c) * D + h * 512 + g * 8;
        for (int dc = 0; dc < 4; ++dc) {
            __syncthreads();
#pragma unroll
            for (int i = 0; i < 8; ++i) { const int row = (tid >> 4) + 32 * i, col = tid & 15;
                const v4u v = *(const GAS v4u*)(KX + (size_t)(b * MEM_LEN + row) * D + h * 512 + dc * 128 + col * 8);
                *(LAS v4u*)(KS + row * 272 + col * 16) = v; }
            __syncthreads();
#pragma unroll
            for (int ks = 0; ks < 4; ++ks) {
                const bf16x8 qf = *(const GAS bf16x8*)(qrow + dc * 128 + ks * 32);
#pragma unroll
                for (int kt = 0; kt < 16; ++kt) { const bf16x8 kf = *(const LAS bf16x8*)(KS + (16 * kt + c) * 272 + ks * 64 + g * 16); S[kt] = __builtin_amdgcn_mfma_f32_16x16x32_bf16(kf, qf, S[kt], 0, 0, 0); }
            }
        }
        float mx = -3.0e38f;
#pragma unroll
        for (int kt = 0; kt < 16; ++kt)
#pragma unroll
            for (int r = 0; r < 4; ++r) mx = fmaxf(mx, S[kt][r]);
        mx = fmaxf(mx, __shfl_xor(mx, 16)); mx = fmaxf(mx, __shfl_xor(mx, 32));
        const float sc2 = 0.044194173824159216f * 1.4426950408889634f;
        float sum = 0.f;
#pragma unroll
        for (int kt = 0; kt < 16; ++kt)
#pragma unroll
            for (int r = 0; r < 4; ++r) { const float p = __builtin_amdgcn_exp2f((S[kt][r] - mx) * sc2); S[kt][r] = p; sum += p; }
        sum += __shfl_xor(sum, 16); sum += __shfl_xor(sum, 32);
        const float inv = 1.f / sum;
        bf16x8 pf[8];
#pragma unroll
        for (int s = 0; s < 8; ++s) { v4u t; t.x = pk2(S[2 * s][0] * inv, S[2 * s][1] * inv); t.y = pk2(S[2 * s][2] * inv, S[2 * s][3] * inv); t.z = pk2(S[2 * s + 1][0] * inv, S[2 * s + 1][1] * inv); t.w = pk2(S[2 * s + 1][2] * inv, S[2 * s + 1][3] * inv);
            pf[s] = __builtin_bit_cast(bf16x8, t); }
        for (int dc = 0; dc < 4; ++dc) {
            __syncthreads();
#pragma unroll
            for (int i = 0; i < 8; ++i) { const int row = (tid >> 5) + 16 * i, col = tid & 31;
                const v4u v = *(const GAS v4u*)(VT + (size_t)(h * 512 + dc * 128 + row) * MM + b * MEM_LEN + col * 8);
                *(LAS v4u*)(KS + row * 528 + col * 16) = v; }
            __syncthreads();
            for (int dt = 0; dt < 8; ++dt) {
                f32x4 acc = {0.f, 0.f, 0.f, 0.f};
#pragma unroll
                for (int s = 0; s < 8; ++s) {
                    const LAS unsigned char* vp = KS + (16 * dt + c) * 528 + 64 * s + 8 * g;
                    const v2u lo = *(const LAS v2u*)vp, hi = *(const LAS v2u*)(vp + 32);
                    v4u t; t.x = lo.x; t.y = lo.y; t.z = hi.x; t.w = hi.y;
                    acc = __builtin_amdgcn_mfma_f32_16x16x32_bf16(__builtin_bit_cast(bf16x8, t), pf[s], acc, 0, 0, 0);
                }
                v2u o; o.x = pk2(acc[0], acc[1]); o.y = pk2(acc[2], acc[3]);
                *(GAS v2u*)(O + (size_t)(m0 + c) * D + h * 512 + dc * 128 + dt * 16 + 4 * g) = o;
            }
        }
    }
}
constexpr int NPL = 15;
enum Phase { PH_CONV = 0, PH_KV, PH_IN, PH_X1, PH_X2, PH_X3, PH_OUT, PH_RN1, PH_Q, PH_XA, PH_O, PH_RN2, PH_UP, PH_DOWN, PH_RN3 };
struct Args { const float* in[31]; float* out; unsigned char* ws; int ph_lo, ph_hi, li, pad; };

__global__ void __launch_bounds__(NTHREADS, 2) fwd(Args args) {
    extern __shared__ __attribute__((aligned(16))) unsigned char lds[];
    Frame F;
    F.lds = (LAS unsigned char*)lds;
    F.tid = threadIdx.x; F.lane = F.tid & 63; F.wave = __builtin_amdgcn_readfirstlane(F.tid >> 6);
    F.G = gridDim.x; F.bx = blockIdx.x;
    unsigned char* ws = args.ws;
    const int lo = args.ph_lo, hi = args.ph_hi;
#define IN(k) (lo <= (k) && (k) < hi)
#define PHASE_BEGIN() int tz_ = threadIdx.x; asm volatile("" : "+v"(tz_)); F.tid = tz_; F.lane = tz_ & 63; F.wave = __builtin_amdgcn_readfirstlane(tz_ >> 6); const int gw = F.bx * NWAVES + F.wave; (void)gw
    const int NGW = F.G * NWAVES;
    float* X = args.out;
    bf16* XN = (bf16*)(ws + WS_XN);
    float* Y = (float*)(ws + WS_Y);

    for (int l = 0; l < DEPTH; ++l) {
        const int pb = l * NPL;
        unsigned char* wl = ws + WS_W + (size_t)(l % NWL) * WL_BYTES;
        bf16* MEMN = (bf16*)(ws + WS_MEMN) + (size_t)l * MM * D;
        if (IN(pb + PH_CONV)) { PHASE_BEGIN();
            LAS float* scr = (LAS float*)(F.lds + RING_OFF + F.wave * 16384);
            const int lc0 = (NWL == 1) ? l : (l == 0 ? 0 : DEPTH), lc1 = (NWL == 1) ? l + 1 : DEPTH;
            for (int lc = lc0; lc < lc1; ++lc) {
                unsigned char* wb = ws + WS_W + (size_t)(lc % NWL) * WL_BYTES;
                const ConvSeg segs[10] = {
                    {args.in[3] + (size_t)lc * D * DIN, D, DIN, 0, 3072, (bf16*)(wb + WL_IN), 0},
                    {args.in[3] + (size_t)lc * D * DIN, D, DIN, 3072, 32, (bf16*)(wb + WL_Z), 0},
                    {args.in[3] + (size_t)lc * D * DIN, D, DIN, 3104, 1024, (bf16*)(wb + WL_IN), 3072},
                    {args.in[4] + (size_t)lc * D * D, D, D, 0, D, (bf16*)(wb + WL_OUT), 0},
                    {args.in[18] + (size_t)lc * D * D, D, D, 0, D, (bf16*)(wb + WL_XQ), 0},
                    {args.in[19] + (size_t)lc * D * D, D, D, 0, D, (bf16*)(wb + WL_XK), 0},
                    {args.in[20] + (size_t)lc * D * D, D, D, 0, D, (bf16*)(wb + WL_XV), 0},
                    {args.in[21] + (size_t)lc * D * D, D, D, 0, D, (bf16*)(wb + WL_XO), 0},
                    {args.in[22] + (size_t)lc * D * DFF, D, DFF, 0, DFF, (bf16*)(wb + WL_UP), 0},
                    {args.in[23] + (size_t)lc * DFF * D, DFF, D, 0, D, (bf16*)(wb + WL_DOWN), 0}};
                int total = 0;
#pragma unroll
                for (int s = 0; s < 10; ++s) total += seg_items(segs[s]);
                for (int it = gw; it < total; it += NGW) {
                    int r = it;
#pragma unroll
                    for (int s = 0; s < 10; ++s) { const int n = seg_items(segs[s]);
                        if (r >= 0 && r < n) p0_transpose_item(segs[s].W, segs[s].K, segs[s].N, segs[s].c0, segs[s].WT, segs[s].r0, segs[s].ncols / 32, scr, r, F.lane);
                        r -= n; }
                }
            }
            for (int lc = lc0; lc < lc1; ++lc) {
                bf16* lg = (bf16*)(ws + WS_W + (size_t)(lc % NWL) * WL_BYTES + WL_LRUG);
                for (int it = gw; it < 16 * 8; it += NGW) { const int mi = it >> 3, gate = mi >> 3, s = (mi >> 2) & 1, gg = mi & 3;
                    p0_transpose_item(args.in[gate ? 15 : 13] + ((size_t)lc * 8 + s * 4 + gg) * 16384, 128, 128, 0, lg + (size_t)((s * 2 + gate) * 4 + gg) * 16384, 0, 4, scr, it & 7, F.lane); }
            }
            if (l == 0) for (int m = gw; m < M; m += NGW) norm_row(F.lane, args.in[0] + (size_t)m * D, args.in[24], XN + (size_t)m * D, X + (size_t)m * D);
            for (int lc = lc0; lc < lc1; ++lc)
                for (int m = gw; m < MM; m += NGW) norm_row(F.lane, args.in[1] + (size_t)m * D, args.in[26] + (size_t)lc * D, (bf16*)(ws + WS_MEMN) + ((size_t)lc * MM + m) * D, nullptr);
        }
        if (IN(pb + PH_KV)) { PHASE_BEGIN();
            const int lc0 = (NWL == 1) ? l : (l == 0 ? 0 : DEPTH), lc1 = (NWL == 1) ? l + 1 : DEPTH;
            if (lc1 > lc0) {
                const bf16* base = (const bf16*)(ws + WS_W);
                pg8::Gemm g{base, base, 0, 0, D};
                pg8::KvOrder S; S.G = F.G; S.c = F.bx; S.NL = lc1 - lc0; S.l0 = lc0;
                S.memn_p0 = (int)((WS_MEMN - WS_W) / MiB) + 4 * lc0; S.memn_ps = 4;
                S.xk_p0 = (int)(((size_t)(lc0 % NWL) * WL_BYTES + WL_XK) / MiB); S.xv_p0 = (int)(((size_t)(lc0 % NWL) * WL_BYTES + WL_XV) / MiB); S.w_ps = (int)(WL_BYTES / MiB);
                pg8::EpiBf16<0> E{(bf16*)(ws + WS_KX), D, (bf16*)(ws + WS_VT), MM};
                pg8::gemm_phase<pg8::EpiBf16<0>, pg8::KvOrder, true, true>(F.lds + RING_OFF, g, S, E);
            }
        }
        if (IN(pb + PH_IN)) { PHASE_BEGIN();
            pg8::Gemm g{XN, (const bf16*)(wl + WL_IN), M, NPB, D}; pg8::StaticOrder S; S.init(M, NPB, F.G, F.bx);
            pg8::EpiBf16<0> E{(bf16*)(ws + WS_PB), NPB, nullptr, 0};
            pg8::gemm_phase<pg8::EpiBf16<0>, pg8::StaticOrder, true, true>(F.lds + RING_OFF, g, S, E);
            zgemm(F, XN, (const bf16*)(wl + WL_Z), (float*)(ws + WS_Z));
        }
        if (IN(pb + PH_X1)) { PHASE_BEGIN();
            gla_u_phase(F, (const bf16*)(ws + WS_PB), (const float*)(ws + WS_Z), args.in[6] + (size_t)l * 4096, args.in[7] + (size_t)l * 256, args.in[8] + (size_t)l * 4096, args.in[9] + (size_t)l * 256,
                        (float*)(ws + WS_GLAU), (float*)(ws + WS_MISC + MISC_DEC)); }
        if (IN(pb + PH_X2)) { PHASE_BEGIN(); gla_state_phase(F, (float*)(ws + WS_GLAU), (const float*)(ws + WS_MISC + MISC_DEC)); }
        if (IN(pb + PH_X3)) { PHASE_BEGIN();
            gla_o_phase(F, (const bf16*)(ws + WS_PB), (const float*)(ws + WS_Z), args.in[6] + (size_t)l * 4096, args.in[7] + (size_t)l * 256, args.in[8] + (size_t)l * 4096, args.in[9] + (size_t)l * 256,
                        (const float*)(ws + WS_GLAU), args.in[10] + (size_t)l * 512, (bf16*)(ws + WS_MIX)); }
        if (IN(pb + PH_X1)) { PHASE_BEGIN();
            lru_phase<false>(F, (const bf16*)(ws + WS_PB), (const bf16*)(wl + WL_LRUG), args.in[11] + (size_t)l * 2048, args.in[12] + (size_t)l * 512, args.in[14] + (size_t)l * 1024, args.in[16] + (size_t)l * 1024, args.in[17] + (size_t)l * 1024,
                             (float*)(ws + WS_MISC + MISC_CAR_A), (float*)(ws + WS_MISC + MISC_CAR_H), nullptr, nullptr); }
        if (IN(pb + PH_X2)) { PHASE_BEGIN(); lru_carry_phase(F, (const float*)(ws + WS_MISC + MISC_CAR_A), (const float*)(ws + WS_MISC + MISC_CAR_H), (float*)(ws + WS_MISC + MISC_CIN)); }
        if (IN(pb + PH_X3)) { PHASE_BEGIN();
            lru_phase<true>(F, (const bf16*)(ws + WS_PB), (const bf16*)(wl + WL_LRUG), args.in[11] + (size_t)l * 2048, args.in[12] + (size_t)l * 512, args.in[14] + (size_t)l * 1024, args.in[16] + (size_t)l * 1024, args.in[17] + (size_t)l * 1024,
                            nullptr, nullptr, (const float*)(ws + WS_MISC + MISC_CIN), (bf16*)(ws + WS_MIX)); }
        if (IN(pb + PH_X2)) { PHASE_BEGIN(); wattn_phase(F, (const bf16*)(ws + WS_PB), args.in[2], args.in[5] + l * 8, (bf16*)(ws + WS_MIX)); }
        if (IN(pb + PH_OUT)) { PHASE_BEGIN();
            pg8::Gemm g{(const bf16*)(ws + WS_MIX), (const bf16*)(wl + WL_OUT), M, D, D}; pg8::StaticOrder S; S.init(M, D, F.G, F.bx);
            pg8::EpiF32 E{Y, D};
            pg8::gemm_phase<pg8::EpiF32, pg8::StaticOrder, true, true>(F.lds + RING_OFF, g, S, E);
        }
        if (IN(pb + PH_RN1)) { PHASE_BEGIN(); for (int m = gw; m < M; m += NGW) resid_norm_row(F.lane, X + (size_t)m * D, Y + (size_t)m * D, args.in[25] + (size_t)l * D, args.in[27] + (size_t)l * D, XN + (size_t)m * D); }
        if (IN(pb + PH_Q)) { PHASE_BEGIN();
            pg8::Gemm g{XN, (const bf16*)(wl + WL_XQ), M, D, D}; pg8::StaticOrder S; S.init(M, D, F.G, F.bx);
            pg8::EpiBf16<0> E{(bf16*)(ws + WS_Q), D, nullptr, 0};
            pg8::gemm_phase<pg8::EpiBf16<0>, pg8::StaticOrder, true, true>(F.lds + RING_OFF, g, S, E);
        }
        if (IN(pb + PH_XA)) { PHASE_BEGIN(); xattn_phase(F, (const bf16*)(ws + WS_Q), (const bf16*)(ws + WS_KX) + (size_t)l * MM * D, (const bf16*)(ws + WS_VT) + (size_t)l * D * MM, (bf16*)(ws + WS_O)); }
        if (IN(pb + PH_O)) { PHASE_BEGIN();
            pg8::Gemm g{(const bf16*)(ws + WS_O), (const bf16*)(wl + WL_XO), M, D, D}; pg8::StaticOrder S; S.init(M, D, F.G, F.bx);
            pg8::EpiF32 E{Y, D};
            pg8::gemm_phase<pg8::EpiF32, pg8::StaticOrder, true, true>(F.lds + RING_OFF, g, S, E);
        }
        if (IN(pb + PH_RN2)) { PHASE_BEGIN(); for (int m = gw; m < M; m += NGW) resid_norm_row(F.lane, X + (size_t)m * D, Y + (size_t)m * D, args.in[28] + (size_t)l * D, args.in[29] + (size_t)l * D, XN + (size_t)m * D); }
        if (IN(pb + PH_UP)) { PHASE_BEGIN();
            pg8::Gemm g{XN, (const bf16*)(wl + WL_UP), M, DFF, D}; pg8::StaticOrder S; S.init(M, DFF, F.G, F.bx);
            pg8::EpiBf16<1> E{(bf16*)(ws + WS_H), DFF, nullptr, 0};
            pg8::gemm_phase<pg8::EpiBf16<1>, pg8::StaticOrder, true, true>(F.lds + RING_OFF, g, S, E);
        }
        if (IN(pb + PH_DOWN)) { PHASE_BEGIN();
            pg8::Gemm g{(const bf16*)(ws + WS_H), (const bf16*)(wl + WL_DOWN), M, D, DFF}; pg8::StaticOrder S; S.init(M, D, F.G, F.bx);
            pg8::EpiF32 E{Y, D};
            pg8::gemm_phase<pg8::EpiF32, pg8::StaticOrder, true, true>(F.lds + RING_OFF, g, S, E);
        }
        if (IN(pb + PH_RN3)) { PHASE_BEGIN(); for (int m = gw; m < M; m += NGW) resid_norm_row(F.lane, X + (size_t)m * D, Y + (size_t)m * D, args.in[30] + (size_t)l * D, (l + 1 < DEPTH) ? args.in[24] + (size_t)(l + 1) * D : nullptr, XN + (size_t)m * D); }
    }
#undef IN
}

__device__ __forceinline__ float block_sum_256(float v, float* red) {
    v = wave_sum(v);
    __syncthreads();
    if ((threadIdx.x & 63) == 0) red[threadIdx.x >> 6] = v;
    __syncthreads();
    return red[0] + red[1] + red[2] + red[3];
}
__device__ __forceinline__ float block_max_256(float v, float* red) {
    v = wave_max(v);
    __syncthreads();
    if ((threadIdx.x & 63) == 0) red[threadIdx.x >> 6] = v;
    __syncthreads();
    return fmaxf(fmaxf(red[0], red[1]), fmaxf(red[2], red[3]));
}
__global__ __launch_bounds__(64) void k_attn_naive(const float* __restrict__ P, const float* __restrict__ rel_bias, const float* __restrict__ sink, float* __restrict__ MIX) {
    __shared__ float sq[128];
    __shared__ float sp[320];
    const int lane = threadIdx.x;
    const int m = blockIdx.x >> 3, hq = blockIdx.x & 7, hkv = hq >> 2;
    const int b = m / SEQ, t = m % SEQ;
    sq[lane] = P[(size_t)m * DIN + O_AQ + hq * 128 + lane];
    sq[lane + 64] = P[(size_t)m * DIN + O_AQ + hq * 128 + lane + 64];
    __syncthreads();
    float s[5];
    float mx = sink[hq];
#pragma unroll
    for (int i = 0; i < 5; ++i) {
        const int jj = lane + 64 * i; const int j = t - 128 + jj;
        float v = -1e30f;
        if (jj <= 256 && j >= 0 && j < SEQ) {
            const float* kr = P + (size_t)(b * SEQ + j) * DIN + O_AK + hkv * 128;
            float acc = 0.f;
            for (int d = 0; d < 128; ++d) acc += sq[d] * kr[d];
            v = acc * 0.08838834764831845f + rel_bias[t5_bucket(j - t) * 8 + hq];
        }
        s[i] = v; mx = fmaxf(mx, v);
    }
    mx = wave_max(mx);
    float sum = 0.f;
#pragma unroll
    for (int i = 0; i < 5; ++i) { const float p = (s[i] > -1e29f) ? expf(s[i] - mx) : 0.f; s[i] = p; sum += p; }
    sum = wave_sum(sum) + expf(sink[hq] - mx);
    const float inv = 1.f / sum;
#pragma unroll
    for (int i = 0; i < 5; ++i) sp[lane + 64 * i] = s[i] * inv;
    __syncthreads();
    float o0 = 0.f, o1 = 0.f;
    for (int jj = 0; jj <= 256; ++jj) {
        const int j = t - 128 + jj;
        if (j < 0 || j >= SEQ) continue;
        const float p = sp[jj];
        const float* vr = P + (size_t)(b * SEQ + j) * DIN + O_AV + hkv * 128;
        o0 += p * vr[lane]; o1 += p * vr[lane + 64];
    }
    MIX[(size_t)m * D + hq * 128 + lane] = o0;
    MIX[(size_t)m * D + hq * 128 + lane + 64] = o1;
}
__global__ __launch_bounds__(256) void k_gla_gates(const float* __restrict__ P, const float* __restrict__ w2f, const float* __restrict__ b2f, const float* __restrict__ w2b, const float* __restrict__ b2b, float* __restrict__ LA) {
    const int m = blockIdx.x, c = threadIdx.x;
    for (int dir = 0; dir < 2; ++dir) {
        const float* z = P + (size_t)m * DIN + (dir ? O_ZB : O_ZF);
        const float* w2 = dir ? w2b : w2f; const float* b2 = dir ? b2b : b2f;
        float acc = b2[c];
        for (int r = 0; r < 16; ++r) acc += z[r] * w2[r * 256 + c];
        LA[((size_t)dir * M + m) * 256 + c] = -softplusf_(-acc) * (1.f / 16.f);
    }
}
__global__ __launch_bounds__(256) void k_gla_rec(const float* __restrict__ P, const float* __restrict__ LA, float* __restrict__ OD) {
    __shared__ float red[2][8][32];
    const int sl = blockIdx.x & 3, dir = (blockIdx.x >> 2) & 1, h = (blockIdx.x >> 3) & 3, b = blockIdx.x >> 5;
    const int i = threadIdx.x & 31, dg = threadIdx.x >> 5;
    float S[8];
#pragma unroll
    for (int e = 0; e < 8; ++e) S[e] = 0.f;
    for (int st = 0; st < SEQ; ++st) {
        const int t = dir ? (SEQ - 1 - st) : st;
        const size_t m = (size_t)b * SEQ + t;
        const float* pr = P + m * DIN;
        const float v = pr[O_BV + h * 128 + sl * 32 + i];
        float part = 0.f;
#pragma unroll
        for (int e = 0; e < 8; ++e) {
            const int d = dg * 8 + e;
            const float a = expf(LA[((size_t)dir * M + m) * 256 + h * 64 + d]);
            const float k = pr[O_BK + h * 64 + d];
            const float q = pr[O_BQ + h * 64 + d] * 0.125f;
            const float sd = a * S[e];
            if (dir) part += q * sd;
            S[e] = sd + k * v;
            if (!dir) part += q * S[e];
        }
        red[st & 1][dg][i] = part;
        __syncthreads();
        if (dg == 0) {
            float o = 0.f;
#pragma unroll
            for (int g = 0; g < 8; ++g) o += red[st & 1][g][i];
            OD[((size_t)dir * M + m) * 512 + h * 128 + sl * 32 + i] = o;
        }
    }
}
__global__ __launch_bounds__(128) void k_gla_out(const float* __restrict__ P, const float* __restrict__ OD, const float* __restrict__ gn, float* __restrict__ MIX) {
    __shared__ float red[2];
    const int m = blockIdx.x >> 2, h = blockIdx.x & 3, d = threadIdx.x;
    const float o = OD[(size_t)m * 512 + h * 128 + d] + OD[((size_t)M + m) * 512 + h * 128 + d];
    float ss = wave_sum(o * o);
    if ((threadIdx.x & 63) == 0) red[threadIdx.x >> 6] = ss;
    __syncthreads();
    ss = red[0] + red[1];
    const float r = rsqrtf(ss / 128.f + EPS);
    const float g = P[(size_t)m * DIN + O_BG + h * 128 + d];
    MIX[(size_t)m * D + 1024 + h * 128 + d] = o * r * gn[h * 128 + d] * (g * sigmoidf_(g));
}
__global__ __launch_bounds__(256) void k_lru_conv(const float* __restrict__ P, const float* __restrict__ cw, const float* __restrict__ cb, float* __restrict__ XC) {
    const int m = blockIdx.x, b = m / SEQ, t = m % SEQ;
    for (int c = threadIdx.x; c < 512; c += 256) {
        float acc = cb[c];
#pragma unroll
        for (int j = 0; j < 4; ++j) { const int tt = t + j - 2; if (tt >= 0 && tt < SEQ) acc += P[(size_t)(b * SEQ + tt) * DIN + O_CX + c] * cw[j * 512 + c]; }
        XC[(size_t)m * 512 + c] = acc;
    }
}
__global__ __launch_bounds__(256) void k_lru_gates(const float* __restrict__ XC, const float* __restrict__ wa, const float* __restrict__ ba, const float* __restrict__ wx, const float* __restrict__ bx, const float* __restrict__ lam, float* __restrict__ AA, float* __restrict__ UU) {
    __shared__ float sx[512];
    const int m = blockIdx.x;
    sx[threadIdx.x] = XC[(size_t)m * 512 + threadIdx.x]; sx[threadIdx.x + 256] = XC[(size_t)m * 512 + threadIdx.x + 256];
    __syncthreads();
    for (int e = threadIdx.x; e < 1024; e += 256) {
        const int s = e >> 9, c = e & 511, g = c >> 7, j = c & 127;
        const float* wap = wa + ((size_t)(s * 4 + g) * 128) * 128 + j;
        const float* wxp = wx + ((size_t)(s * 4 + g) * 128) * 128 + j;
        float ra = ba[s * 512 + c], ri = bx[s * 512 + c];
        for (int i = 0; i < 128; ++i) { const float xv = sx[g * 128 + i]; ra += xv * wap[i * 128]; ri += xv * wxp[i * 128]; }
        const float r = sigmoidf_(ra), ig = sigmoidf_(ri);
        const float log_a = -8.f * r * softplusf_(-lam[s * 512 + c]);
        AA[((size_t)s * M + m) * 512 + c] = expf(log_a);
        UU[((size_t)s * M + m) * 512 + c] = sqrtf(-expm1f(2.f * log_a)) * (ig * sx[c]);
    }
}
__global__ __launch_bounds__(256) void k_lru_scan(const float* __restrict__ AA, const float* __restrict__ UU, float* __restrict__ HH) {
    const int id = blockIdx.x * 256 + threadIdx.x;
    const int c = id & 511, s = (id >> 9) & 1, b = id >> 10;
    float h = 0.f;
    for (int st = 0; st < SEQ; ++st) {
        const int t = s ? (SEQ - 1 - st) : st;
        const size_t idx = ((size_t)s * M + (size_t)b * SEQ + t) * 512 + c;
        h = AA[idx] * h + UU[idx];
        HH[idx] = h;
    }
}
__global__ __launch_bounds__(256) void k_lru_out(const float* __restrict__ P, const float* __restrict__ HH, float* __restrict__ MIX) {
    const int m = blockIdx.x;
    for (int c = threadIdx.x; c < 512; c += 256) {
        const float h = HH[(size_t)m * 512 + c] + HH[((size_t)M + m) * 512 + c];
        MIX[(size_t)m * D + 1536 + c] = h * gelu_tanh(P[(size_t)m * DIN + O_CY + c]);
    }
}
__global__ __launch_bounds__(256) void k_xattn(const float* __restrict__ Q, const float* __restrict__ KX, const float* __restrict__ VX, float* __restrict__ O) {
    __shared__ float sq[2048];
    __shared__ float sp[256];
    __shared__ float red[4];
    const int m = blockIdx.x, b = m / SEQ;
    for (int i = threadIdx.x; i < 2048; i += 256) sq[i] = Q[(size_t)m * D + i];
    __syncthreads();
    for (int h = 0; h < 4; ++h) {
        const float* kr = KX + (size_t)(b * MEM_LEN + threadIdx.x) * D + h * 512;
        float acc = 0.f;
        for (int d = 0; d < 512; ++d) acc += sq[h * 512 + d] * kr[d];
        acc *= 0.044194173824159216f;
        const float mx = block_max_256(acc, red);
        const float p = expf(acc - mx);
        const float sum = block_sum_256(p, red);
        __syncthreads();
        sp[threadIdx.x] = p / sum;
        __syncthreads();
        float o0 = 0.f, o1 = 0.f;
        for (int k = 0; k < MEM_LEN; ++k) {
            const float* vr = VX + (size_t)(b * MEM_LEN + k) * D + h * 512;
            o0 += sp[k] * vr[threadIdx.x]; o1 += sp[k] * vr[threadIdx.x + 256];
        }
        O[(size_t)m * D + h * 512 + threadIdx.x] = o0;
        O[(size_t)m * D + h * 512 + threadIdx.x + 256] = o1;
        __syncthreads();
    }
}

__global__ __launch_bounds__(256) void k_bridge_P(const bf16* __restrict__ PB, const float* __restrict__ Z, float* __restrict__ P) {
    const int m = blockIdx.x;
    for (int c = threadIdx.x; c < DIN; c += 256) {
        float v;
        if (c < 3072) v = bf2f(PB[(size_t)m * NPB + c]);
        else if (c < 3104) v = Z[(size_t)m * 32 + (c - 3072)];
        else v = bf2f(PB[(size_t)m * NPB + (c - 32)]);
        P[(size_t)m * DIN + c] = v;
    }
}
__global__ __launch_bounds__(256) void k_f32_to_bf16(const float* __restrict__ s, bf16* __restrict__ d, size_t n) {
    for (size_t i = (size_t)blockIdx.x * 256 + threadIdx.x; i < n; i += (size_t)gridDim.x * 256) d[i] = (bf16)f2bf(s[i]);
}
__global__ __launch_bounds__(256) void k_bf16_to_f32(const bf16* __restrict__ s, float* __restrict__ d, size_t n) {
    for (size_t i = (size_t)blockIdx.x * 256 + threadIdx.x; i < n; i += (size_t)gridDim.x * 256) d[i] = bf2f(s[i]);
}
__global__ __launch_bounds__(256) void k_vt_to_vx(const bf16* __restrict__ VT, float* __restrict__ VX) {
    const int r = blockIdx.x;
    for (int c = threadIdx.x; c < D; c += 256) VX[(size_t)r * D + c] = bf2f(VT[(size_t)c * MM + r]);
}

constexpr int MIX_BRIDGE_C0 = 1024, MIX_BRIDGE_C1 = 1536;
__global__ __launch_bounds__(256) void k_mix_bridge(const float* __restrict__ s, bf16* __restrict__ d, int c0, int c1) {
    const int m = blockIdx.x;
    for (int c = c0 + threadIdx.x; c < c1; c += 256) d[(size_t)m * D + c] = (bf16)f2bf(s[(size_t)m * D + c]);
}
extern "C" void kernel_launch(void* const* d_in, const int* in_sizes, int n_in, void* d_out, int out_size, void* d_ws, size_t ws_size, hipStream_t stream) {
    static int grid = 0;
    if (grid == 0) {
        int dev = 0, cus = 0;
        if (hipGetDevice(&dev) != hipSuccess || hipDeviceGetAttribute(&cus, hipDeviceAttributeMultiprocessorCount, dev) != hipSuccess) { fprintf(stderr, "kernel_launch: device query failed\n"); grid = -1; return; }
        if (hipFuncSetAttribute((const void*)fwd, hipFuncAttributeMaxDynamicSharedMemorySize, LDS_BYTES) != hipSuccess) { fprintf(stderr, "kernel_launch: hipFuncSetAttribute failed\n"); grid = -1; return; }
        grid = cus;
    }
    if (grid < 0) return;
    const float* rel_bias = (const float*)d_in[2]; const float* attn_sink = (const float*)d_in[5];
    const float* w2f = (const float*)d_in[6]; const float* b2f = (const float*)d_in[7]; const float* w2b = (const float*)d_in[8]; const float* b2b = (const float*)d_in[9];
    const float* gla_norm = (const float*)d_in[10]; const float* conv_w = (const float*)d_in[11]; const float* conv_b = (const float*)d_in[12];
    const float* lru_wa = (const float*)d_in[13]; const float* lru_ba = (const float*)d_in[14]; const float* lru_wx = (const float*)d_in[15]; const float* lru_bx = (const float*)d_in[16];
    const float* lru_lambda = (const float*)d_in[17];
    unsigned char* ws = (unsigned char*)d_ws;
    float* nb = (float*)(ws + WS_END); size_t off = 0;
    auto take = [&](size_t n) { float* p = nb + off; off += (n + 63) & ~(size_t)63; return p; };
    float* P = take((size_t)M * DIN); float* MIXf = take((size_t)M * D); float* Qf = take((size_t)M * D); float* Of = take((size_t)M * D);
    float* KXf = take((size_t)MM * D); float* VXf = take((size_t)MM * D);
    float* LA = take((size_t)2 * M * 256); float* OD = take((size_t)2 * M * 512); float* XC = take((size_t)M * 512);
    float* AA = take((size_t)2 * M * 512); float* UU = take((size_t)2 * M * 512); float* HH = take((size_t)2 * M * 512);
    if (WS_END + off * 4 > ws_size) { fprintf(stderr, "kernel_launch: workspace too small: need %zu have %zu\n", WS_END + off * 4, ws_size); return; }
    (void)hipMemsetAsync(ws + WS_CTL, 0, CTL_ZERO_BYTES, stream);
    Args a{};
    for (int i = 0; i < 31; ++i) a.in[i] = (const float*)d_in[i];
    a.out = (float*)d_out; a.ws = ws;
    auto phase = [&](int p) { a.ph_lo = p; a.ph_hi = p + 1; a.li = 0; hipLaunchKernelGGL(fwd, dim3(grid), dim3(NTHREADS), LDS_BYTES, stream, a); };
    for (int l = 0; l < DEPTH; ++l) {
        const int pb = l * NPL;
        phase(pb + PH_CONV); phase(pb + PH_KV); phase(pb + PH_IN);
        phase(pb + PH_X1); phase(pb + PH_X2); phase(pb + PH_X3);
        phase(pb + PH_OUT); phase(pb + PH_RN1); phase(pb + PH_Q);
        phase(pb + PH_XA);
        phase(pb + PH_O); phase(pb + PH_RN2); phase(pb + PH_UP); phase(pb + PH_DOWN); phase(pb + PH_RN3);
    }
}
```

```cpp
#include <hip/hip_runtime.h>
#include <cstdint>
#include <cstdio>

namespace pg8 {
#define PG8_LAS __attribute__((address_space(3)))
typedef unsigned short bf16_t;
typedef short bf16x8 __attribute__((ext_vector_type(8)));
typedef float f32x4 __attribute__((ext_vector_type(4)));
typedef unsigned u32x4 __attribute__((ext_vector_type(4)));
constexpr int BM = 256, BK = 64, HALF = 128, HTB = HALF * BK * 2  , STAGE_BYTES = 8 * HTB, NXCD = 8, WGM = 8;

__host__ __device__ __forceinline__ int lds_byte(int r, int c) { const int st = (r >> 4) * 2 + (c >> 5), rr = r & 15, cc = c & 31, ob = rr * 64 + cc * 2; return st * 1024 + (ob ^ (((ob >> 9) & 1) << 5)); }
__host__ __device__ __forceinline__ void stage_rc(int b, int& R, int& C) { const int st = b / 1024, sb = b % 1024, swz = sb ^ (((sb >> 9) & 1) << 5); R = (st >> 1) * 16 + swz / 64; C = (st & 1) * 32 + (swz % 64) / 2; }
__host__ __device__ __forceinline__ int perm32(int rho) { const int n = rho >> 4, i = rho & 15; return 8 * (i >> 2) + 4 * n + (i & 3); }

struct Unit { int pm, pn, om, on, kind; };
struct Gemm { const bf16_t* A; const bf16_t* Bt; int M, N, K; };

struct StaticOrder {
    int nM, nN, nwg, G, c;
    __host__ __device__ void init(int M, int N, int G_, int c_) { nM = M / BM; nN = N / BM; nwg = nM * nN; G = G_; c = c_; }
    __host__ __device__ bool next(int i, Unit& u) const {
        const long L = (long)i * G + c; if (L >= nwg) return false;
        int wgid = (int)L; { const int q = nwg / NXCD, r = nwg % NXCD, xcd = wgid % NXCD, off = wgid / NXCD; wgid = (xcd < r ? xcd * (q + 1) : r * (q + 1) + (xcd - r) * q) + off; }
        const int nig = WGM * nN, gid = wgid / nig, fm = gid * WGM, gsz = (nM - fm) < WGM ? (nM - fm) : WGM;
        u.pm = fm + ((wgid % nig) % gsz); u.pn = (wgid % nig) / gsz; u.om = u.pm; u.on = u.pn; u.kind = 0; return true;
    }
    __device__ __forceinline__ void a_ready(const Unit&) const {}
    __device__ __forceinline__ void done(const Unit&) const {}
};
struct KvOrder {
    int G, c, NL, l0, memn_p0, memn_ps, xk_p0, xv_p0, w_ps;
    __host__ __device__ bool next(int i, Unit& u) const {
        const long L = (long)i * G + c; if (L >= (long)NL * 64) return false;
        const int l = (int)L / 64, r = (int)L % 64;
        if (r < 32) { const int pm = r & 3, pn = r >> 2; u.kind = 0; u.pm = memn_p0 + l * memn_ps + pm; u.pn = xk_p0 + l * w_ps + pn; u.om = (l0 + l) * 4 + pm; u.on = pn; }
        else { const int q = r - 32, pm = q & 7, pn = q >> 3; u.kind = 1; u.pm = xv_p0 + l * w_ps + pm; u.pn = memn_p0 + l * memn_ps + pn; u.om = (l0 + l) * 8 + pm; u.on = pn; }
        return true;
    }
    __device__ __forceinline__ void a_ready(const Unit&) const {}
    __device__ __forceinline__ void done(const Unit&) const {}
};

__device__ __forceinline__ unsigned cvt_pk_bf16(float lo, float hi) { unsigned r; asm volatile("v_cvt_pk_bf16_f32 %0, %1, %2" : "=v"(r) : "v"(lo), "v"(hi)); return r; }

template <int ACT  > struct EpiBf16 {
    static constexpr bool PERM = true, AFTER_DRAIN = false;
    bf16_t* O; int ldc; bf16_t* O1; int ldc1;
    __device__ __forceinline__ void operator()(const f32x4 (&acc)[2][2][4][2], const Unit& u, int wr, int wc, int fr, int fq) const {
        bf16_t* base = u.kind ? O1 : O; const int ld = u.kind ? ldc1 : ldc;
        const int row0 = u.om * BM + wr * 64 + fr, col0 = u.on * BM + wc * 32 + 8 * fq;
#pragma unroll
        for (int ai = 0; ai < 2; ++ai)
#pragma unroll
            for (int m = 0; m < 4; ++m) { bf16_t* rowp = base + (size_t)(row0 + ai * HALF + m * 16) * ld + col0;
#pragma unroll
                for (int bj = 0; bj < 2; ++bj) { f32x4 v0 = acc[ai][bj][m][0], v1 = acc[ai][bj][m][1];
                    if (ACT == 1) {
#pragma unroll
                        for (int j = 0; j < 4; ++j) { const float a = fmaxf(v0[j], 0.f), b = fmaxf(v1[j], 0.f); v0[j] = a * a; v1[j] = b * b; } }
                    u32x4 w; w.x = cvt_pk_bf16(v0[0], v0[1]); w.y = cvt_pk_bf16(v0[2], v0[3]); w.z = cvt_pk_bf16(v1[0], v1[1]); w.w = cvt_pk_bf16(v1[2], v1[3]);
                    *(u32x4*)(rowp + bj * HALF) = w; } }
    }
};
struct EpiF32 {
    static constexpr bool PERM = false, AFTER_DRAIN = false;
    float* C; int ldc;
    __device__ __forceinline__ void operator()(const f32x4 (&acc)[2][2][4][2], const Unit& u, int wr, int wc, int fr, int fq) const {
        const int row0 = u.om * BM + wr * 64 + fr, col0 = u.on * BM + wc * 32 + 4 * fq;
#pragma unroll
        for (int ai = 0; ai < 2; ++ai)
#pragma unroll
            for (int m = 0; m < 4; ++m) { float* rowp = C + (size_t)(row0 + ai * HALF + m * 16) * ldc + col0;
#pragma unroll
                for (int bj = 0; bj < 2; ++bj)
#pragma unroll
                    for (int n = 0; n < 2; ++n) *(f32x4*)(rowp + bj * HALF + n * 16) = acc[ai][bj][m][n]; }
    }
};

template <class Epi, class Sched, bool ALIGN_EPI = false, bool SP2 = false>
__device__ __forceinline__ void gemm_phase(PG8_LAS unsigned char* lds, const Gemm g, const Sched& S, const Epi& E) {
    int tid_ = threadIdx.x; asm volatile("" : "+v"(tid_));
    const int tid = tid_, wid = __builtin_amdgcn_readfirstlane(tid >> 6), lane = tid & 63, wr = wid >> 2, wc = wid & 3, fr = lane & 15, fq = lane >> 4;
    const int K = g.K, nt = K / BK;
    unsigned voffA[2], voffB[2];
#pragma unroll
    for (int i = 0; i < 2; ++i) { int R, C; stage_rc(tid * 16 + i * 8192, R, C); const int Rb = Epi::PERM ? ((R & ~31) + perm32(R & 31)) : R;
        voffA[i] = (unsigned)(R * K + C) * 2u; voffB[i] = (unsigned)(Rb * K + C) * 2u; }
    const size_t kstep = (size_t)(BK * 2);
    const size_t hstep = (size_t)HALF * K * 2;
    const size_t tstep = 2 * hstep;
    const unsigned ldsw = (unsigned)wid * 1024u;
    const int aoff = lds_byte(wr * 64 + fr, fq * 8), boff = lds_byte(wc * 32 + fr, fq * 8);
#define PG8_SA(b, h) (((b) * 2 + (h)) * HTB)
#define PG8_SB(b, h) ((4 + (b) * 2 + (h)) * HTB)
#define PG8_STAGE(bufoff, gbase, voff) do { _Pragma("unroll") for (int _i = 0; _i < 2; ++_i) \
        __builtin_amdgcn_global_load_lds((const unsigned*)((const char*)(gbase) + (voff)[_i]), (PG8_LAS unsigned*)(lds + (bufoff) + ldsw + _i * 8192), 16, 0, 0); } while (0)
#define PG8_LDA(dst, b, h) do { _Pragma("unroll") for (int m = 0; m < 4; ++m) _Pragma("unroll") for (int k = 0; k < 2; ++k) dst[m][k] = *(const PG8_LAS bf16x8*)(lds + PG8_SA(b, h) + aoff + m * 2048 + k * 1024); } while (0)
#define PG8_LDB(dst, b, h) do { _Pragma("unroll") for (int n = 0; n < 2; ++n) _Pragma("unroll") for (int k = 0; k < 2; ++k) dst[n][k] = *(const PG8_LAS bf16x8*)(lds + PG8_SB(b, h) + boff + n * 2048 + k * 1024); } while (0)
#define PG8_MMA(ai, bj, At, Bt) do { __builtin_amdgcn_s_setprio(1); _Pragma("unroll") for (int m = 0; m < 4; ++m) _Pragma("unroll") for (int n = 0; n < 2; ++n) _Pragma("unroll") for (int k = 0; k < 2; ++k) \
        acc[ai][bj][m][n] = __builtin_amdgcn_mfma_f32_16x16x32_bf16(Bt[n][k], At[m][k], acc[ai][bj][m][n], 0, 0, 0); __builtin_amdgcn_s_setprio(0); } while (0)
#define PG8_WAIT_V(n) asm volatile("s_waitcnt vmcnt(" #n ")" ::: "memory")
#define PG8_WAIT_L(n) asm volatile("s_waitcnt lgkmcnt(" #n ")" ::: "memory")
#define PG8_BAR __builtin_amdgcn_s_barrier()
#define PG8_SCHED __builtin_amdgcn_sched_barrier(0)
    Unit cur, nxt; int ui = 0;
    if (!S.next(0, cur)) return;
    f32x4 acc[2][2][4][2];
#pragma unroll
    for (int a = 0; a < 2; ++a)
#pragma unroll
        for (int b = 0; b < 2; ++b)
#pragma unroll
            for (int m = 0; m < 4; ++m)
#pragma unroll
                for (int n = 0; n < 2; ++n) acc[a][b][m][n] = (f32x4){0.f, 0.f, 0.f, 0.f};
    bf16x8 At[4][2], B0[2][2], B1[2][2];
    const char* cA = (const char*)g.A + (size_t)cur.pm * tstep; const char* cB = (const char*)g.Bt + (size_t)cur.pn * tstep;
    S.a_ready(cur);
    if constexpr (SP2) {
        PG8_STAGE(PG8_SB(0, 0), cB, voffB); PG8_STAGE(PG8_SB(0, 1), cB + hstep, voffB); PG8_STAGE(PG8_SA(0, 0), cA, voffA); PG8_STAGE(PG8_SA(0, 1), cA + hstep, voffA);
        if (wr == 1) PG8_BAR;
        PG8_WAIT_V(2); PG8_BAR;
        PG8_STAGE(PG8_SB(1, 0), cB + kstep, voffB); PG8_STAGE(PG8_SA(1, 0), cA + kstep, voffA); PG8_STAGE(PG8_SB(1, 1), cB + hstep + kstep, voffB);
        PG8_WAIT_V(6); PG8_BAR;
    } else {
        PG8_STAGE(PG8_SB(0, 0), cB, voffB); PG8_STAGE(PG8_SA(0, 0), cA, voffA); PG8_STAGE(PG8_SB(0, 1), cB + hstep, voffB); PG8_STAGE(PG8_SA(0, 1), cA + hstep, voffA);
        if (wr == 1) PG8_BAR;
        PG8_WAIT_V(4); PG8_BAR;
        PG8_STAGE(PG8_SB(1, 0), cB + kstep, voffB); PG8_STAGE(PG8_SA(1, 0), cA + kstep, voffA); PG8_STAGE(PG8_SB(1, 1), cB + hstep + kstep, voffB);
        PG8_WAIT_V(6); PG8_BAR;
    }
    for (;;) {
        const bool has_next = S.next(ui + 1, nxt);
        const char* nA = has_next ? (const char*)g.A + (size_t)nxt.pm * tstep : cA; const char* nB = has_next ? (const char*)g.Bt + (size_t)nxt.pn * tstep : cB;
        for (int t = 0; t < nt; t += 2) {
            const bool last = (t == nt - 2);
            const char* a1 = cA + (size_t)(t + 1) * kstep;
            const char* a2 = last ? nA : cA + (size_t)(t + 2) * kstep; const char* b2 = last ? nB : cB + (size_t)(t + 2) * kstep;
            const char* a3 = a2 + kstep; const char* b3 = b2 + kstep;
            if (last && has_next) S.a_ready(nxt);
            if constexpr (SP2) {
            PG8_LDB(B0, 0, 0); PG8_LDB(B1, 0, 1); PG8_SCHED; PG8_LDA(At, 0, 0); PG8_STAGE(PG8_SA(1, 1), a1 + hstep, voffA);
            PG8_WAIT_V(8); PG8_WAIT_L(0); PG8_BAR; PG8_MMA(0, 0, At, B0); PG8_MMA(0, 1, At, B1); PG8_BAR; PG8_SCHED;
            PG8_LDA(At, 0, 1); PG8_STAGE(PG8_SB(0, 0), b2, voffB); PG8_STAGE(PG8_SB(0, 1), b2 + hstep, voffB); PG8_STAGE(PG8_SA(0, 0), a2, voffA);
            PG8_WAIT_V(8); PG8_WAIT_L(0); PG8_BAR; PG8_MMA(1, 0, At, B0); PG8_MMA(1, 1, At, B1); PG8_BAR; PG8_SCHED;
            PG8_LDB(B0, 1, 0); PG8_LDB(B1, 1, 1); PG8_SCHED; PG8_LDA(At, 1, 0); PG8_STAGE(PG8_SA(0, 1), a2 + hstep, voffA);
            PG8_WAIT_V(8); PG8_WAIT_L(0); PG8_BAR; PG8_MMA(0, 0, At, B0); PG8_MMA(0, 1, At, B1); PG8_BAR; PG8_SCHED;
            PG8_LDA(At, 1, 1); PG8_STAGE(PG8_SB(1, 0), b3, voffB); PG8_STAGE(PG8_SB(1, 1), b3 + hstep, voffB); PG8_STAGE(PG8_SA(1, 0), a3, voffA);
            PG8_WAIT_V(8); PG8_WAIT_L(0); PG8_BAR; PG8_MMA(1, 0, At, B0); PG8_MMA(1, 1, At, B1); PG8_BAR; PG8_SCHED;
            } else {
            PG8_LDB(B0, 0, 0); PG8_SCHED; PG8_LDA(At, 0, 0); PG8_STAGE(PG8_SA(1, 1), a1 + hstep, voffA);
            PG8_WAIT_L(8); PG8_BAR; PG8_WAIT_L(0); PG8_MMA(0, 0, At, B0); PG8_BAR; PG8_SCHED;
            PG8_LDB(B1, 0, 1); PG8_STAGE(PG8_SB(0, 0), b2, voffB);
            PG8_BAR; PG8_WAIT_L(0); PG8_MMA(0, 1, At, B1); PG8_BAR;
            PG8_LDA(At, 0, 1); PG8_STAGE(PG8_SA(0, 0), a2, voffA);
            PG8_BAR; PG8_WAIT_L(0); PG8_MMA(1, 0, At, B0); PG8_BAR; PG8_SCHED;
            PG8_STAGE(PG8_SB(0, 1), b2 + hstep, voffB);
            PG8_WAIT_V(6); PG8_BAR; PG8_MMA(1, 1, At, B1); PG8_BAR;
            PG8_LDB(B0, 1, 0); PG8_SCHED; PG8_LDA(At, 1, 0); PG8_STAGE(PG8_SA(0, 1), a2 + hstep, voffA);
            PG8_WAIT_L(8); PG8_BAR; PG8_WAIT_L(0); PG8_MMA(0, 0, At, B0); PG8_BAR; PG8_SCHED;
            PG8_LDB(B1, 1, 1); PG8_STAGE(PG8_SB(1, 0), b3, voffB);
            PG8_BAR; PG8_WAIT_L(0); PG8_MMA(0, 1, At, B1); PG8_BAR;
            PG8_LDA(At, 1, 1); PG8_STAGE(PG8_SA(1, 0), a3, voffA);
            PG8_BAR; PG8_WAIT_L(0); PG8_MMA(1, 0, At, B0); PG8_BAR; PG8_SCHED;
            PG8_STAGE(PG8_SB(1, 1), b3 + hstep, voffB);
            PG8_WAIT_V(6); PG8_BAR; PG8_MMA(1, 1, At, B1); PG8_BAR;
            }
        }
        if constexpr (ALIGN_EPI) { if (wr == 0) PG8_BAR; }
        if constexpr (!Epi::AFTER_DRAIN) { E(acc, cur, wr, wc, fr, fq); S.done(cur); }
        if (!has_next) break;
#pragma unroll
        for (int a = 0; a < 2; ++a)
#pragma unroll
            for (int b = 0; b < 2; ++b)
#pragma unroll
                for (int m = 0; m < 4; ++m)
#pragma unroll
                    for (int n = 0; n < 2; ++n) acc[a][b][m][n] = (f32x4){0.f, 0.f, 0.f, 0.f};
        cur = nxt; cA = nA; cB = nB; ++ui;
        if constexpr (ALIGN_EPI) { if (wr == 1) PG8_BAR; }
    }
    PG8_WAIT_V(0);
    if constexpr (!ALIGN_EPI) { if (wr == 0) PG8_BAR; }
    PG8_BAR;
    if constexpr (Epi::AFTER_DRAIN) { E.fused(acc, cur, wr, wc, fr, fq, lds, wid, lane); S.done(cur); }
#undef PG8_SA
#undef PG8_SB
#undef PG8_STAGE
#undef PG8_LDA
#undef PG8_LDB
#undef PG8_MMA
#undef PG8_WAIT_V
#undef PG8_WAIT_L
#undef PG8_BAR
#undef PG8_SCHED
}
}

constexpr int D = 2048, BATCH = 4, SEQ = 2048, DEPTH = 4, M = BATCH * SEQ, MEM_LEN = 256, MM = BATCH * MEM_LEN;
constexpr int DIN = 4128, DFF = 8192;
constexpr int O_AQ = 0, O_AK = 1024, O_AV = 1280, O_BQ = 1536, O_BK = 1792, O_BV = 2048, O_BG = 2560, O_ZF = 3072, O_ZB = 3088, O_CX = 3104, O_CY = 3616;
constexpr int NPB = 4096;
constexpr int PB_CX = 3072, PB_CY = 3584;
constexpr float EPS = 1e-6f;
constexpr int NWAVES = 8, NTHREADS = 512;

#ifndef NWL
#define NWL 4
#endif
constexpr size_t MiB = 1u << 20;
constexpr size_t WS_CTL = 0, CTL_ZERO_BYTES = 1 * MiB;
constexpr size_t WS_W = 1 * MiB, WL_BYTES = 121 * MiB;
constexpr size_t WL_IN = 0, WL_OUT = 16 * MiB, WL_XQ = 24 * MiB, WL_XK = 32 * MiB, WL_XV = 40 * MiB, WL_XO = 48 * MiB, WL_UP = 56 * MiB, WL_DOWN = 88 * MiB, WL_Z = 120 * MiB, WL_LRUG = 120 * MiB + 256 * 1024;
constexpr size_t WS_XN = WS_W + NWL * WL_BYTES;
constexpr size_t WS_MEMN = WS_XN + 32 * MiB;
constexpr size_t WS_KX = WS_MEMN + 16 * MiB;
constexpr size_t WS_VT = WS_KX + 16 * MiB;
constexpr size_t WS_Y = WS_VT + 16 * MiB;
constexpr size_t WS_Z = WS_Y + 64 * MiB;
constexpr size_t WS_BIG = WS_Z + 1 * MiB;
constexpr size_t WS_PB = WS_BIG;
constexpr size_t WS_MIX = WS_BIG + 64 * MiB;
constexpr size_t WS_GLAU = WS_BIG + 96 * MiB;
constexpr size_t WS_MISC = WS_BIG + 128 * MiB;
constexpr size_t WS_H = WS_BIG;
constexpr size_t WS_Q = WS_BIG, WS_O = WS_BIG + 32 * MiB;
constexpr size_t WS_END = WS_BIG + 136 * MiB;
constexpr int CW_TMO = 0, CW_BAR = 4096;

constexpr int RING_OFF = 0, RING_BYTES = 131072, SCR_BYTES = 143360;
constexpr int LDSCTL_OFF = SCR_BYTES, MISC_OFF = LDSCTL_OFF + 320;
constexpr int LDS_BYTES = 147456;

#define GAS __attribute__((address_space(1)))
#define LAS __attribute__((address_space(3)))
typedef unsigned short bf16;
typedef unsigned v4u __attribute__((ext_vector_type(4)));
typedef unsigned v2u __attribute__((ext_vector_type(2)));
typedef float f32x4 __attribute__((ext_vector_type(4)));
typedef short bf16x8 __attribute__((ext_vector_type(8)));
typedef short s16x4 __attribute__((ext_vector_type(4)));
#define LDS_WAIT() asm volatile("s_waitcnt lgkmcnt(0)" ::: "memory")
#define VM_WAIT() asm volatile("s_waitcnt vmcnt(0)" ::: "memory")
__device__ __forceinline__ unsigned f2bf(float f) { unsigned u = __builtin_bit_cast(unsigned, f); return (u + 0x7fffu + ((u >> 16) & 1u)) >> 16; }
__device__ __forceinline__ unsigned pk2(float lo, float hi) { return f2bf(lo) | (f2bf(hi) << 16); }
__device__ __forceinline__ float bf2f(unsigned short b) { return __builtin_bit_cast(float, (unsigned)b << 16); }
__device__ __forceinline__ float wave_sum(float v) {
#pragma unroll
    for (int o = 1; o < 64; o <<= 1) v += __shfl_xor(v, o);
    return v;
}
__device__ __forceinline__ float wave_max(float v) {
#pragma unroll
    for (int o = 1; o < 64; o <<= 1) v = fmaxf(v, __shfl_xor(v, o));
    return v;
}
__device__ __forceinline__ float sigmoidf_(float x) { return 1.f / (1.f + expf(-x)); }
__device__ __forceinline__ float softplusf_(float x) { return fmaxf(x, 0.f) + log1pf(expf(-fabsf(x))); }
__device__ __forceinline__ float gelu_tanh(float x) { return 0.5f * x * (1.f + tanhf(0.7978845608028654f * (x + 0.044715f * x * x * x))); }
__device__ __forceinline__ int t5_bucket(int rel) {
    const int ret = rel > 0 ? 16 : 0; const int n = rel < 0 ? -rel : rel;
    if (n < 8) return ret + n;
    int k = 0; while (k < 7 && (64 << (k + 1)) <= n * n) ++k;
    return ret + 8 + k;
}

struct Frame {
    LAS unsigned char* lds;
    int tid, lane, wave, G, bx;
};

__device__ __forceinline__ void p0_transpose_item(const float* W, int K, int N, int c0, bf16* WT, int r0, int nblk, LAS float* scr, int item, int lane) {
    const int kb = item / nblk, nb = item % nblk, k0 = 64 * kb, n0 = 32 * nb;
#pragma unroll 8
    for (int i = 0; i < 32; ++i) { const int kk = 2 * i + (lane >> 5); scr[kk * 33 + (lane & 31)] = W[(size_t)(k0 + kk) * N + c0 + n0 + (lane & 31)]; }
    LDS_WAIT(); asm volatile("" ::: "memory");
    const int c = lane & 7;
#pragma unroll
    for (int j = 0; j < 4; ++j) { const int n = (lane >> 3) + 8 * j; const LAS float* s = scr + (8 * c) * 33 + n;
        v4u o; o.x = pk2(s[0 * 33], s[1 * 33]); o.y = pk2(s[2 * 33], s[3 * 33]); o.z = pk2(s[4 * 33], s[5 * 33]); o.w = pk2(s[6 * 33], s[7 * 33]);
        *(GAS v4u*)(WT + (size_t)(r0 + n0 + n) * K + k0 + 8 * c) = o; }
    LDS_WAIT(); asm volatile("" ::: "memory");
}
struct ConvSeg { const float* W; int K, N, c0, ncols; bf16* WT; int r0; };
__device__ __forceinline__ int seg_items(const ConvSeg& s) { return (s.K / 64) * (s.ncols / 32); }

__device__ __forceinline__ void norm_row(int lane, const float* src, const float* g, bf16* xn, float* copy_dst) {
    const GAS f32x4* xr = (const GAS f32x4*)src + lane; const GAS f32x4* gr = (const GAS f32x4*)g + lane;
    f32x4 v[8]; float s = 0.f;
#pragma unroll
    for (int j = 0; j < 8; ++j) { v[j] = xr[64 * j]; s += (v[j].x * v[j].x + v[j].y * v[j].y) + (v[j].z * v[j].z + v[j].w * v[j].w); }
    const float r = rsqrtf(wave_sum(s) * (1.f / D) + EPS);
    GAS v2u* o8 = (GAS v2u*)xn + lane;
#pragma unroll
    for (int j = 0; j < 8; ++j) { const f32x4 gg = gr[64 * j]; v2u w; w.x = pk2(v[j].x * r * gg.x, v[j].y * r * gg.y); w.y = pk2(v[j].z * r * gg.z, v[j].w * r * gg.w); o8[64 * j] = w;
        if (copy_dst) ((GAS f32x4*)copy_dst + lane)[64 * j] = v[j]; }
}
__device__ __forceinline__ void resid_norm_row(int lane, float* x, const float* y, const float* g1, const float* g2, bf16* xn) {
    const GAS f32x4* yr = (const GAS f32x4*)y + lane; GAS f32x4* xr = (GAS f32x4*)x + lane;
    const GAS f32x4* g1r = (const GAS f32x4*)g1 + lane;
    f32x4 v[8]; float s = 0.f;
#pragma unroll
    for (int j = 0; j < 8; ++j) { v[j] = yr[64 * j]; s += (v[j].x * v[j].x + v[j].y * v[j].y) + (v[j].z * v[j].z + v[j].w * v[j].w); }
    const float r = rsqrtf(wave_sum(s) * (1.f / D) + EPS);
    float s2 = 0.f;
#pragma unroll
    for (int j = 0; j < 8; ++j) { const f32x4 gg = g1r[64 * j]; const f32x4 xo = xr[64 * j];
        v[j].x = xo.x + v[j].x * r * gg.x; v[j].y = xo.y + v[j].y * r * gg.y; v[j].z = xo.z + v[j].z * r * gg.z; v[j].w = xo.w + v[j].w * r * gg.w;
        xr[64 * j] = v[j]; s2 += (v[j].x * v[j].x + v[j].y * v[j].y) + (v[j].z * v[j].z + v[j].w * v[j].w); }
    if (g2) {
        const float r2 = rsqrtf(wave_sum(s2) * (1.f / D) + EPS);
        const GAS f32x4* g2r = (const GAS f32x4*)g2 + lane; GAS v2u* o8 = (GAS v2u*)xn + lane;
#pragma unroll
        for (int j = 0; j < 8; ++j) { const f32x4 gg = g2r[64 * j]; v2u w; w.x = pk2(v[j].x * r2 * gg.x, v[j].y * r2 * gg.y); w.y = pk2(v[j].z * r2 * gg.z, v[j].w * r2 * gg.w); o8[64 * j] = w; }
    }
}
__device__ __forceinline__ void zgemm(const Frame& F, const bf16* XN, const bf16* WZ, float* Z) {
    const int lane = F.lane, g = lane >> 4, c = lane & 15;
    for (int tile = F.wave * F.G + F.bx; tile < (M / 16) * 2; tile += NWAVES * F.G) {
        const int rt = tile >> 1, ct = tile & 1;
        const bf16* ap = XN + (size_t)(rt * 16 + c) * D + g * 8;
        const bf16* bp = WZ + (size_t)(ct * 16 + c) * D + g * 8;
        f32x4 acc = {0.f, 0.f, 0.f, 0.f};
#pragma unroll 8
        for (int ks = 0; ks < D / 32; ++ks) { const bf16x8 a = *(const GAS bf16x8*)(ap + ks * 32); const bf16x8 b = *(const GAS bf16x8*)(bp + ks * 32); acc = __builtin_amdgcn_mfma_f32_16x16x32_bf16(a, b, acc, 0, 0, 0); }
#pragma unroll
        for (int r = 0; r < 4; ++r) Z[(size_t)(rt * 16 + 4 * g + r) * 32 + ct * 16 + c] = acc[r];
    }
}

#define XB_TMO      128
#define XB_XCNT(j)  (256  + 64 * (j))
#define XB_XSUB(j)  (1280 + 64 * (j))
#define XB_XGEN(j)  (2304 + 64 * (j))
#define XB_TOP      3328
#define XB_TOPGEN   3392
#define XCD_BAR_WORDS 3456
#define XB_SPIN_CAP (1u << 18)
#define LAS __attribute__((address_space(3)))

__device__ __forceinline__ unsigned xb_ld(unsigned* p)              { return __hip_atomic_load(p, __ATOMIC_RELAXED, __HIP_MEMORY_SCOPE_AGENT); }
__device__ __forceinline__ unsigned xb_add(unsigned* p, unsigned v) { return __hip_atomic_fetch_add(p, v, __ATOMIC_RELAXED, __HIP_MEMORY_SCOPE_AGENT); }
__device__ __forceinline__ unsigned xb_xcc_id() { return (unsigned)__builtin_amdgcn_s_getreg((3 << 11) | 20) & 0xFu; }
#define XB_SPIN(cond, bar) do { unsigned _sp = 0; while (cond) { __builtin_amdgcn_s_sleep(1); \
    if ((++_sp & 255u) == 0u) { if (xb_ld(&(bar)[XB_TMO])) break; if (_sp > XB_SPIN_CAP) { atomicAdd(&(bar)[XB_TMO], 1u); break; } } } } while (0)

struct XcdBarrier {
    unsigned* bar; unsigned x;
    volatile LAS unsigned* st;
};

__device__ __forceinline__ XcdBarrier xcd_barrier_post(unsigned* bar, volatile LAS unsigned* st) {
    XcdBarrier b; b.bar = bar; b.x = xb_xcc_id(); b.st = st;
    if (threadIdx.x == 0) (void)xb_add(&bar[XB_XCNT(b.x)], 1u);
    return b;
}
__device__ __forceinline__ void xcd_barrier_complete(unsigned* bar, unsigned x, unsigned& nloc, unsigned& nx) {
    const unsigned G = gridDim.x * gridDim.y * gridDim.z;
    unsigned sum, cnt, mine, sp = 0u;
    for (;;) {
        sum = 0u; cnt = 0u; mine = 0u;
#pragma unroll
        for (unsigned j = 0; j < 16; ++j) { const unsigned c = xb_ld(&bar[XB_XCNT(j)]); sum += c; cnt += (c > 0u) ? 1u : 0u; mine = (j == x) ? c : mine; }
        if (sum == G) break;
        __builtin_amdgcn_s_sleep(1);
        if ((++sp & 255u) == 0u) { if (xb_ld(&bar[XB_TMO])) break; if (sp > XB_SPIN_CAP) { atomicAdd(&bar[XB_TMO], 1u); break; } }
    }
    nloc = mine > 0u ? mine : 1u; nx = cnt > 0u ? cnt : 1u;
}

__device__ __forceinline__ void xcd_barrier(const XcdBarrier& b) {
    asm volatile("s_waitcnt vmcnt(0)" ::: "memory");
    __syncthreads();
    if (threadIdx.x == 0) {
        unsigned* bar = b.bar;
        __builtin_amdgcn_s_waitcnt(0);
        unsigned nloc = b.st[0], nx = b.st[1];
        if (nloc == 0u) { xcd_barrier_complete(bar, b.x, nloc, nx); b.st[0] = nloc; b.st[1] = nx; }
        const unsigned old = xb_add(&bar[XB_XSUB(b.x)], 1u);
        const unsigned gen = old / nloc;
        if (old + 1u == (gen + 1u) * nloc) {
            __builtin_amdgcn_fence(__ATOMIC_RELEASE, "agent");
            asm volatile("s_waitcnt vmcnt(0)" ::: "memory");
            const unsigned og = xb_add(&bar[XB_TOP], 1u);
            const unsigned tg = og / nx;
            if (og + 1u == (tg + 1u) * nx) xb_add(&bar[XB_TOPGEN], 1u);
            else XB_SPIN(xb_ld(&bar[XB_TOPGEN]) == tg, bar);
            __builtin_amdgcn_fence(__ATOMIC_ACQUIRE, "agent");
            xb_add(&bar[XB_XGEN(b.x)], 1u);
            asm volatile("s_waitcnt vmcnt(0)" ::: "memory");
        } else {
            XB_SPIN(xb_ld(&bar[XB_XGEN(b.x)]) == gen, bar);
            __builtin_amdgcn_fence(__ATOMIC_ACQUIRE, "agent");
            asm volatile("s_waitcnt vmcnt(0)" ::: "memory");
        }
    }
    __syncthreads();
}
constexpr size_t MISC_DEC = 3 * MiB;
constexpr int GL_Z = 0, GL_TF = 8192, GL_TB = 10240, GL_VI = 12288, GL_A = 29696, GL_B = 38912, GL_P = 48128, GL_SI = 57344, GL_OF = 74752;
__device__ __forceinline__ bf16x8 tr_frag(LAS unsigned char* p, int stride4) {
    const s16x4 lo = __builtin_amdgcn_ds_read_tr16_b64_v4i16((LAS s16x4*)p);
    const s16x4 hi = __builtin_amdgcn_ds_read_tr16_b64_v4i16((LAS s16x4*)(p + stride4));
    return __builtin_shufflevector(lo, hi, 0, 1, 2, 3, 4, 5, 6, 7);
}
__device__ __forceinline__ void gla_gates(const Frame& F, const float* __restrict__ Zrow, const float* __restrict__ w2f, const float* __restrict__ b2f, const float* __restrict__ w2b, const float* __restrict__ b2b,
                                          int h, float (&cf)[8], float (&cb)[8], float& totf, float& totb) {
    LAS float* ZS = (LAS float*)(F.lds + GL_Z); LAS float* TF = (LAS float*)(F.lds + GL_TF); LAS float* TB = (LAS float*)(F.lds + GL_TB);
    const int tid = F.tid, k = tid & 63, tg = F.wave;
    ((LAS f32x4*)ZS)[tid] = ((const GAS f32x4*)Zrow)[tid];
    float wf[16], wb[16];
#pragma unroll
    for (int r = 0; r < 16; ++r) { wf[r] = w2f[r * 256 + h * 64 + k]; wb[r] = w2b[r * 256 + h * 64 + k]; }
    const float bfv = b2f[h * 64 + k], bbv = b2b[h * 64 + k];
    __syncthreads();
#pragma unroll
    for (int i = 0; i < 8; ++i) { const int t = tg * 8 + i; float af = bfv, ab = bbv;
#pragma unroll
        for (int r = 0; r < 16; ++r) { af += ZS[t * 32 + r] * wf[r]; ab += ZS[t * 32 + 16 + r] * wb[r]; }
        cf[i] = -softplusf_(-af) * 0.0625f; cb[i] = -softplusf_(-ab) * 0.0625f; }
#pragma unroll
    for (int i = 1; i < 8; ++i) cf[i] += cf[i - 1];
#pragma unroll
    for (int i = 6; i >= 0; --i) cb[i] += cb[i + 1];
    TF[tg * 64 + k] = cf[7]; TB[tg * 64 + k] = cb[0];
    __syncthreads();
    float ef = 0.f, eb = 0.f; totf = 0.f; totb = 0.f;
#pragma unroll
    for (int g2 = 0; g2 < 8; ++g2) { const float a = TF[g2 * 64 + k], bq = TB[g2 * 64 + k]; totf += a; totb += bq; ef += (g2 < tg) ? a : 0.f; eb += (g2 > tg) ? bq : 0.f; }
#pragma unroll
    for (int i = 0; i < 8; ++i) { cf[i] += ef; cb[i] += eb; }
}
__device__ __forceinline__ void gla_stage_v(const Frame& F, const bf16* __restrict__ PB, size_t m0, int h) {
    LAS unsigned char* VI = F.lds + GL_VI;
#pragma unroll
    for (int i = 0; i < 2; ++i) { const int ch = F.tid + NTHREADS * i, row = ch >> 4, col = ch & 15;
        *(LAS v4u*)(VI + row * 272 + col * 16) = *(const GAS v4u*)(PB + (m0 + row) * NPB + O_BV + h * 128 + col * 8); }
}
__device__ __forceinline__ void gla_u_phase(const Frame& F, const bf16* __restrict__ PB, const float* __restrict__ Z, const float* __restrict__ w2f, const float* __restrict__ b2f,
                                            const float* __restrict__ w2b, const float* __restrict__ b2b, float* __restrict__ U, float* __restrict__ DEC) {
    const int tid = F.tid, lane = F.lane, g = lane >> 4, c = lane & 15, w = F.wave, k = tid & 63, tg = F.wave;
    LAS unsigned char* VI = F.lds + GL_VI;
    for (int unit = F.bx; unit < BATCH * 4 * 32; unit += F.G) {
        const int b = unit >> 7, h = (unit >> 5) & 3, n = unit & 31;
        const size_t m0 = (size_t)b * SEQ + n * 64;
        __syncthreads();
        float cf[8], cb[8], totf, totb;
        gla_gates(F, Z + m0 * 32, w2f, b2f, w2b, b2b, h, cf, cb, totf, totb);
#pragma unroll
        for (int i = 0; i < 8; ++i) { const int t = tg * 8 + i; const float kk = bf2f(PB[(m0 + t) * NPB + O_BK + h * 64 + k]);
            *(LAS unsigned short*)(F.lds + GL_A + t * 144 + k * 2) = (unsigned short)f2bf(kk * __expf(totf - cf[i]));
            *(LAS unsigned short*)(F.lds + GL_B + t * 144 + k * 2) = (unsigned short)f2bf(kk * __expf(totb - cb[i])); }
        const size_t ub = (size_t)(b * 4 + h) * 32 + n;
        if (tg == 0) { DEC[ub * 64 + k] = __expf(totf); DEC[(ub + 512) * 64 + k] = __expf(totb); }
        gla_stage_v(F, PB, m0, h);
        __syncthreads();
        bf16x8 vf[2];
#pragma unroll
        for (int ts = 0; ts < 2; ++ts) vf[ts] = tr_frag(VI + (32 * ts + 8 * g + (c >> 2)) * 272 + (16 * w + 4 * (c & 3)) * 2, 4 * 272);
#pragma unroll
        for (int d = 0; d < 2; ++d) {
            LAS unsigned char* KS = F.lds + (d ? GL_B : GL_A);
            float* Ud = U + (ub + (size_t)d * 512) * 8192;
#pragma unroll
            for (int kt = 0; kt < 4; ++kt) {
                f32x4 acc = {0.f, 0.f, 0.f, 0.f};
#pragma unroll
                for (int ts = 0; ts < 2; ++ts) { const bf16x8 af = tr_frag(KS + (32 * ts + 8 * g + (c >> 2)) * 144 + (16 * kt + 4 * (c & 3)) * 2, 4 * 144);
                    acc = __builtin_amdgcn_mfma_f32_16x16x32_bf16(af, vf[ts], acc, 0, 0, 0); }
#pragma unroll
                for (int r = 0; r < 4; ++r) Ud[(16 * kt + 4 * g + r) * 128 + 16 * w + c] = acc[r];
            }
        }
    }
}
__device__ __forceinline__ void gla_state_phase(const Frame& F, float* __restrict__ U, const float* __restrict__ DEC) {
    const int id = F.bx * NTHREADS + F.tid;
    if (id < 32 * 64 * 32) {
        const int seq = id >> 11, k = (id >> 5) & 63, e4 = id & 31, d = seq >> 4;
        const int bh = seq & 15;
        f32x4 S = {0.f, 0.f, 0.f, 0.f};
#pragma unroll 4
        for (int st = 0; st < 32; ++st) { const int n = d ? 31 - st : st; const size_t idx = (size_t)d * 512 + bh * 32 + n;
            GAS f32x4* p = (GAS f32x4*)(U + idx * 8192 + k * 128) + e4; const float dec = DEC[idx * 64 + k];
            const f32x4 u = *p; *p = S; S = S * dec + u; }
    }
}
__device__ __forceinline__ void gla_o_phase(const Frame& F, const bf16* __restrict__ PB, const float* __restrict__ Z, const float* __restrict__ w2f, const float* __restrict__ b2f,
                                            const float* __restrict__ w2b, const float* __restrict__ b2b, const float* __restrict__ U, const float* __restrict__ gn, bf16* __restrict__ MIX) {
    const int tid = F.tid, lane = F.lane, g = lane >> 4, c = lane & 15, w = F.wave, k = tid & 63, tg = F.wave;
    LAS unsigned char* VI = F.lds + GL_VI; LAS unsigned char* QI = F.lds + GL_A; LAS unsigned char* KI = F.lds + GL_B; LAS unsigned char* PI = F.lds + GL_P; LAS unsigned char* SI = F.lds + GL_SI;
    LAS float* OF = (LAS float*)(F.lds + GL_OF);
    for (int unit = F.bx; unit < BATCH * 4 * 32; unit += F.G) {
        const int b = unit >> 7, h = (unit >> 5) & 3, n = unit & 31;
        const size_t m0 = (size_t)b * SEQ + n * 64;
        __syncthreads();
        float cf[8], cb[8], totf, totb;
        gla_gates(F, Z + m0 * 32, w2f, b2f, w2b, b2b, h, cf, cb, totf, totb);
        float qv[8], kv[8];
#pragma unroll
        for (int i = 0; i < 8; ++i) { const int t = tg * 8 + i; qv[i] = bf2f(PB[(m0 + t) * NPB + O_BQ + h * 64 + k]) * 0.125f; kv[i] = bf2f(PB[(m0 + t) * NPB + O_BK + h * 64 + k]); }
        gla_stage_v(F, PB, m0, h);
        const size_t ub = (size_t)(b * 4 + h) * 32 + n;
        f32x4 acc[4];
#pragma unroll
        for (int tt = 0; tt < 4; ++tt) acc[tt] = (f32x4){0.f, 0.f, 0.f, 0.f};
#pragma unroll
        for (int d = 0; d < 2; ++d) {
            __syncthreads();
#pragma unroll
            for (int i = 0; i < 8; ++i) { const int t = tg * 8 + i; const float cc = d ? cb[i] : cf[i];
                *(LAS unsigned short*)(QI + t * 144 + k * 2) = (unsigned short)f2bf(qv[i] * __expf(cc));
                *(LAS unsigned short*)(KI + t * 144 + k * 2) = (unsigned short)f2bf(kv[i] * __expf(-cc)); }
            {   const float* Sd = U + (ub + (size_t)d * 512) * 8192; const int row = tid >> 3, c16 = (tid & 7) * 16;
                const GAS f32x4* sp = (const GAS f32x4*)(Sd + row * 128 + c16);
                const f32x4 s0 = sp[0], s1 = sp[1], s2 = sp[2], s3 = sp[3];
                v4u o0, o1; o0.x = pk2(s0.x, s0.y); o0.y = pk2(s0.z, s0.w); o0.z = pk2(s1.x, s1.y); o0.w = pk2(s1.z, s1.w); o1.x = pk2(s2.x, s2.y); o1.y = pk2(s2.z, s2.w); o1.z = pk2(s3.x, s3.y); o1.w = pk2(s3.z, s3.w);
                *(LAS v4u*)(SI + row * 272 + c16 * 2) = o0; *(LAS v4u*)(SI + row * 272 + c16 * 2 + 16) = o1; }
            __syncthreads();
#pragma unroll
            for (int q2 = 0; q2 < 2; ++q2) {
                const int id = 2 * w + q2, tt = id >> 2, jt = id & 3;
                f32x4 p = {0.f, 0.f, 0.f, 0.f};
#pragma unroll
                for (int ks = 0; ks < 2; ++ks) { const bf16x8 a = *(const LAS bf16x8*)(QI + (16 * tt + c) * 144 + ks * 64 + g * 16), bb = *(const LAS bf16x8*)(KI + (16 * jt + c) * 144 + ks * 64 + g * 16);
                    p = __builtin_amdgcn_mfma_f32_16x16x32_bf16(a, bb, p, 0, 0, 0); }
#pragma unroll
                for (int r = 0; r < 4; ++r) { const int t = 16 * tt + 4 * g + r, j = 16 * jt + c; const bool keep = d ? (j > t) : (j <= t);
                    *(LAS unsigned short*)(PI + t * 144 + j * 2) = (unsigned short)f2bf(keep ? p[r] : 0.f); }
            }
            __syncthreads();
            bf16x8 vf[2], sf[2];
#pragma unroll
            for (int s2 = 0; s2 < 2; ++s2) { vf[s2] = tr_frag(VI + (32 * s2 + 8 * g + (c >> 2)) * 272 + (16 * w + 4 * (c & 3)) * 2, 4 * 272);
                sf[s2] = tr_frag(SI + (32 * s2 + 8 * g + (c >> 2)) * 272 + (16 * w + 4 * (c & 3)) * 2, 4 * 272); }
#pragma unroll
            for (int tt = 0; tt < 4; ++tt)
#pragma unroll
                for (int s2 = 0; s2 < 2; ++s2) { const bf16x8 pa = *(const LAS bf16x8*)(PI + (16 * tt + c) * 144 + s2 * 64 + g * 16), qa = *(const LAS bf16x8*)(QI + (16 * tt + c) * 144 + s2 * 64 + g * 16);
                    acc[tt] = __builtin_amdgcn_mfma_f32_16x16x32_bf16(pa, vf[s2], acc[tt], 0, 0, 0);
                    acc[tt] = __builtin_amdgcn_mfma_f32_16x16x32_bf16(qa, sf[s2], acc[tt], 0, 0, 0); }
        }
#pragma unroll
        for (int tt = 0; tt < 4; ++tt)
#pragma unroll
            for (int r = 0; r < 4; ++r) OF[(16 * tt + 4 * g + r) * 132 + 16 * w + c] = acc[tt][r];
        __syncthreads();
        {   const int t = tid >> 3, c16 = (tid & 7) * 16;
            float o[16]; float ss = 0.f;
#pragma unroll
            for (int e = 0; e < 16; ++e) { o[e] = OF[t * 132 + c16 + e]; ss += o[e] * o[e]; }
            ss += __shfl_xor(ss, 1); ss += __shfl_xor(ss, 2); ss += __shfl_xor(ss, 4);
            const float rs = rsqrtf(ss * (1.f / 128.f) + EPS);
            const v4u g0 = *(const GAS v4u*)(PB + (m0 + t) * NPB + O_BG + h * 128 + c16), g1 = *(const GAS v4u*)(PB + (m0 + t) * NPB + O_BG + h * 128 + c16 + 8);
            const unsigned gg[8] = {g0.x, g0.y, g0.z, g0.w, g1.x, g1.y, g1.z, g1.w};
            unsigned oo[8];
#pragma unroll
            for (int e = 0; e < 8; ++e) { const float ga = bf2f((unsigned short)(gg[e] & 0xffffu)), gb = bf2f((unsigned short)(gg[e] >> 16));
                oo[e] = pk2(o[2 * e] * rs * gn[h * 128 + c16 + 2 * e] * (ga * sigmoidf_(ga)), o[2 * e + 1] * rs * gn[h * 128 + c16 + 2 * e + 1] * (gb * sigmoidf_(gb))); }
            v4u o0, o1; o0.x = oo[0]; o0.y = oo[1]; o0.z = oo[2]; o0.w = oo[3]; o1.x = oo[4]; o1.y = oo[5]; o1.z = oo[6]; o1.w = oo[7];
            *(GAS v4u*)(MIX + (m0 + t) * D + 1024 + h * 128 + c16) = o0; *(GAS v4u*)(MIX + (m0 + t) * D + 1024 + h * 128 + c16 + 8) = o1;
        }
    }
}
constexpr int LRU_LD = 132;
constexpr size_t MISC_CAR_A = 0, MISC_CAR_H = 1 * MiB, MISC_CIN = 2 * MiB;
template <bool FINAL>
__device__ __forceinline__ void lru_phase(const Frame& F, const bf16* __restrict__ PB, const bf16* __restrict__ LRUG, const float* __restrict__ cw, const float* __restrict__ cb,
                                          const float* __restrict__ ba, const float* __restrict__ bx, const float* __restrict__ lam, float* __restrict__ CAR_A, float* __restrict__ CAR_H,
                                          const float* __restrict__ CIN, bf16* __restrict__ MIX) {
    LAS float* XF = (LAS float*)(F.lds);
    LAS float* AS = (LAS float*)(F.lds + 33792);
    LAS float* US = (LAS float*)(F.lds + 2 * 33792);
    LAS unsigned char* XB = F.lds + 3 * 33792;
    const int tid = F.tid, lane = F.lane, g4 = lane >> 4, c = lane & 15, w = F.wave;
    for (int unit = F.bx; unit < BATCH * 32 * 4; unit += F.G) {
        const int b = unit >> 7, n = (unit >> 2) & 31, g = unit & 3, t0 = n * 64;
        __syncthreads();
        {
            const int ch2 = tid & 63, tb = (tid >> 6) * 8, ch = g * 128 + 2 * ch2;
            float w0[4], w1[4];
#pragma unroll
            for (int j = 0; j < 4; ++j) { w0[j] = cw[j * 512 + ch]; w1[j] = cw[j * 512 + ch + 1]; }
            const float b0 = cb[ch], b1 = cb[ch + 1];
            float x0[11], x1[11];
#pragma unroll
            for (int i = 0; i < 11; ++i) { const int t = t0 + tb - 2 + i; unsigned v = 0u; if (t >= 0 && t < SEQ) v = *(const GAS unsigned*)(PB + (size_t)(b * SEQ + t) * NPB + PB_CX + ch);
                x0[i] = bf2f((unsigned short)(v & 0xffffu)); x1[i] = bf2f((unsigned short)(v >> 16)); }
#pragma unroll
            for (int r = 0; r < 8; ++r) { float y0 = b0, y1 = b1;
#pragma unroll
                for (int j = 0; j < 4; ++j) { y0 += x0[r + j] * w0[j]; y1 += x1[r + j] * w1[j]; }
                XF[(tb + r) * LRU_LD + 2 * ch2] = y0; XF[(tb + r) * LRU_LD + 2 * ch2 + 1] = y1;
                *(LAS unsigned*)(XB + (tb + r) * 272 + ch2 * 4) = pk2(y0, y1); }
        }
        __syncthreads();
#pragma unroll
        for (int s = 0; s < 2; ++s) {
            {
                const int j = 16 * w + c, chj = g * 128 + j;
                const bf16* wap = LRUG + ((size_t)((s * 2 + 0) * 4 + g) * 128 + j) * 128 + g4 * 8;
                const bf16* wxp = LRUG + ((size_t)((s * 2 + 1) * 4 + g) * 128 + j) * 128 + g4 * 8;
                bf16x8 waf[4], wxf[4];
#pragma unroll
                for (int ks = 0; ks < 4; ++ks) { waf[ks] = *(const GAS bf16x8*)(wap + ks * 32); wxf[ks] = *(const GAS bf16x8*)(wxp + ks * 32); }
                const float bav = ba[s * 512 + chj], bxv = bx[s * 512 + chj], sp = softplusf_(-lam[s * 512 + chj]);
                LAS float* U = s == 0 ? US : XF;
#pragma unroll
                for (int tt = 0; tt < 4; ++tt) {
                    f32x4 ga = {0.f, 0.f, 0.f, 0.f}, gx = {0.f, 0.f, 0.f, 0.f};
#pragma unroll
                    for (int ks = 0; ks < 4; ++ks) { const bf16x8 xf = *(const LAS bf16x8*)(XB + (16 * tt + c) * 272 + ks * 64 + g4 * 16);
                        ga = __builtin_amdgcn_mfma_f32_16x16x32_bf16(xf, waf[ks], ga, 0, 0, 0); gx = __builtin_amdgcn_mfma_f32_16x16x32_bf16(xf, wxf[ks], gx, 0, 0, 0); }
#pragma unroll
                    for (int r = 0; r < 4; ++r) { const int t = 16 * tt + 4 * g4 + r;
                        const float rg = sigmoidf_(ga[r] + bav), ig = sigmoidf_(gx[r] + bxv);
                        const float la = -8.f * rg * sp, a = __expf(la);
                        const float xv = XF[t * LRU_LD + j];
                        AS[t * LRU_LD + j] = a; U[t * LRU_LD + j] = sqrtf(-expm1f(2.f * la)) * (ig * xv); }
                }
            }
            __syncthreads();
            if (tid < 128) {
                LAS float* U = s == 0 ? US : XF;
                const size_t ci = ((size_t)((s * BATCH + b) * 32 + n)) * 512 + g * 128 + tid;
                float h = FINAL ? CIN[ci] : 0.f, ap = 1.f;
#pragma unroll 8
                for (int st = 0; st < 64; ++st) { const int t = s ? 63 - st : st; const float a = AS[t * LRU_LD + tid], u = U[t * LRU_LD + tid]; h = a * h + u; ap *= a;
                    if (FINAL) { if (s == 0) US[t * LRU_LD + tid] = h; else US[t * LRU_LD + tid] += h; } }
                if (!FINAL) { CAR_A[ci] = ap; CAR_H[ci] = h; }
            }
            __syncthreads();
        }
        if (FINAL) {
            const int t = tid >> 3, c16 = (tid & 7) * 16;
            const size_t m = (size_t)b * SEQ + t0 + t;
            const v4u y0 = *(const GAS v4u*)(PB + m * NPB + PB_CY + g * 128 + c16), y1 = *(const GAS v4u*)(PB + m * NPB + PB_CY + g * 128 + c16 + 8);
            const unsigned yy[8] = {y0.x, y0.y, y0.z, y0.w, y1.x, y1.y, y1.z, y1.w};
            unsigned oo[8];
#pragma unroll
            for (int e = 0; e < 8; ++e) { const float ya = bf2f((unsigned short)(yy[e] & 0xffffu)), yb = bf2f((unsigned short)(yy[e] >> 16));
                oo[e] = pk2(US[t * LRU_LD + c16 + 2 * e] * gelu_tanh(ya), US[t * LRU_LD + c16 + 2 * e + 1] * gelu_tanh(yb)); }
            v4u o0, o1; o0.x = oo[0]; o0.y = oo[1]; o0.z = oo[2]; o0.w = oo[3]; o1.x = oo[4]; o1.y = oo[5]; o1.z = oo[6]; o1.w = oo[7];
            *(GAS v4u*)(MIX + m * D + 1536 + g * 128 + c16) = o0; *(GAS v4u*)(MIX + m * D + 1536 + g * 128 + c16 + 8) = o1;
        }
    }
}
__device__ __forceinline__ void lru_carry_phase(const Frame& F, const float* __restrict__ CAR_A, const float* __restrict__ CAR_H, float* __restrict__ CIN) {
    const int id = F.bx * NTHREADS + F.tid;
    if (id < 2 * BATCH * 512) {
        const int s = id >> 11, b = (id >> 9) & 3, ch = id & 511;
        float h = 0.f;
        for (int st = 0; st < 32; ++st) { const int n = s ? 31 - st : st; const size_t ci = ((size_t)((s * BATCH + b) * 32 + n)) * 512 + ch;
            CIN[ci] = h; h = CAR_A[ci] * h + CAR_H[ci]; }
    }
}
__device__ __forceinline__ void wattn_phase(const Frame& F, const bf16* __restrict__ PB, const float* __restrict__ rel_bias, const float* __restrict__ sink, bf16* __restrict__ MIX) {
    LAS unsigned char* KS = F.lds;
    LAS float* btab = (LAS float*)(F.lds + 400 * 272);
    const int lane = F.lane, g = lane >> 4, c = lane & 15, w = F.wave, tid = F.tid;
    for (int unit = F.bx; unit < BATCH * 8 * (SEQ / 128); unit += F.G) {
        const int b = unit >> 7, hq = (unit >> 4) & 7, qb = unit & 15, hkv = hq >> 2;
        const int q0 = qb * 128;
        __syncthreads();
        for (int ch = tid; ch < 400 * 16; ch += NTHREADS) { const int i = ch >> 4, col = ch & 15; int j = q0 - 128 + i; j = j < 0 ? 0 : (j > SEQ - 1 ? SEQ - 1 : j);
            const v4u v = *(const GAS v4u*)(PB + (size_t)(b * SEQ + j) * NPB + O_AK + hkv * 128 + col * 8);
            *(LAS v4u*)(KS + i * 272 + col * 16) = v; }
        if (tid < 304) { const int rel = tid - 143; btab[tid] = (rel >= -128 && rel <= 128) ? rel_bias[t5_bucket(rel) * 8 + hq] : 0.f; }
        __syncthreads();
        f32x4 S[18];
#pragma unroll
        for (int kt = 0; kt < 18; ++kt) S[kt] = (f32x4){0.f, 0.f, 0.f, 0.f};
        const bf16* qrow = PB + (size_t)(b * SEQ + q0 + 16 * w + c) * NPB + O_AQ + hq * 128 + g * 8;
#pragma unroll
        for (int ks = 0; ks < 4; ++ks) {
            const bf16x8 qf = *(const GAS bf16x8*)(qrow + ks * 32);
#pragma unroll
            for (int kt = 0; kt < 18; ++kt) { const bf16x8 kf = *(const LAS bf16x8*)(KS + (16 * w + 16 * kt + c) * 272 + ks * 64 + g * 16); S[kt] = __builtin_amdgcn_mfma_f32_16x16x32_bf16(kf, qf, S[kt], 0, 0, 0);
                if (kt == 8 || kt == 17) __builtin_amdgcn_sched_barrier(0); }
        }
        const float snk = sink[hq];
        float mx = snk;
#pragma unroll
        for (int kt = 0; kt < 18; ++kt)
#pragma unroll
            for (int r = 0; r < 4; ++r) {
                const int rel = 16 * kt + 4 * g + r - 128 - c;
                const int j = q0 + 16 * w + c + rel;
                const bool ok = (rel >= -128) && (rel <= 128) && (j >= 0) && (j < SEQ);
                const float bias = btab[(4 * g - c + 15) + 16 * kt + r];
                const float s = ok ? S[kt][r] * 0.08838834764831845f + bias : -1e30f;
                S[kt][r] = s; mx = fmaxf(mx, s);
                if (r == 3 && (kt & 1)) __builtin_amdgcn_sched_barrier(0);
            }
        mx = fmaxf(mx, __shfl_xor(mx, 16)); mx = fmaxf(mx, __shfl_xor(mx, 32));
        float sum = 0.f;
#pragma unroll
        for (int kt = 0; kt < 18; ++kt)
#pragma unroll
            for (int r = 0; r < 4; ++r) { const float p = (S[kt][r] > -1e29f) ? __builtin_amdgcn_exp2f((S[kt][r] - mx) * 1.4426950408889634f) : 0.f; S[kt][r] = p; sum += p; }
        sum += __shfl_xor(sum, 16); sum += __shfl_xor(sum, 32);
        sum += __builtin_amdgcn_exp2f((snk - mx) * 1.4426950408889634f);
        const float inv = 1.f / sum;
        bf16x8 pf[9];
#pragma unroll
        for (int s = 0; s < 9; ++s) { v4u t; t.x = pk2(S[2 * s][0] * inv, S[2 * s][1] * inv); t.y = pk2(S[2 * s][2] * inv, S[2 * s][3] * inv); t.z = pk2(S[2 * s + 1][0] * inv, S[2 * s + 1][1] * inv); t.w = pk2(S[2 * s + 1][2] * inv, S[2 * s + 1][3] * inv);
            pf[s] = __builtin_bit_cast(bf16x8, t); }
        __syncthreads();
        for (int ch = tid; ch < 400 * 16; ch += NTHREADS) { const int i = ch >> 4, col = ch & 15; int j = q0 - 128 + i; j = j < 0 ? 0 : (j > SEQ - 1 ? SEQ - 1 : j);
            const v4u v = *(const GAS v4u*)(PB + (size_t)(b * SEQ + j) * NPB + O_AV + hkv * 128 + col * 8);
            *(LAS v4u*)(KS + i * 272 + col * 16) = v; }
        __syncthreads();
        for (int dt = 0; dt < 8; ++dt) {
            f32x4 acc = {0.f, 0.f, 0.f, 0.f};
#pragma unroll
            for (int s = 0; s < 9; ++s) {
                LAS unsigned char* vp = KS + (16 * w + 32 * s + 4 * g + (c >> 2)) * 272 + (16 * dt + 4 * (c & 3)) * 2;
                const s16x4 lo = __builtin_amdgcn_ds_read_tr16_b64_v4i16((LAS s16x4*)vp);
                const s16x4 hi = __builtin_amdgcn_ds_read_tr16_b64_v4i16((LAS s16x4*)(vp + 16 * 272));
                const bf16x8 vf = __builtin_shufflevector(lo, hi, 0, 1, 2, 3, 4, 5, 6, 7);
                acc = __builtin_amdgcn_mfma_f32_16x16x32_bf16(vf, pf[s], acc, 0, 0, 0);
            }
            v2u o; o.x = pk2(acc[0], acc[1]); o.y = pk2(acc[2], acc[3]);
            *(GAS v2u*)(MIX + (size_t)(b * SEQ + q0 + 16 * w + c) * D + hq * 128 + dt * 16 + 4 * g) = o;
        }
    }
}
__device__ __forceinline__ void xattn_phase(const Frame& F, const bf16* __restrict__ Q, const bf16* __restrict__ KX, const bf16* __restrict__ VT, bf16* __restrict__ O) {
    LAS unsigned char* KS = F.lds;
    const int lane = F.lane, g = lane >> 4, c = lane & 15, w = F.wave, tid = F.tid;
    for (int unit = F.bx; unit < BATCH * 4 * (SEQ / 128); unit += F.G) {
        const int b = unit >> 6, h = (unit >> 4) & 3, qb = unit & 15;
        const int m0 = b * SEQ + qb * 128 + w * 16;
        f32x4 S[16];
#pragma unroll
        for (int kt = 0; kt < 16; ++kt) S[kt] = (f32x4){0.f, 0.f, 0.f, 0.f};
        const bf16* qrow = Q + (size_t)(m0 + c) * D + h * 512 + g * 8;
        for (int dc = 0; dc < 4; ++dc) {
            __syncthreads();
#pragma unroll
            for (int i = 0; i < 8; ++i) { const int row = (tid >> 4) + 32 * i, col = tid & 15;
                const v4u v = *(const GAS v4u*)(KX + (size_t)(b * MEM_LEN + row) * D + h * 512 + dc * 128 + col * 8);
                *(LAS v4u*)(KS + row * 272 + col * 16) = v; }
            __syncthreads();
#pragma unroll
            for (int ks = 0; ks < 4; ++ks) {
                const bf16x8 qf = *(const GAS bf16x8*)(qrow + dc * 128 + ks * 32);
#pragma unroll
                for (int kt = 0; kt < 16; ++kt) { const bf16x8 kf = *(const LAS bf16x8*)(KS + (16 * kt + c) * 272 + ks * 64 + g * 16); S[kt] = __builtin_amdgcn_mfma_f32_16x16x32_bf16(kf, qf, S[kt], 0, 0, 0); }
            }
        }
        float mx = -3.0e38f;
#pragma unroll
        for (int kt = 0; kt < 16; ++kt)
#pragma unroll
            for (int r = 0; r < 4; ++r) mx = fmaxf(mx, S[kt][r]);
        mx = fmaxf(mx, __shfl_xor(mx, 16)); mx = fmaxf(mx, __shfl_xor(mx, 32));
        const float sc2 = 0.044194173824159216f * 1.4426950408889634f;
        float sum = 0.f;
#pragma unroll
        for (int kt = 0; kt < 16; ++kt)
#pragma unroll
            for (int r = 0; r < 4; ++r) { const float p = __builtin_amdgcn_exp2f((S[kt][r] - mx) * sc2); S[kt][r] = p; sum += p; }
        sum += __shfl_xor(sum, 16); sum += __shfl_xor(sum, 32);
        const float inv = 1.f / sum;
        bf16x8 pf[8];
#pragma unroll
        for (int s = 0; s < 8; ++s) { v4u t; t.x = pk2(S[2 * s][0] * inv, S[2 * s][1] * inv); t.y = pk2(S[2 * s][2] * inv, S[2 * s][3] * inv); t.z = pk2(S[2 * s + 1][0] * inv, S[2 * s + 1][1] * inv); t.w = pk2(S[2 * s + 1][2] * inv, S[2 * s + 1][3] * inv);
            pf[s] = __builtin_bit_cast(bf16x8, t); }
        for (int dc = 0; dc < 4; ++dc) {
            __syncthreads();
#pragma unroll
            for (int i = 0; i < 8; ++i) { const int row = (tid >> 5) + 16 * i, col = tid & 31;
                const v4u v = *(const GAS v4u*)(VT + (size_t)(h * 512 + dc * 128 + row) * MM + b * MEM_LEN + col * 8);
                *(LAS v4u*)(KS + row * 528 + col * 16) = v; }
            __syncthreads();
            for (int dt = 0; dt < 8; ++dt) {
                f32x4 acc = {0.f, 0.f, 0.f, 0.f};
#pragma unroll
                for (int s = 0; s < 8; ++s) {
                    const LAS unsigned char* vp = KS + (16 * dt + c) * 528 + 64 * s + 8 * g;
                    const v2u lo = *(const LAS v2u*)vp, hi = *(const LAS v2u*)(vp + 32);
                    v4u t; t.x = lo.x; t.y = lo.y; t.z = hi.x; t.w = hi.y;
                    acc = __builtin_amdgcn_mfma_f32_16x16x32_bf16(__builtin_bit_cast(bf16x8, t), pf[s], acc, 0, 0, 0);
                }
                v2u o; o.x = pk2(acc[0], acc[1]); o.y = pk2(acc[2], acc[3]);
                *(GAS v2u*)(O + (size_t)(m0 + c) * D + h * 512 + dc * 128 + dt * 16 + 4 * g) = o;
            }
        }
    }
}
constexpr int NPL = 15;
enum Phase { PH_CONV = 0, PH_KV, PH_IN, PH_X1, PH_X2, PH_X3, PH_OUT, PH_RN1, PH_Q, PH_XA, PH_O, PH_RN2, PH_UP, PH_DOWN, PH_RN3 };
#define CAS __attribute__((address_space(4)))
struct Args { const float* in[31]; float* out; unsigned char* ws; int ph_lo, ph_hi, li, pad; };

__global__ void __launch_bounds__(NTHREADS, 2) fwd(Args args) {
    extern __shared__ __attribute__((aligned(16))) unsigned char lds[];
    Frame F;
    F.lds = (LAS unsigned char*)lds;
    F.tid = threadIdx.x; F.lane = F.tid & 63; F.wave = __builtin_amdgcn_readfirstlane(F.tid >> 6);
    F.G = gridDim.x; F.bx = blockIdx.x;
    unsigned char* ws = args.ws;
    const int lo = args.ph_lo, hi = args.ph_hi;
    for (int u = F.tid; u < (LDS_BYTES - LDSCTL_OFF) / 4; u += NTHREADS) ((LAS unsigned*)(F.lds + LDSCTL_OFF))[u] = 0u;
    __syncthreads();
    XcdBarrier bar; bar.bar = (unsigned*)(ws + WS_CTL) + CW_BAR; bar.x = 0; bar.st = nullptr;
    const bool one_launch = (hi - lo) > 1;
    if (one_launch) bar = xcd_barrier_post((unsigned*)(ws + WS_CTL) + CW_BAR, (volatile LAS unsigned*)(F.lds + MISC_OFF) + 8);
#define SEAM(k) do { if (one_launch && (k) + 1 < hi) xcd_barrier(bar); } while (0)
#define IN(k) (lo <= (k) && (k) < hi)
#define PHASE_BEGIN() const CAS Args* ka_ = (const CAS Args*)__builtin_amdgcn_kernarg_segment_ptr(); asm volatile("" : "+s"(ka_)); int tz_ = threadIdx.x; asm volatile("" : "+v"(tz_)); F.tid = tz_; F.lane = tz_ & 63; F.wave = __builtin_amdgcn_readfirstlane(tz_ >> 6); const int gw = F.bx * NWAVES + F.wave; (void)gw
    const int NGW = F.G * NWAVES;
    float* X = args.out;
    bf16* XN = (bf16*)(ws + WS_XN);
    float* Y = (float*)(ws + WS_Y);

    for (int l = 0; l < DEPTH; ++l) {
        const int pb = l * NPL;
        unsigned char* wl = ws + WS_W + (size_t)(l % NWL) * WL_BYTES;
        bf16* MEMN = (bf16*)(ws + WS_MEMN) + (size_t)l * MM * D;
        if (IN(pb + PH_CONV)) { PHASE_BEGIN();
            LAS float* scr = (LAS float*)(F.lds + RING_OFF + F.wave * 16384);
            const int lc0 = (NWL == 1) ? l : (l == 0 ? 0 : DEPTH), lc1 = (NWL == 1) ? l + 1 : DEPTH;
            for (int lc = lc0; lc < lc1; ++lc) {
                unsigned char* wb = ws + WS_W + (size_t)(lc % NWL) * WL_BYTES;
                const ConvSeg segs[10] = {
                    {ka_->in[3] + (size_t)lc * D * DIN, D, DIN, 0, 3072, (bf16*)(wb + WL_IN), 0},
                    {ka_->in[3] + (size_t)lc * D * DIN, D, DIN, 3072, 32, (bf16*)(wb + WL_Z), 0},
                    {ka_->in[3] + (size_t)lc * D * DIN, D, DIN, 3104, 1024, (bf16*)(wb + WL_IN), 3072},
                    {ka_->in[4] + (size_t)lc * D * D, D, D, 0, D, (bf16*)(wb + WL_OUT), 0},
                    {ka_->in[18] + (size_t)lc * D * D, D, D, 0, D, (bf16*)(wb + WL_XQ), 0},
                    {ka_->in[19] + (size_t)lc * D * D, D, D, 0, D, (bf16*)(wb + WL_XK), 0},
                    {ka_->in[20] + (size_t)lc * D * D, D, D, 0, D, (bf16*)(wb + WL_XV), 0},
                    {ka_->in[21] + (size_t)lc * D * D, D, D, 0, D, (bf16*)(wb + WL_XO), 0},
                    {ka_->in[22] + (size_t)lc * D * DFF, D, DFF, 0, DFF, (bf16*)(wb + WL_UP), 0},
                    {ka_->in[23] + (size_t)lc * DFF * D, DFF, D, 0, D, (bf16*)(wb + WL_DOWN), 0}};
                int total = 0;
#pragma unroll
                for (int s = 0; s < 10; ++s) total += seg_items(segs[s]);
                for (int it = gw; it < total; it += NGW) {
                    int r = it;
#pragma unroll
                    for (int s = 0; s < 10; ++s) { const int n = seg_items(segs[s]);
                        if (r >= 0 && r < n) p0_transpose_item(segs[s].W, segs[s].K, segs[s].N, segs[s].c0, segs[s].WT, segs[s].r0, segs[s].ncols / 32, scr, r, F.lane);
                        r -= n; }
                }
            }
            for (int lc = lc0; lc < lc1; ++lc) {
                bf16* lg = (bf16*)(ws + WS_W + (size_t)(lc % NWL) * WL_BYTES + WL_LRUG);
                for (int it = gw; it < 16 * 8; it += NGW) { const int mi = it >> 3, gate = mi >> 3, s = (mi >> 2) & 1, gg = mi & 3;
                    p0_transpose_item(ka_->in[gate ? 15 : 13] + ((size_t)lc * 8 + s * 4 + gg) * 16384, 128, 128, 0, lg + (size_t)((s * 2 + gate) * 4 + gg) * 16384, 0, 4, scr, it & 7, F.lane); }
            }
            if (l == 0) for (int m = gw; m < M; m += NGW) norm_row(F.lane, ka_->in[0] + (size_t)m * D, ka_->in[24], XN + (size_t)m * D, X + (size_t)m * D);
            for (int lc = lc0; lc < lc1; ++lc)
                for (int m = gw; m < MM; m += NGW) norm_row(F.lane, ka_->in[1] + (size_t)m * D, ka_->in[26] + (size_t)lc * D, (bf16*)(ws + WS_MEMN) + ((size_t)lc * MM + m) * D, nullptr);
        }
        if (l == 0 || NWL == 1) SEAM(pb + PH_CONV);
        if (IN(pb + PH_KV)) { PHASE_BEGIN();
            const int lc0 = (NWL == 1) ? l : (l == 0 ? 0 : DEPTH), lc1 = (NWL == 1) ? l + 1 : DEPTH;
            if (lc1 > lc0) {
                const bf16* base = (const bf16*)(ws + WS_W);
                pg8::Gemm g{base, base, 0, 0, D};
                pg8::KvOrder S; S.G = F.G; S.c = F.bx; S.NL = lc1 - lc0; S.l0 = lc0;
                S.memn_p0 = (int)((WS_MEMN - WS_W) / MiB) + 4 * lc0; S.memn_ps = 4;
                S.xk_p0 = (int)(((size_t)(lc0 % NWL) * WL_BYTES + WL_XK) / MiB); S.xv_p0 = (int)(((size_t)(lc0 % NWL) * WL_BYTES + WL_XV) / MiB); S.w_ps = (int)(WL_BYTES / MiB);
                pg8::EpiBf16<0> E{(bf16*)(ws + WS_KX), D, (bf16*)(ws + WS_VT), MM};
                pg8::gemm_phase<pg8::EpiBf16<0>, pg8::KvOrder, true, true>(F.lds + RING_OFF, g, S, E);
            }
        }
        if (l == 0 || NWL == 1) SEAM(pb + PH_KV);
        if (IN(pb + PH_IN)) { PHASE_BEGIN();
            pg8::Gemm g{XN, (const bf16*)(wl + WL_IN), M, NPB, D}; pg8::StaticOrder S; S.init(M, NPB, F.G, F.bx);
            pg8::EpiBf16<0> E{(bf16*)(ws + WS_PB), NPB, nullptr, 0};
            pg8::gemm_phase<pg8::EpiBf16<0>, pg8::StaticOrder, true, true>(F.lds + RING_OFF, g, S, E);
            zgemm(F, XN, (const bf16*)(wl + WL_Z), (float*)(ws + WS_Z));
        }
        SEAM(pb + PH_IN);
        if (IN(pb + PH_X1)) { PHASE_BEGIN();
            gla_u_phase(F, (const bf16*)(ws + WS_PB), (const float*)(ws + WS_Z), ka_->in[6] + (size_t)l * 4096, ka_->in[7] + (size_t)l * 256, ka_->in[8] + (size_t)l * 4096, ka_->in[9] + (size_t)l * 256,
                        (float*)(ws + WS_GLAU), (float*)(ws + WS_MISC + MISC_DEC));
            lru_phase<false>(F, (const bf16*)(ws + WS_PB), (const bf16*)(wl + WL_LRUG), ka_->in[11] + (size_t)l * 2048, ka_->in[12] + (size_t)l * 512, ka_->in[14] + (size_t)l * 1024, ka_->in[16] + (size_t)l * 1024, ka_->in[17] + (size_t)l * 1024,
                             (float*)(ws + WS_MISC + MISC_CAR_A), (float*)(ws + WS_MISC + MISC_CAR_H), nullptr, nullptr); }
        SEAM(pb + PH_X1);
        if (IN(pb + PH_X2)) { PHASE_BEGIN();
            gla_state_phase(F, (float*)(ws + WS_GLAU), (const float*)(ws + WS_MISC + MISC_DEC));
            lru_carry_phase(F, (const float*)(ws + WS_MISC + MISC_CAR_A), (const float*)(ws + WS_MISC + MISC_CAR_H), (float*)(ws + WS_MISC + MISC_CIN));
            wattn_phase(F, (const bf16*)(ws + WS_PB), ka_->in[2], ka_->in[5] + l * 8, (bf16*)(ws + WS_MIX)); }
        SEAM(pb + PH_X2);
        if (IN(pb + PH_X3)) { PHASE_BEGIN();
            gla_o_phase(F, (const bf16*)(ws + WS_PB), (const float*)(ws + WS_Z), ka_->in[6] + (size_t)l * 4096, ka_->in[7] + (size_t)l * 256, ka_->in[8] + (size_t)l * 4096, ka_->in[9] + (size_t)l * 256,
                        (const float*)(ws + WS_GLAU), ka_->in[10] + (size_t)l * 512, (bf16*)(ws + WS_MIX));
            lru_phase<true>(F, (const bf16*)(ws + WS_PB), (const bf16*)(wl + WL_LRUG), ka_->in[11] + (size_t)l * 2048, ka_->in[12] + (size_t)l * 512, ka_->in[14] + (size_t)l * 1024, ka_->in[16] + (size_t)l * 1024, ka_->in[17] + (size_t)l * 1024,
                            nullptr, nullptr, (const float*)(ws + WS_MISC + MISC_CIN), (bf16*)(ws + WS_MIX)); }
        SEAM(pb + PH_X3);
        if (IN(pb + PH_OUT)) { PHASE_BEGIN();
            pg8::Gemm g{(const bf16*)(ws + WS_MIX), (const bf16*)(wl + WL_OUT), M, D, D}; pg8::StaticOrder S; S.init(M, D, F.G, F.bx);
            pg8::EpiF32 E{Y, D};
            pg8::gemm_phase<pg8::EpiF32, pg8::StaticOrder, true, true>(F.lds + RING_OFF, g, S, E);
        }
        SEAM(pb + PH_OUT);
        if (IN(pb + PH_RN1)) { PHASE_BEGIN(); for (int m = gw; m < M; m += NGW) resid_norm_row(F.lane, X + (size_t)m * D, Y + (size_t)m * D, ka_->in[25] + (size_t)l * D, ka_->in[27] + (size_t)l * D, XN + (size_t)m * D); }
        SEAM(pb + PH_RN1);
        if (IN(pb + PH_Q)) { PHASE_BEGIN();
            pg8::Gemm g{XN, (const bf16*)(wl + WL_XQ), M, D, D}; pg8::StaticOrder S; S.init(M, D, F.G, F.bx);
            pg8::EpiBf16<0> E{(bf16*)(ws + WS_Q), D, nullptr, 0};
            pg8::gemm_phase<pg8::EpiBf16<0>, pg8::StaticOrder, true, true>(F.lds + RING_OFF, g, S, E);
        }
        SEAM(pb + PH_Q);
        if (IN(pb + PH_XA)) { PHASE_BEGIN(); xattn_phase(F, (const bf16*)(ws + WS_Q), (const bf16*)(ws + WS_KX) + (size_t)l * MM * D, (const bf16*)(ws + WS_VT) + (size_t)l * D * MM, (bf16*)(ws + WS_O)); }
        SEAM(pb + PH_XA);
        if (IN(pb + PH_O)) { PHASE_BEGIN();
            pg8::Gemm g{(const bf16*)(ws + WS_O), (const bf16*)(wl + WL_XO), M, D, D}; pg8::StaticOrder S; S.init(M, D, F.G, F.bx);
            pg8::EpiF32 E{Y, D};
            pg8::gemm_phase<pg8::EpiF32, pg8::StaticOrder, true, true>(F.lds + RING_OFF, g, S, E);
        }
        SEAM(pb + PH_O);
        if (IN(pb + PH_RN2)) { PHASE_BEGIN(); for (int m = gw; m < M; m += NGW) resid_norm_row(F.lane, X + (size_t)m * D, Y + (size_t)m * D, ka_->in[28] + (size_t)l * D, ka_->in[29] + (size_t)l * D, XN + (size_t)m * D); }
        SEAM(pb + PH_RN2);
        if (IN(pb + PH_UP)) { PHASE_BEGIN();
            pg8::Gemm g{XN, (const bf16*)(wl + WL_UP), M, DFF, D}; pg8::StaticOrder S; S.init(M, DFF, F.G, F.bx);
            pg8::EpiBf16<1> E{(bf16*)(ws + WS_H), DFF, nullptr, 0};
            pg8::gemm_phase<pg8::EpiBf16<1>, pg8::StaticOrder, true, true>(F.lds + RING_OFF, g, S, E);
        }
        SEAM(pb + PH_UP);
        if (IN(pb + PH_DOWN)) { PHASE_BEGIN();
            pg8::Gemm g{(const bf16*)(ws + WS_H), (const bf16*)(wl + WL_DOWN), M, D, DFF}; pg8::StaticOrder S; S.init(M, D, F.G, F.bx);
            pg8::EpiF32 E{Y, D};
            pg8::gemm_phase<pg8::EpiF32, pg8::StaticOrder, true, true>(F.lds + RING_OFF, g, S, E);
        }
        SEAM(pb + PH_DOWN);
        if (IN(pb + PH_RN3)) { PHASE_BEGIN(); for (int m = gw; m < M; m += NGW) resid_norm_row(F.lane, X + (size_t)m * D, Y + (size_t)m * D, ka_->in[30] + (size_t)l * D, (l + 1 < DEPTH) ? ka_->in[24] + (size_t)(l + 1) * D : nullptr, XN + (size_t)m * D); }
        SEAM(pb + PH_RN3);
    }
#undef IN
#undef SEAM
}
extern "C" void kernel_launch(void* const* d_in, const int* in_sizes, int n_in, void* d_out, int out_size, void* d_ws, size_t ws_size, hipStream_t stream) {
    static int grid = 0;
    if (grid == 0) {
        int dev = 0, cus = 0;
        if (n_in != 31 || out_size != M * D || ws_size < WS_END) { fprintf(stderr, "kernel_launch: built for 31 inputs, %d outputs, >= %zu bytes of workspace; got %d, %d, %zu\n", M * D, (size_t)WS_END, n_in, out_size, ws_size); grid = -1; return; }
        if (hipGetDevice(&dev) != hipSuccess || hipDeviceGetAttribute(&cus, hipDeviceAttributeMultiprocessorCount, dev) != hipSuccess) { fprintf(stderr, "kernel_launch: device query failed\n"); grid = -1; return; }
        if (hipFuncSetAttribute((const void*)fwd, hipFuncAttributeMaxDynamicSharedMemorySize, LDS_BYTES) != hipSuccess) { fprintf(stderr, "kernel_launch: hipFuncSetAttribute failed\n"); grid = -1; return; }
        int per_cu = 0;
        if (hipOccupancyMaxActiveBlocksPerMultiprocessor(&per_cu, (const void*)fwd, NTHREADS, LDS_BYTES) != hipSuccess || per_cu < 1) { fprintf(stderr, "kernel_launch: occupancy query reports %d workgroups per CU\n", per_cu); (void)hipGetLastError(); }
        grid = cus;
    }
    if (grid < 0) return;
    unsigned char* ws = (unsigned char*)d_ws;
    (void)hipMemsetAsync(ws + WS_CTL, 0, CTL_ZERO_BYTES, stream);
    Args a{};
    for (int i = 0; i < 31; ++i) a.in[i] = (const float*)d_in[i];
    a.out = (float*)d_out; a.ws = ws;
#if defined(MK_PER_PHASE) && MK_PER_PHASE
    for (int p = 0; p < DEPTH * NPL; ++p) { if (NWL == 4 && p >= NPL && (p % NPL) < 2) continue; a.ph_lo = p; a.ph_hi = p + 1; hipLaunchKernelGGL(fwd, dim3(grid), dim3(NTHREADS), LDS_BYTES, stream, a); }
#else
    a.ph_lo = 0; a.ph_hi = DEPTH * NPL;
    hipLaunchKernelGGL(fwd, dim3(grid), dim3(NTHREADS), LDS_BYTES, stream, a);
    const hipError_t le = hipPeekAtLastError();
    if (le != hipSuccess) fprintf(stderr, "kernel_launch: launch failed: %s\n", hipGetErrorName(le));
#endif
}
```

```cpp
#include <hip/hip_runtime.h>
#include <cstdint>
#include <cstdio>

namespace pg8 {
#define PG8_LAS __attribute__((address_space(3)))
typedef unsigned short bf16_t;
typedef short bf16x8 __attribute__((ext_vector_type(8)));
typedef float f32x4 __attribute__((ext_vector_type(4)));
typedef unsigned u32x4 __attribute__((ext_vector_type(4)));
constexpr int BM = 256, BK = 64, HALF = 128, HTB = HALF * BK * 2  , STAGE_BYTES = 8 * HTB, NXCD = 8, WGM = 8;

__host__ __device__ __forceinline__ int lds_byte(int r, int c) { const int st = (r >> 4) * 2 + (c >> 5), rr = r & 15, cc = c & 31, ob = rr * 64 + cc * 2; return st * 1024 + (ob ^ (((ob >> 9) & 1) << 5)); }
__host__ __device__ __forceinline__ void stage_rc(int b, int& R, int& C) { const int st = b / 1024, sb = b % 1024, swz = sb ^ (((sb >> 9) & 1) << 5); R = (st >> 1) * 16 + swz / 64; C = (st & 1) * 32 + (swz % 64) / 2; }
__host__ __device__ __forceinline__ int perm32(int rho) { const int n = rho >> 4, i = rho & 15; return 8 * (i >> 2) + 4 * n + (i & 3); }

struct Unit { int pm, pn, om, on, kind; };
struct Gemm { const bf16_t* A; const bf16_t* Bt; int M, N, K; };

struct StaticOrder {
    int nM, nN, nwg, G, c;
    __host__ __device__ void init(int M, int N, int G_, int c_) { nM = M / BM; nN = N / BM; nwg = nM * nN; G = G_; c = c_; }
    __host__ __device__ bool next(int i, Unit& u) const {
        const long L = (long)i * G + c; if (L >= nwg) return false;
        int wgid = (int)L; { const int q = nwg / NXCD, r = nwg % NXCD, xcd = wgid % NXCD, off = wgid / NXCD; wgid = (xcd < r ? xcd * (q + 1) : r * (q + 1) + (xcd - r) * q) + off; }
        const int nig = WGM * nN, gid = wgid / nig, fm = gid * WGM, gsz = (nM - fm) < WGM ? (nM - fm) : WGM;
        u.pm = fm + ((wgid % nig) % gsz); u.pn = (wgid % nig) / gsz; u.om = u.pm; u.on = u.pn; u.kind = 0; return true;
    }
    __device__ __forceinline__ void a_ready(const Unit&) const {}
    __device__ __forceinline__ void done(const Unit&) const {}
};
struct KvOrder {
    int G, c, NL, l0, memn_p0, memn_ps, xk_p0, xv_p0, w_ps;
    __host__ __device__ bool next(int i, Unit& u) const {
        const long L = (long)i * G + c; if (L >= (long)NL * 64) return false;
        const int l = (int)L / 64, r = (int)L % 64;
        if (r < 32) { const int pm = r & 3, pn = r >> 2; u.kind = 0; u.pm = memn_p0 + l * memn_ps + pm; u.pn = xk_p0 + l * w_ps + pn; u.om = (l0 + l) * 4 + pm; u.on = pn; }
        else { const int q = r - 32, pm = q & 7, pn = q >> 3; u.kind = 1; u.pm = xv_p0 + l * w_ps + pm; u.pn = memn_p0 + l * memn_ps + pn; u.om = (l0 + l) * 8 + pm; u.on = pn; }
        return true;
    }
    __device__ __forceinline__ void a_ready(const Unit&) const {}
    __device__ __forceinline__ void done(const Unit&) const {}
};

__device__ __forceinline__ unsigned cvt_pk_bf16(float lo, float hi) { unsigned r; asm volatile("v_cvt_pk_bf16_f32 %0, %1, %2" : "=v"(r) : "v"(lo), "v"(hi)); return r; }

template <int ACT  > struct EpiBf16 {
    static constexpr bool PERM = true, AFTER_DRAIN = false;
    bf16_t* O; int ldc; bf16_t* O1; int ldc1; const float* rs;
    __device__ __forceinline__ void operator()(const f32x4 (&acc)[2][2][4][2], const Unit& u, int wr, int wc, int fr, int fq) const {
        bf16_t* base = u.kind ? O1 : O; const int ld = u.kind ? ldc1 : ldc;
        const int row0 = u.om * BM + wr * 64 + fr, col0 = u.on * BM + wc * 32 + 8 * fq;
#pragma unroll
        for (int ai = 0; ai < 2; ++ai)
#pragma unroll
            for (int m = 0; m < 4; ++m) { bf16_t* rowp = base + (size_t)(row0 + ai * HALF + m * 16) * ld + col0;
                const float sc = rs ? rs[row0 + ai * HALF + m * 16] : 1.f;
#pragma unroll
                for (int bj = 0; bj < 2; ++bj) { f32x4 v0 = acc[ai][bj][m][0] * sc, v1 = acc[ai][bj][m][1] * sc;
                    if (ACT == 1) {
#pragma unroll
                        for (int j = 0; j < 4; ++j) { const float a = fmaxf(v0[j], 0.f), b = fmaxf(v1[j], 0.f); v0[j] = a * a; v1[j] = b * b; } }
                    u32x4 w; w.x = cvt_pk_bf16(v0[0], v0[1]); w.y = cvt_pk_bf16(v0[2], v0[3]); w.z = cvt_pk_bf16(v1[0], v1[1]); w.w = cvt_pk_bf16(v1[2], v1[3]);
                    *(u32x4*)(rowp + bj * HALF) = w; } }
    }
};
struct EpiF32 {
    static constexpr bool PERM = false, AFTER_DRAIN = false;
    float* C; int ldc;
    __device__ __forceinline__ void operator()(const f32x4 (&acc)[2][2][4][2], const Unit& u, int wr, int wc, int fr, int fq) const {
        const int row0 = u.om * BM + wr * 64 + fr, col0 = u.on * BM + wc * 32 + 4 * fq;
#pragma unroll
        for (int ai = 0; ai < 2; ++ai)
#pragma unroll
            for (int m = 0; m < 4; ++m) { float* rowp = C + (size_t)(row0 + ai * HALF + m * 16) * ldc + col0;
#pragma unroll
                for (int bj = 0; bj < 2; ++bj)
#pragma unroll
                    for (int n = 0; n < 2; ++n) *(f32x4*)(rowp + bj * HALF + n * 16) = acc[ai][bj][m][n]; }
    }
};

template <class Epi, class Sched, bool ALIGN_EPI = false, bool SP2 = false>
__device__ __forceinline__ void gemm_phase(PG8_LAS unsigned char* lds, const Gemm g, const Sched& S, const Epi& E, const int tid_in) {
    int tid_ = tid_in; asm volatile("" : "+v"(tid_));
    const int tid = tid_, wid = __builtin_amdgcn_readfirstlane(tid >> 6), lane = tid & 63, wr = wid >> 2, wc = wid & 3, fr = lane & 15, fq = lane >> 4;
    const int K = g.K, nt = K / BK;
    unsigned voffA[2], voffB[2];
#pragma unroll
    for (int i = 0; i < 2; ++i) { int R, C; stage_rc(tid * 16 + i * 8192, R, C); const int Rb = Epi::PERM ? ((R & ~31) + perm32(R & 31)) : R;
        voffA[i] = (unsigned)(R * K + C) * 2u; voffB[i] = (unsigned)(Rb * K + C) * 2u; }
    const size_t kstep = (size_t)(BK * 2);
    const size_t hstep = (size_t)HALF * K * 2;
    const size_t tstep = 2 * hstep;
    const unsigned ldsw = (unsigned)wid * 1024u;
    const int aoff = lds_byte(wr * 64 + fr, fq * 8), boff = lds_byte(wc * 32 + fr, fq * 8);
#define PG8_SA(b, h) (((b) * 2 + (h)) * HTB)
#define PG8_SB(b, h) ((4 + (b) * 2 + (h)) * HTB)
#define PG8_STAGE(bufoff, gbase, voff) do { _Pragma("unroll") for (int _i = 0; _i < 2; ++_i) \
        __builtin_amdgcn_global_load_lds((const unsigned*)((const char*)(gbase) + (voff)[_i]), (PG8_LAS unsigned*)(lds + (bufoff) + ldsw + _i * 8192), 16, 0, 0); } while (0)
#define PG8_LDA(dst, b, h) do { _Pragma("unroll") for (int m = 0; m < 4; ++m) _Pragma("unroll") for (int k = 0; k < 2; ++k) dst[m][k] = *(const PG8_LAS bf16x8*)(lds + PG8_SA(b, h) + aoff + m * 2048 + k * 1024); } while (0)
#define PG8_LDB(dst, b, h) do { _Pragma("unroll") for (int n = 0; n < 2; ++n) _Pragma("unroll") for (int k = 0; k < 2; ++k) dst[n][k] = *(const PG8_LAS bf16x8*)(lds + PG8_SB(b, h) + boff + n * 2048 + k * 1024); } while (0)
#define PG8_MMA(ai, bj, At, Bt) do { __builtin_amdgcn_s_setprio(1); _Pragma("unroll") for (int m = 0; m < 4; ++m) _Pragma("unroll") for (int n = 0; n < 2; ++n) _Pragma("unroll") for (int k = 0; k < 2; ++k) \
        acc[ai][bj][m][n] = __builtin_amdgcn_mfma_f32_16x16x32_bf16(Bt[n][k], At[m][k], acc[ai][bj][m][n], 0, 0, 0); __builtin_amdgcn_s_setprio(0); } while (0)
#define PG8_WAIT_V(n) asm volatile("s_waitcnt vmcnt(" #n ")" ::: "memory")
#define PG8_WAIT_L(n) asm volatile("s_waitcnt lgkmcnt(" #n ")" ::: "memory")
#define PG8_BAR __builtin_amdgcn_s_barrier()
#define PG8_SCHED __builtin_amdgcn_sched_barrier(0)
    Unit cur, nxt; int ui = 0;
    if (!S.next(0, cur)) return;
    f32x4 acc[2][2][4][2];
#pragma unroll
    for (int a = 0; a < 2; ++a)
#pragma unroll
        for (int b = 0; b < 2; ++b)
#pragma unroll
            for (int m = 0; m < 4; ++m)
#pragma unroll
                for (int n = 0; n < 2; ++n) acc[a][b][m][n] = (f32x4){0.f, 0.f, 0.f, 0.f};
    bf16x8 At[4][2], B0[2][2], B1[2][2];
    const char* cA = (const char*)g.A + (size_t)cur.pm * tstep; const char* cB = (const char*)g.Bt + (size_t)cur.pn * tstep;
    S.a_ready(cur);
    if constexpr (SP2) {
        PG8_STAGE(PG8_SB(0, 0), cB, voffB); PG8_STAGE(PG8_SB(0, 1), cB + hstep, voffB); PG8_STAGE(PG8_SA(0, 0), cA, voffA); PG8_STAGE(PG8_SA(0, 1), cA + hstep, voffA);
        if (wr == 1) PG8_BAR;
        PG8_WAIT_V(2); PG8_BAR;
        PG8_STAGE(PG8_SB(1, 0), cB + kstep, voffB); PG8_STAGE(PG8_SA(1, 0), cA + kstep, voffA); PG8_STAGE(PG8_SB(1, 1), cB + hstep + kstep, voffB);
        PG8_WAIT_V(6); PG8_BAR;
    } else {
        PG8_STAGE(PG8_SB(0, 0), cB, voffB); PG8_STAGE(PG8_SA(0, 0), cA, voffA); PG8_STAGE(PG8_SB(0, 1), cB + hstep, voffB); PG8_STAGE(PG8_SA(0, 1), cA + hstep, voffA);
        if (wr == 1) PG8_BAR;
        PG8_WAIT_V(4); PG8_BAR;
        PG8_STAGE(PG8_SB(1, 0), cB + kstep, voffB); PG8_STAGE(PG8_SA(1, 0), cA + kstep, voffA); PG8_STAGE(PG8_SB(1, 1), cB + hstep + kstep, voffB);
        PG8_WAIT_V(6); PG8_BAR;
    }
    for (;;) {
        const bool has_next = S.next(ui + 1, nxt);
        const char* nA = has_next ? (const char*)g.A + (size_t)nxt.pm * tstep : cA; const char* nB = has_next ? (const char*)g.Bt + (size_t)nxt.pn * tstep : cB;
        for (int t = 0; t < nt; t += 2) {
            const bool last = (t == nt - 2);
            const char* a1 = cA + (size_t)(t + 1) * kstep;
            const char* a2 = last ? nA : cA + (size_t)(t + 2) * kstep; const char* b2 = last ? nB : cB + (size_t)(t + 2) * kstep;
            const char* a3 = a2 + kstep; const char* b3 = b2 + kstep;
            if (last && has_next) S.a_ready(nxt);
            if constexpr (SP2) {
            PG8_LDB(B0, 0, 0); PG8_LDB(B1, 0, 1); PG8_SCHED; PG8_LDA(At, 0, 0); PG8_STAGE(PG8_SA(1, 1), a1 + hstep, voffA);
            PG8_WAIT_V(8); PG8_WAIT_L(0); PG8_BAR; PG8_MMA(0, 0, At, B0); PG8_MMA(0, 1, At, B1); PG8_BAR; PG8_SCHED;
            PG8_LDA(At, 0, 1); PG8_STAGE(PG8_SB(0, 0), b2, voffB); PG8_STAGE(PG8_SB(0, 1), b2 + hstep, voffB); PG8_STAGE(PG8_SA(0, 0), a2, voffA);
            PG8_WAIT_V(8); PG8_WAIT_L(0); PG8_BAR; PG8_MMA(1, 0, At, B0); PG8_MMA(1, 1, At, B1); PG8_BAR; PG8_SCHED;
            PG8_LDB(B0, 1, 0); PG8_LDB(B1, 1, 1); PG8_SCHED; PG8_LDA(At, 1, 0); PG8_STAGE(PG8_SA(0, 1), a2 + hstep, voffA);
            PG8_WAIT_V(8); PG8_WAIT_L(0); PG8_BAR; PG8_MMA(0, 0, At, B0); PG8_MMA(0, 1, At, B1); PG8_BAR; PG8_SCHED;
            PG8_LDA(At, 1, 1); PG8_STAGE(PG8_SB(1, 0), b3, voffB); PG8_STAGE(PG8_SB(1, 1), b3 + hstep, voffB); PG8_STAGE(PG8_SA(1, 0), a3, voffA);
            PG8_WAIT_V(8); PG8_WAIT_L(0); PG8_BAR; PG8_MMA(1, 0, At, B0); PG8_MMA(1, 1, At, B1); PG8_BAR; PG8_SCHED;
            } else {
            PG8_LDB(B0, 0, 0); PG8_SCHED; PG8_LDA(At, 0, 0); PG8_STAGE(PG8_SA(1, 1), a1 + hstep, voffA);
            PG8_WAIT_L(8); PG8_BAR; PG8_WAIT_L(0); PG8_MMA(0, 0, At, B0); PG8_BAR; PG8_SCHED;
            PG8_LDB(B1, 0, 1); PG8_STAGE(PG8_SB(0, 0), b2, voffB);
            PG8_BAR; PG8_WAIT_L(0); PG8_MMA(0, 1, At, B1); PG8_BAR;
            PG8_LDA(At, 0, 1); PG8_STAGE(PG8_SA(0, 0), a2, voffA);
            PG8_BAR; PG8_WAIT_L(0); PG8_MMA(1, 0, At, B0); PG8_BAR; PG8_SCHED;
            PG8_STAGE(PG8_SB(0, 1), b2 + hstep, voffB);
            PG8_WAIT_V(6); PG8_BAR; PG8_MMA(1, 1, At, B1); PG8_BAR;
            PG8_LDB(B0, 1, 0); PG8_SCHED; PG8_LDA(At, 1, 0); PG8_STAGE(PG8_SA(0, 1), a2 + hstep, voffA);
            PG8_WAIT_L(8); PG8_BAR; PG8_WAIT_L(0); PG8_MMA(0, 0, At, B0); PG8_BAR; PG8_SCHED;
            PG8_LDB(B1, 1, 1); PG8_STAGE(PG8_SB(1, 0), b3, voffB);
            PG8_BAR; PG8_WAIT_L(0); PG8_MMA(0, 1, At, B1); PG8_BAR;
            PG8_LDA(At, 1, 1); PG8_STAGE(PG8_SA(1, 0), a3, voffA);
            PG8_BAR; PG8_WAIT_L(0); PG8_MMA(1, 0, At, B0); PG8_BAR; PG8_SCHED;
            PG8_STAGE(PG8_SB(1, 1), b3 + hstep, voffB);
            PG8_WAIT_V(6); PG8_BAR; PG8_MMA(1, 1, At, B1); PG8_BAR;
            }
        }
        if constexpr (ALIGN_EPI) { if (wr == 0) PG8_BAR; }
        if constexpr (!Epi::AFTER_DRAIN) { E(acc, cur, wr, wc, fr, fq); S.done(cur); }
        if (!has_next) break;
#pragma unroll
        for (int a = 0; a < 2; ++a)
#pragma unroll
            for (int b = 0; b < 2; ++b)
#pragma unroll
                for (int m = 0; m < 4; ++m)
#pragma unroll
                    for (int n = 0; n < 2; ++n) acc[a][b][m][n] = (f32x4){0.f, 0.f, 0.f, 0.f};
        cur = nxt; cA = nA; cB = nB; ++ui;
        if constexpr (ALIGN_EPI) { if (wr == 1) PG8_BAR; }
    }
    PG8_WAIT_V(0);
    if constexpr (!ALIGN_EPI) { if (wr == 0) PG8_BAR; }
    PG8_BAR;
    if constexpr (Epi::AFTER_DRAIN) { E.fused(acc, cur, wr, wc, fr, fq, lds, wid, lane); S.done(cur); }
#undef PG8_SA
#undef PG8_SB
#undef PG8_STAGE
#undef PG8_LDA
#undef PG8_LDB
#undef PG8_MMA
#undef PG8_WAIT_V
#undef PG8_WAIT_L
#undef PG8_BAR
#undef PG8_SCHED
}
}

constexpr int D = 2048, BATCH = 4, SEQ = 2048, DEPTH = 4, M = BATCH * SEQ, MEM_LEN = 256, MM = BATCH * MEM_LEN;
constexpr int DIN = 4128, DFF = 8192;
constexpr int O_AQ = 0, O_AK = 1024, O_AV = 1280, O_BQ = 1536, O_BK = 1792, O_BV = 2048, O_BG = 2560, O_ZF = 3072, O_ZB = 3088, O_CX = 3104, O_CY = 3616;
constexpr int NPB = 4096;
constexpr int PB_CX = 3072, PB_CY = 3584;
constexpr float EPS = 1e-6f;
constexpr int NWAVES = 8, NTHREADS = 512;

#ifndef PROBE_REP
#define PROBE_REP 0
#endif
#ifndef NWL
#define NWL 4
#endif
constexpr size_t MiB = 1u << 20;
constexpr size_t WS_CTL = 0, CTL_ZERO_BYTES = 1 * MiB;
constexpr size_t WS_W = 1 * MiB, WL_BYTES = 121 * MiB;
constexpr size_t WL_IN = 0, WL_OUT = 16 * MiB, WL_XQ = 24 * MiB, WL_XK = 32 * MiB, WL_XV = 40 * MiB, WL_XO = 48 * MiB, WL_UP = 56 * MiB, WL_DOWN = 88 * MiB, WL_Z = 120 * MiB, WL_LRUG = 120 * MiB + 256 * 1024;
constexpr size_t WS_XN = WS_W + NWL * WL_BYTES;
constexpr size_t WS_MEMN = WS_XN + 32 * MiB;
constexpr size_t WS_KX = WS_MEMN + 16 * MiB;
constexpr size_t WS_VT = WS_KX + 16 * MiB;
constexpr size_t WS_Y = WS_VT + 16 * MiB;
constexpr size_t WS_Z = WS_Y + 64 * MiB;
constexpr size_t WS_BIG = WS_Z + 1 * MiB;
constexpr size_t WS_PB = WS_BIG;
constexpr size_t WS_MIX = WS_BIG + 64 * MiB;
constexpr size_t WS_GLAU = WS_BIG + 96 * MiB;
constexpr size_t WS_MISC = WS_BIG + 128 * MiB;
constexpr size_t WS_H = WS_BIG;
constexpr size_t WS_Q = WS_BIG, WS_O = WS_BIG + 32 * MiB;
constexpr size_t WS_END = WS_BIG + 136 * MiB;
constexpr int CW_TMO = 0, CW_BAR = 4096;

constexpr int RING_OFF = 0, RING_BYTES = 131072, SCR_BYTES = 143360;
constexpr int LDSCTL_OFF = SCR_BYTES, MISC_OFF = LDSCTL_OFF + 320;
constexpr int LDS_BYTES = 147456;

#define GAS __attribute__((address_space(1)))
#define LAS __attribute__((address_space(3)))
typedef unsigned short bf16;
typedef unsigned v4u __attribute__((ext_vector_type(4)));
typedef unsigned v2u __attribute__((ext_vector_type(2)));
typedef float f32x4 __attribute__((ext_vector_type(4)));
typedef short bf16x8 __attribute__((ext_vector_type(8)));
typedef short s16x4 __attribute__((ext_vector_type(4)));
#define LDS_WAIT() asm volatile("s_waitcnt lgkmcnt(0)" ::: "memory")
#define VM_WAIT() asm volatile("s_waitcnt vmcnt(0)" ::: "memory")
__device__ __forceinline__ unsigned f2bf(float f) { unsigned u = __builtin_bit_cast(unsigned, f); return (u + 0x7fffu + ((u >> 16) & 1u)) >> 16; }
__device__ __forceinline__ unsigned pk2(float lo, float hi) { return f2bf(lo) | (f2bf(hi) << 16); }
__device__ __forceinline__ float bf2f(unsigned short b) { return __builtin_bit_cast(float, (unsigned)b << 16); }
__device__ __forceinline__ float wave_sum(float v) {
#pragma unroll
    for (int o = 1; o < 64; o <<= 1) v += __shfl_xor(v, o);
    return v;
}
__device__ __forceinline__ float wave_max(float v) {
#pragma unroll
    for (int o = 1; o < 64; o <<= 1) v = fmaxf(v, __shfl_xor(v, o));
    return v;
}
__device__ __forceinline__ float sigmoidf_(float x) { return __builtin_amdgcn_rcpf(1.f + __builtin_amdgcn_exp2f(-1.4426950408889634f * x)); }
__device__ __forceinline__ float softplusf_(float x) { return fmaxf(x, 0.f) + 0.6931471805599453f * __builtin_amdgcn_logf(1.f + __builtin_amdgcn_exp2f(-1.4426950408889634f * fabsf(x))); }
__device__ __forceinline__ float gelu_tanh(float x) { return x * sigmoidf_(1.5957691216057308f * (x + 0.044715f * x * x * x)); }
__device__ __forceinline__ int t5_bucket(int rel) {
    const int ret = rel > 0 ? 16 : 0; const int n = rel < 0 ? -rel : rel;
    if (n < 8) return ret + n;
    int k = 0; while (k < 7 && (64 << (k + 1)) <= n * n) ++k;
    return ret + 8 + k;
}

struct Frame {
    LAS unsigned char* lds;
    int tid, lane, wave, G, bx;
};

__device__ __forceinline__ void p0_transpose_item(const float* W, int K, int N, int c0, bf16* WT, int r0, int nblk, const float* gk, LAS float* scr, int item, int lane) {
    const int kb = item / nblk, nb = item % nblk, k0 = 64 * kb, n0 = 32 * nb;
#pragma unroll 8
    for (int i = 0; i < 32; ++i) { const int kk = 2 * i + (lane >> 5); const float gs = gk ? gk[k0 + kk] : 1.f; scr[kk * 33 + (lane & 31)] = W[(size_t)(k0 + kk) * N + c0 + n0 + (lane & 31)] * gs; }
    LDS_WAIT(); asm volatile("" ::: "memory");
    const int c = lane & 7;
#pragma unroll
    for (int j = 0; j < 4; ++j) { const int n = (lane >> 3) + 8 * j; const LAS float* s = scr + (8 * c) * 33 + n;
        v4u o; o.x = pk2(s[0 * 33], s[1 * 33]); o.y = pk2(s[2 * 33], s[3 * 33]); o.z = pk2(s[4 * 33], s[5 * 33]); o.w = pk2(s[6 * 33], s[7 * 33]);
        *(GAS v4u*)(WT + (size_t)(r0 + n0 + n) * K + k0 + 8 * c) = o; }
    LDS_WAIT(); asm volatile("" ::: "memory");
}
struct ConvSeg { const float* W; int K, N, c0, ncols; bf16* WT; int r0; const float* gain; };
__device__ __forceinline__ int seg_items(const ConvSeg& s) { return (s.K / 64) * (s.ncols / 32); }

__device__ __forceinline__ void norm_row(int lane, const float* src, const float* g, bf16* xn, float* copy_dst) {
    const GAS f32x4* xr = (const GAS f32x4*)src + lane; const GAS f32x4* gr = (const GAS f32x4*)g + lane;
    f32x4 v[8]; float s = 0.f;
#pragma unroll
    for (int j = 0; j < 8; ++j) { v[j] = xr[64 * j]; s += (v[j].x * v[j].x + v[j].y * v[j].y) + (v[j].z * v[j].z + v[j].w * v[j].w); }
    const float r = rsqrtf(wave_sum(s) * (1.f / D) + EPS);
    GAS v2u* o8 = (GAS v2u*)xn + lane;
#pragma unroll
    for (int j = 0; j < 8; ++j) { const f32x4 gg = gr[64 * j]; v2u w; w.x = pk2(v[j].x * r * gg.x, v[j].y * r * gg.y); w.y = pk2(v[j].z * r * gg.z, v[j].w * r * gg.w); o8[64 * j] = w;
        if (copy_dst) ((GAS f32x4*)copy_dst + lane)[64 * j] = v[j]; }
}
__device__ __forceinline__ void init_row(int lane, const float* x, bf16* xb, float* rs) {
    const GAS f32x4* xr = (const GAS f32x4*)x; GAS v4u* ob = (GAS v4u*)xb;
    float s = 0.f;
#pragma unroll
    for (int j = 0; j < 4; ++j) { const int ch = lane + 64 * j; const f32x4 a = xr[2 * ch], b = xr[2 * ch + 1];
        s += (a.x * a.x + a.y * a.y) + (a.z * a.z + a.w * a.w) + (b.x * b.x + b.y * b.y) + (b.z * b.z + b.w * b.w);
        v4u w; w.x = pk2(a.x, a.y); w.y = pk2(a.z, a.w); w.z = pk2(b.x, b.y); w.w = pk2(b.z, b.w); ob[ch] = w; }
    s = wave_sum(s);
    if (lane == 0) *rs = rsqrtf(s * (1.f / D) + EPS);
}
__device__ __forceinline__ void resid_row(int lane, bf16* xb, const bf16* y, const float* g1, float* rs, float* outf) {
    GAS v4u* xr = (GAS v4u*)xb; const GAS v4u* yr = (const GAS v4u*)y; const GAS f32x4* gr = (const GAS f32x4*)g1;
    v4u xv[4], yv[4]; float s = 0.f;
#pragma unroll
    for (int j = 0; j < 4; ++j) { const int ch = lane + 64 * j; xv[j] = xr[ch]; yv[j] = yr[ch]; }
#pragma unroll
    for (int j = 0; j < 4; ++j) { const unsigned yy[4] = {yv[j].x, yv[j].y, yv[j].z, yv[j].w};
#pragma unroll
        for (int e = 0; e < 4; ++e) { const float a = bf2f((unsigned short)(yy[e] & 0xffffu)), b = bf2f((unsigned short)(yy[e] >> 16)); s += a * a + b * b; } }
    const float r = rsqrtf(wave_sum(s) * (1.f / D) + EPS);
    float s2 = 0.f;
#pragma unroll
    for (int j = 0; j < 4; ++j) { const int ch = lane + 64 * j; const f32x4 ga = gr[2 * ch], gb = gr[2 * ch + 1];
        const float gg[8] = {ga.x, ga.y, ga.z, ga.w, gb.x, gb.y, gb.z, gb.w};
        const unsigned yy[4] = {yv[j].x, yv[j].y, yv[j].z, yv[j].w}, xx[4] = {xv[j].x, xv[j].y, xv[j].z, xv[j].w};
        float xn[8];
#pragma unroll
        for (int e = 0; e < 4; ++e) {
            xn[2 * e] = bf2f((unsigned short)(xx[e] & 0xffffu)) + bf2f((unsigned short)(yy[e] & 0xffffu)) * r * gg[2 * e];
            xn[2 * e + 1] = bf2f((unsigned short)(xx[e] >> 16)) + bf2f((unsigned short)(yy[e] >> 16)) * r * gg[2 * e + 1];
            s2 += xn[2 * e] * xn[2 * e] + xn[2 * e + 1] * xn[2 * e + 1]; }
        v4u w; w.x = pk2(xn[0], xn[1]); w.y = pk2(xn[2], xn[3]); w.z = pk2(xn[4], xn[5]); w.w = pk2(xn[6], xn[7]); xr[ch] = w;
        if (outf) { GAS f32x4* of = (GAS f32x4*)outf; of[2 * ch] = (f32x4){xn[0], xn[1], xn[2], xn[3]}; of[2 * ch + 1] = (f32x4){xn[4], xn[5], xn[6], xn[7]}; } }
    s2 = wave_sum(s2);
    if (lane == 0) *rs = rsqrtf(s2 * (1.f / D) + EPS);
}
template <int NR>
__device__ __forceinline__ void resid_rows(int lane, bf16* xb0, const bf16* y0, size_t stride_el, const float* g1, float* rs0, size_t rs_stride, float* outf0) {
    v4u xv[NR][4], yv[NR][4];
#pragma unroll
    for (int i = 0; i < NR; ++i)
#pragma unroll
        for (int j = 0; j < 4; ++j) { const int ch = lane + 64 * j; xv[i][j] = ((const GAS v4u*)(xb0 + i * stride_el))[ch]; yv[i][j] = ((const GAS v4u*)(y0 + i * stride_el))[ch]; }
    f32x4 ga[4], gb[4];
#pragma unroll
    for (int j = 0; j < 4; ++j) { const int ch = lane + 64 * j; ga[j] = ((const GAS f32x4*)g1)[2 * ch]; gb[j] = ((const GAS f32x4*)g1)[2 * ch + 1]; }
#pragma unroll
    for (int i = 0; i < NR; ++i) {
        float s = 0.f;
#pragma unroll
        for (int j = 0; j < 4; ++j) { const unsigned yy[4] = {yv[i][j].x, yv[i][j].y, yv[i][j].z, yv[i][j].w};
#pragma unroll
            for (int e = 0; e < 4; ++e) { const float a = bf2f((unsigned short)(yy[e] & 0xffffu)), b = bf2f((unsigned short)(yy[e] >> 16)); s += a * a + b * b; } }
        const float r = rsqrtf(wave_sum(s) * (1.f / D) + EPS);
        float s2 = 0.f;
        GAS v4u* xr = (GAS v4u*)(xb0 + i * stride_el);
#pragma unroll
        for (int j = 0; j < 4; ++j) { const int ch = lane + 64 * j;
            const float gg[8] = {ga[j].x, ga[j].y, ga[j].z, ga[j].w, gb[j].x, gb[j].y, gb[j].z, gb[j].w};
            const unsigned yy[4] = {yv[i][j].x, yv[i][j].y, yv[i][j].z, yv[i][j].w}, xx[4] = {xv[i][j].x, xv[i][j].y, xv[i][j].z, xv[i][j].w};
            float xn[8];
#pragma unroll
            for (int e = 0; e < 4; ++e) {
                xn[2 * e] = bf2f((unsigned short)(xx[e] & 0xffffu)) + bf2f((unsigned short)(yy[e] & 0xffffu)) * r * gg[2 * e];
                xn[2 * e + 1] = bf2f((unsigned short)(xx[e] >> 16)) + bf2f((unsigned short)(yy[e] >> 16)) * r * gg[2 * e + 1];
                s2 += xn[2 * e] * xn[2 * e] + xn[2 * e + 1] * xn[2 * e + 1]; }
            v4u w; w.x = pk2(xn[0], xn[1]); w.y = pk2(xn[2], xn[3]); w.z = pk2(xn[4], xn[5]); w.w = pk2(xn[6], xn[7]); xr[ch] = w;
            if (outf0) { GAS f32x4* of = (GAS f32x4*)(outf0 + i * stride_el); of[2 * ch] = (f32x4){xn[0], xn[1], xn[2], xn[3]}; of[2 * ch + 1] = (f32x4){xn[4], xn[5], xn[6], xn[7]}; } }
        s2 = wave_sum(s2);
        if (lane == 0) rs0[i * rs_stride] = rsqrtf(s2 * (1.f / D) + EPS);
    }
}
__device__ __forceinline__ void zgemm(const Frame& F, const bf16* XN, const bf16* WZ, const float* RS, float* Z) {
    const int lane = F.lane, g = lane >> 4, c = lane & 15;
    for (int tile = F.wave * F.G + F.bx; tile < (M / 16) * 2; tile += NWAVES * F.G) {
        const int rt = tile >> 1, ct = tile & 1;
        const bf16* ap = XN + (size_t)(rt * 16 + c) * D + g * 8;
        const bf16* bp = WZ + (size_t)(ct * 16 + c) * D + g * 8;
        f32x4 acc = {0.f, 0.f, 0.f, 0.f};
#pragma unroll 8
        for (int ks = 0; ks < D / 32; ++ks) { const bf16x8 a = *(const GAS bf16x8*)(ap + ks * 32); const bf16x8 b = *(const GAS bf16x8*)(bp + ks * 32); acc = __builtin_amdgcn_mfma_f32_16x16x32_bf16(a, b, acc, 0, 0, 0); }
#pragma unroll
        for (int r = 0; r < 4; ++r) Z[(size_t)(rt * 16 + 4 * g + r) * 32 + ct * 16 + c] = acc[r] * RS[rt * 16 + 4 * g + r];
    }
}

#define XB_TMO      128
#define XB_XCNT(j)  (256  + 64 * (j))
#define XB_XSUB(j)  (1280 + 64 * (j))
#define XB_XGEN(j)  (2304 + 64 * (j))
#define XB_TOP      3328
#define XB_TOPGEN   3392
#define XCD_BAR_WORDS 3456
#define XB_SPIN_CAP (1u << 18)
#define LAS __attribute__((address_space(3)))

__device__ __forceinline__ unsigned xb_ld(unsigned* p)              { return __hip_atomic_load(p, __ATOMIC_RELAXED, __HIP_MEMORY_SCOPE_AGENT); }
__device__ __forceinline__ unsigned xb_add(unsigned* p, unsigned v) { return __hip_atomic_fetch_add(p, v, __ATOMIC_RELAXED, __HIP_MEMORY_SCOPE_AGENT); }
__device__ __forceinline__ unsigned xb_xcc_id() { return (unsigned)__builtin_amdgcn_s_getreg((3 << 11) | 20) & 0xFu; }
#define XB_SPIN(cond, bar) do { unsigned _sp = 0; while (cond) { __builtin_amdgcn_s_sleep(1); \
    if ((++_sp & 255u) == 0u) { if (xb_ld(&(bar)[XB_TMO])) break; if (_sp > XB_SPIN_CAP) { atomicAdd(&(bar)[XB_TMO], 1u); break; } } } } while (0)

struct XcdBarrier {
    unsigned* bar; unsigned x;
    volatile LAS unsigned* st;
};

__device__ __forceinline__ XcdBarrier xcd_barrier_post(unsigned* bar, volatile LAS unsigned* st) {
    XcdBarrier b; b.bar = bar; b.x = xb_xcc_id(); b.st = st;
    if (threadIdx.x == 0) (void)xb_add(&bar[XB_XCNT(b.x)], 1u);
    return b;
}
__device__ __forceinline__ void xcd_barrier_complete(unsigned* bar, unsigned x, unsigned& nloc, unsigned& nx) {
    const unsigned G = gridDim.x * gridDim.y * gridDim.z;
    unsigned sum, cnt, mine, sp = 0u;
    for (;;) {
        sum = 0u; cnt = 0u; mine = 0u;
#pragma unroll
        for (unsigned j = 0; j < 16; ++j) { const unsigned c = xb_ld(&bar[XB_XCNT(j)]); sum += c; cnt += (c > 0u) ? 1u : 0u; mine = (j == x) ? c : mine; }
        if (sum == G) break;
        __builtin_amdgcn_s_sleep(1);
        if ((++sp & 255u) == 0u) { if (xb_ld(&bar[XB_TMO])) break; if (sp > XB_SPIN_CAP) { atomicAdd(&bar[XB_TMO], 1u); break; } }
    }
    nloc = mine > 0u ? mine : 1u; nx = cnt > 0u ? cnt : 1u;
}

__device__ __forceinline__ void xcd_barrier(const XcdBarrier& b) {
    asm volatile("s_waitcnt vmcnt(0)" ::: "memory");
    __syncthreads();
    if (threadIdx.x == 0) {
        unsigned* bar = b.bar;
        __builtin_amdgcn_s_waitcnt(0);
        unsigned nloc = b.st[0], nx = b.st[1];
        if (nloc == 0u) { xcd_barrier_complete(bar, b.x, nloc, nx); b.st[0] = nloc; b.st[1] = nx; }
        const unsigned old = xb_add(&bar[XB_XSUB(b.x)], 1u);
        const unsigned gen = old / nloc;
        if (old + 1u == (gen + 1u) * nloc) {
            __builtin_amdgcn_fence(__ATOMIC_RELEASE, "agent");
            asm volatile("s_waitcnt vmcnt(0)" ::: "memory");
            const unsigned og = xb_add(&bar[XB_TOP], 1u);
            const unsigned tg = og / nx;
            if (og + 1u == (tg + 1u) * nx) xb_add(&bar[XB_TOPGEN], 1u);
            else XB_SPIN(xb_ld(&bar[XB_TOPGEN]) == tg, bar);
            __builtin_amdgcn_fence(__ATOMIC_ACQUIRE, "agent");
            xb_add(&bar[XB_XGEN(b.x)], 1u);
            asm volatile("s_waitcnt vmcnt(0)" ::: "memory");
        } else {
            XB_SPIN(xb_ld(&bar[XB_XGEN(b.x)]) == gen, bar);
            __builtin_amdgcn_fence(__ATOMIC_ACQUIRE, "agent");
            asm volatile("s_waitcnt vmcnt(0)" ::: "memory");
        }
    }
    __syncthreads();
}
constexpr size_t MISC_DEC = 3 * MiB;
constexpr int GL_Z = 0, GL_TF = 8192, GL_TB = 10240, GL_VI = 12288, GL_A = 29696, GL_B = 38912, GL_P = 48128, GL_SI = 57344, GL_OF = 74752;
__device__ __forceinline__ bf16x8 tr_frag(LAS unsigned char* p, int stride4) {
    const s16x4 lo = __builtin_amdgcn_ds_read_tr16_b64_v4i16((LAS s16x4*)p);
    const s16x4 hi = __builtin_amdgcn_ds_read_tr16_b64_v4i16((LAS s16x4*)(p + stride4));
    return __builtin_shufflevector(lo, hi, 0, 1, 2, 3, 4, 5, 6, 7);
}
struct GlaW { float wf[16], wb[16], bfv, bbv; };
__device__ __forceinline__ void gla_load_w(GlaW& W, int k, int h, const float* __restrict__ w2f, const float* __restrict__ b2f, const float* __restrict__ w2b, const float* __restrict__ b2b) {
#pragma unroll
    for (int r = 0; r < 16; ++r) { W.wf[r] = w2f[r * 256 + h * 64 + k]; W.wb[r] = w2b[r * 256 + h * 64 + k]; }
    W.bfv = b2f[h * 64 + k]; W.bbv = b2b[h * 64 + k];
}
__device__ __forceinline__ void gla_gates(const Frame& F, const f32x4 zreg, const GlaW& W, float (&cf)[8], float (&cb)[8], float& totf, float& totb) {
    LAS float* ZS = (LAS float*)(F.lds + GL_Z); LAS float* TF = (LAS float*)(F.lds + GL_TF); LAS float* TB = (LAS float*)(F.lds + GL_TB);
    const int tid = F.tid, k = tid & 63, tg = F.wave;
    ((LAS f32x4*)ZS)[tid] = zreg;
    __syncthreads();
#pragma unroll
    for (int i = 0; i < 8; ++i) { const int t = tg * 8 + i; float af = W.bfv, ab = W.bbv;
#pragma unroll
        for (int r = 0; r < 16; ++r) { af += ZS[t * 32 + r] * W.wf[r]; ab += ZS[t * 32 + 16 + r] * W.wb[r]; }
        cf[i] = -softplusf_(-af) * 0.0625f; cb[i] = -softplusf_(-ab) * 0.0625f; }
#pragma unroll
    for (int i = 1; i < 8; ++i) cf[i] += cf[i - 1];
#pragma unroll
    for (int i = 6; i >= 0; --i) cb[i] += cb[i + 1];
    TF[tg * 64 + k] = cf[7]; TB[tg * 64 + k] = cb[0];
    __syncthreads();
    float ef = 0.f, eb = 0.f; totf = 0.f; totb = 0.f;
#pragma unroll
    for (int g2 = 0; g2 < 8; ++g2) { const float a = TF[g2 * 64 + k], bq = TB[g2 * 64 + k]; totf += a; totb += bq; ef += (g2 < tg) ? a : 0.f; eb += (g2 > tg) ? bq : 0.f; }
#pragma unroll
    for (int i = 0; i < 8; ++i) { cf[i] += ef; cb[i] += eb; }
}
__device__ __forceinline__ void gla_load_v(const Frame& F, const bf16* __restrict__ PB, size_t m0, int h, v4u (&vr)[2]) {
#pragma unroll
    for (int i = 0; i < 2; ++i) { const int ch = F.tid + NTHREADS * i, row = ch >> 4, col = ch & 15; vr[i] = *(const GAS v4u*)(PB + (m0 + row) * NPB + O_BV + h * 128 + col * 8); }
}
__device__ __forceinline__ void gla_store_v(const Frame& F, const v4u (&vr)[2]) {
    LAS unsigned char* VI = F.lds + GL_VI;
#pragma unroll
    for (int i = 0; i < 2; ++i) { const int ch = F.tid + NTHREADS * i, row = ch >> 4, col = ch & 15; *(LAS v4u*)(VI + row * 272 + col * 16) = vr[i]; }
}
__device__ __forceinline__ void gla_u_phase(const Frame& F, const bf16* __restrict__ PB, const float* __restrict__ Z, const float* __restrict__ w2f, const float* __restrict__ b2f,
                                            const float* __restrict__ w2b, const float* __restrict__ b2b, float* __restrict__ U, float* __restrict__ DEC) {
    const int tid = F.tid, lane = F.lane, g = lane >> 4, c = lane & 15, w = F.wave, k = tid & 63, tg = F.wave;
    LAS unsigned char* VI = F.lds + GL_VI;
    GlaW W; int h_loaded = -1;
    for (int unit = F.bx; unit < BATCH * 4 * 32; unit += F.G) {
        const int b = unit >> 7, h = (unit >> 5) & 3, n = unit & 31;
        const size_t m0 = (size_t)b * SEQ + n * 64;
        if (h != h_loaded) { gla_load_w(W, k, h, w2f, b2f, w2b, b2b); h_loaded = h; }
        const f32x4 zreg = ((const GAS f32x4*)(Z + m0 * 32))[tid];
        unsigned short kraw[8];
#pragma unroll
        for (int i = 0; i < 8; ++i) kraw[i] = PB[(m0 + tg * 8 + i) * NPB + O_BK + h * 64 + k];
        v4u vr[2]; gla_load_v(F, PB, m0, h, vr);
        __syncthreads();
        float cf[8], cb[8], totf, totb;
        gla_gates(F, zreg, W, cf, cb, totf, totb);
#pragma unroll
        for (int i = 0; i < 8; ++i) { const int t = tg * 8 + i; const float kk = bf2f(kraw[i]);
            *(LAS unsigned short*)(F.lds + GL_A + t * 144 + k * 2) = (unsigned short)f2bf(kk * __expf(totf - cf[i]));
            *(LAS unsigned short*)(F.lds + GL_B + t * 144 + k * 2) = (unsigned short)f2bf(kk * __expf(totb - cb[i])); }
        const size_t ub = (size_t)(b * 4 + h) * 32 + n;
        if (tg == 0) { DEC[ub * 64 + k] = __expf(totf); DEC[(ub + 512) * 64 + k] = __expf(totb); }
        gla_store_v(F, vr);
        __syncthreads();
        bf16x8 vf[2];
#pragma unroll
        for (int ts = 0; ts < 2; ++ts) vf[ts] = tr_frag(VI + (32 * ts + 8 * g + (c >> 2)) * 272 + (16 * w + 4 * (c & 3)) * 2, 4 * 272);
#pragma unroll
        for (int d = 0; d < 2; ++d) {
            LAS unsigned char* KS = F.lds + (d ? GL_B : GL_A);
            float* Ud = U + (ub + (size_t)d * 512) * 8192;
#pragma unroll
            for (int kt = 0; kt < 4; ++kt) {
                f32x4 acc = {0.f, 0.f, 0.f, 0.f};
#pragma unroll
                for (int ts = 0; ts < 2; ++ts) { const bf16x8 af = tr_frag(KS + (32 * ts + 8 * g + (c >> 2)) * 144 + (16 * kt + 4 * (c & 3)) * 2, 4 * 144);
                    acc = __builtin_amdgcn_mfma_f32_16x16x32_bf16(af, vf[ts], acc, 0, 0, 0); }
#pragma unroll
                for (int r = 0; r < 4; ++r) Ud[(16 * kt + 4 * g + r) * 128 + 16 * w + c] = acc[r];
            }
        }
    }
}
__device__ __forceinline__ void gla_state_phase(const Frame& F, float* __restrict__ U, const float* __restrict__ DEC) {
    typedef float f32x2 __attribute__((ext_vector_type(2)));
    for (int id = F.bx * NTHREADS + F.tid; id < 32 * 64 * 64; id += F.G * NTHREADS) {
        const int seq = id >> 12, k = (id >> 6) & 63, e2 = id & 63, d = seq >> 4, bh = seq & 15;
        GAS f32x2* p0 = (GAS f32x2*)(U + ((size_t)d * 512 + bh * 32) * 8192 + k * 128) + e2;
        const float* d0 = DEC + ((size_t)d * 512 + bh * 32) * 64 + k;
        f32x2 u[32]; float dc[32];
#pragma unroll
        for (int n = 0; n < 32; ++n) { u[n] = p0[(size_t)n * 4096]; dc[n] = d0[n * 64]; }
        f32x2 S = {0.f, 0.f};
        if (d == 0) {
#pragma unroll
            for (int n = 0; n < 32; ++n) { const f32x2 t = u[n]; u[n] = S; S = S * dc[n] + t; }
        } else {
#pragma unroll
            for (int n = 31; n >= 0; --n) { const f32x2 t = u[n]; u[n] = S; S = S * dc[n] + t; }
        }
#pragma unroll
        for (int n = 0; n < 32; ++n) p0[(size_t)n * 4096] = u[n];
    }
}
__device__ __forceinline__ void gla_o_phase(const Frame& F, const bf16* __restrict__ PB, const float* __restrict__ Z, const float* __restrict__ w2f, const float* __restrict__ b2f,
                                            const float* __restrict__ w2b, const float* __restrict__ b2b, const float* __restrict__ U, const float* __restrict__ gn, bf16* __restrict__ MIX) {
    const int tid = F.tid, lane = F.lane, g = lane >> 4, c = lane & 15, w = F.wave, k = tid & 63, tg = F.wave;
    LAS unsigned char* VI = F.lds + GL_VI; LAS unsigned char* QI = F.lds + GL_A; LAS unsigned char* KI = F.lds + GL_B; LAS unsigned char* PI = F.lds + GL_P; LAS unsigned char* SI = F.lds + GL_SI;
    LAS float* OF = (LAS float*)(F.lds + GL_OF);
    GlaW W; int h_loaded = -1;
    for (int unit = F.bx; unit < BATCH * 4 * 32; unit += F.G) {
        const int b = unit >> 7, h = (unit >> 5) & 3, n = unit & 31;
        const size_t m0 = (size_t)b * SEQ + n * 64;
        const size_t ub = (size_t)(b * 4 + h) * 32 + n;
        if (h != h_loaded) { gla_load_w(W, k, h, w2f, b2f, w2b, b2b); h_loaded = h; }
        const f32x4 zreg = ((const GAS f32x4*)(Z + m0 * 32))[tid];
        unsigned short qraw[8], kraw[8];
#pragma unroll
        for (int i = 0; i < 8; ++i) { qraw[i] = PB[(m0 + tg * 8 + i) * NPB + O_BQ + h * 64 + k]; kraw[i] = PB[(m0 + tg * 8 + i) * NPB + O_BK + h * 64 + k]; }
        v4u vr[2]; gla_load_v(F, PB, m0, h, vr);
        f32x4 sreg[2][4];
#pragma unroll
        for (int d = 0; d < 2; ++d) { const GAS f32x4* sp = (const GAS f32x4*)(U + (ub + (size_t)d * 512) * 8192 + (tid >> 3) * 128 + (tid & 7) * 16);
#pragma unroll
            for (int q4 = 0; q4 < 4; ++q4) sreg[d][q4] = sp[q4]; }
        const v4u g0 = *(const GAS v4u*)(PB + (m0 + (tid >> 3)) * NPB + O_BG + h * 128 + (tid & 7) * 16), g1 = *(const GAS v4u*)(PB + (m0 + (tid >> 3)) * NPB + O_BG + h * 128 + (tid & 7) * 16 + 8);
        __syncthreads();
        float cf[8], cb[8], totf, totb;
        gla_gates(F, zreg, W, cf, cb, totf, totb);
        float qv[8], kv[8];
#pragma unroll
        for (int i = 0; i < 8; ++i) { qv[i] = bf2f(qraw[i]) * 0.125f; kv[i] = bf2f(kraw[i]); }
        gla_store_v(F, vr);
        f32x4 acc[4];
#pragma unroll
        for (int tt = 0; tt < 4; ++tt) acc[tt] = (f32x4){0.f, 0.f, 0.f, 0.f};
#pragma unroll
        for (int d = 0; d < 2; ++d) {
            __syncthreads();
#pragma unroll
            for (int i = 0; i < 8; ++i) { const int t = tg * 8 + i; const float cc = d ? cb[i] : cf[i];
                *(LAS unsigned short*)(QI + t * 144 + k * 2) = (unsigned short)f2bf(qv[i] * __expf(cc));
                *(LAS unsigned short*)(KI + t * 144 + k * 2) = (unsigned short)f2bf(kv[i] * __expf(-cc)); }
            {   const int row = tid >> 3, c16 = (tid & 7) * 16;
                const f32x4 s0 = sreg[d][0], s1 = sreg[d][1], s2 = sreg[d][2], s3 = sreg[d][3];
                v4u o0, o1; o0.x = pk2(s0.x, s0.y); o0.y = pk2(s0.z, s0.w); o0.z = pk2(s1.x, s1.y); o0.w = pk2(s1.z, s1.w); o1.x = pk2(s2.x, s2.y); o1.y = pk2(s2.z, s2.w); o1.z = pk2(s3.x, s3.y); o1.w = pk2(s3.z, s3.w);
                *(LAS v4u*)(SI + row * 272 + c16 * 2) = o0; *(LAS v4u*)(SI + row * 272 + c16 * 2 + 16) = o1; }
            __syncthreads();
#pragma unroll
            for (int q2 = 0; q2 < 2; ++q2) {
                const int id = 2 * w + q2, tt = id >> 2, jt = id & 3;
                f32x4 p = {0.f, 0.f, 0.f, 0.f};
#pragma unroll
                for (int ks = 0; ks < 2; ++ks) { const bf16x8 a = *(const LAS bf16x8*)(QI + (16 * tt + c) * 144 + ks * 64 + g * 16), bb = *(const LAS bf16x8*)(KI + (16 * jt + c) * 144 + ks * 64 + g * 16);
                    p = __builtin_amdgcn_mfma_f32_16x16x32_bf16(a, bb, p, 0, 0, 0); }
#pragma unroll
                for (int r = 0; r < 4; ++r) { const int t = 16 * tt + 4 * g + r, j = 16 * jt + c; const bool keep = d ? (j > t) : (j <= t);
                    *(LAS unsigned short*)(PI + t * 144 + j * 2) = (unsigned short)f2bf(keep ? p[r] : 0.f); }
            }
            __syncthreads();
            bf16x8 vf[2], sf[2];
#pragma unroll
            for (int s2 = 0; s2 < 2; ++s2) { vf[s2] = tr_frag(VI + (32 * s2 + 8 * g + (c >> 2)) * 272 + (16 * w + 4 * (c & 3)) * 2, 4 * 272);
                sf[s2] = tr_frag(SI + (32 * s2 + 8 * g + (c >> 2)) * 272 + (16 * w + 4 * (c & 3)) * 2, 4 * 272); }
#pragma unroll
            for (int tt = 0; tt < 4; ++tt)
#pragma unroll
                for (int s2 = 0; s2 < 2; ++s2) { const bf16x8 pa = *(const LAS bf16x8*)(PI + (16 * tt + c) * 144 + s2 * 64 + g * 16), qa = *(const LAS bf16x8*)(QI + (16 * tt + c) * 144 + s2 * 64 + g * 16);
                    acc[tt] = __builtin_amdgcn_mfma_f32_16x16x32_bf16(pa, vf[s2], acc[tt], 0, 0, 0);
                    acc[tt] = __builtin_amdgcn_mfma_f32_16x16x32_bf16(qa, sf[s2], acc[tt], 0, 0, 0); }
        }
#pragma unroll
        for (int tt = 0; tt < 4; ++tt)
#pragma unroll
            for (int r = 0; r < 4; ++r) OF[(16 * tt + 4 * g + r) * 132 + 16 * w + c] = acc[tt][r];
        __syncthreads();
        {   const int t = tid >> 3, c16 = (tid & 7) * 16;
            float o[16]; float ss = 0.f;
#pragma unroll
            for (int e = 0; e < 16; ++e) { o[e] = OF[t * 132 + c16 + e]; ss += o[e] * o[e]; }
            ss += __shfl_xor(ss, 1); ss += __shfl_xor(ss, 2); ss += __shfl_xor(ss, 4);
            const float rs = rsqrtf(ss * (1.f / 128.f) + EPS);
            const unsigned gg[8] = {g0.x, g0.y, g0.z, g0.w, g1.x, g1.y, g1.z, g1.w};
            unsigned oo[8];
#pragma unroll
            for (int e = 0; e < 8; ++e) { const float ga = bf2f((unsigned short)(gg[e] & 0xffffu)), gb = bf2f((unsigned short)(gg[e] >> 16));
                oo[e] = pk2(o[2 * e] * rs * gn[h * 128 + c16 + 2 * e] * (ga * sigmoidf_(ga)), o[2 * e + 1] * rs * gn[h * 128 + c16 + 2 * e + 1] * (gb * sigmoidf_(gb))); }
            v4u o0, o1; o0.x = oo[0]; o0.y = oo[1]; o0.z = oo[2]; o0.w = oo[3]; o1.x = oo[4]; o1.y = oo[5]; o1.z = oo[6]; o1.w = oo[7];
            *(GAS v4u*)(MIX + (m0 + t) * D + 1024 + h * 128 + c16) = o0; *(GAS v4u*)(MIX + (m0 + t) * D + 1024 + h * 128 + c16 + 8) = o1;
        }
    }
}
constexpr int LRU_LD = 132;
constexpr size_t MISC_CAR_A = 0, MISC_CAR_H = 1 * MiB, MISC_CIN = 2 * MiB, MISC_RS = 4 * MiB;
template <bool FINAL>
__device__ __forceinline__ void lru_phase(const Frame& F, const bf16* __restrict__ PB, const bf16* __restrict__ LRUG, const float* __restrict__ cw, const float* __restrict__ cb,
                                          const float* __restrict__ ba, const float* __restrict__ bx, const float* __restrict__ lam, float* __restrict__ CAR_A, float* __restrict__ CAR_H,
                                          const float* __restrict__ CIN, bf16* __restrict__ MIX) {
    LAS float* XF = (LAS float*)(F.lds);
    LAS float* AS = (LAS float*)(F.lds + 33792);
    LAS float* US = (LAS float*)(F.lds + 2 * 33792);
    LAS unsigned char* XB = F.lds + 3 * 33792;
    const int tid = F.tid, lane = F.lane, g4 = lane >> 4, c = lane & 15, w = F.wave;
    const bool g_const = (F.G & 3) == 0;
    int g_loaded = -1;
    bf16x8 waf[2][4], wxf[2][4]; float bav[2], bxv[2], spv[2], w0[4], w1[4], cb0 = 0.f, cb1 = 0.f;
    for (int unit = F.bx; unit < BATCH * 32 * 4; unit += F.G) {
        const int b = unit >> 7, n = (unit >> 2) & 31, g = unit & 3, t0 = n * 64;
        if (!g_const || g != g_loaded) {
            const int j = 16 * w + c, chj = g * 128 + j;
#pragma unroll
            for (int s = 0; s < 2; ++s) {
                const bf16* wap = LRUG + ((size_t)((s * 2 + 0) * 4 + g) * 128 + j) * 128 + g4 * 8;
                const bf16* wxp = LRUG + ((size_t)((s * 2 + 1) * 4 + g) * 128 + j) * 128 + g4 * 8;
#pragma unroll
                for (int ks = 0; ks < 4; ++ks) { waf[s][ks] = *(const GAS bf16x8*)(wap + ks * 32); wxf[s][ks] = *(const GAS bf16x8*)(wxp + ks * 32); }
                bav[s] = ba[s * 512 + chj]; bxv[s] = bx[s * 512 + chj]; spv[s] = softplusf_(-lam[s * 512 + chj]);
            }
            const int ch = g * 128 + 2 * (tid & 63);
#pragma unroll
            for (int jj = 0; jj < 4; ++jj) { w0[jj] = cw[jj * 512 + ch]; w1[jj] = cw[jj * 512 + ch + 1]; }
            cb0 = cb[ch]; cb1 = cb[ch + 1];
            g_loaded = g;
        }
        __syncthreads();
        {
            const int ch2 = tid & 63, tb = (tid >> 6) * 8, ch = g * 128 + 2 * ch2;
            const float b0 = cb0, b1 = cb1;
            float x0[11], x1[11];
#pragma unroll
            for (int i = 0; i < 11; ++i) { const int t = t0 + tb - 2 + i; unsigned v = 0u; if (t >= 0 && t < SEQ) v = *(const GAS unsigned*)(PB + (size_t)(b * SEQ + t) * NPB + PB_CX + ch);
                x0[i] = bf2f((unsigned short)(v & 0xffffu)); x1[i] = bf2f((unsigned short)(v >> 16)); }
#pragma unroll
            for (int r = 0; r < 8; ++r) { float y0 = b0, y1 = b1;
#pragma unroll
                for (int j = 0; j < 4; ++j) { y0 += x0[r + j] * w0[j]; y1 += x1[r + j] * w1[j]; }
                XF[(tb + r) * LRU_LD + 2 * ch2] = y0; XF[(tb + r) * LRU_LD + 2 * ch2 + 1] = y1;
                *(LAS unsigned*)(XB + (tb + r) * 272 + ch2 * 4) = pk2(y0, y1); }
        }
        __syncthreads();
#pragma unroll
        for (int s = 0; s < 2; ++s) {
            {
                const int j = 16 * w + c;
                LAS float* U = s == 0 ? US : XF;
#pragma unroll
                for (int tt = 0; tt < 4; ++tt) {
                    f32x4 ga = {0.f, 0.f, 0.f, 0.f}, gx = {0.f, 0.f, 0.f, 0.f};
#pragma unroll
                    for (int ks = 0; ks < 4; ++ks) { const bf16x8 xf = *(const LAS bf16x8*)(XB + (16 * tt + c) * 272 + ks * 64 + g4 * 16);
                        ga = __builtin_amdgcn_mfma_f32_16x16x32_bf16(xf, waf[s][ks], ga, 0, 0, 0); gx = __builtin_amdgcn_mfma_f32_16x16x32_bf16(xf, wxf[s][ks], gx, 0, 0, 0); }
#pragma unroll
                    for (int r = 0; r < 4; ++r) { const int t = 16 * tt + 4 * g4 + r;
                        const float rg = sigmoidf_(ga[r] + bav[s]), ig = sigmoidf_(gx[r] + bxv[s]);
                        const float a = __builtin_amdgcn_exp2f(-8.f * 1.4426950408889634f * rg * spv[s]);
                        const float xv = XF[t * LRU_LD + j];
                        AS[t * LRU_LD + j] = a; U[t * LRU_LD + j] = __builtin_amdgcn_sqrtf(fmaxf(1.f - a * a, 0.f)) * (ig * xv); }
                }
            }
            __syncthreads();
            if (tid < 128) {
                LAS float* U = s == 0 ? US : XF;
                const size_t ci = ((size_t)((s * BATCH + b) * 32 + n)) * 512 + g * 128 + tid;
                float h = FINAL ? CIN[ci] : 0.f, ap = 1.f;
#pragma unroll 8
                for (int st = 0; st < 64; ++st) { const int t = s ? 63 - st : st; const float a = AS[t * LRU_LD + tid], u = U[t * LRU_LD + tid]; h = a * h + u; ap *= a;
                    if (FINAL) { if (s == 0) US[t * LRU_LD + tid] = h; else US[t * LRU_LD + tid] += h; } }
                if (!FINAL) { CAR_A[ci] = ap; CAR_H[ci] = h; }
            }
            __syncthreads();
        }
        if (FINAL) {
            const int t = tid >> 3, c16 = (tid & 7) * 16;
            const size_t m = (size_t)b * SEQ + t0 + t;
            const v4u y0 = *(const GAS v4u*)(PB + m * NPB + PB_CY + g * 128 + c16), y1 = *(const GAS v4u*)(PB + m * NPB + PB_CY + g * 128 + c16 + 8);
            const unsigned yy[8] = {y0.x, y0.y, y0.z, y0.w, y1.x, y1.y, y1.z, y1.w};
            unsigned oo[8];
#pragma unroll
            for (int e = 0; e < 8; ++e) { const float ya = bf2f((unsigned short)(yy[e] & 0xffffu)), yb = bf2f((unsigned short)(yy[e] >> 16));
                oo[e] = pk2(US[t * LRU_LD + c16 + 2 * e] * gelu_tanh(ya), US[t * LRU_LD + c16 + 2 * e + 1] * gelu_tanh(yb)); }
            v4u o0, o1; o0.x = oo[0]; o0.y = oo[1]; o0.z = oo[2]; o0.w = oo[3]; o1.x = oo[4]; o1.y = oo[5]; o1.z = oo[6]; o1.w = oo[7];
            *(GAS v4u*)(MIX + m * D + 1536 + g * 128 + c16) = o0; *(GAS v4u*)(MIX + m * D + 1536 + g * 128 + c16 + 8) = o1;
        }
    }
}
__device__ __forceinline__ void lru_carry_phase(const Frame& F, const float* __restrict__ CAR_A, const float* __restrict__ CAR_H, float* __restrict__ CIN) {
    const int id = F.bx * NTHREADS + F.tid;
    if (id < 2 * BATCH * 512) {
        const int s = id >> 11, b = (id >> 9) & 3, ch = id & 511;
        float h = 0.f;
        for (int st = 0; st < 32; ++st) { const int n = s ? 31 - st : st; const size_t ci = ((size_t)((s * BATCH + b) * 32 + n)) * 512 + ch;
            CIN[ci] = h; h = CAR_A[ci] * h + CAR_H[ci]; }
    }
}
#define WA_LOAD(colbase, u_) do { const int b_ = (u_) >> 7, hkv_ = (((u_) >> 4) & 7) >> 2, q0_ = ((u_) & 15) * 128; \
    _Pragma("unroll") for (int i_ = 0; i_ < 12; ++i_) { const int ch_ = tid + NTHREADS * i_, r_ = ch_ >> 4, col_ = ch_ & 15; int j_ = q0_ - 128 + r_; j_ = j_ < 0 ? 0 : (j_ > SEQ - 1 ? SEQ - 1 : j_); \
        kreg[i_] = *(const GAS v4u*)(PB + (size_t)(b_ * SEQ + j_) * NPB + (colbase) + hkv_ * 128 + col_ * 8); } } while (0)
#define WA_STORE() do { _Pragma("unroll") for (int i_ = 0; i_ < 12; ++i_) { const int ch_ = tid + NTHREADS * i_, r_ = ch_ >> 4, col_ = ch_ & 15; \
        *(LAS v4u*)(KS + r_ * 272 + col_ * 16) = kreg[i_]; } } while (0)
__device__ __forceinline__ void wattn_phase(const Frame& F, const bf16* __restrict__ PB, const float* __restrict__ rel_bias, const float* __restrict__ sink, bf16* __restrict__ MIX) {
    LAS unsigned char* KS = F.lds;
    LAS float* btab = (LAS float*)(F.lds + 384 * 272);
    const int lane = F.lane, g = lane >> 4, c = lane & 15, w = F.wave, tid = F.tid;
    constexpr int NUNITS = BATCH * 8 * (SEQ / 128);
    v4u kreg[12];
    int unit = F.bx, bias_hq = -1;
    if (unit < NUNITS) WA_LOAD(O_AK, unit);
    while (unit < NUNITS) {
        const int b = unit >> 7, hq = (unit >> 4) & 7, qb = unit & 15;
        const int q0 = qb * 128;
        __syncthreads();
        WA_STORE();
        if (hq != bias_hq) { if (tid < 304) { const int rel = tid - 143; btab[tid] = (rel >= -128 && rel <= 128) ? rel_bias[t5_bucket(rel) * 8 + hq] : -1e30f; } bias_hq = hq; }
        __syncthreads();
        WA_LOAD(O_AV, unit);
        f32x4 S[17];
#pragma unroll
        for (int kt = 0; kt < 17; ++kt) S[kt] = (f32x4){0.f, 0.f, 0.f, 0.f};
        const bf16* qrow = PB + (size_t)(b * SEQ + q0 + 16 * w + c) * NPB + O_AQ + hq * 128 + g * 8;
#pragma unroll
        for (int ks = 0; ks < 4; ++ks) {
            const bf16x8 qf = *(const GAS bf16x8*)(qrow + ks * 32);
#pragma unroll
            for (int kt = 0; kt < 17; ++kt) { const bf16x8 kf = *(const LAS bf16x8*)(KS + (16 * w + 16 * kt + c) * 272 + ks * 64 + g * 16); S[kt] = __builtin_amdgcn_mfma_f32_16x16x32_bf16(kf, qf, S[kt], 0, 0, 0);
                if (kt == 8 || kt == 16) __builtin_amdgcn_sched_barrier(0); }
        }
        const float snk = sink[hq];
        float mx = snk;
        const int row_lo = (qb == 0) ? 128 : 0, row_n = ((qb == SEQ / 128 - 1) ? 256 : 384) - row_lo;
#pragma unroll
        for (int kt = 0; kt < 17; ++kt)
#pragma unroll
            for (int r = 0; r < 4; ++r) {
                const int row = 16 * w + 16 * kt + 4 * g + r;
                const float bias = btab[(4 * g - c + 15) + 16 * kt + r];
                const float s = ((unsigned)(row - row_lo) < (unsigned)row_n) ? S[kt][r] * 0.08838834764831845f + bias : -1e30f;
                S[kt][r] = s; mx = fmaxf(mx, s);
                if (r == 3 && (kt & 1)) __builtin_amdgcn_sched_barrier(0);
            }
        mx = fmaxf(mx, __shfl_xor(mx, 16)); mx = fmaxf(mx, __shfl_xor(mx, 32));
        float sum = 0.f;
#pragma unroll
        for (int kt = 0; kt < 17; ++kt)
#pragma unroll
            for (int r = 0; r < 4; ++r) { const float p = __builtin_amdgcn_exp2f((S[kt][r] - mx) * 1.4426950408889634f); S[kt][r] = p; sum += p; }
        sum += __shfl_xor(sum, 16); sum += __shfl_xor(sum, 32);
        sum += __builtin_amdgcn_exp2f((snk - mx) * 1.4426950408889634f);
        const float inv = 1.f / sum;
        bf16x8 pf[9];
#pragma unroll
        for (int s = 0; s < 9; ++s) { v4u t; t.x = pk2(S[2 * s][0] * inv, S[2 * s][1] * inv); t.y = pk2(S[2 * s][2] * inv, S[2 * s][3] * inv);
            if (s < 8) { t.z = pk2(S[2 * s + 1][0] * inv, S[2 * s + 1][1] * inv); t.w = pk2(S[2 * s + 1][2] * inv, S[2 * s + 1][3] * inv); } else { t.z = 0u; t.w = 0u; }
            pf[s] = __builtin_bit_cast(bf16x8, t); }
        __syncthreads();
        WA_STORE();
        __syncthreads();
        const int nxt = unit + F.G;
        if (nxt < NUNITS) WA_LOAD(O_AK, nxt);
        for (int dt = 0; dt < 8; ++dt) {
            f32x4 acc = {0.f, 0.f, 0.f, 0.f};
#pragma unroll
            for (int s = 0; s < 9; ++s) {
                LAS unsigned char* vp = KS + (16 * w + 32 * s + 4 * g + (c >> 2)) * 272 + (16 * dt + 4 * (c & 3)) * 2;
                const s16x4 lo = __builtin_amdgcn_ds_read_tr16_b64_v4i16((LAS s16x4*)vp);
                const s16x4 hi = __builtin_amdgcn_ds_read_tr16_b64_v4i16((LAS s16x4*)(vp + (s < 8 ? 16 * 272 : 0)));
                const bf16x8 vf = __builtin_shufflevector(lo, hi, 0, 1, 2, 3, 4, 5, 6, 7);
                acc = __builtin_amdgcn_mfma_f32_16x16x32_bf16(vf, pf[s], acc, 0, 0, 0);
            }
            v2u o; o.x = pk2(acc[0], acc[1]); o.y = pk2(acc[2], acc[3]);
            *(GAS v2u*)(MIX + (size_t)(b * SEQ + q0 + 16 * w + c) * D + hq * 128 + dt * 16 + 4 * g) = o;
        }
        unit = nxt;
    }
}
#undef WA_LOAD
#undef WA_STORE
#define XA_LOAD(u_, st_) do { const int b_ = (u_) >> 6, h_ = ((u_) >> 4) & 3; \
    if ((st_) < 4) { _Pragma("unroll") for (int i_ = 0; i_ < 8; ++i_) { const int row_ = (tid >> 4) + 32 * i_, col_ = tid & 15; \
            R[i_] = *(const GAS v4u*)(KX + (size_t)(b_ * MEM_LEN + row_) * D + h_ * 512 + (st_) * 128 + col_ * 8); } } \
    else { _Pragma("unroll") for (int i_ = 0; i_ < 8; ++i_) { const int row_ = (tid >> 5) + 16 * i_, col_ = tid & 31; \
            R[i_] = *(const GAS v4u*)(VT + (size_t)(h_ * 512 + ((st_) - 4) * 128 + row_) * MM + b_ * MEM_LEN + col_ * 8); } } } while (0)
#define XA_STORE(st_) do { if ((st_) < 4) { _Pragma("unroll") for (int i_ = 0; i_ < 8; ++i_) { const int row_ = (tid >> 4) + 32 * i_, col_ = tid & 15; *(LAS v4u*)(KS + row_ * 272 + col_ * 16) = R[i_]; } } \
    else { _Pragma("unroll") for (int i_ = 0; i_ < 8; ++i_) { const int row_ = (tid >> 5) + 16 * i_, col_ = tid & 31; *(LAS v4u*)(KS + row_ * 528 + col_ * 16) = R[i_]; } } } while (0)
__device__ __forceinline__ void xattn_phase(const Frame& F, const bf16* __restrict__ Q, const bf16* __restrict__ KX, const bf16* __restrict__ VT, bf16* __restrict__ O) {
    LAS unsigned char* KS = F.lds;
    const int lane = F.lane, g = lane >> 4, c = lane & 15, w = F.wave, tid = F.tid;
    constexpr int NUNITS = BATCH * 4 * (SEQ / 128);
    v4u R[8];
    int unit = F.bx;
    if (unit < NUNITS) XA_LOAD(unit, 0);
    while (unit < NUNITS) {
        const int b = unit >> 6, h = (unit >> 4) & 3, qb = unit & 15;
        const int m0 = b * SEQ + qb * 128 + w * 16;
        const int nxt = unit + F.G;
        f32x4 S[16];
#pragma unroll
        for (int kt = 0; kt < 16; ++kt) S[kt] = (f32x4){0.f, 0.f, 0.f, 0.f};
        const bf16* qrow = Q + (size_t)(m0 + c) * D + h * 512 + g * 8;
#pragma unroll
        for (int dc = 0; dc < 4; ++dc) {
            bf16x8 qf[4];
#pragma unroll
            for (int ks = 0; ks < 4; ++ks) qf[ks] = *(const GAS bf16x8*)(qrow + dc * 128 + ks * 32);
            __syncthreads();
            XA_STORE(dc);
            __syncthreads();
            XA_LOAD(unit, dc + 1);
#pragma unroll
            for (int ks = 0; ks < 4; ++ks) {
#pragma unroll
                for (int kt = 0; kt < 16; ++kt) { const bf16x8 kf = *(const LAS bf16x8*)(KS + (16 * kt + c) * 272 + ks * 64 + g * 16); S[kt] = __builtin_amdgcn_mfma_f32_16x16x32_bf16(kf, qf[ks], S[kt], 0, 0, 0); }
            }
        }
        float mx = -3.0e38f;
#pragma unroll
        for (int kt = 0; kt < 16; ++kt)
#pragma unroll
            for (int r = 0; r < 4; ++r) mx = fmaxf(mx, S[kt][r]);
        mx = fmaxf(mx, __shfl_xor(mx, 16)); mx = fmaxf(mx, __shfl_xor(mx, 32));
        const float sc2 = 0.044194173824159216f * 1.4426950408889634f;
        float sum = 0.f;
#pragma unroll
        for (int kt = 0; kt < 16; ++kt)
#pragma unroll
            for (int r = 0; r < 4; ++r) { const float p = __builtin_amdgcn_exp2f((S[kt][r] - mx) * sc2); S[kt][r] = p; sum += p; }
        sum += __shfl_xor(sum, 16); sum += __shfl_xor(sum, 32);
        const float inv = 1.f / sum;
        bf16x8 pf[8];
#pragma unroll
        for (int s = 0; s < 8; ++s) { v4u t; t.x = pk2(S[2 * s][0] * inv, S[2 * s][1] * inv); t.y = pk2(S[2 * s][2] * inv, S[2 * s][3] * inv); t.z = pk2(S[2 * s + 1][0] * inv, S[2 * s + 1][1] * inv); t.w = pk2(S[2 * s + 1][2] * inv, S[2 * s + 1][3] * inv);
            pf[s] = __builtin_bit_cast(bf16x8, t); }
#pragma unroll
        for (int dc = 0; dc < 4; ++dc) {
            __syncthreads();
            XA_STORE(4 + dc);
            __syncthreads();
            if (dc < 3) XA_LOAD(unit, 5 + dc); else if (nxt < NUNITS) XA_LOAD(nxt, 0);
            for (int dt = 0; dt < 8; ++dt) {
                f32x4 acc = {0.f, 0.f, 0.f, 0.f};
#pragma unroll
                for (int s = 0; s < 8; ++s) {
                    const LAS unsigned char* vp = KS + (16 * dt + c) * 528 + 64 * s + 8 * g;
                    const v2u lo = *(const LAS v2u*)vp, hi = *(const LAS v2u*)(vp + 32);
                    v4u t; t.x = lo.x; t.y = lo.y; t.z = hi.x; t.w = hi.y;
                    acc = __builtin_amdgcn_mfma_f32_16x16x32_bf16(__builtin_bit_cast(bf16x8, t), pf[s], acc, 0, 0, 0);
                }
                v2u o; o.x = pk2(acc[0], acc[1]); o.y = pk2(acc[2], acc[3]);
                *(GAS v2u*)(O + (size_t)(m0 + c) * D + h * 512 + dc * 128 + dt * 16 + 4 * g) = o;
            }
        }
        unit = nxt;
    }
}
#undef XA_LOAD
#undef XA_STORE
constexpr int NPL = 15;
enum Phase { PH_CONV = 0, PH_KV, PH_IN, PH_X1, PH_X2, PH_X3, PH_OUT, PH_RN1, PH_Q, PH_XA, PH_O, PH_RN2, PH_UP, PH_DOWN, PH_RN3 };
#define CAS __attribute__((address_space(4)))
struct Args { const float* in[31]; float* out; unsigned char* ws; int ph_lo, ph_hi, li, pad; };

__global__ void __launch_bounds__(NTHREADS, 2) fwd(Args args) {
    extern __shared__ __attribute__((aligned(16))) unsigned char lds[];
    Frame F;
    F.lds = (LAS unsigned char*)lds;
    const int wave_s = __builtin_amdgcn_readfirstlane(threadIdx.x >> 6);
    F.tid = threadIdx.x; F.lane = F.tid & 63; F.wave = wave_s;
    F.G = gridDim.x; F.bx = blockIdx.x;
    unsigned char* ws_top = args.ws;
    const int lo = args.ph_lo, hi = args.ph_hi;
    for (int u = F.tid; u < (LDS_BYTES - LDSCTL_OFF) / 4; u += NTHREADS) ((LAS unsigned*)(F.lds + LDSCTL_OFF))[u] = 0u;
    __syncthreads();
    XcdBarrier bar; bar.bar = (unsigned*)(ws_top + WS_CTL) + CW_BAR; bar.x = 0; bar.st = nullptr;
    const bool one_launch = (hi - lo) > 1;
    if (one_launch) bar = xcd_barrier_post((unsigned*)(ws_top + WS_CTL) + CW_BAR, (volatile LAS unsigned*)(F.lds + MISC_OFF) + 8);
#define SEAM(k) do { if (one_launch && (k) + 1 < hi) { xcd_barrier(bar); if (PROBE_REP & 512) xcd_barrier(bar); } } while (0)
#define IN(k) (lo <= (k) && (k) < hi)
#define REPS(bit) (1 + ((PROBE_REP >> (bit)) & 1))
#define PHASE_BEGIN() const CAS Args* ka_ = (const CAS Args*)__builtin_amdgcn_kernarg_segment_ptr(); asm volatile("" : "+s"(ka_)); \
    unsigned mk_ = ~0u; int l = l_it; asm volatile("" : "+s"(mk_), "+s"(l));     \
    int tz_ = (wave_s << 6) + (int)__builtin_amdgcn_mbcnt_hi(mk_, __builtin_amdgcn_mbcnt_lo(mk_, 0u)); asm volatile("" : "+v"(tz_)); F.tid = tz_; F.lane = tz_ & 63; F.wave = __builtin_amdgcn_readfirstlane(tz_ >> 6); \
    unsigned char* ws = ka_->ws; float* X = ka_->out; bf16* XN = (bf16*)(ws + WS_XN); bf16* Y = (bf16*)(ws + WS_Y); float* RS = (float*)(ws + WS_MISC + MISC_RS); unsigned char* wl = ws + WS_W + (size_t)(l % NWL) * WL_BYTES; \
    const int gw = F.bx * NWAVES + F.wave; (void)gw; (void)X; (void)XN; (void)Y; (void)wl; (void)RS
    const int NGW = F.G * NWAVES;

    for (int l_it = 0; l_it < DEPTH; ++l_it) {
        const int pb = l_it * NPL;
        for (int rep_ = 0; rep_ < REPS(0); ++rep_) if (IN(pb + PH_CONV)) { PHASE_BEGIN();
            LAS float* scr = (LAS float*)(F.lds + RING_OFF + F.wave * 16384);
            const int lc0 = (NWL == 1) ? l : (l == 0 ? 0 : DEPTH), lc1 = (NWL == 1) ? l + 1 : DEPTH;
            for (int lc = lc0; lc < lc1; ++lc) {
                unsigned char* wb = ws + WS_W + (size_t)(lc % NWL) * WL_BYTES;
                const ConvSeg segs[10] = {
                    {ka_->in[3] + (size_t)lc * D * DIN, D, DIN, 0, 3072, (bf16*)(wb + WL_IN), 0, ka_->in[24] + (size_t)lc * D},
                    {ka_->in[3] + (size_t)lc * D * DIN, D, DIN, 3072, 32, (bf16*)(wb + WL_Z), 0, ka_->in[24] + (size_t)lc * D},
                    {ka_->in[3] + (size_t)lc * D * DIN, D, DIN, 3104, 1024, (bf16*)(wb + WL_IN), 3072, ka_->in[24] + (size_t)lc * D},
                    {ka_->in[4] + (size_t)lc * D * D, D, D, 0, D, (bf16*)(wb + WL_OUT), 0, nullptr},
                    {ka_->in[18] + (size_t)lc * D * D, D, D, 0, D, (bf16*)(wb + WL_XQ), 0, ka_->in[27] + (size_t)lc * D},
                    {ka_->in[19] + (size_t)lc * D * D, D, D, 0, D, (bf16*)(wb + WL_XK), 0, nullptr},
                    {ka_->in[20] + (size_t)lc * D * D, D, D, 0, D, (bf16*)(wb + WL_XV), 0, nullptr},
                    {ka_->in[21] + (size_t)lc * D * D, D, D, 0, D, (bf16*)(wb + WL_XO), 0, nullptr},
                    {ka_->in[22] + (size_t)lc * D * DFF, D, DFF, 0, DFF, (bf16*)(wb + WL_UP), 0, ka_->in[29] + (size_t)lc * D},
                    {ka_->in[23] + (size_t)lc * DFF * D, DFF, D, 0, D, (bf16*)(wb + WL_DOWN), 0, nullptr}};
                int total = 0;
#pragma unroll
                for (int s = 0; s < 10; ++s) total += seg_items(segs[s]);
                for (int it = gw; it < total; it += NGW) {
                    int r = it;
#pragma unroll
                    for (int s = 0; s < 10; ++s) { const int n = seg_items(segs[s]);
                        if (r >= 0 && r < n) p0_transpose_item(segs[s].W, segs[s].K, segs[s].N, segs[s].c0, segs[s].WT, segs[s].r0, segs[s].ncols / 32, segs[s].gain, scr, r, F.lane);
                        r -= n; }
                }
            }
            for (int lc = lc0; lc < lc1; ++lc) {
                bf16* lg = (bf16*)(ws + WS_W + (size_t)(lc % NWL) * WL_BYTES + WL_LRUG);
                for (int it = gw; it < 16 * 8; it += NGW) { const int mi = it >> 3, gate = mi >> 3, s = (mi >> 2) & 1, gg = mi & 3;
                    p0_transpose_item(ka_->in[gate ? 15 : 13] + ((size_t)lc * 8 + s * 4 + gg) * 16384, 128, 128, 0, lg + (size_t)((s * 2 + gate) * 4 + gg) * 16384, 0, 4, nullptr, scr, it & 7, F.lane); }
            }
            if (l == 0) for (int m = gw; m < M; m += NGW) init_row(F.lane, ka_->in[0] + (size_t)m * D, XN + (size_t)m * D, RS + m);
            for (int lc = lc0; lc < lc1; ++lc)
                for (int m = gw; m < MM; m += NGW) norm_row(F.lane, ka_->in[1] + (size_t)m * D, ka_->in[26] + (size_t)lc * D, (bf16*)(ws + WS_MEMN) + ((size_t)lc * MM + m) * D, nullptr);
        }
        if (l_it == 0 || NWL == 1) SEAM(pb + PH_CONV);
        for (int rep_ = 0; rep_ < REPS(1); ++rep_) if (IN(pb + PH_KV)) { PHASE_BEGIN();
            const int lc0 = (NWL == 1) ? l : (l == 0 ? 0 : DEPTH), lc1 = (NWL == 1) ? l + 1 : DEPTH;
            if (lc1 > lc0) {
                const bf16* base = (const bf16*)(ws + WS_W);
                pg8::Gemm g{base, base, 0, 0, D};
                pg8::KvOrder S; S.G = F.G; S.c = F.bx; S.NL = lc1 - lc0; S.l0 = lc0;
                S.memn_p0 = (int)((WS_MEMN - WS_W) / MiB) + 4 * lc0; S.memn_ps = 4;
                S.xk_p0 = (int)(((size_t)(lc0 % NWL) * WL_BYTES + WL_XK) / MiB); S.xv_p0 = (int)(((size_t)(lc0 % NWL) * WL_BYTES + WL_XV) / MiB); S.w_ps = (int)(WL_BYTES / MiB);
                pg8::EpiBf16<0> E{(bf16*)(ws + WS_KX), D, (bf16*)(ws + WS_VT), MM, nullptr};
                pg8::gemm_phase<pg8::EpiBf16<0>, pg8::KvOrder, true, true>(F.lds + RING_OFF, g, S, E, F.tid);
            }
        }
        if (l_it == 0 || NWL == 1) SEAM(pb + PH_KV);
        for (int rep_ = 0; rep_ < REPS(2); ++rep_) if (IN(pb + PH_IN)) { PHASE_BEGIN();
            pg8::Gemm g{XN, (const bf16*)(wl + WL_IN), M, NPB, D}; pg8::StaticOrder S; S.init(M, NPB, F.G, F.bx);
            pg8::EpiBf16<0> E{(bf16*)(ws + WS_PB), NPB, nullptr, 0, RS};
            pg8::gemm_phase<pg8::EpiBf16<0>, pg8::StaticOrder, true, true>(F.lds + RING_OFF, g, S, E, F.tid);
            zgemm(F, XN, (const bf16*)(wl + WL_Z), RS, (float*)(ws + WS_Z));
        }
        SEAM(pb + PH_IN);
        if (IN(pb + PH_X1)) { PHASE_BEGIN();
            for (int rep_ = 0; rep_ < REPS(3); ++rep_) gla_u_phase(F, (const bf16*)(ws + WS_PB), (const float*)(ws + WS_Z), ka_->in[6] + (size_t)l * 4096, ka_->in[7] + (size_t)l * 256, ka_->in[8] + (size_t)l * 4096, ka_->in[9] + (size_t)l * 256,
                        (float*)(ws + WS_GLAU), (float*)(ws + WS_MISC + MISC_DEC));
            for (int rep_ = 0; rep_ < REPS(5); ++rep_) lru_phase<false>(F, (const bf16*)(ws + WS_PB), (const bf16*)(wl + WL_LRUG), ka_->in[11] + (size_t)l * 2048, ka_->in[12] + (size_t)l * 512, ka_->in[14] + (size_t)l * 1024, ka_->in[16] + (size_t)l * 1024, ka_->in[17] + (size_t)l * 1024,
                             (float*)(ws + WS_MISC + MISC_CAR_A), (float*)(ws + WS_MISC + MISC_CAR_H), nullptr, nullptr); }
        SEAM(pb + PH_X1);
        if (IN(pb + PH_X2)) { PHASE_BEGIN();
            gla_state_phase(F, (float*)(ws + WS_GLAU), (const float*)(ws + WS_MISC + MISC_DEC));
            lru_carry_phase(F, (const float*)(ws + WS_MISC + MISC_CAR_A), (const float*)(ws + WS_MISC + MISC_CAR_H), (float*)(ws + WS_MISC + MISC_CIN));
            for (int rep_ = 0; rep_ < REPS(6); ++rep_) wattn_phase(F, (const bf16*)(ws + WS_PB), ka_->in[2], ka_->in[5] + l * 8, (bf16*)(ws + WS_MIX)); }
        SEAM(pb + PH_X2);
        if (IN(pb + PH_X3)) { PHASE_BEGIN();
            for (int rep_ = 0; rep_ < REPS(7); ++rep_) gla_o_phase(F, (const bf16*)(ws + WS_PB), (const float*)(ws + WS_Z), ka_->in[6] + (size_t)l * 4096, ka_->in[7] + (size_t)l * 256, ka_->in[8] + (size_t)l * 4096, ka_->in[9] + (size_t)l * 256,
                        (const float*)(ws + WS_GLAU), ka_->in[10] + (size_t)l * 512, (bf16*)(ws + WS_MIX));
            for (int rep_ = 0; rep_ < REPS(8); ++rep_) lru_phase<true>(F, (const bf16*)(ws + WS_PB), (const bf16*)(wl + WL_LRUG), ka_->in[11] + (size_t)l * 2048, ka_->in[12] + (size_t)l * 512, ka_->in[14] + (size_t)l * 1024, ka_->in[16] + (size_t)l * 1024, ka_->in[17] + (size_t)l * 1024,
                            nullptr, nullptr, (const float*)(ws + WS_MISC + MISC_CIN), (bf16*)(ws + WS_MIX)); }
        SEAM(pb + PH_X3);
        for (int rep_ = 0; rep_ < REPS(2); ++rep_) if (IN(pb + PH_OUT)) { PHASE_BEGIN();
            pg8::Gemm g{(const bf16*)(ws + WS_MIX), (const bf16*)(wl + WL_OUT), M, D, D}; pg8::StaticOrder S; S.init(M, D, F.G, F.bx);
            pg8::EpiBf16<0> E{Y, D, nullptr, 0, nullptr};
            pg8::gemm_phase<pg8::EpiBf16<0>, pg8::StaticOrder, true, true>(F.lds + RING_OFF, g, S, E, F.tid);
        }
        SEAM(pb + PH_OUT);
        if (IN(pb + PH_RN1)) { PHASE_BEGIN(); if (NGW * 4 == M) resid_rows<4>(F.lane, XN + (size_t)gw * D, Y + (size_t)gw * D, (size_t)NGW * D, ka_->in[25] + (size_t)l * D, RS + gw, (size_t)NGW, nullptr); else for (int m = gw; m < M; m += NGW) resid_row(F.lane, XN + (size_t)m * D, Y + (size_t)m * D, ka_->in[25] + (size_t)l * D, RS + m, nullptr); }
        SEAM(pb + PH_RN1);
        for (int rep_ = 0; rep_ < REPS(2); ++rep_) if (IN(pb + PH_Q)) { PHASE_BEGIN();
            pg8::Gemm g{XN, (const bf16*)(wl + WL_XQ), M, D, D}; pg8::StaticOrder S; S.init(M, D, F.G, F.bx);
            pg8::EpiBf16<0> E{(bf16*)(ws + WS_Q), D, nullptr, 0, RS};
            pg8::gemm_phase<pg8::EpiBf16<0>, pg8::StaticOrder, true, true>(F.lds + RING_OFF, g, S, E, F.tid);
        }
        SEAM(pb + PH_Q);
        for (int rep_ = 0; rep_ < REPS(4); ++rep_) if (IN(pb + PH_XA)) { PHASE_BEGIN(); xattn_phase(F, (const bf16*)(ws + WS_Q), (const bf16*)(ws + WS_KX) + (size_t)l * MM * D, (const bf16*)(ws + WS_VT) + (size_t)l * D * MM, (bf16*)(ws + WS_O)); }
        SEAM(pb + PH_XA);
        for (int rep_ = 0; rep_ < REPS(2); ++rep_) if (IN(pb + PH_O)) { PHASE_BEGIN();
            pg8::Gemm g{(const bf16*)(ws + WS_O), (const bf16*)(wl + WL_XO), M, D, D}; pg8::StaticOrder S; S.init(M, D, F.G, F.bx);
            pg8::EpiBf16<0> E{Y, D, nullptr, 0, nullptr};
            pg8::gemm_phase<pg8::EpiBf16<0>, pg8::StaticOrder, true, true>(F.lds + RING_OFF, g, S, E, F.tid);
        }
        SEAM(pb + PH_O);
        if (IN(pb + PH_RN2)) { PHASE_BEGIN(); if (NGW * 4 == M) resid_rows<4>(F.lane, XN + (size_t)gw * D, Y + (size_t)gw * D, (size_t)NGW * D, ka_->in[28] + (size_t)l * D, RS + gw, (size_t)NGW, nullptr); else for (int m = gw; m < M; m += NGW) resid_row(F.lane, XN + (size_t)m * D, Y + (size_t)m * D, ka_->in[28] + (size_t)l * D, RS + m, nullptr); }
        SEAM(pb + PH_RN2);
        for (int rep_ = 0; rep_ < REPS(2); ++rep_) if (IN(pb + PH_UP)) { PHASE_BEGIN();
            pg8::Gemm g{XN, (const bf16*)(wl + WL_UP), M, DFF, D}; pg8::StaticOrder S; S.init(M, DFF, F.G, F.bx);
            pg8::EpiBf16<1> E{(bf16*)(ws + WS_H), DFF, nullptr, 0, RS};
            pg8::gemm_phase<pg8::EpiBf16<1>, pg8::StaticOrder, true, true>(F.lds + RING_OFF, g, S, E, F.tid);
        }
        SEAM(pb + PH_UP);
        for (int rep_ = 0; rep_ < REPS(2); ++rep_) if (IN(pb + PH_DOWN)) { PHASE_BEGIN();
            pg8::Gemm g{(const bf16*)(ws + WS_H), (const bf16*)(wl + WL_DOWN), M, D, DFF}; pg8::StaticOrder S; S.init(M, D, F.G, F.bx);
            pg8::EpiBf16<0> E{Y, D, nullptr, 0, nullptr};
            pg8::gemm_phase<pg8::EpiBf16<0>, pg8::StaticOrder, true, true>(F.lds + RING_OFF, g, S, E, F.tid);
        }
        SEAM(pb + PH_DOWN);
        if (IN(pb + PH_RN3)) { PHASE_BEGIN(); if (NGW * 4 == M) resid_rows<4>(F.lane, XN + (size_t)gw * D, Y + (size_t)gw * D, (size_t)NGW * D, ka_->in[30] + (size_t)l * D, RS + gw, (size_t)NGW, (l + 1 < DEPTH) ? nullptr : X + (size_t)gw * D); else for (int m = gw; m < M; m += NGW) resid_row(F.lane, XN + (size_t)m * D, Y + (size_t)m * D, ka_->in[30] + (size_t)l * D, RS + m, (l + 1 < DEPTH) ? nullptr : X + (size_t)m * D); }
        SEAM(pb + PH_RN3);
    }
#undef IN
#undef SEAM
}
extern "C" void kernel_launch(void* const* d_in, const int* in_sizes, int n_in, void* d_out, int out_size, void* d_ws, size_t ws_size, hipStream_t stream) {
    static int grid = 0;
    if (grid == 0) {
        int dev = 0, cus = 0;
        if (n_in != 31 || out_size != M * D || ws_size < WS_END) { fprintf(stderr, "kernel_launch: built for 31 inputs, %d outputs, >= %zu bytes of workspace; got %d, %d, %zu\n", M * D, (size_t)WS_END, n_in, out_size, ws_size); grid = -1; return; }
        if (hipGetDevice(&dev) != hipSuccess || hipDeviceGetAttribute(&cus, hipDeviceAttributeMultiprocessorCount, dev) != hipSuccess) { fprintf(stderr, "kernel_launch: device query failed\n"); grid = -1; return; }
        if (hipFuncSetAttribute((const void*)fwd, hipFuncAttributeMaxDynamicSharedMemorySize, LDS_BYTES) != hipSuccess) { fprintf(stderr, "kernel_launch: hipFuncSetAttribute failed\n"); grid = -1; return; }
        int per_cu = 0;
        if (hipOccupancyMaxActiveBlocksPerMultiprocessor(&per_cu, (const void*)fwd, NTHREADS, LDS_BYTES) != hipSuccess || per_cu < 1) { fprintf(stderr, "kernel_launch: occupancy query reports %d workgroups per CU\n", per_cu); (void)hipGetLastError(); }
        grid = cus;
    }
    if (grid < 0) return;
    unsigned char* ws = (unsigned char*)d_ws;
    (void)hipMemsetAsync(ws + WS_CTL, 0, CTL_ZERO_BYTES, stream);
    Args a{};
    for (int i = 0; i < 31; ++i) a.in[i] = (const float*)d_in[i];
    a.out = (float*)d_out; a.ws = ws;
#if defined(MK_PER_PHASE) && MK_PER_PHASE
    for (int p = 0; p < DEPTH * NPL; ++p) { if (NWL == 4 && p >= NPL && (p % NPL) < 2) continue; a.ph_lo = p; a.ph_hi = p + 1; hipLaunchKernelGGL(fwd, dim3(grid), dim3(NTHREADS), LDS_BYTES, stream, a); }
#else
    a.ph_lo = 0; a.ph_hi = DEPTH * NPL;
    hipLaunchKernelGGL(fwd, dim3(grid), dim3(NTHREADS), LDS_BYTES, stream, a);
    const hipError_t le = hipPeekAtLastError();
    if (le != hipSuccess) fprintf(stderr, "kernel_launch: launch failed: %s\n", hipGetErrorName(le));
#endif
}
```

```cpp
#include <hip/hip_runtime.h>
#include <cstdint>
#include <cstdio>

__device__ __forceinline__ float lane_xor_f(float v, int mask, int lane) { return __builtin_bit_cast(float, __builtin_amdgcn_ds_bpermute((lane ^ mask) << 2, __builtin_bit_cast(int, v))); }
namespace pg8 {
#define PG8_LAS __attribute__((address_space(3)))
typedef unsigned short bf16_t;
typedef short bf16x8 __attribute__((ext_vector_type(8)));
typedef float f32x4 __attribute__((ext_vector_type(4)));
typedef unsigned u32x4 __attribute__((ext_vector_type(4)));
constexpr int BM = 256, BK = 64, HALF = 128, HTB = HALF * BK * 2  , STAGE_BYTES = 8 * HTB, NXCD = 8, WGM = 8;

__host__ __device__ __forceinline__ int lds_byte(int r, int c) { const int st = (r >> 4) * 2 + (c >> 5), rr = r & 15, cc = c & 31, ob = rr * 64 + cc * 2; return st * 1024 + (ob ^ (((ob >> 9) & 1) << 5)); }
__host__ __device__ __forceinline__ void stage_rc(int b, int& R, int& C) { const int st = b / 1024, sb = b % 1024, swz = sb ^ (((sb >> 9) & 1) << 5); R = (st >> 1) * 16 + swz / 64; C = (st & 1) * 32 + (swz % 64) / 2; }
__host__ __device__ __forceinline__ int perm32(int rho) { const int n = rho >> 4, i = rho & 15; return 8 * (i >> 2) + 4 * n + (i & 3); }

struct Unit { int pm, pn, om, on, kind; };
struct Gemm { const bf16_t* A; const bf16_t* Bt; int M, N, K; };

struct StaticOrder {
    int nM, nN, nwg, G, c;
    __host__ __device__ void init(int M, int N, int G_, int c_) { nM = M / BM; nN = N / BM; nwg = nM * nN; G = G_; c = c_; }
    __host__ __device__ bool next(int i, Unit& u) const {
        const long L = (long)i * G + c; if (L >= nwg) return false;
        int wgid = (int)L; { const int q = nwg / NXCD, r = nwg % NXCD, xcd = wgid % NXCD, off = wgid / NXCD; wgid = (xcd < r ? xcd * (q + 1) : r * (q + 1) + (xcd - r) * q) + off; }
        const int nig = WGM * nN, gid = wgid / nig, fm = gid * WGM, gsz = (nM - fm) < WGM ? (nM - fm) : WGM;
        u.pm = fm + ((wgid % nig) % gsz); u.pn = (wgid % nig) / gsz; u.om = u.pm; u.on = u.pn; u.kind = 0; return true;
    }
    __device__ __forceinline__ void a_ready(const Unit&) const {}
    __device__ __forceinline__ void done(const Unit&) const {}
};
struct KvOrder {
    int G, c, NL, l0, memn_p0, memn_ps, xk_p0, xv_p0, w_ps;
    __host__ __device__ bool next(int i, Unit& u) const {
        const long L = (long)i * G + c; if (L >= (long)NL * 64) return false;
        const int l = (int)L / 64, r = (int)L % 64;
        if (r < 32) { const int pm = r & 3, pn = r >> 2; u.kind = 0; u.pm = memn_p0 + l * memn_ps + pm; u.pn = xk_p0 + l * w_ps + pn; u.om = (l0 + l) * 4 + pm; u.on = pn; }
        else { const int q = r - 32, pm = q & 7, pn = q >> 3; u.kind = 1; u.pm = xv_p0 + l * w_ps + pm; u.pn = memn_p0 + l * memn_ps + pn; u.om = (l0 + l) * 8 + pm; u.on = pn; }
        return true;
    }
    __device__ __forceinline__ void a_ready(const Unit&) const {}
    __device__ __forceinline__ void done(const Unit&) const {}
};

__device__ __forceinline__ unsigned cvt_pk_bf16(float lo, float hi) { unsigned r; asm volatile("v_cvt_pk_bf16_f32 %0, %1, %2" : "=v"(r) : "v"(lo), "v"(hi)); return r; }

template <int ACT  > struct EpiBf16 {
    static constexpr bool PERM = true, AFTER_DRAIN = false;
    bf16_t* O; int ldc; bf16_t* O1; int ldc1; const float* rs;
    __device__ __forceinline__ void operator()(const f32x4 (&acc)[2][2][4][2], const Unit& u, int wr, int wc, int fr, int fq) const {
        bf16_t* base = u.kind ? O1 : O; const int ld = u.kind ? ldc1 : ldc;
        const int row0 = u.om * BM + wr * 64 + fr, col0 = u.on * BM + wc * 32 + 8 * fq;
#pragma unroll
        for (int ai = 0; ai < 2; ++ai)
#pragma unroll
            for (int m = 0; m < 4; ++m) { bf16_t* rowp = base + (size_t)(row0 + ai * HALF + m * 16) * ld + col0;
                const float sc = rs ? rs[row0 + ai * HALF + m * 16] : 1.f;
#pragma unroll
                for (int bj = 0; bj < 2; ++bj) { f32x4 v0 = acc[ai][bj][m][0] * sc, v1 = acc[ai][bj][m][1] * sc;
                    if (ACT == 1) {
#pragma unroll
                        for (int j = 0; j < 4; ++j) { const float a = fmaxf(v0[j], 0.f), b = fmaxf(v1[j], 0.f); v0[j] = a * a; v1[j] = b * b; } }
                    u32x4 w; w.x = cvt_pk_bf16(v0[0], v0[1]); w.y = cvt_pk_bf16(v0[2], v0[3]); w.z = cvt_pk_bf16(v1[0], v1[1]); w.w = cvt_pk_bf16(v1[2], v1[3]);
                    *(u32x4*)(rowp + bj * HALF) = w; } }
    }
};
struct EpiF32 {
    static constexpr bool PERM = false, AFTER_DRAIN = false;
    float* C; int ldc;
    __device__ __forceinline__ void operator()(const f32x4 (&acc)[2][2][4][2], const Unit& u, int wr, int wc, int fr, int fq) const {
        const int row0 = u.om * BM + wr * 64 + fr, col0 = u.on * BM + wc * 32 + 4 * fq;
#pragma unroll
        for (int ai = 0; ai < 2; ++ai)
#pragma unroll
            for (int m = 0; m < 4; ++m) { float* rowp = C + (size_t)(row0 + ai * HALF + m * 16) * ldc + col0;
#pragma unroll
                for (int bj = 0; bj < 2; ++bj)
#pragma unroll
                    for (int n = 0; n < 2; ++n) *(f32x4*)(rowp + bj * HALF + n * 16) = acc[ai][bj][m][n]; }
    }
};

template <class Epi, class Sched, bool ALIGN_EPI = false, bool SP2 = false>
__device__ __forceinline__ void gemm_phase(PG8_LAS unsigned char* lds, const Gemm g, const Sched& S, const Epi& E, const int tid_in) {
    int tid_ = tid_in; asm volatile("" : "+v"(tid_));
    const int tid = tid_, wid = __builtin_amdgcn_readfirstlane(tid >> 6), lane = tid & 63, wr = wid >> 2, wc = wid & 3, fr = lane & 15, fq = lane >> 4;
    const int K = g.K, nt = K / BK;
    unsigned voffA[2], voffB[2];
#pragma unroll
    for (int i = 0; i < 2; ++i) { int R, C; stage_rc(tid * 16 + i * 8192, R, C); const int Rb = Epi::PERM ? ((R & ~31) + perm32(R & 31)) : R;
        voffA[i] = (unsigned)(R * K + C) * 2u; voffB[i] = (unsigned)(Rb * K + C) * 2u; }
    const size_t kstep = (size_t)(BK * 2);
    const size_t hstep = (size_t)HALF * K * 2;
    const size_t tstep = 2 * hstep;
    const unsigned ldsw = (unsigned)wid * 1024u;
    const int aoff = lds_byte(wr * 64 + fr, fq * 8), boff = lds_byte(wc * 32 + fr, fq * 8);
#define PG8_SA(b, h) (((b) * 2 + (h)) * HTB)
#define PG8_SB(b, h) ((4 + (b) * 2 + (h)) * HTB)
#define PG8_STAGE(bufoff, gbase, voff) do { _Pragma("unroll") for (int _i = 0; _i < 2; ++_i) \
        __builtin_amdgcn_global_load_lds((const unsigned*)((const char*)(gbase) + (voff)[_i]), (PG8_LAS unsigned*)(lds + (bufoff) + ldsw + _i * 8192), 16, 0, 0); } while (0)
#define PG8_LDA(dst, b, h) do { _Pragma("unroll") for (int m = 0; m < 4; ++m) _Pragma("unroll") for (int k = 0; k < 2; ++k) dst[m][k] = *(const PG8_LAS bf16x8*)(lds + PG8_SA(b, h) + aoff + m * 2048 + k * 1024); } while (0)
#define PG8_LDB(dst, b, h) do { _Pragma("unroll") for (int n = 0; n < 2; ++n) _Pragma("unroll") for (int k = 0; k < 2; ++k) dst[n][k] = *(const PG8_LAS bf16x8*)(lds + PG8_SB(b, h) + boff + n * 2048 + k * 1024); } while (0)
#define PG8_MMA(ai, bj, At, Bt) do { __builtin_amdgcn_s_setprio(1); _Pragma("unroll") for (int m = 0; m < 4; ++m) _Pragma("unroll") for (int n = 0; n < 2; ++n) _Pragma("unroll") for (int k = 0; k < 2; ++k) \
        acc[ai][bj][m][n] = __builtin_amdgcn_mfma_f32_16x16x32_bf16(Bt[n][k], At[m][k], acc[ai][bj][m][n], 0, 0, 0); __builtin_amdgcn_s_setprio(0); } while (0)
#define PG8_WAIT_V(n) asm volatile("s_waitcnt vmcnt(" #n ")" ::: "memory")
#define PG8_WAIT_L(n) asm volatile("s_waitcnt lgkmcnt(" #n ")" ::: "memory")
#define PG8_BAR __builtin_amdgcn_s_barrier()
#define PG8_SCHED __builtin_amdgcn_sched_barrier(0)
    Unit cur, nxt; int ui = 0;
    if (!S.next(0, cur)) return;
    f32x4 acc[2][2][4][2];
#pragma unroll
    for (int a = 0; a < 2; ++a)
#pragma unroll
        for (int b = 0; b < 2; ++b)
#pragma unroll
            for (int m = 0; m < 4; ++m)
#pragma unroll
                for (int n = 0; n < 2; ++n) acc[a][b][m][n] = (f32x4){0.f, 0.f, 0.f, 0.f};
    bf16x8 At[4][2], B0[2][2], B1[2][2];
    const char* cA = (const char*)g.A + (size_t)cur.pm * tstep; const char* cB = (const char*)g.Bt + (size_t)cur.pn * tstep;
    S.a_ready(cur);
    if constexpr (SP2) {
        PG8_STAGE(PG8_SB(0, 0), cB, voffB); PG8_STAGE(PG8_SB(0, 1), cB + hstep, voffB); PG8_STAGE(PG8_SA(0, 0), cA, voffA); PG8_STAGE(PG8_SA(0, 1), cA + hstep, voffA);
        if (wr == 1) PG8_BAR;
        PG8_WAIT_V(2); PG8_BAR;
        PG8_STAGE(PG8_SB(1, 0), cB + kstep, voffB); PG8_STAGE(PG8_SA(1, 0), cA + kstep, voffA); PG8_STAGE(PG8_SB(1, 1), cB + hstep + kstep, voffB);
        PG8_WAIT_V(6); PG8_BAR;
    } else {
        PG8_STAGE(PG8_SB(0, 0), cB, voffB); PG8_STAGE(PG8_SA(0, 0), cA, voffA); PG8_STAGE(PG8_SB(0, 1), cB + hstep, voffB); PG8_STAGE(PG8_SA(0, 1), cA + hstep, voffA);
        if (wr == 1) PG8_BAR;
        PG8_WAIT_V(4); PG8_BAR;
        PG8_STAGE(PG8_SB(1, 0), cB + kstep, voffB); PG8_STAGE(PG8_SA(1, 0), cA + kstep, voffA); PG8_STAGE(PG8_SB(1, 1), cB + hstep + kstep, voffB);
        PG8_WAIT_V(6); PG8_BAR;
    }
    for (;;) {
        const bool has_next = S.next(ui + 1, nxt);
        const char* nA = has_next ? (const char*)g.A + (size_t)nxt.pm * tstep : cA; const char* nB = has_next ? (const char*)g.Bt + (size_t)nxt.pn * tstep : cB;
        for (int t = 0; t < nt; t += 2) {
            const bool last = (t == nt - 2);
            const char* a1 = cA + (size_t)(t + 1) * kstep;
            const char* a2 = last ? nA : cA + (size_t)(t + 2) * kstep; const char* b2 = last ? nB : cB + (size_t)(t + 2) * kstep;
            const char* a3 = a2 + kstep; const char* b3 = b2 + kstep;
            if (last && has_next) S.a_ready(nxt);
            if constexpr (SP2) {
            PG8_LDB(B0, 0, 0); PG8_LDB(B1, 0, 1); PG8_SCHED; PG8_LDA(At, 0, 0); PG8_STAGE(PG8_SA(1, 1), a1 + hstep, voffA);
            PG8_WAIT_V(8); PG8_WAIT_L(0); PG8_BAR; PG8_MMA(0, 0, At, B0); PG8_MMA(0, 1, At, B1); PG8_BAR; PG8_SCHED;
            PG8_LDA(At, 0, 1); PG8_STAGE(PG8_SB(0, 0), b2, voffB); PG8_STAGE(PG8_SB(0, 1), b2 + hstep, voffB); PG8_STAGE(PG8_SA(0, 0), a2, voffA);
            PG8_WAIT_V(8); PG8_WAIT_L(0); PG8_BAR; PG8_MMA(1, 0, At, B0); PG8_MMA(1, 1, At, B1); PG8_BAR; PG8_SCHED;
            PG8_LDB(B0, 1, 0); PG8_LDB(B1, 1, 1); PG8_SCHED; PG8_LDA(At, 1, 0); PG8_STAGE(PG8_SA(0, 1), a2 + hstep, voffA);
            PG8_WAIT_V(8); PG8_WAIT_L(0); PG8_BAR; PG8_MMA(0, 0, At, B0); PG8_MMA(0, 1, At, B1); PG8_BAR; PG8_SCHED;
            PG8_LDA(At, 1, 1); PG8_STAGE(PG8_SB(1, 0), b3, voffB); PG8_STAGE(PG8_SB(1, 1), b3 + hstep, voffB); PG8_STAGE(PG8_SA(1, 0), a3, voffA);
            PG8_WAIT_V(8); PG8_WAIT_L(0); PG8_BAR; PG8_MMA(1, 0, At, B0); PG8_MMA(1, 1, At, B1); PG8_BAR; PG8_SCHED;
            } else {
            PG8_LDB(B0, 0, 0); PG8_SCHED; PG8_LDA(At, 0, 0); PG8_STAGE(PG8_SA(1, 1), a1 + hstep, voffA);
            PG8_WAIT_L(8); PG8_BAR; PG8_WAIT_L(0); PG8_MMA(0, 0, At, B0); PG8_BAR; PG8_SCHED;
            PG8_LDB(B1, 0, 1); PG8_STAGE(PG8_SB(0, 0), b2, voffB);
            PG8_BAR; PG8_WAIT_L(0); PG8_MMA(0, 1, At, B1); PG8_BAR;
            PG8_LDA(At, 0, 1); PG8_STAGE(PG8_SA(0, 0), a2, voffA);
            PG8_BAR; PG8_WAIT_L(0); PG8_MMA(1, 0, At, B0); PG8_BAR; PG8_SCHED;
            PG8_STAGE(PG8_SB(0, 1), b2 + hstep, voffB);
            PG8_WAIT_V(6); PG8_BAR; PG8_MMA(1, 1, At, B1); PG8_BAR;
            PG8_LDB(B0, 1, 0); PG8_SCHED; PG8_LDA(At, 1, 0); PG8_STAGE(PG8_SA(0, 1), a2 + hstep, voffA);
            PG8_WAIT_L(8); PG8_BAR; PG8_WAIT_L(0); PG8_MMA(0, 0, At, B0); PG8_BAR; PG8_SCHED;
            PG8_LDB(B1, 1, 1); PG8_STAGE(PG8_SB(1, 0), b3, voffB);
            PG8_BAR; PG8_WAIT_L(0); PG8_MMA(0, 1, At, B1); PG8_BAR;
            PG8_LDA(At, 1, 1); PG8_STAGE(PG8_SA(1, 0), a3, voffA);
            PG8_BAR; PG8_WAIT_L(0); PG8_MMA(1, 0, At, B0); PG8_BAR; PG8_SCHED;
            PG8_STAGE(PG8_SB(1, 1), b3 + hstep, voffB);
            PG8_WAIT_V(6); PG8_BAR; PG8_MMA(1, 1, At, B1); PG8_BAR;
            }
        }
        if constexpr (ALIGN_EPI) { if (wr == 0) PG8_BAR; }
        if constexpr (!Epi::AFTER_DRAIN) { E(acc, cur, wr, wc, fr, fq); S.done(cur); }
        if (!has_next) break;
#pragma unroll
        for (int a = 0; a < 2; ++a)
#pragma unroll
            for (int b = 0; b < 2; ++b)
#pragma unroll
                for (int m = 0; m < 4; ++m)
#pragma unroll
                    for (int n = 0; n < 2; ++n) acc[a][b][m][n] = (f32x4){0.f, 0.f, 0.f, 0.f};
        cur = nxt; cA = nA; cB = nB; ++ui;
        if constexpr (ALIGN_EPI) { if (wr == 1) PG8_BAR; }
    }
    PG8_WAIT_V(0);
    if constexpr (!ALIGN_EPI) { if (wr == 0) PG8_BAR; }
    PG8_BAR;
    if constexpr (Epi::AFTER_DRAIN) { E.fused(acc, cur, wr, wc, fr, fq, lds, wid, lane); S.done(cur); }
#undef PG8_SA
#undef PG8_SB
#undef PG8_STAGE
#undef PG8_LDA
#undef PG8_LDB
#undef PG8_MMA
#undef PG8_WAIT_V
#undef PG8_WAIT_L
#undef PG8_BAR
#undef PG8_SCHED
}
}

constexpr int D = 2048, BATCH = 4, SEQ = 2048, DEPTH = 4, M = BATCH * SEQ, MEM_LEN = 256, MM = BATCH * MEM_LEN;
constexpr int DIN = 4128, DFF = 8192;
constexpr int O_AQ = 0, O_AK = 1024, O_AV = 1280, O_BQ = 1536, O_BK = 1792, O_BV = 2048, O_BG = 2560, O_ZF = 3072, O_ZB = 3088, O_CX = 3104, O_CY = 3616;
constexpr int NPB = 4096;
constexpr int PB_CX = 3072, PB_CY = 3584;
constexpr float EPS = 1e-6f;
constexpr int NWAVES = 8, NTHREADS = 512;

#ifndef PROBE_REP
#define PROBE_REP 0
#endif
#ifndef NWL
#define NWL 4
#endif
constexpr size_t MiB = 1u << 20;
constexpr size_t WS_CTL = 0, CTL_ZERO_BYTES = 1 * MiB;
constexpr size_t WS_W = 1 * MiB, WL_BYTES = 121 * MiB;
constexpr size_t WL_IN = 0, WL_OUT = 16 * MiB, WL_XQ = 24 * MiB, WL_XK = 32 * MiB, WL_XV = 40 * MiB, WL_XO = 48 * MiB, WL_UP = 56 * MiB, WL_DOWN = 88 * MiB, WL_Z = 120 * MiB, WL_LRUG = 120 * MiB + 256 * 1024;
constexpr size_t WS_XN = WS_W + NWL * WL_BYTES;
constexpr size_t WS_MEMN = WS_XN + 32 * MiB;
constexpr size_t WS_KX = WS_MEMN + 16 * MiB;
constexpr size_t WS_VT = WS_KX + 16 * MiB;
constexpr size_t WS_Y = WS_VT + 16 * MiB;
constexpr size_t WS_Z = WS_Y + 64 * MiB;
constexpr size_t WS_BIG = WS_Z + 1 * MiB;
constexpr size_t WS_PB = WS_BIG;
constexpr size_t WS_MIX = WS_BIG + 64 * MiB;
constexpr size_t WS_GLAU = WS_BIG + 96 * MiB;
constexpr size_t WS_MISC = WS_BIG + 128 * MiB;
constexpr size_t WS_H = WS_BIG;
constexpr size_t WS_Q = WS_BIG, WS_O = WS_BIG + 32 * MiB;
constexpr size_t WS_END = WS_BIG + 136 * MiB;
constexpr int CW_TMO = 0, CW_BAR = 4096;

constexpr int RING_OFF = 0, RING_BYTES = 131072, SCR_BYTES = 143360;
constexpr int LDSCTL_OFF = SCR_BYTES, MISC_OFF = LDSCTL_OFF + 320;
constexpr int LDS_BYTES = 147456;

#define GAS __attribute__((address_space(1)))
#define LAS __attribute__((address_space(3)))
typedef unsigned short bf16;
typedef unsigned v4u __attribute__((ext_vector_type(4)));
typedef unsigned v2u __attribute__((ext_vector_type(2)));
typedef float f32x4 __attribute__((ext_vector_type(4)));
typedef short bf16x8 __attribute__((ext_vector_type(8)));
typedef short s16x4 __attribute__((ext_vector_type(4)));
#define LDS_WAIT() asm volatile("s_waitcnt lgkmcnt(0)" ::: "memory")
#define VM_WAIT() asm volatile("s_waitcnt vmcnt(0)" ::: "memory")
__device__ __forceinline__ unsigned f2bf(float f) { unsigned u = __builtin_bit_cast(unsigned, f); return (u + 0x7fffu + ((u >> 16) & 1u)) >> 16; }
__device__ __forceinline__ unsigned pk2(float lo, float hi) { return f2bf(lo) | (f2bf(hi) << 16); }
__device__ __forceinline__ float bf2f(unsigned short b) { return __builtin_bit_cast(float, (unsigned)b << 16); }
__device__ __forceinline__ float wave_sum(float v, int lane) {
#pragma unroll
    for (int o = 1; o < 64; o <<= 1) v += lane_xor_f(v, o, lane);
    return v;
}
__device__ __forceinline__ float wave_max(float v, int lane) {
#pragma unroll
    for (int o = 1; o < 64; o <<= 1) v = fmaxf(v, lane_xor_f(v, o, lane));
    return v;
}
__device__ __forceinline__ float sigmoidf_(float x) { return __builtin_amdgcn_rcpf(1.f + __builtin_amdgcn_exp2f(-1.4426950408889634f * x)); }
__device__ __forceinline__ float softplusf_(float x) { return fmaxf(x, 0.f) + 0.6931471805599453f * __builtin_amdgcn_logf(1.f + __builtin_amdgcn_exp2f(-1.4426950408889634f * fabsf(x))); }
__device__ __forceinline__ float gelu_tanh(float x) { return x * sigmoidf_(1.5957691216057308f * (x + 0.044715f * x * x * x)); }
__device__ __forceinline__ int t5_bucket(int rel) {
    const int ret = rel > 0 ? 16 : 0; const int n = rel < 0 ? -rel : rel;
    if (n < 8) return ret + n;
    int k = 0; while (k < 7 && (64 << (k + 1)) <= n * n) ++k;
    return ret + 8 + k;
}

struct Frame {
    LAS unsigned char* lds;
    int tid, lane, wave, G, bx;
};

__device__ __forceinline__ void p0_transpose_item(const float* W, int K, int N, int c0, bf16* WT, int r0, int nblk, const float* gk, LAS float* scr, int item, int lane) {
    const int kb = item / nblk, nb = item % nblk, k0 = 64 * kb, n0 = 32 * nb;
    const int c = lane & 7;
    f32x4 g0 = {1.f, 1.f, 1.f, 1.f}, g1 = {1.f, 1.f, 1.f, 1.f};
    if (gk) { g0 = *(const GAS f32x4*)(gk + k0 + 8 * c); g1 = *(const GAS f32x4*)(gk + k0 + 8 * c + 4); }
    f32x4 wv[8];
#pragma unroll
    for (int i = 0; i < 8; ++i) wv[i] = *(const GAS f32x4*)(W + (size_t)(k0 + 8 * i + (lane >> 3)) * N + c0 + n0 + 4 * (lane & 7));
#pragma unroll
    for (int i = 0; i < 8; ++i) { LAS float* d = scr + (8 * i + (lane >> 3)) * 33 + 4 * (lane & 7); d[0] = wv[i].x; d[1] = wv[i].y; d[2] = wv[i].z; d[3] = wv[i].w; }
    LDS_WAIT(); asm volatile("" ::: "memory");
#pragma unroll
    for (int j = 0; j < 4; ++j) { const int n = (lane >> 3) + 8 * j; const LAS float* s = scr + (8 * c) * 33 + n;
        v4u o; o.x = pk2(s[0 * 33] * g0.x, s[1 * 33] * g0.y); o.y = pk2(s[2 * 33] * g0.z, s[3 * 33] * g0.w); o.z = pk2(s[4 * 33] * g1.x, s[5 * 33] * g1.y); o.w = pk2(s[6 * 33] * g1.z, s[7 * 33] * g1.w);
        *(GAS v4u*)(WT + (size_t)(r0 + n0 + n) * K + k0 + 8 * c) = o; }
    LDS_WAIT(); asm volatile("" ::: "memory");
}
struct ConvSeg { const float* W; int K, N, c0, ncols; bf16* WT; int r0; const float* gain; };
__device__ __forceinline__ int seg_items(const ConvSeg& s) { return (s.K / 64) * (s.ncols / 32); }

__device__ __forceinline__ void norm_row(int lane, const float* src, const float* g, bf16* xn, float* copy_dst) {
    const GAS f32x4* xr = (const GAS f32x4*)src + lane; const GAS f32x4* gr = (const GAS f32x4*)g + lane;
    f32x4 v[8]; float s = 0.f;
#pragma unroll
    for (int j = 0; j < 8; ++j) { v[j] = xr[64 * j]; s += (v[j].x * v[j].x + v[j].y * v[j].y) + (v[j].z * v[j].z + v[j].w * v[j].w); }
    const float r = rsqrtf(wave_sum(s, lane) * (1.f / D) + EPS);
    GAS v2u* o8 = (GAS v2u*)xn + lane;
#pragma unroll
    for (int j = 0; j < 8; ++j) { const f32x4 gg = gr[64 * j]; v2u w; w.x = pk2(v[j].x * r * gg.x, v[j].y * r * gg.y); w.y = pk2(v[j].z * r * gg.z, v[j].w * r * gg.w); o8[64 * j] = w;
        if (copy_dst) ((GAS f32x4*)copy_dst + lane)[64 * j] = v[j]; }
}
__device__ __forceinline__ void init_row(int lane, const float* x, bf16* xb, float* rs) {
    const GAS f32x4* xr = (const GAS f32x4*)x; GAS v4u* ob = (GAS v4u*)xb;
    float s = 0.f;
#pragma unroll
    for (int j = 0; j < 4; ++j) { const int ch = lane + 64 * j; const f32x4 a = xr[2 * ch], b = xr[2 * ch + 1];
        s += (a.x * a.x + a.y * a.y) + (a.z * a.z + a.w * a.w) + (b.x * b.x + b.y * b.y) + (b.z * b.z + b.w * b.w);
        v4u w; w.x = pk2(a.x, a.y); w.y = pk2(a.z, a.w); w.z = pk2(b.x, b.y); w.w = pk2(b.z, b.w); ob[ch] = w; }
    s = wave_sum(s, lane);
    if (lane == 0) *rs = rsqrtf(s * (1.f / D) + EPS);
}
__device__ __forceinline__ void resid_row(int lane, bf16* xb, const bf16* y, const float* g1, float* rs, float* outf) {
    GAS v4u* xr = (GAS v4u*)xb; const GAS v4u* yr = (const GAS v4u*)y; const GAS f32x4* gr = (const GAS f32x4*)g1;
    v4u xv[4], yv[4]; float s = 0.f;
#pragma unroll
    for (int j = 0; j < 4; ++j) { const int ch = lane + 64 * j; xv[j] = xr[ch]; yv[j] = yr[ch]; }
#pragma unroll
    for (int j = 0; j < 4; ++j) { const unsigned yy[4] = {yv[j].x, yv[j].y, yv[j].z, yv[j].w};
#pragma unroll
        for (int e = 0; e < 4; ++e) { const float a = bf2f((unsigned short)(yy[e] & 0xffffu)), b = bf2f((unsigned short)(yy[e] >> 16)); s += a * a + b * b; } }
    const float r = rsqrtf(wave_sum(s, lane) * (1.f / D) + EPS);
    float s2 = 0.f;
#pragma unroll
    for (int j = 0; j < 4; ++j) { const int ch = lane + 64 * j; const f32x4 ga = gr[2 * ch], gb = gr[2 * ch + 1];
        const float gg[8] = {ga.x, ga.y, ga.z, ga.w, gb.x, gb.y, gb.z, gb.w};
        const unsigned yy[4] = {yv[j].x, yv[j].y, yv[j].z, yv[j].w}, xx[4] = {xv[j].x, xv[j].y, xv[j].z, xv[j].w};
        float xn[8];
#pragma unroll
        for (int e = 0; e < 4; ++e) {
            xn[2 * e] = bf2f((unsigned short)(xx[e] & 0xffffu)) + bf2f((unsigned short)(yy[e] & 0xffffu)) * r * gg[2 * e];
            xn[2 * e + 1] = bf2f((unsigned short)(xx[e] >> 16)) + bf2f((unsigned short)(yy[e] >> 16)) * r * gg[2 * e + 1];
            s2 += xn[2 * e] * xn[2 * e] + xn[2 * e + 1] * xn[2 * e + 1]; }
        v4u w; w.x = pk2(xn[0], xn[1]); w.y = pk2(xn[2], xn[3]); w.z = pk2(xn[4], xn[5]); w.w = pk2(xn[6], xn[7]); xr[ch] = w;
        if (outf) { GAS f32x4* of = (GAS f32x4*)outf; of[2 * ch] = (f32x4){xn[0], xn[1], xn[2], xn[3]}; of[2 * ch + 1] = (f32x4){xn[4], xn[5], xn[6], xn[7]}; } }
    s2 = wave_sum(s2, lane);
    if (lane == 0) *rs = rsqrtf(s2 * (1.f / D) + EPS);
}
template <int NR>
__device__ __forceinline__ void resid_rows(int lane, bf16* xb0, const bf16* y0, size_t stride_el, const float* g1, float* rs0, size_t rs_stride, float* outf0) {
    v4u xv[NR][4], yv[NR][4];
#pragma unroll
    for (int i = 0; i < NR; ++i)
#pragma unroll
        for (int j = 0; j < 4; ++j) { const int ch = lane + 64 * j; xv[i][j] = ((const GAS v4u*)(xb0 + i * stride_el))[ch]; yv[i][j] = ((const GAS v4u*)(y0 + i * stride_el))[ch]; }
    f32x4 ga[4], gb[4];
#pragma unroll
    for (int j = 0; j < 4; ++j) { const int ch = lane + 64 * j; ga[j] = ((const GAS f32x4*)g1)[2 * ch]; gb[j] = ((const GAS f32x4*)g1)[2 * ch + 1]; }
#pragma unroll
    for (int i = 0; i < NR; ++i) {
        float s = 0.f;
#pragma unroll
        for (int j = 0; j < 4; ++j) { const unsigned yy[4] = {yv[i][j].x, yv[i][j].y, yv[i][j].z, yv[i][j].w};
#pragma unroll
            for (int e = 0; e < 4; ++e) { const float a = bf2f((unsigned short)(yy[e] & 0xffffu)), b = bf2f((unsigned short)(yy[e] >> 16)); s += a * a + b * b; } }
        const float r = rsqrtf(wave_sum(s, lane) * (1.f / D) + EPS);
        float s2 = 0.f;
        GAS v4u* xr = (GAS v4u*)(xb0 + i * stride_el);
#pragma unroll
        for (int j = 0; j < 4; ++j) { const int ch = lane + 64 * j;
            const float gg[8] = {ga[j].x, ga[j].y, ga[j].z, ga[j].w, gb[j].x, gb[j].y, gb[j].z, gb[j].w};
            const unsigned yy[4] = {yv[i][j].x, yv[i][j].y, yv[i][j].z, yv[i][j].w}, xx[4] = {xv[i][j].x, xv[i][j].y, xv[i][j].z, xv[i][j].w};
            float xn[8];
#pragma unroll
            for (int e = 0; e < 4; ++e) {
                xn[2 * e] = bf2f((unsigned short)(xx[e] & 0xffffu)) + bf2f((unsigned short)(yy[e] & 0xffffu)) * r * gg[2 * e];
                xn[2 * e + 1] = bf2f((unsigned short)(xx[e] >> 16)) + bf2f((unsigned short)(yy[e] >> 16)) * r * gg[2 * e + 1];
                s2 += xn[2 * e] * xn[2 * e] + xn[2 * e + 1] * xn[2 * e + 1]; }
            v4u w; w.x = pk2(xn[0], xn[1]); w.y = pk2(xn[2], xn[3]); w.z = pk2(xn[4], xn[5]); w.w = pk2(xn[6], xn[7]); xr[ch] = w;
            if (outf0) { GAS f32x4* of = (GAS f32x4*)(outf0 + i * stride_el); of[2 * ch] = (f32x4){xn[0], xn[1], xn[2], xn[3]}; of[2 * ch + 1] = (f32x4){xn[4], xn[5], xn[6], xn[7]}; } }
        s2 = wave_sum(s2, lane);
        if (lane == 0) rs0[i * rs_stride] = rsqrtf(s2 * (1.f / D) + EPS);
    }
}
__device__ __forceinline__ void zgemm(const Frame& F, const bf16* XN, const bf16* WZ, const float* RS, float* Z) {
    const int lane = F.lane, g = lane >> 4, c = lane & 15;
    for (int tile = F.wave * F.G + F.bx; tile < (M / 16) * 2; tile += NWAVES * F.G) {
        const int rt = tile >> 1, ct = tile & 1;
        const bf16* ap = XN + (size_t)(rt * 16 + c) * D + g * 8;
        const bf16* bp = WZ + (size_t)(ct * 16 + c) * D + g * 8;
        f32x4 acc = {0.f, 0.f, 0.f, 0.f};
#pragma unroll 8
        for (int ks = 0; ks < D / 32; ++ks) { const bf16x8 a = *(const GAS bf16x8*)(ap + ks * 32); const bf16x8 b = *(const GAS bf16x8*)(bp + ks * 32); acc = __builtin_amdgcn_mfma_f32_16x16x32_bf16(a, b, acc, 0, 0, 0); }
#pragma unroll
        for (int r = 0; r < 4; ++r) Z[(size_t)(rt * 16 + 4 * g + r) * 32 + ct * 16 + c] = acc[r] * RS[rt * 16 + 4 * g + r];
    }
}

#define XB_TMO      128
#define XB_XCNT(j)  (256  + 64 * (j))
#define XB_XSUB(j)  (1280 + 64 * (j))
#define XB_XGEN(j)  (2304 + 64 * (j))
#define XB_TOP      3328
#define XB_TOPGEN   3392
#define XCD_BAR_WORDS 3456
#define XB_SPIN_CAP (1u << 18)
#define LAS __attribute__((address_space(3)))

__device__ __forceinline__ unsigned xb_ld(unsigned* p)              { return __hip_atomic_load(p, __ATOMIC_RELAXED, __HIP_MEMORY_SCOPE_AGENT); }
__device__ __forceinline__ unsigned xb_add(unsigned* p, unsigned v) { return __hip_atomic_fetch_add(p, v, __ATOMIC_RELAXED, __HIP_MEMORY_SCOPE_AGENT); }
__device__ __forceinline__ unsigned xb_xcc_id() { return (unsigned)__builtin_amdgcn_s_getreg((3 << 11) | 20) & 0xFu; }
#define XB_SPIN(cond, bar) do { unsigned _sp = 0; while (cond) { __builtin_amdgcn_s_sleep(1); \
    if ((++_sp & 255u) == 0u) { if (xb_ld(&(bar)[XB_TMO])) break; if (_sp > XB_SPIN_CAP) { atomicAdd(&(bar)[XB_TMO], 1u); break; } } } } while (0)

struct XcdBarrier {
    unsigned* bar; unsigned x;
    volatile LAS unsigned* st;
};

__device__ __forceinline__ XcdBarrier xcd_barrier_post(unsigned* bar, volatile LAS unsigned* st) {
    XcdBarrier b; b.bar = bar; b.x = xb_xcc_id(); b.st = st;
    if (threadIdx.x == 0) (void)xb_add(&bar[XB_XCNT(b.x)], 1u);
    return b;
}
__device__ __forceinline__ void xcd_barrier_complete(unsigned* bar, unsigned x, unsigned& nloc, unsigned& nx) {
    const unsigned G = gridDim.x * gridDim.y * gridDim.z;
    unsigned sum, cnt, mine, sp = 0u;
    for (;;) {
        sum = 0u; cnt = 0u; mine = 0u;
#pragma unroll
        for (unsigned j = 0; j < 16; ++j) { const unsigned c = xb_ld(&bar[XB_XCNT(j)]); sum += c; cnt += (c > 0u) ? 1u : 0u; mine = (j == x) ? c : mine; }
        if (sum == G) break;
        __builtin_amdgcn_s_sleep(1);
        if ((++sp & 255u) == 0u) { if (xb_ld(&bar[XB_TMO])) break; if (sp > XB_SPIN_CAP) { atomicAdd(&bar[XB_TMO], 1u); break; } }
    }
    nloc = mine > 0u ? mine : 1u; nx = cnt > 0u ? cnt : 1u;
}

__device__ __forceinline__ void xcd_barrier(const XcdBarrier& b) {
    asm volatile("s_waitcnt vmcnt(0)" ::: "memory");
    __syncthreads();
    if (threadIdx.x == 0) {
        unsigned* bar = b.bar;
        __builtin_amdgcn_s_waitcnt(0);
        unsigned nloc = b.st[0], nx = b.st[1];
        if (nloc == 0u) { xcd_barrier_complete(bar, b.x, nloc, nx); b.st[0] = nloc; b.st[1] = nx; }
        const unsigned old = xb_add(&bar[XB_XSUB(b.x)], 1u);
        const unsigned gen = old / nloc;
        if (old + 1u == (gen + 1u) * nloc) {
            __builtin_amdgcn_fence(__ATOMIC_RELEASE, "agent");
            asm volatile("s_waitcnt vmcnt(0)" ::: "memory");
            const unsigned og = xb_add(&bar[XB_TOP], 1u);
            const unsigned tg = og / nx;
            if (og + 1u == (tg + 1u) * nx) xb_add(&bar[XB_TOPGEN], 1u);
            else XB_SPIN(xb_ld(&bar[XB_TOPGEN]) == tg, bar);
            __builtin_amdgcn_fence(__ATOMIC_ACQUIRE, "agent");
            xb_add(&bar[XB_XGEN(b.x)], 1u);
            asm volatile("s_waitcnt vmcnt(0)" ::: "memory");
        } else {
            XB_SPIN(xb_ld(&bar[XB_XGEN(b.x)]) == gen, bar);
            __builtin_amdgcn_fence(__ATOMIC_ACQUIRE, "agent");
            asm volatile("s_waitcnt vmcnt(0)" ::: "memory");
        }
    }
    __syncthreads();
}
constexpr size_t MISC_DEC = 3 * MiB;
constexpr int GL_Z = 0, GL_TF = 8192, GL_TB = 10240, GL_VI = 12288, GL_A = 30720, GL_B = 39936, GL_P = 49152, GL_SI = 58368, GL_OF = 76800, GL_VS = 288;
__device__ __forceinline__ bf16x8 tr_frag(LAS unsigned char* p, int stride4) {
    const s16x4 lo = __builtin_amdgcn_ds_read_tr16_b64_v4i16((LAS s16x4*)p);
    const s16x4 hi = __builtin_amdgcn_ds_read_tr16_b64_v4i16((LAS s16x4*)(p + stride4));
    return __builtin_shufflevector(lo, hi, 0, 1, 2, 3, 4, 5, 6, 7);
}
struct GlaW { float wf[16], wb[16], bfv, bbv; };
__device__ __forceinline__ void gla_load_w(GlaW& W, int k, int h, const float* __restrict__ w2f, const float* __restrict__ b2f, const float* __restrict__ w2b, const float* __restrict__ b2b) {
#pragma unroll
    for (int r = 0; r < 16; ++r) { W.wf[r] = w2f[r * 256 + h * 64 + k]; W.wb[r] = w2b[r * 256 + h * 64 + k]; }
    W.bfv = b2f[h * 64 + k]; W.bbv = b2b[h * 64 + k];
}
__device__ __forceinline__ void gla_gates(const Frame& F, const f32x4 zreg, const GlaW& W, float (&cf)[8], float (&cb)[8], float& totf, float& totb) {
    LAS float* ZS = (LAS float*)(F.lds + GL_Z); LAS float* TF = (LAS float*)(F.lds + GL_TF); LAS float* TB = (LAS float*)(F.lds + GL_TB);
    const int tid = F.tid, k = tid & 63, tg = F.wave;
    ((LAS f32x4*)ZS)[tid] = zreg;
    __syncthreads();
#pragma unroll
    for (int i = 0; i < 8; ++i) { const int t = tg * 8 + i; float af = W.bfv, ab = W.bbv;
#pragma unroll
        for (int r = 0; r < 16; ++r) { af += ZS[t * 32 + r] * W.wf[r]; ab += ZS[t * 32 + 16 + r] * W.wb[r]; }
        cf[i] = -softplusf_(-af) * 0.0625f; cb[i] = -softplusf_(-ab) * 0.0625f; }
#pragma unroll
    for (int i = 1; i < 8; ++i) cf[i] += cf[i - 1];
#pragma unroll
    for (int i = 6; i >= 0; --i) cb[i] += cb[i + 1];
    TF[tg * 64 + k] = cf[7]; TB[tg * 64 + k] = cb[0];
    __syncthreads();
    float ef = 0.f, eb = 0.f; totf = 0.f; totb = 0.f;
#pragma unroll
    for (int g2 = 0; g2 < 8; ++g2) { const float a = TF[g2 * 64 + k], bq = TB[g2 * 64 + k]; totf += a; totb += bq; ef += (g2 < tg) ? a : 0.f; eb += (g2 > tg) ? bq : 0.f; }
#pragma unroll
    for (int i = 0; i < 8; ++i) { cf[i] += ef; cb[i] += eb; }
}
__device__ __forceinline__ void gla_load_v(const Frame& F, const bf16* __restrict__ PB, size_t m0, int h, v4u (&vr)[2]) {
#pragma unroll
    for (int i = 0; i < 2; ++i) { const int ch = F.tid + NTHREADS * i, row = ch >> 4, col = ch & 15; vr[i] = *(const GAS v4u*)(PB + (m0 + row) * NPB + O_BV + h * 128 + col * 8); }
}
__device__ __forceinline__ void gla_store_v(const Frame& F, const v4u (&vr)[2]) {
    LAS unsigned char* VI = F.lds + GL_VI;
#pragma unroll
    for (int i = 0; i < 2; ++i) { const int ch = F.tid + NTHREADS * i, row = ch >> 4, col = ch & 15; *(LAS v4u*)(VI + row * GL_VS + col * 16) = vr[i]; }
}
__device__ __forceinline__ void gla_u_phase(const Frame& F, const bf16* __restrict__ PB, const float* __restrict__ Z, const float* __restrict__ w2f, const float* __restrict__ b2f,
                                            const float* __restrict__ w2b, const float* __restrict__ b2b, float* __restrict__ U, float* __restrict__ DEC) {
    const int tid = F.tid, lane = F.lane, g = lane >> 4, c = lane & 15, w = F.wave, k = tid & 63, tg = F.wave;
    LAS unsigned char* VI = F.lds + GL_VI;
    GlaW W; int h_loaded = -1;
    for (int unit = F.bx; unit < BATCH * 4 * 32; unit += F.G) {
        const int b = unit >> 7, h = (unit >> 5) & 3, n = unit & 31;
        const size_t m0 = (size_t)b * SEQ + n * 64;
        if (h != h_loaded) { gla_load_w(W, k, h, w2f, b2f, w2b, b2b); h_loaded = h; }
        const f32x4 zreg = ((const GAS f32x4*)(Z + m0 * 32))[tid];
        unsigned short kraw[8];
#pragma unroll
        for (int i = 0; i < 8; ++i) kraw[i] = PB[(m0 + tg * 8 + i) * NPB + O_BK + h * 64 + k];
        v4u vr[2]; gla_load_v(F, PB, m0, h, vr);
        __syncthreads();
        float cf[8], cb[8], totf, totb;
        gla_gates(F, zreg, W, cf, cb, totf, totb);
#pragma unroll
        for (int i = 0; i < 8; ++i) { const int t = tg * 8 + i; const float kk = bf2f(kraw[i]);
            *(LAS unsigned short*)(F.lds + GL_A + t * 144 + k * 2) = (unsigned short)f2bf(kk * __expf(totf - cf[i]));
            *(LAS unsigned short*)(F.lds + GL_B + t * 144 + k * 2) = (unsigned short)f2bf(kk * __expf(totb - cb[i])); }
        const size_t ub = (size_t)(b * 4 + h) * 32 + n;
        if (tg == 0) { DEC[ub * 64 + k] = __expf(totf); DEC[(ub + 512) * 64 + k] = __expf(totb); }
        gla_store_v(F, vr);
        __syncthreads();
        bf16x8 vf[2];
#pragma unroll
        for (int ts = 0; ts < 2; ++ts) vf[ts] = tr_frag(VI + (32 * ts + 8 * g + (c >> 2)) * GL_VS + (16 * w + 4 * (c & 3)) * 2, 4 * GL_VS);
#pragma unroll
        for (int d = 0; d < 2; ++d) {
            LAS unsigned char* KS = F.lds + (d ? GL_B : GL_A);
            float* Ud = U + (ub + (size_t)d * 512) * 8192;
#pragma unroll
            for (int kt = 0; kt < 4; ++kt) {
                f32x4 acc = {0.f, 0.f, 0.f, 0.f};
#pragma unroll
                for (int ts = 0; ts < 2; ++ts) { const bf16x8 af = tr_frag(KS + (32 * ts + 8 * g + (c >> 2)) * 144 + (16 * kt + 4 * (c & 3)) * 2, 4 * 144);
                    acc = __builtin_amdgcn_mfma_f32_16x16x32_bf16(af, vf[ts], acc, 0, 0, 0); }
#pragma unroll
                for (int r = 0; r < 4; ++r) Ud[(16 * kt + 4 * g + r) * 128 + 16 * w + c] = acc[r];
            }
        }
    }
}
__device__ __forceinline__ void gla_state_phase(const Frame& F, float* __restrict__ U, const float* __restrict__ DEC) {
    typedef float f32x2 __attribute__((ext_vector_type(2)));
    for (int id = F.bx * NTHREADS + F.tid; id < 32 * 64 * 64; id += F.G * NTHREADS) {
        const int seq = id >> 12, k = (id >> 6) & 63, e2 = id & 63, d = seq >> 4, bh = seq & 15;
        GAS f32x2* p0 = (GAS f32x2*)(U + ((size_t)d * 512 + bh * 32) * 8192 + k * 128) + e2;
        const float* d0 = DEC + ((size_t)d * 512 + bh * 32) * 64 + k;
        f32x2 u[32]; float dc[32];
#pragma unroll
        for (int n = 0; n < 32; ++n) { u[n] = p0[(size_t)n * 4096]; dc[n] = d0[n * 64]; }
        f32x2 S = {0.f, 0.f};
        if (d == 0) {
#pragma unroll
            for (int n = 0; n < 32; ++n) { const f32x2 t = u[n]; u[n] = S; S = S * dc[n] + t; }
        } else {
#pragma unroll
            for (int n = 31; n >= 0; --n) { const f32x2 t = u[n]; u[n] = S; S = S * dc[n] + t; }
        }
#pragma unroll
        for (int n = 0; n < 32; ++n) p0[(size_t)n * 4096] = u[n];
    }
}
__device__ __forceinline__ void gla_o_phase(const Frame& F, const bf16* __restrict__ PB, const float* __restrict__ Z, const float* __restrict__ w2f, const float* __restrict__ b2f,
                                            const float* __restrict__ w2b, const float* __restrict__ b2b, const float* __restrict__ U, const float* __restrict__ gn, bf16* __restrict__ MIX) {
    const int tid = F.tid, lane = F.lane, g = lane >> 4, c = lane & 15, w = F.wave, k = tid & 63, tg = F.wave;
    LAS unsigned char* VI = F.lds + GL_VI; LAS unsigned char* QI = F.lds + GL_A; LAS unsigned char* KI = F.lds + GL_B; LAS unsigned char* PI = F.lds + GL_P; LAS unsigned char* SI = F.lds + GL_SI;
    LAS float* OF = (LAS float*)(F.lds + GL_OF);
    GlaW W; int h_loaded = -1;
    for (int unit = F.bx; unit < BATCH * 4 * 32; unit += F.G) {
        const int b = unit >> 7, h = (unit >> 5) & 3, n = unit & 31;
        const size_t m0 = (size_t)b * SEQ + n * 64;
        const size_t ub = (size_t)(b * 4 + h) * 32 + n;
        if (h != h_loaded) { gla_load_w(W, k, h, w2f, b2f, w2b, b2b); h_loaded = h; }
        const f32x4 zreg = ((const GAS f32x4*)(Z + m0 * 32))[tid];
        unsigned short qraw[8], kraw[8];
#pragma unroll
        for (int i = 0; i < 8; ++i) { qraw[i] = PB[(m0 + tg * 8 + i) * NPB + O_BQ + h * 64 + k]; kraw[i] = PB[(m0 + tg * 8 + i) * NPB + O_BK + h * 64 + k]; }
        v4u vr[2]; gla_load_v(F, PB, m0, h, vr);
        f32x4 sreg[2][4];
#pragma unroll
        for (int d = 0; d < 2; ++d) { const GAS f32x4* sp = (const GAS f32x4*)(U + (ub + (size_t)d * 512) * 8192 + (tid >> 3) * 128 + (tid & 7) * 16);
#pragma unroll
            for (int q4 = 0; q4 < 4; ++q4) sreg[d][q4] = sp[q4]; }
        const v4u g0 = *(const GAS v4u*)(PB + (m0 + (tid >> 3)) * NPB + O_BG + h * 128 + (tid & 7) * 16), g1 = *(const GAS v4u*)(PB + (m0 + (tid >> 3)) * NPB + O_BG + h * 128 + (tid & 7) * 16 + 8);
        __syncthreads();
        float cf[8], cb[8], totf, totb;
        gla_gates(F, zreg, W, cf, cb, totf, totb);
        float qv[8], kv[8];
#pragma unroll
        for (int i = 0; i < 8; ++i) { qv[i] = bf2f(qraw[i]) * 0.125f; kv[i] = bf2f(kraw[i]); }
        gla_store_v(F, vr);
        f32x4 acc[4];
#pragma unroll
        for (int tt = 0; tt < 4; ++tt) acc[tt] = (f32x4){0.f, 0.f, 0.f, 0.f};
#pragma unroll
        for (int d = 0; d < 2; ++d) {
            __syncthreads();
#pragma unroll
            for (int i = 0; i < 8; ++i) { const int t = tg * 8 + i; const float cc = d ? cb[i] : cf[i];
                *(LAS unsigned short*)(QI + t * 144 + k * 2) = (unsigned short)f2bf(qv[i] * __expf(cc));
                *(LAS unsigned short*)(KI + t * 144 + k * 2) = (unsigned short)f2bf(kv[i] * __expf(-cc)); }
            {   const int row = tid >> 3, c16 = (tid & 7) * 16;
                const f32x4 s0 = sreg[d][0], s1 = sreg[d][1], s2 = sreg[d][2], s3 = sreg[d][3];
                v4u o0, o1; o0.x = pk2(s0.x, s0.y); o0.y = pk2(s0.z, s0.w); o0.z = pk2(s1.x, s1.y); o0.w = pk2(s1.z, s1.w); o1.x = pk2(s2.x, s2.y); o1.y = pk2(s2.z, s2.w); o1.z = pk2(s3.x, s3.y); o1.w = pk2(s3.z, s3.w);
                *(LAS v4u*)(SI + row * GL_VS + c16 * 2) = o0; *(LAS v4u*)(SI + row * GL_VS + c16 * 2 + 16) = o1; }
            __syncthreads();
#pragma unroll
            for (int q2 = 0; q2 < 2; ++q2) {
                const int id = 2 * w + q2, tt = id >> 2, jt = id & 3;
                f32x4 p = {0.f, 0.f, 0.f, 0.f};
#pragma unroll
                for (int ks = 0; ks < 2; ++ks) { const bf16x8 a = *(const LAS bf16x8*)(QI + (16 * tt + c) * 144 + ks * 64 + g * 16), bb = *(const LAS bf16x8*)(KI + (16 * jt + c) * 144 + ks * 64 + g * 16);
                    p = __builtin_amdgcn_mfma_f32_16x16x32_bf16(a, bb, p, 0, 0, 0); }
#pragma unroll
                for (int r = 0; r < 4; ++r) { const int t = 16 * tt + 4 * g + r, j = 16 * jt + c; const bool keep = d ? (j > t) : (j <= t);
                    *(LAS unsigned short*)(PI + t * 144 + j * 2) = (unsigned short)f2bf(keep ? p[r] : 0.f); }
            }
            __syncthreads();
            bf16x8 vf[2], sf[2];
#pragma unroll
            for (int s2 = 0; s2 < 2; ++s2) { vf[s2] = tr_frag(VI + (32 * s2 + 8 * g + (c >> 2)) * GL_VS + (16 * w + 4 * (c & 3)) * 2, 4 * GL_VS);
                sf[s2] = tr_frag(SI + (32 * s2 + 8 * g + (c >> 2)) * GL_VS + (16 * w + 4 * (c & 3)) * 2, 4 * GL_VS); }
#pragma unroll
            for (int tt = 0; tt < 4; ++tt)
#pragma unroll
                for (int s2 = 0; s2 < 2; ++s2) { const bf16x8 pa = *(const LAS bf16x8*)(PI + (16 * tt + c) * 144 + s2 * 64 + g * 16), qa = *(const LAS bf16x8*)(QI + (16 * tt + c) * 144 + s2 * 64 + g * 16);
                    acc[tt] = __builtin_amdgcn_mfma_f32_16x16x32_bf16(pa, vf[s2], acc[tt], 0, 0, 0);
                    acc[tt] = __builtin_amdgcn_mfma_f32_16x16x32_bf16(qa, sf[s2], acc[tt], 0, 0, 0); }
        }
#pragma unroll
        for (int tt = 0; tt < 4; ++tt)
#pragma unroll
            for (int r = 0; r < 4; ++r) OF[(16 * tt + 4 * g + r) * 132 + 16 * w + c] = acc[tt][r];
        __syncthreads();
        {   const int t = tid >> 3, c16 = (tid & 7) * 16;
            float o[16]; float ss = 0.f;
#pragma unroll
            for (int e = 0; e < 16; ++e) { o[e] = OF[t * 132 + c16 + e]; ss += o[e] * o[e]; }
            ss += lane_xor_f(ss, 1, lane); ss += lane_xor_f(ss, 2, lane); ss += lane_xor_f(ss, 4, lane);
            const float rs = rsqrtf(ss * (1.f / 128.f) + EPS);
            const unsigned gg[8] = {g0.x, g0.y, g0.z, g0.w, g1.x, g1.y, g1.z, g1.w};
            unsigned oo[8];
#pragma unroll
            for (int e = 0; e < 8; ++e) { const float ga = bf2f((unsigned short)(gg[e] & 0xffffu)), gb = bf2f((unsigned short)(gg[e] >> 16));
                oo[e] = pk2(o[2 * e] * rs * gn[h * 128 + c16 + 2 * e] * (ga * sigmoidf_(ga)), o[2 * e + 1] * rs * gn[h * 128 + c16 + 2 * e + 1] * (gb * sigmoidf_(gb))); }
            v4u o0, o1; o0.x = oo[0]; o0.y = oo[1]; o0.z = oo[2]; o0.w = oo[3]; o1.x = oo[4]; o1.y = oo[5]; o1.z = oo[6]; o1.w = oo[7];
            *(GAS v4u*)(MIX + (m0 + t) * D + 1024 + h * 128 + c16) = o0; *(GAS v4u*)(MIX + (m0 + t) * D + 1024 + h * 128 + c16 + 8) = o1;
        }
    }
}
constexpr int LRU_LD = 132;
constexpr size_t MISC_CAR_A = 0, MISC_CAR_H = 1 * MiB, MISC_CIN = 2 * MiB, MISC_RS = 4 * MiB;
template <bool FINAL>
__device__ __forceinline__ void lru_phase(const Frame& F, const bf16* __restrict__ PB, const bf16* __restrict__ LRUG, const float* __restrict__ cw, const float* __restrict__ cb,
                                          const float* __restrict__ ba, const float* __restrict__ bx, const float* __restrict__ lam, float* __restrict__ CAR_A, float* __restrict__ CAR_H,
                                          const float* __restrict__ CIN, bf16* __restrict__ MIX) {
    LAS float* XF = (LAS float*)(F.lds);
    LAS float* AS = (LAS float*)(F.lds + 33792);
    LAS float* US = (LAS float*)(F.lds + 2 * 33792);
    LAS unsigned char* XB = F.lds + 3 * 33792;
    const int tid = F.tid, lane = F.lane, g4 = lane >> 4, c = lane & 15, w = F.wave;
    const bool g_const = (F.G & 3) == 0;
    int g_loaded = -1;
    bf16x8 waf[2][4], wxf[2][4]; float bav[2], bxv[2], spv[2], w0[4], w1[4], cb0 = 0.f, cb1 = 0.f;
    for (int unit = F.bx; unit < BATCH * 32 * 4; unit += F.G) {
        const int b = unit >> 7, n = (unit >> 2) & 31, g = unit & 3, t0 = n * 64;
        if (!g_const || g != g_loaded) {
            const int j = 16 * w + c, chj = g * 128 + j;
#pragma unroll
            for (int s = 0; s < 2; ++s) {
                const bf16* wap = LRUG + ((size_t)((s * 2 + 0) * 4 + g) * 128 + j) * 128 + g4 * 8;
                const bf16* wxp = LRUG + ((size_t)((s * 2 + 1) * 4 + g) * 128 + j) * 128 + g4 * 8;
#pragma unroll
                for (int ks = 0; ks < 4; ++ks) { waf[s][ks] = *(const GAS bf16x8*)(wap + ks * 32); wxf[s][ks] = *(const GAS bf16x8*)(wxp + ks * 32); }
                bav[s] = ba[s * 512 + chj]; bxv[s] = bx[s * 512 + chj]; spv[s] = softplusf_(-lam[s * 512 + chj]);
            }
            const int ch = g * 128 + 2 * (tid & 63);
#pragma unroll
            for (int jj = 0; jj < 4; ++jj) { w0[jj] = cw[jj * 512 + ch]; w1[jj] = cw[jj * 512 + ch + 1]; }
            cb0 = cb[ch]; cb1 = cb[ch + 1];
            g_loaded = g;
        }
        __syncthreads();
        {
            const int ch2 = tid & 63, tb = (tid >> 6) * 8, ch = g * 128 + 2 * ch2;
            const float b0 = cb0, b1 = cb1;
            float x0[11], x1[11];
#pragma unroll
            for (int i = 0; i < 11; ++i) { const int t = t0 + tb - 2 + i; unsigned v = 0u; if (t >= 0 && t < SEQ) v = *(const GAS unsigned*)(PB + (size_t)(b * SEQ + t) * NPB + PB_CX + ch);
                x0[i] = bf2f((unsigned short)(v & 0xffffu)); x1[i] = bf2f((unsigned short)(v >> 16)); }
#pragma unroll
            for (int r = 0; r < 8; ++r) { float y0 = b0, y1 = b1;
#pragma unroll
                for (int j = 0; j < 4; ++j) { y0 += x0[r + j] * w0[j]; y1 += x1[r + j] * w1[j]; }
                XF[(tb + r) * LRU_LD + 2 * ch2] = y0; XF[(tb + r) * LRU_LD + 2 * ch2 + 1] = y1;
                *(LAS unsigned*)(XB + (tb + r) * 272 + ch2 * 4) = pk2(y0, y1); }
        }
        __syncthreads();
#pragma unroll
        for (int s = 0; s < 2; ++s) {
            {
                const int j = 16 * w + c;
                LAS float* U = s == 0 ? US : XF;
#pragma unroll
                for (int tt = 0; tt < 4; ++tt) {
                    f32x4 ga = {0.f, 0.f, 0.f, 0.f}, gx = {0.f, 0.f, 0.f, 0.f};
#pragma unroll
                    for (int ks = 0; ks < 4; ++ks) { const bf16x8 xf = *(const LAS bf16x8*)(XB + (16 * tt + c) * 272 + ks * 64 + g4 * 16);
                        ga = __builtin_amdgcn_mfma_f32_16x16x32_bf16(xf, waf[s][ks], ga, 0, 0, 0); gx = __builtin_amdgcn_mfma_f32_16x16x32_bf16(xf, wxf[s][ks], gx, 0, 0, 0); }
#pragma unroll
                    for (int r = 0; r < 4; ++r) { const int t = 16 * tt + 4 * g4 + r;
                        const float rg = sigmoidf_(ga[r] + bav[s]), ig = sigmoidf_(gx[r] + bxv[s]);
                        const float a = __builtin_amdgcn_exp2f(-8.f * 1.4426950408889634f * rg * spv[s]);
                        const float xv = XF[t * LRU_LD + j];
                        AS[t * LRU_LD + j] = a; U[t * LRU_LD + j] = __builtin_amdgcn_sqrtf(fmaxf(1.f - a * a, 0.f)) * (ig * xv); }
                }
            }
            __syncthreads();
            if (tid < 128) {
                LAS float* U = s == 0 ? US : XF;
                const size_t ci = ((size_t)((s * BATCH + b) * 32 + n)) * 512 + g * 128 + tid;
                float h = FINAL ? CIN[ci] : 0.f, ap = 1.f;
#pragma unroll 8
                for (int st = 0; st < 64; ++st) { const int t = s ? 63 - st : st; const float a = AS[t * LRU_LD + tid], u = U[t * LRU_LD + tid]; h = a * h + u; ap *= a;
                    if (FINAL) { if (s == 0) US[t * LRU_LD + tid] = h; else US[t * LRU_LD + tid] += h; } }
                if (!FINAL) { CAR_A[ci] = ap; CAR_H[ci] = h; }
            }
            __syncthreads();
        }
        if (FINAL) {
            const int t = tid >> 3, c16 = (tid & 7) * 16;
            const size_t m = (size_t)b * SEQ + t0 + t;
            const v4u y0 = *(const GAS v4u*)(PB + m * NPB + PB_CY + g * 128 + c16), y1 = *(const GAS v4u*)(PB + m * NPB + PB_CY + g * 128 + c16 + 8);
            const unsigned yy[8] = {y0.x, y0.y, y0.z, y0.w, y1.x, y1.y, y1.z, y1.w};
            unsigned oo[8];
#pragma unroll
            for (int e = 0; e < 8; ++e) { const float ya = bf2f((unsigned short)(yy[e] & 0xffffu)), yb = bf2f((unsigned short)(yy[e] >> 16));
                oo[e] = pk2(US[t * LRU_LD + c16 + 2 * e] * gelu_tanh(ya), US[t * LRU_LD + c16 + 2 * e + 1] * gelu_tanh(yb)); }
            v4u o0, o1; o0.x = oo[0]; o0.y = oo[1]; o0.z = oo[2]; o0.w = oo[3]; o1.x = oo[4]; o1.y = oo[5]; o1.z = oo[6]; o1.w = oo[7];
            *(GAS v4u*)(MIX + m * D + 1536 + g * 128 + c16) = o0; *(GAS v4u*)(MIX + m * D + 1536 + g * 128 + c16 + 8) = o1;
        }
    }
}
__device__ __forceinline__ void lru_carry_phase(const Frame& F, const float* __restrict__ CAR_A, const float* __restrict__ CAR_H, float* __restrict__ CIN) {
    const int id = F.bx * NTHREADS + F.tid;
    if (id < 2 * BATCH * 512) {
        const int s = id >> 11, b = (id >> 9) & 3, ch = id & 511;
        float h = 0.f;
        for (int st = 0; st < 32; ++st) { const int n = s ? 31 - st : st; const size_t ci = ((size_t)((s * BATCH + b) * 32 + n)) * 512 + ch;
            CIN[ci] = h; h = CAR_A[ci] * h + CAR_H[ci]; }
    }
}
#define WA_LOAD(colbase, u_) do { const int b_ = (u_) >> 7, hkv_ = (((u_) >> 4) & 7) >> 2, q0_ = ((u_) & 15) * 128; \
    _Pragma("unroll") for (int i_ = 0; i_ < 12; ++i_) { const int ch_ = tid + NTHREADS * i_, r_ = ch_ >> 4, col_ = ch_ & 15; int j_ = q0_ - 128 + r_; j_ = j_ < 0 ? 0 : (j_ > SEQ - 1 ? SEQ - 1 : j_); \
        kreg[i_] = *(const GAS v4u*)(PB + (size_t)(b_ * SEQ + j_) * NPB + (colbase) + hkv_ * 128 + col_ * 8); } } while (0)
#define WA_STORE(stride_) do { _Pragma("unroll") for (int i_ = 0; i_ < 12; ++i_) { const int ch_ = tid + NTHREADS * i_, r_ = ch_ >> 4, col_ = ch_ & 15; \
        *(LAS v4u*)(KS + r_ * (stride_) + col_ * 16) = kreg[i_]; } } while (0)
__device__ __forceinline__ void wattn_phase(const Frame& F, const bf16* __restrict__ PB, const float* __restrict__ rel_bias, const float* __restrict__ sink, bf16* __restrict__ MIX) {
    LAS unsigned char* KS = F.lds;
    LAS float* btab = (LAS float*)(F.lds + 384 * 288);
    const int lane = F.lane, g = lane >> 4, c = lane & 15, w = F.wave, tid = F.tid;
    constexpr int NUNITS = BATCH * 8 * (SEQ / 128);
    v4u kreg[12];
    int unit = F.bx, bias_hq = -1;
    if (unit < NUNITS) WA_LOAD(O_AK, unit);
    while (unit < NUNITS) {
        const int b = unit >> 7, hq = (unit >> 4) & 7, qb = unit & 15;
        const int q0 = qb * 128;
        __syncthreads();
        WA_STORE(272);
        if (hq != bias_hq) { if (tid < 304) { const int rel = tid - 143; btab[tid] = (rel >= -128 && rel <= 128) ? rel_bias[t5_bucket(rel) * 8 + hq] : -1e30f; } bias_hq = hq; }
        __syncthreads();
        WA_LOAD(O_AV, unit);
        f32x4 S[17];
#pragma unroll
        for (int kt = 0; kt < 17; ++kt) S[kt] = (f32x4){0.f, 0.f, 0.f, 0.f};
        const bf16* qrow = PB + (size_t)(b * SEQ + q0 + 16 * w + c) * NPB + O_AQ + hq * 128 + g * 8;
#pragma unroll
        for (int ks = 0; ks < 4; ++ks) {
            const bf16x8 qf = *(const GAS bf16x8*)(qrow + ks * 32);
#pragma unroll
            for (int kt = 0; kt < 17; ++kt) { const bf16x8 kf = *(const LAS bf16x8*)(KS + (16 * w + 16 * kt + c) * 272 + ks * 64 + g * 16); S[kt] = __builtin_amdgcn_mfma_f32_16x16x32_bf16(kf, qf, S[kt], 0, 0, 0);
                if (kt == 8 || kt == 16) __builtin_amdgcn_sched_barrier(0); }
        }
        const float snk = sink[hq];
        float mx = snk;
        const int row_lo = (qb == 0) ? 128 : 0, row_n = ((qb == SEQ / 128 - 1) ? 256 : 384) - row_lo;
#pragma unroll
        for (int kt = 0; kt < 17; ++kt)
#pragma unroll
            for (int r = 0; r < 4; ++r) {
                const int row = 16 * w + 16 * kt + 4 * g + r;
                const float bias = btab[(4 * g - c + 15) + 16 * kt + r];
                const float s = ((unsigned)(row - row_lo) < (unsigned)row_n) ? S[kt][r] * 0.08838834764831845f + bias : -1e30f;
                S[kt][r] = s; mx = fmaxf(mx, s);
                if (r == 3 && (kt & 1)) __builtin_amdgcn_sched_barrier(0);
            }
        mx = fmaxf(mx, lane_xor_f(mx, 16, lane)); mx = fmaxf(mx, lane_xor_f(mx, 32, lane));
        float sum = 0.f;
#pragma unroll
        for (int kt = 0; kt < 17; ++kt)
#pragma unroll
            for (int r = 0; r < 4; ++r) { const float p = __builtin_amdgcn_exp2f((S[kt][r] - mx) * 1.4426950408889634f); S[kt][r] = p; sum += p; }
        sum += lane_xor_f(sum, 16, lane); sum += lane_xor_f(sum, 32, lane);
        sum += __builtin_amdgcn_exp2f((snk - mx) * 1.4426950408889634f);
        const float inv = 1.f / sum;
        bf16x8 pf[9];
#pragma unroll
        for (int s = 0; s < 9; ++s) { v4u t; t.x = pk2(S[2 * s][0] * inv, S[2 * s][1] * inv); t.y = pk2(S[2 * s][2] * inv, S[2 * s][3] * inv);
            if (s < 8) { t.z = pk2(S[2 * s + 1][0] * inv, S[2 * s + 1][1] * inv); t.w = pk2(S[2 * s + 1][2] * inv, S[2 * s + 1][3] * inv); } else { t.z = 0u; t.w = 0u; }
            pf[s] = __builtin_bit_cast(bf16x8, t); }
        __syncthreads();
        WA_STORE(288);
        __syncthreads();
        const int nxt = unit + F.G;
        if (nxt < NUNITS) WA_LOAD(O_AK, nxt);
        for (int dt = 0; dt < 8; ++dt) {
            f32x4 acc = {0.f, 0.f, 0.f, 0.f};
#pragma unroll
            for (int s = 0; s < 9; ++s) {
                LAS unsigned char* vp = KS + (16 * w + 32 * s + 4 * g + (c >> 2)) * 288 + (16 * dt + 4 * (c & 3)) * 2;
                const s16x4 lo = __builtin_amdgcn_ds_read_tr16_b64_v4i16((LAS s16x4*)vp);
                const s16x4 hi = __builtin_amdgcn_ds_read_tr16_b64_v4i16((LAS s16x4*)(vp + (s < 8 ? 16 * 288 : 0)));
                const bf16x8 vf = __builtin_shufflevector(lo, hi, 0, 1, 2, 3, 4, 5, 6, 7);
                acc = __builtin_amdgcn_mfma_f32_16x16x32_bf16(vf, pf[s], acc, 0, 0, 0);
            }
            v2u o; o.x = pk2(acc[0], acc[1]); o.y = pk2(acc[2], acc[3]);
            *(GAS v2u*)(MIX + (size_t)(b * SEQ + q0 + 16 * w + c) * D + hq * 128 + dt * 16 + 4 * g) = o;
        }
        unit = nxt;
    }
}
#undef WA_LOAD
#undef WA_STORE
#define XA_LOAD(u_, st_) do { const int b_ = (u_) >> 6, h_ = ((u_) >> 4) & 3; \
    if ((st_) < 4) { _Pragma("unroll") for (int i_ = 0; i_ < 8; ++i_) { const int row_ = (tid >> 4) + 32 * i_, col_ = tid & 15; \
            R[i_] = *(const GAS v4u*)(KX + (size_t)(b_ * MEM_LEN + row_) * D + h_ * 512 + (st_) * 128 + col_ * 8); } } \
    else { _Pragma("unroll") for (int i_ = 0; i_ < 8; ++i_) { const int row_ = (tid >> 5) + 16 * i_, col_ = tid & 31; \
            R[i_] = *(const GAS v4u*)(VT + (size_t)(h_ * 512 + ((st_) - 4) * 128 + row_) * MM + b_ * MEM_LEN + col_ * 8); } } } while (0)
#define XA_STORE(st_) do { if ((st_) < 4) { _Pragma("unroll") for (int i_ = 0; i_ < 8; ++i_) { const int row_ = (tid >> 4) + 32 * i_, col_ = tid & 15; *(LAS v4u*)(KS + row_ * 272 + col_ * 16) = R[i_]; } } \
    else { _Pragma("unroll") for (int i_ = 0; i_ < 8; ++i_) { const int row_ = (tid >> 5) + 16 * i_, col_ = tid & 31; *(LAS v4u*)(KS + row_ * 528 + col_ * 16) = R[i_]; } } } while (0)
__device__ __forceinline__ void xattn_phase(const Frame& F, const bf16* __restrict__ Q, const bf16* __restrict__ KX, const bf16* __restrict__ VT, bf16* __restrict__ O) {
    LAS unsigned char* KS = F.lds;
    const int lane = F.lane, g = lane >> 4, c = lane & 15, w = F.wave, tid = F.tid;
    constexpr int NUNITS = BATCH * 4 * (SEQ / 128);
    v4u R[8];
    int unit = F.bx;
    if (unit < NUNITS) XA_LOAD(unit, 0);
    while (unit < NUNITS) {
        const int b = unit >> 6, h = (unit >> 4) & 3, qb = unit & 15;
        const int m0 = b * SEQ + qb * 128 + w * 16;
        const int nxt = unit + F.G;
        f32x4 S[16];
#pragma unroll
        for (int kt = 0; kt < 16; ++kt) S[kt] = (f32x4){0.f, 0.f, 0.f, 0.f};
        const bf16* qrow = Q + (size_t)(m0 + c) * D + h * 512 + g * 8;
#pragma unroll
        for (int dc = 0; dc < 4; ++dc) {
            bf16x8 qf[4];
#pragma unroll
            for (int ks = 0; ks < 4; ++ks) qf[ks] = *(const GAS bf16x8*)(qrow + dc * 128 + ks * 32);
            __syncthreads();
            XA_STORE(dc);
            __syncthreads();
            XA_LOAD(unit, dc + 1);
#pragma unroll
            for (int ks = 0; ks < 4; ++ks) {
#pragma unroll
                for (int kt = 0; kt < 16; ++kt) { const bf16x8 kf = *(const LAS bf16x8*)(KS + (16 * kt + c) * 272 + ks * 64 + g * 16); S[kt] = __builtin_amdgcn_mfma_f32_16x16x32_bf16(kf, qf[ks], S[kt], 0, 0, 0); }
            }
        }
        float mx = -3.0e38f;
#pragma unroll
        for (int kt = 0; kt < 16; ++kt)
#pragma unroll
            for (int r = 0; r < 4; ++r) mx = fmaxf(mx, S[kt][r]);
        mx = fmaxf(mx, lane_xor_f(mx, 16, lane)); mx = fmaxf(mx, lane_xor_f(mx, 32, lane));
        const float sc2 = 0.044194173824159216f * 1.4426950408889634f;
        float sum = 0.f;
#pragma unroll
        for (int kt = 0; kt < 16; ++kt)
#pragma unroll
            for (int r = 0; r < 4; ++r) { const float p = __builtin_amdgcn_exp2f((S[kt][r] - mx) * sc2); S[kt][r] = p; sum += p; }
        sum += lane_xor_f(sum, 16, lane); sum += lane_xor_f(sum, 32, lane);
        const float inv = 1.f / sum;
        bf16x8 pf[8];
#pragma unroll
        for (int s = 0; s < 8; ++s) { v4u t; t.x = pk2(S[2 * s][0] * inv, S[2 * s][1] * inv); t.y = pk2(S[2 * s][2] * inv, S[2 * s][3] * inv); t.z = pk2(S[2 * s + 1][0] * inv, S[2 * s + 1][1] * inv); t.w = pk2(S[2 * s + 1][2] * inv, S[2 * s + 1][3] * inv);
            pf[s] = __builtin_bit_cast(bf16x8, t); }
#pragma unroll
        for (int dc = 0; dc < 4; ++dc) {
            __syncthreads();
            XA_STORE(4 + dc);
            __syncthreads();
            if (dc < 3) XA_LOAD(unit, 5 + dc); else if (nxt < NUNITS) XA_LOAD(nxt, 0);
            for (int dt = 0; dt < 8; ++dt) {
                f32x4 acc = {0.f, 0.f, 0.f, 0.f};
#pragma unroll
                for (int s = 0; s < 8; ++s) {
                    const LAS unsigned char* vp = KS + (16 * dt + c) * 528 + 64 * s + 8 * g;
                    const v2u lo = *(const LAS v2u*)vp, hi = *(const LAS v2u*)(vp + 32);
                    v4u t; t.x = lo.x; t.y = lo.y; t.z = hi.x; t.w = hi.y;
                    acc = __builtin_amdgcn_mfma_f32_16x16x32_bf16(__builtin_bit_cast(bf16x8, t), pf[s], acc, 0, 0, 0);
                }
                v2u o; o.x = pk2(acc[0], acc[1]); o.y = pk2(acc[2], acc[3]);
                *(GAS v2u*)(O + (size_t)(m0 + c) * D + h * 512 + dc * 128 + dt * 16 + 4 * g) = o;
            }
        }
        unit = nxt;
    }
}
#undef XA_LOAD
#undef XA_STORE
constexpr int NPL = 15;
enum Phase { PH_CONV = 0, PH_KV, PH_IN, PH_X1, PH_X2, PH_X3, PH_OUT, PH_RN1, PH_Q, PH_XA, PH_O, PH_RN2, PH_UP, PH_DOWN, PH_RN3 };
#define CAS __attribute__((address_space(4)))
struct Args { const float* in[31]; float* out; unsigned char* ws; int ph_lo, ph_hi, li, pad; };

__global__ void __launch_bounds__(NTHREADS, 2) fwd(Args args) {
    extern __shared__ __attribute__((aligned(16))) unsigned char lds[];
    Frame F;
    F.lds = (LAS unsigned char*)lds;
    const int wave_s = __builtin_amdgcn_readfirstlane(threadIdx.x >> 6);
    F.tid = threadIdx.x; F.lane = F.tid & 63; F.wave = wave_s;
    F.G = gridDim.x; F.bx = blockIdx.x;
    unsigned char* ws_top = args.ws;
    const int lo = args.ph_lo, hi = args.ph_hi;
    for (int u = F.tid; u < (LDS_BYTES - LDSCTL_OFF) / 4; u += NTHREADS) ((LAS unsigned*)(F.lds + LDSCTL_OFF))[u] = 0u;
    __syncthreads();
    XcdBarrier bar; bar.bar = (unsigned*)(ws_top + WS_CTL) + CW_BAR; bar.x = 0; bar.st = nullptr;
    const bool one_launch = (hi - lo) > 1;
    if (one_launch) bar = xcd_barrier_post((unsigned*)(ws_top + WS_CTL) + CW_BAR, (volatile LAS unsigned*)(F.lds + MISC_OFF) + 8);
#define SEAM(k) do { if (one_launch && (k) + 1 < hi) { xcd_barrier(bar); if (PROBE_REP & 512) xcd_barrier(bar); } } while (0)
#define IN(k) (lo <= (k) && (k) < hi)
#define REPS(bit) (1 + ((PROBE_REP >> (bit)) & 1))
#define PHASE_BEGIN() const CAS Args* ka_ = (const CAS Args*)__builtin_amdgcn_kernarg_segment_ptr(); asm volatile("" : "+s"(ka_)); \
    unsigned mk_ = ~0u; int l = l_it, bx_ = (int)blockIdx.x, G_ = (int)gridDim.x; asm volatile("" : "+s"(mk_), "+s"(l), "+s"(bx_), "+s"(G_)); F.bx = bx_; F.G = G_;     \
    int tz_ = (wave_s << 6) + (int)__builtin_amdgcn_mbcnt_hi(mk_, __builtin_amdgcn_mbcnt_lo(mk_, 0u)); asm volatile("" : "+v"(tz_)); F.tid = tz_; F.lane = tz_ & 63; F.wave = __builtin_amdgcn_readfirstlane(tz_ >> 6); \
    unsigned char* ws = ka_->ws; float* X = ka_->out; bf16* XN = (bf16*)(ws + WS_XN); bf16* Y = (bf16*)(ws + WS_Y); float* RS = (float*)(ws + WS_MISC + MISC_RS); unsigned char* wl = ws + WS_W + (size_t)(l % NWL) * WL_BYTES; \
    const int gw = F.bx * NWAVES + F.wave, NGW = F.G * NWAVES; (void)gw; (void)NGW; (void)X; (void)XN; (void)Y; (void)wl; (void)RS

    for (int l_it = 0; l_it < DEPTH; ++l_it) {
        const int pb = l_it * NPL;
        for (int rep_ = 0; rep_ < REPS(0); ++rep_) if (IN(pb + PH_CONV)) { PHASE_BEGIN();
            LAS float* scr = (LAS float*)(F.lds + RING_OFF + F.wave * 16384);
            const int lc0 = (NWL == 1) ? l : (l == 0 ? 0 : DEPTH), lc1 = (NWL == 1) ? l + 1 : DEPTH;
            for (int lc = lc0; lc < lc1; ++lc) {
                unsigned char* wb = ws + WS_W + (size_t)(lc % NWL) * WL_BYTES;
                const ConvSeg segs[10] = {
                    {ka_->in[3] + (size_t)lc * D * DIN, D, DIN, 0, 3072, (bf16*)(wb + WL_IN), 0, ka_->in[24] + (size_t)lc * D},
                    {ka_->in[3] + (size_t)lc * D * DIN, D, DIN, 3072, 32, (bf16*)(wb + WL_Z), 0, ka_->in[24] + (size_t)lc * D},
                    {ka_->in[3] + (size_t)lc * D * DIN, D, DIN, 3104, 1024, (bf16*)(wb + WL_IN), 3072, ka_->in[24] + (size_t)lc * D},
                    {ka_->in[4] + (size_t)lc * D * D, D, D, 0, D, (bf16*)(wb + WL_OUT), 0, nullptr},
                    {ka_->in[18] + (size_t)lc * D * D, D, D, 0, D, (bf16*)(wb + WL_XQ), 0, ka_->in[27] + (size_t)lc * D},
                    {ka_->in[19] + (size_t)lc * D * D, D, D, 0, D, (bf16*)(wb + WL_XK), 0, nullptr},
                    {ka_->in[20] + (size_t)lc * D * D, D, D, 0, D, (bf16*)(wb + WL_XV), 0, nullptr},
                    {ka_->in[21] + (size_t)lc * D * D, D, D, 0, D, (bf16*)(wb + WL_XO), 0, nullptr},
                    {ka_->in[22] + (size_t)lc * D * DFF, D, DFF, 0, DFF, (bf16*)(wb + WL_UP), 0, ka_->in[29] + (size_t)lc * D},
                    {ka_->in[23] + (size_t)lc * DFF * D, DFF, D, 0, D, (bf16*)(wb + WL_DOWN), 0, nullptr}};
                int total = 0;
#pragma unroll
                for (int s = 0; s < 10; ++s) total += seg_items(segs[s]);
                for (int it = gw; it < total; it += NGW) {
                    int r = it;
#pragma unroll
                    for (int s = 0; s < 10; ++s) { const int n = seg_items(segs[s]);
                        if (r >= 0 && r < n) p0_transpose_item(segs[s].W, segs[s].K, segs[s].N, segs[s].c0, segs[s].WT, segs[s].r0, segs[s].ncols / 32, segs[s].gain, scr, r, F.lane);
                        r -= n; }
                }
            }
            for (int lc = lc0; lc < lc1; ++lc) {
                bf16* lg = (bf16*)(ws + WS_W + (size_t)(lc % NWL) * WL_BYTES + WL_LRUG);
                for (int it = gw; it < 16 * 8; it += NGW) { const int mi = it >> 3, gate = mi >> 3, s = (mi >> 2) & 1, gg = mi & 3;
                    p0_transpose_item(ka_->in[gate ? 15 : 13] + ((size_t)lc * 8 + s * 4 + gg) * 16384, 128, 128, 0, lg + (size_t)((s * 2 + gate) * 4 + gg) * 16384, 0, 4, nullptr, scr, it & 7, F.lane); }
            }
            if (l == 0) for (int m = gw; m < M; m += NGW) init_row(F.lane, ka_->in[0] + (size_t)m * D, XN + (size_t)m * D, RS + m);
            for (int lc = lc0; lc < lc1; ++lc)
                for (int m = gw; m < MM; m += NGW) norm_row(F.lane, ka_->in[1] + (size_t)m * D, ka_->in[26] + (size_t)lc * D, (bf16*)(ws + WS_MEMN) + ((size_t)lc * MM + m) * D, nullptr);
        }
        if (l_it == 0 || NWL == 1) SEAM(pb + PH_CONV);
        for (int rep_ = 0; rep_ < REPS(1); ++rep_) if (IN(pb + PH_KV)) { PHASE_BEGIN();
            const int lc0 = (NWL == 1) ? l : (l == 0 ? 0 : DEPTH), lc1 = (NWL == 1) ? l + 1 : DEPTH;
            if (lc1 > lc0) {
                const bf16* base = (const bf16*)(ws + WS_W);
                pg8::Gemm g{base, base, 0, 0, D};
                pg8::KvOrder S; S.G = F.G; S.c = F.bx; S.NL = lc1 - lc0; S.l0 = lc0;
                S.memn_p0 = (int)((WS_MEMN - WS_W) / MiB) + 4 * lc0; S.memn_ps = 4;
                S.xk_p0 = (int)(((size_t)(lc0 % NWL) * WL_BYTES + WL_XK) / MiB); S.xv_p0 = (int)(((size_t)(lc0 % NWL) * WL_BYTES + WL_XV) / MiB); S.w_ps = (int)(WL_BYTES / MiB);
                pg8::EpiBf16<0> E{(bf16*)(ws + WS_KX), D, (bf16*)(ws + WS_VT), MM, nullptr};
                pg8::gemm_phase<pg8::EpiBf16<0>, pg8::KvOrder, true, true>(F.lds + RING_OFF, g, S, E, F.tid);
            }
        }
        if (l_it == 0 || NWL == 1) SEAM(pb + PH_KV);
        for (int rep_ = 0; rep_ < REPS(2); ++rep_) if (IN(pb + PH_IN)) { if (rep_ > 0 && (PROBE_REP & 1024)) xcd_barrier(bar); PHASE_BEGIN();
            pg8::Gemm g{XN, (const bf16*)(wl + WL_IN), M, NPB, D}; pg8::StaticOrder S; S.init(M, NPB, F.G, F.bx);
            pg8::EpiBf16<0> E{(bf16*)(ws + WS_PB), NPB, nullptr, 0, RS};
            pg8::gemm_phase<pg8::EpiBf16<0>, pg8::StaticOrder, true, true>(F.lds + RING_OFF, g, S, E, F.tid);
            zgemm(F, XN, (const bf16*)(wl + WL_Z), RS, (float*)(ws + WS_Z));
        }
        SEAM(pb + PH_IN);
        if (IN(pb + PH_X1)) { PHASE_BEGIN();
            for (int rep_ = 0; rep_ < REPS(3); ++rep_) gla_u_phase(F, (const bf16*)(ws + WS_PB), (const float*)(ws + WS_Z), ka_->in[6] + (size_t)l * 4096, ka_->in[7] + (size_t)l * 256, ka_->in[8] + (size_t)l * 4096, ka_->in[9] + (size_t)l * 256,
                        (float*)(ws + WS_GLAU), (float*)(ws + WS_MISC + MISC_DEC));
            for (int rep_ = 0; rep_ < REPS(5); ++rep_) lru_phase<false>(F, (const bf16*)(ws + WS_PB), (const bf16*)(wl + WL_LRUG), ka_->in[11] + (size_t)l * 2048, ka_->in[12] + (size_t)l * 512, ka_->in[14] + (size_t)l * 1024, ka_->in[16] + (size_t)l * 1024, ka_->in[17] + (size_t)l * 1024,
                             (float*)(ws + WS_MISC + MISC_CAR_A), (float*)(ws + WS_MISC + MISC_CAR_H), nullptr, nullptr); }
        SEAM(pb + PH_X1);
        if (IN(pb + PH_X2)) { PHASE_BEGIN();
            gla_state_phase(F, (float*)(ws + WS_GLAU), (const float*)(ws + WS_MISC + MISC_DEC));
            lru_carry_phase(F, (const float*)(ws + WS_MISC + MISC_CAR_A), (const float*)(ws + WS_MISC + MISC_CAR_H), (float*)(ws + WS_MISC + MISC_CIN));
            for (int rep_ = 0; rep_ < REPS(6); ++rep_) wattn_phase(F, (const bf16*)(ws + WS_PB), ka_->in[2], ka_->in[5] + l * 8, (bf16*)(ws + WS_MIX)); }
        SEAM(pb + PH_X2);
        if (IN(pb + PH_X3)) { PHASE_BEGIN();
            for (int rep_ = 0; rep_ < REPS(7); ++rep_) gla_o_phase(F, (const bf16*)(ws + WS_PB), (const float*)(ws + WS_Z), ka_->in[6] + (size_t)l * 4096, ka_->in[7] + (size_t)l * 256, ka_->in[8] + (size_t)l * 4096, ka_->in[9] + (size_t)l * 256,
                        (const float*)(ws + WS_GLAU), ka_->in[10] + (size_t)l * 512, (bf16*)(ws + WS_MIX));
            for (int rep_ = 0; rep_ < REPS(8); ++rep_) lru_phase<true>(F, (const bf16*)(ws + WS_PB), (const bf16*)(wl + WL_LRUG), ka_->in[11] + (size_t)l * 2048, ka_->in[12] + (size_t)l * 512, ka_->in[14] + (size_t)l * 1024, ka_->in[16] + (size_t)l * 1024, ka_->in[17] + (size_t)l * 1024,
                            nullptr, nullptr, (const float*)(ws + WS_MISC + MISC_CIN), (bf16*)(ws + WS_MIX)); }
        SEAM(pb + PH_X3);
        for (int rep_ = 0; rep_ < REPS(2); ++rep_) if (IN(pb + PH_OUT)) { if (rep_ > 0 && (PROBE_REP & 1024)) xcd_barrier(bar); PHASE_BEGIN();
            pg8::Gemm g{(const bf16*)(ws + WS_MIX), (const bf16*)(wl + WL_OUT), M, D, D}; pg8::StaticOrder S; S.init(M, D, F.G, F.bx);
            pg8::EpiBf16<0> E{Y, D, nullptr, 0, nullptr};
            pg8::gemm_phase<pg8::EpiBf16<0>, pg8::StaticOrder, true, true>(F.lds + RING_OFF, g, S, E, F.tid);
        }
        SEAM(pb + PH_OUT);
        if (IN(pb + PH_RN1)) { PHASE_BEGIN(); if (NGW * 4 == M) resid_rows<4>(F.lane, XN + (size_t)gw * D, Y + (size_t)gw * D, (size_t)NGW * D, ka_->in[25] + (size_t)l * D, RS + gw, (size_t)NGW, nullptr); else for (int m = gw; m < M; m += NGW) resid_row(F.lane, XN + (size_t)m * D, Y + (size_t)m * D, ka_->in[25] + (size_t)l * D, RS + m, nullptr);  if (PROBE_REP & 2048) resid_rows<4>(F.lane, XN + (size_t)gw * D, Y + (size_t)gw * D, (size_t)NGW * D, (const float*)(ws + WS_CTL + 512 * 1024), RS + gw, (size_t)NGW, nullptr); }
        SEAM(pb + PH_RN1);
        for (int rep_ = 0; rep_ < REPS(2); ++rep_) if (IN(pb + PH_Q)) { if (rep_ > 0 && (PROBE_REP & 1024)) xcd_barrier(bar); PHASE_BEGIN();
            pg8::Gemm g{XN, (const bf16*)(wl + WL_XQ), M, D, D}; pg8::StaticOrder S; S.init(M, D, F.G, F.bx);
            pg8::EpiBf16<0> E{(bf16*)(ws + WS_Q), D, nullptr, 0, RS};
            pg8::gemm_phase<pg8::EpiBf16<0>, pg8::StaticOrder, true, true>(F.lds + RING_OFF, g, S, E, F.tid);
        }
        SEAM(pb + PH_Q);
        for (int rep_ = 0; rep_ < REPS(4); ++rep_) if (IN(pb + PH_XA)) { PHASE_BEGIN(); xattn_phase(F, (const bf16*)(ws + WS_Q), (const bf16*)(ws + WS_KX) + (size_t)l * MM * D, (const bf16*)(ws + WS_VT) + (size_t)l * D * MM, (bf16*)(ws + WS_O)); }
        SEAM(pb + PH_XA);
        for (int rep_ = 0; rep_ < REPS(2); ++rep_) if (IN(pb + PH_O)) { if (rep_ > 0 && (PROBE_REP & 1024)) xcd_barrier(bar); PHASE_BEGIN();
            pg8::Gemm g{(const bf16*)(ws + WS_O), (const bf16*)(wl + WL_XO), M, D, D}; pg8::StaticOrder S; S.init(M, D, F.G, F.bx);
            pg8::EpiBf16<0> E{Y, D, nullptr, 0, nullptr};
            pg8::gemm_phase<pg8::EpiBf16<0>, pg8::StaticOrder, true, true>(F.lds + RING_OFF, g, S, E, F.tid);
        }
        SEAM(pb + PH_O);
        if (IN(pb + PH_RN2)) { PHASE_BEGIN(); if (NGW * 4 == M) resid_rows<4>(F.lane, XN + (size_t)gw * D, Y + (size_t)gw * D, (size_t)NGW * D, ka_->in[28] + (size_t)l * D, RS + gw, (size_t)NGW, nullptr); else for (int m = gw; m < M; m += NGW) resid_row(F.lane, XN + (size_t)m * D, Y + (size_t)m * D, ka_->in[28] + (size_t)l * D, RS + m, nullptr);  if (PROBE_REP & 2048) resid_rows<4>(F.lane, XN + (size_t)gw * D, Y + (size_t)gw * D, (size_t)NGW * D, (const float*)(ws + WS_CTL + 512 * 1024), RS + gw, (size_t)NGW, nullptr); }
        SEAM(pb + PH_RN2);
        for (int rep_ = 0; rep_ < REPS(2); ++rep_) if (IN(pb + PH_UP)) { if (rep_ > 0 && (PROBE_REP & 1024)) xcd_barrier(bar); PHASE_BEGIN();
            pg8::Gemm g{XN, (const bf16*)(wl + WL_UP), M, DFF, D}; pg8::StaticOrder S; S.init(M, DFF, F.G, F.bx);
            pg8::EpiBf16<1> E{(bf16*)(ws + WS_H), DFF, nullptr, 0, RS};
            pg8::gemm_phase<pg8::EpiBf16<1>, pg8::StaticOrder, true, true>(F.lds + RING_OFF, g, S, E, F.tid);
        }
        SEAM(pb + PH_UP);
        for (int rep_ = 0; rep_ < REPS(2); ++rep_) if (IN(pb + PH_DOWN)) { if (rep_ > 0 && (PROBE_REP & 1024)) xcd_barrier(bar); PHASE_BEGIN();
            pg8::Gemm g{(const bf16*)(ws + WS_H), (const bf16*)(wl + WL_DOWN), M, D, DFF}; pg8::StaticOrder S; S.init(M, D, F.G, F.bx);
            pg8::EpiBf16<0> E{Y, D, nullptr, 0, nullptr};
            pg8::gemm_phase<pg8::EpiBf16<0>, pg8::StaticOrder, true, true>(F.lds + RING_OFF, g, S, E, F.tid);
        }
        SEAM(pb + PH_DOWN);
        if (IN(pb + PH_RN3)) { PHASE_BEGIN(); if (NGW * 4 == M) resid_rows<4>(F.lane, XN + (size_t)gw * D, Y + (size_t)gw * D, (size_t)NGW * D, ka_->in[30] + (size_t)l * D, RS + gw, (size_t)NGW, (l + 1 < DEPTH) ? nullptr : X + (size_t)gw * D); else for (int m = gw; m < M; m += NGW) resid_row(F.lane, XN + (size_t)m * D, Y + (size_t)m * D, ka_->in[30] + (size_t)l * D, RS + m, (l + 1 < DEPTH) ? nullptr : X + (size_t)m * D);  if (PROBE_REP & 2048) resid_rows<4>(F.lane, XN + (size_t)gw * D, Y + (size_t)gw * D, (size_t)NGW * D, (const float*)(ws + WS_CTL + 512 * 1024), RS + gw, (size_t)NGW, nullptr); }
        SEAM(pb + PH_RN3);
    }
#undef IN
#undef SEAM
}
extern "C" void kernel_launch(void* const* d_in, const int* in_sizes, int n_in, void* d_out, int out_size, void* d_ws, size_t ws_size, hipStream_t stream) {
    static int grid = 0;
    if (grid == 0) {
        int dev = 0, cus = 0;
        if (n_in != 31 || out_size != M * D || ws_size < WS_END) { fprintf(stderr, "kernel_launch: built for 31 inputs, %d outputs, >= %zu bytes of workspace; got %d, %d, %zu\n", M * D, (size_t)WS_END, n_in, out_size, ws_size); grid = -1; return; }
        if (hipGetDevice(&dev) != hipSuccess || hipDeviceGetAttribute(&cus, hipDeviceAttributeMultiprocessorCount, dev) != hipSuccess) { fprintf(stderr, "kernel_launch: device query failed\n"); grid = -1; return; }
        if (hipFuncSetAttribute((const void*)fwd, hipFuncAttributeMaxDynamicSharedMemorySize, LDS_BYTES) != hipSuccess) { fprintf(stderr, "kernel_launch: hipFuncSetAttribute failed\n"); grid = -1; return; }
        int per_cu = 0;
        if (hipOccupancyMaxActiveBlocksPerMultiprocessor(&per_cu, (const void*)fwd, NTHREADS, LDS_BYTES) != hipSuccess || per_cu < 1) { fprintf(stderr, "kernel_launch: occupancy query reports %d workgroups per CU\n", per_cu); (void)hipGetLastError(); }
        grid = cus;
    }
    if (grid < 0) return;
    unsigned char* ws = (unsigned char*)d_ws;
    (void)hipMemsetAsync(ws + WS_CTL, 0, CTL_ZERO_BYTES, stream);
    Args a{};
    for (int i = 0; i < 31; ++i) a.in[i] = (const float*)d_in[i];
    a.out = (float*)d_out; a.ws = ws;
#if defined(MK_PER_PHASE) && MK_PER_PHASE
    for (int p = 0; p < DEPTH * NPL; ++p) { if (NWL == 4 && p >= NPL && (p % NPL) < 2) continue; a.ph_lo = p; a.ph_hi = p + 1; hipLaunchKernelGGL(fwd, dim3(grid), dim3(NTHREADS), LDS_BYTES, stream, a); }
#else
    a.ph_lo = 0; a.ph_hi = DEPTH * NPL;
    hipLaunchKernelGGL(fwd, dim3(grid), dim3(NTHREADS), LDS_BYTES, stream, a);
    const hipError_t le = hipPeekAtLastError();
    if (le != hipSuccess) fprintf(stderr, "kernel_launch: launch failed: %s\n", hipGetErrorName(le));
#endif
}
```

```cpp
#include <hip/hip_runtime.h>
#include <cstdint>
#include <cstdio>

__device__ __forceinline__ float lane_xor_f(float v, int mask, int lane) { return __builtin_bit_cast(float, __builtin_amdgcn_ds_bpermute((lane ^ mask) << 2, __builtin_bit_cast(int, v))); }
namespace pg8 {
#define PG8_LAS __attribute__((address_space(3)))
typedef unsigned short bf16_t;
typedef short bf16x8 __attribute__((ext_vector_type(8)));
typedef float f32x4 __attribute__((ext_vector_type(4)));
typedef unsigned u32x4 __attribute__((ext_vector_type(4)));
constexpr int BM = 256, BK = 64, HALF = 128, HTB = HALF * BK * 2  , STAGE_BYTES = 8 * HTB, NXCD = 8, WGM = 8;

__host__ __device__ __forceinline__ int lds_byte(int r, int c) { const int st = (r >> 4) * 2 + (c >> 5), rr = r & 15, cc = c & 31, ob = rr * 64 + cc * 2; return st * 1024 + (ob ^ (((ob >> 9) & 1) << 5)); }
__host__ __device__ __forceinline__ void stage_rc(int b, int& R, int& C) { const int st = b / 1024, sb = b % 1024, swz = sb ^ (((sb >> 9) & 1) << 5); R = (st >> 1) * 16 + swz / 64; C = (st & 1) * 32 + (swz % 64) / 2; }
__host__ __device__ __forceinline__ int perm32(int rho) { const int n = rho >> 4, i = rho & 15; return 8 * (i >> 2) + 4 * n + (i & 3); }

struct Unit { int pm, pn, om, on, kind; };
struct Gemm { const bf16_t* A; const bf16_t* Bt; int M, N, K; };

struct StaticOrder {
    int nM, nN, nwg, G, c;
    __host__ __device__ void init(int M, int N, int G_, int c_) { nM = M / BM; nN = N / BM; nwg = nM * nN; G = G_; c = c_; }
    __host__ __device__ bool next(int i, Unit& u) const {
        const long L = (long)i * G + c; if (L >= nwg) return false;
        int wgid = (int)L; { const int q = nwg / NXCD, r = nwg % NXCD, xcd = wgid % NXCD, off = wgid / NXCD; wgid = (xcd < r ? xcd * (q + 1) : r * (q + 1) + (xcd - r) * q) + off; }
        const int nig = WGM * nN, gid = wgid / nig, fm = gid * WGM, gsz = (nM - fm) < WGM ? (nM - fm) : WGM;
        u.pm = fm + ((wgid % nig) % gsz); u.pn = (wgid % nig) / gsz; u.om = u.pm; u.on = u.pn; u.kind = 0; return true;
    }
    __device__ __forceinline__ void a_ready(const Unit&) const {}
    __device__ __forceinline__ void done(const Unit&) const {}
};
struct KvOrder {
    int G, c, NL, l0, memn_p0, memn_ps, xk_p0, xv_p0, w_ps;
    __host__ __device__ bool next(int i, Unit& u) const {
        const long L = (long)i * G + c; if (L >= (long)NL * 64) return false;
        const int l = (int)L / 64, r = (int)L % 64;
        if (r < 32) { const int pm = r & 3, pn = r >> 2; u.kind = 0; u.pm = memn_p0 + l * memn_ps + pm; u.pn = xk_p0 + l * w_ps + pn; u.om = (l0 + l) * 4 + pm; u.on = pn; }
        else { const int q = r - 32, pm = q & 7, pn = q >> 3; u.kind = 1; u.pm = xv_p0 + l * w_ps + pm; u.pn = memn_p0 + l * memn_ps + pn; u.om = (l0 + l) * 8 + pm; u.on = pn; }
        return true;
    }
    __device__ __forceinline__ void a_ready(const Unit&) const {}
    __device__ __forceinline__ void done(const Unit&) const {}
};

__device__ __forceinline__ unsigned cvt_pk_bf16(float lo, float hi) { unsigned r; asm volatile("v_cvt_pk_bf16_f32 %0, %1, %2" : "=v"(r) : "v"(lo), "v"(hi)); return r; }

template <int ACT  > struct EpiBf16 {
    static constexpr bool PERM = true, AFTER_DRAIN = false;
    bf16_t* O; int ldc; bf16_t* O1; int ldc1; const float* rs;
    __device__ __forceinline__ void operator()(const f32x4 (&acc)[2][2][4][2], const Unit& u, int wr, int wc, int fr, int fq) const {
        bf16_t* base = u.kind ? O1 : O; const int ld = u.kind ? ldc1 : ldc;
        const int row0 = u.om * BM + wr * 64 + fr, col0 = u.on * BM + wc * 32 + 8 * fq;
#pragma unroll
        for (int ai = 0; ai < 2; ++ai)
#pragma unroll
            for (int m = 0; m < 4; ++m) { bf16_t* rowp = base + (size_t)(row0 + ai * HALF + m * 16) * ld + col0;
                const float sc = rs ? rs[row0 + ai * HALF + m * 16] : 1.f;
#pragma unroll
                for (int bj = 0; bj < 2; ++bj) { f32x4 v0 = acc[ai][bj][m][0] * sc, v1 = acc[ai][bj][m][1] * sc;
                    if (ACT == 1) {
#pragma unroll
                        for (int j = 0; j < 4; ++j) { const float a = fmaxf(v0[j], 0.f), b = fmaxf(v1[j], 0.f); v0[j] = a * a; v1[j] = b * b; } }
                    u32x4 w; w.x = cvt_pk_bf16(v0[0], v0[1]); w.y = cvt_pk_bf16(v0[2], v0[3]); w.z = cvt_pk_bf16(v1[0], v1[1]); w.w = cvt_pk_bf16(v1[2], v1[3]);
                    *(u32x4*)(rowp + bj * HALF) = w; } }
    }
};
struct EpiF32 {
    static constexpr bool PERM = false, AFTER_DRAIN = false;
    float* C; int ldc;
    __device__ __forceinline__ void operator()(const f32x4 (&acc)[2][2][4][2], const Unit& u, int wr, int wc, int fr, int fq) const {
        const int row0 = u.om * BM + wr * 64 + fr, col0 = u.on * BM + wc * 32 + 4 * fq;
#pragma unroll
        for (int ai = 0; ai < 2; ++ai)
#pragma unroll
            for (int m = 0; m < 4; ++m) { float* rowp = C + (size_t)(row0 + ai * HALF + m * 16) * ldc + col0;
#pragma unroll
                for (int bj = 0; bj < 2; ++bj)
#pragma unroll
                    for (int n = 0; n < 2; ++n) *(f32x4*)(rowp + bj * HALF + n * 16) = acc[ai][bj][m][n]; }
    }
};

template <class Epi, class Sched, bool ALIGN_EPI = false, bool SP2 = false>
__device__ __forceinline__ void gemm_phase(PG8_LAS unsigned char* lds, const Gemm g, const Sched& S, const Epi& E, const int tid_in) {
    int tid_ = tid_in; asm volatile("" : "+v"(tid_));
    const int tid = tid_, wid = __builtin_amdgcn_readfirstlane(tid >> 6), lane = tid & 63, wr = wid >> 2, wc = wid & 3, fr = lane & 15, fq = lane >> 4;
    const int K = g.K, nt = K / BK;
    unsigned voffA[2], voffB[2];
#pragma unroll
    for (int i = 0; i < 2; ++i) { int R, C; stage_rc(tid * 16 + i * 8192, R, C); const int Rb = Epi::PERM ? ((R & ~31) + perm32(R & 31)) : R;
        voffA[i] = (unsigned)(R * K + C) * 2u; voffB[i] = (unsigned)(Rb * K + C) * 2u; }
    const size_t kstep = (size_t)(BK * 2);
    const size_t hstep = (size_t)HALF * K * 2;
    const size_t tstep = 2 * hstep;
    const unsigned ldsw = (unsigned)wid * 1024u;
    const int aoff = lds_byte(wr * 64 + fr, fq * 8), boff = lds_byte(wc * 32 + fr, fq * 8);
#define PG8_SA(b, h) (((b) * 2 + (h)) * HTB)
#define PG8_SB(b, h) ((4 + (b) * 2 + (h)) * HTB)
#define PG8_STAGE(bufoff, gbase, voff) do { _Pragma("unroll") for (int _i = 0; _i < 2; ++_i) \
        __builtin_amdgcn_global_load_lds((const unsigned*)((const char*)(gbase) + (voff)[_i]), (PG8_LAS unsigned*)(lds + (bufoff) + ldsw + _i * 8192), 16, 0, 0); } while (0)
#define PG8_LDA(dst, b, h) do { _Pragma("unroll") for (int m = 0; m < 4; ++m) _Pragma("unroll") for (int k = 0; k < 2; ++k) dst[m][k] = *(const PG8_LAS bf16x8*)(lds + PG8_SA(b, h) + aoff + m * 2048 + k * 1024); } while (0)
#define PG8_LDB(dst, b, h) do { _Pragma("unroll") for (int n = 0; n < 2; ++n) _Pragma("unroll") for (int k = 0; k < 2; ++k) dst[n][k] = *(const PG8_LAS bf16x8*)(lds + PG8_SB(b, h) + boff + n * 2048 + k * 1024); } while (0)
#define PG8_MMA(ai, bj, At, Bt) do { __builtin_amdgcn_s_setprio(1); _Pragma("unroll") for (int m = 0; m < 4; ++m) _Pragma("unroll") for (int n = 0; n < 2; ++n) _Pragma("unroll") for (int k = 0; k < 2; ++k) \
        acc[ai][bj][m][n] = __builtin_amdgcn_mfma_f32_16x16x32_bf16(Bt[n][k], At[m][k], acc[ai][bj][m][n], 0, 0, 0); __builtin_amdgcn_s_setprio(0); } while (0)
#define PG8_WAIT_V(n) asm volatile("s_waitcnt vmcnt(" #n ")" ::: "memory")
#define PG8_WAIT_L(n) asm volatile("s_waitcnt lgkmcnt(" #n ")" ::: "memory")
#define PG8_BAR __builtin_amdgcn_s_barrier()
#define PG8_SCHED __builtin_amdgcn_sched_barrier(0)
    Unit cur, nxt; int ui = 0;
    if (!S.next(0, cur)) return;
    f32x4 acc[2][2][4][2];
#pragma unroll
    for (int a = 0; a < 2; ++a)
#pragma unroll
        for (int b = 0; b < 2; ++b)
#pragma unroll
            for (int m = 0; m < 4; ++m)
#pragma unroll
                for (int n = 0; n < 2; ++n) acc[a][b][m][n] = (f32x4){0.f, 0.f, 0.f, 0.f};
    bf16x8 At[4][2], B0[2][2], B1[2][2];
    const char* cA = (const char*)g.A + (size_t)cur.pm * tstep; const char* cB = (const char*)g.Bt + (size_t)cur.pn * tstep;
    S.a_ready(cur);
    if constexpr (SP2) {
        PG8_STAGE(PG8_SB(0, 0), cB, voffB); PG8_STAGE(PG8_SB(0, 1), cB + hstep, voffB); PG8_STAGE(PG8_SA(0, 0), cA, voffA); PG8_STAGE(PG8_SA(0, 1), cA + hstep, voffA);
        if (wr == 1) PG8_BAR;
        PG8_WAIT_V(2); PG8_BAR;
        PG8_STAGE(PG8_SB(1, 0), cB + kstep, voffB); PG8_STAGE(PG8_SA(1, 0), cA + kstep, voffA); PG8_STAGE(PG8_SB(1, 1), cB + hstep + kstep, voffB);
        PG8_WAIT_V(6); PG8_BAR;
    } else {
        PG8_STAGE(PG8_SB(0, 0), cB, voffB); PG8_STAGE(PG8_SA(0, 0), cA, voffA); PG8_STAGE(PG8_SB(0, 1), cB + hstep, voffB); PG8_STAGE(PG8_SA(0, 1), cA + hstep, voffA);
        if (wr == 1) PG8_BAR;
        PG8_WAIT_V(4); PG8_BAR;
        PG8_STAGE(PG8_SB(1, 0), cB + kstep, voffB); PG8_STAGE(PG8_SA(1, 0), cA + kstep, voffA); PG8_STAGE(PG8_SB(1, 1), cB + hstep + kstep, voffB);
        PG8_WAIT_V(6); PG8_BAR;
    }
    for (;;) {
        const bool has_next = S.next(ui + 1, nxt);
        const char* nA = has_next ? (const char*)g.A + (size_t)nxt.pm * tstep : cA; const char* nB = has_next ? (const char*)g.Bt + (size_t)nxt.pn * tstep : cB;
        for (int t = 0; t < nt; t += 2) {
            const bool last = (t == nt - 2);
            const char* a1 = cA + (size_t)(t + 1) * kstep;
            const char* a2 = last ? nA : cA + (size_t)(t + 2) * kstep; const char* b2 = last ? nB : cB + (size_t)(t + 2) * kstep;
            const char* a3 = a2 + kstep; const char* b3 = b2 + kstep;
            if (last && has_next) S.a_ready(nxt);
            if constexpr (SP2) {
            PG8_LDB(B0, 0, 0); PG8_LDB(B1, 0, 1); PG8_SCHED; PG8_LDA(At, 0, 0); PG8_STAGE(PG8_SA(1, 1), a1 + hstep, voffA);
            PG8_WAIT_V(8); PG8_WAIT_L(0); PG8_BAR; PG8_MMA(0, 0, At, B0); PG8_MMA(0, 1, At, B1); PG8_BAR; PG8_SCHED;
            PG8_LDA(At, 0, 1); PG8_STAGE(PG8_SB(0, 0), b2, voffB); PG8_STAGE(PG8_SB(0, 1), b2 + hstep, voffB); PG8_STAGE(PG8_SA(0, 0), a2, voffA);
            PG8_WAIT_V(8); PG8_WAIT_L(0); PG8_BAR; PG8_MMA(1, 0, At, B0); PG8_MMA(1, 1, At, B1); PG8_BAR; PG8_SCHED;
            PG8_LDB(B0, 1, 0); PG8_LDB(B1, 1, 1); PG8_SCHED; PG8_LDA(At, 1, 0); PG8_STAGE(PG8_SA(0, 1), a2 + hstep, voffA);
            PG8_WAIT_V(8); PG8_WAIT_L(0); PG8_BAR; PG8_MMA(0, 0, At, B0); PG8_MMA(0, 1, At, B1); PG8_BAR; PG8_SCHED;
            PG8_LDA(At, 1, 1); PG8_STAGE(PG8_SB(1, 0), b3, voffB); PG8_STAGE(PG8_SB(1, 1), b3 + hstep, voffB); PG8_STAGE(PG8_SA(1, 0), a3, voffA);
            PG8_WAIT_V(8); PG8_WAIT_L(0); PG8_BAR; PG8_MMA(1, 0, At, B0); PG8_MMA(1, 1, At, B1); PG8_BAR; PG8_SCHED;
            } else {
            PG8_LDB(B0, 0, 0); PG8_SCHED; PG8_LDA(At, 0, 0); PG8_STAGE(PG8_SA(1, 1), a1 + hstep, voffA);
            PG8_WAIT_L(8); PG8_BAR; PG8_WAIT_L(0); PG8_MMA(0, 0, At, B0); PG8_BAR; PG8_SCHED;
            PG8_LDB(B1, 0, 1); PG8_STAGE(PG8_SB(0, 0), b2, voffB);
            PG8_BAR; PG8_WAIT_L(0); PG8_MMA(0, 1, At, B1); PG8_BAR;
            PG8_LDA(At, 0, 1); PG8_STAGE(PG8_SA(0, 0), a2, voffA);
            PG8_BAR; PG8_WAIT_L(0); PG8_MMA(1, 0, At, B0); PG8_BAR; PG8_SCHED;
            PG8_STAGE(PG8_SB(0, 1), b2 + hstep, voffB);
            PG8_WAIT_V(6); PG8_BAR; PG8_MMA(1, 1, At, B1); PG8_BAR;
            PG8_LDB(B0, 1, 0); PG8_SCHED; PG8_LDA(At, 1, 0); PG8_STAGE(PG8_SA(0, 1), a2 + hstep, voffA);
            PG8_WAIT_L(8); PG8_BAR; PG8_WAIT_L(0); PG8_MMA(0, 0, At, B0); PG8_BAR; PG8_SCHED;
            PG8_LDB(B1, 1, 1); PG8_STAGE(PG8_SB(1, 0), b3, voffB);
            PG8_BAR; PG8_WAIT_L(0); PG8_MMA(0, 1, At, B1); PG8_BAR;
            PG8_LDA(At, 1, 1); PG8_STAGE(PG8_SA(1, 0), a3, voffA);
            PG8_BAR; PG8_WAIT_L(0); PG8_MMA(1, 0, At, B0); PG8_BAR; PG8_SCHED;
            PG8_STAGE(PG8_SB(1, 1), b3 + hstep, voffB);
            PG8_WAIT_V(6); PG8_BAR; PG8_MMA(1, 1, At, B1); PG8_BAR;
            }
        }
        if constexpr (ALIGN_EPI) { if (wr == 0) PG8_BAR; }
        if constexpr (!Epi::AFTER_DRAIN) { E(acc, cur, wr, wc, fr, fq); S.done(cur); }
        if (!has_next) break;
#pragma unroll
        for (int a = 0; a < 2; ++a)
#pragma unroll
            for (int b = 0; b < 2; ++b)
#pragma unroll
                for (int m = 0; m < 4; ++m)
#pragma unroll
                    for (int n = 0; n < 2; ++n) acc[a][b][m][n] = (f32x4){0.f, 0.f, 0.f, 0.f};
        cur = nxt; cA = nA; cB = nB; ++ui;
        if constexpr (ALIGN_EPI) { if (wr == 1) PG8_BAR; }
    }
    PG8_WAIT_V(0);
    if constexpr (!ALIGN_EPI) { if (wr == 0) PG8_BAR; }
    PG8_BAR;
    if constexpr (Epi::AFTER_DRAIN) { E.fused(acc, cur, wr, wc, fr, fq, lds, wid, lane); S.done(cur); }
#undef PG8_SA
#undef PG8_SB
#undef PG8_STAGE
#undef PG8_LDA
#undef PG8_LDB
#undef PG8_MMA
#undef PG8_WAIT_V
#undef PG8_WAIT_L
#undef PG8_BAR
#undef PG8_SCHED
}
}

constexpr int D = 2048, BATCH = 4, SEQ = 2048, DEPTH = 4, M = BATCH * SEQ, MEM_LEN = 256, MM = BATCH * MEM_LEN;
constexpr int DIN = 4128, DFF = 8192;
constexpr int O_AQ = 0, O_AK = 1024, O_AV = 1280, O_BQ = 1536, O_BK = 1792, O_BV = 2048, O_BG = 2560, O_ZF = 3072, O_ZB = 3088, O_CX = 3104, O_CY = 3616;
constexpr int NPB = 4096;
constexpr int PB_CX = 3072, PB_CY = 3584;
constexpr float EPS = 1e-6f;
constexpr int NWAVES = 8, NTHREADS = 512;

#ifndef PROBE_REP
#define PROBE_REP 0
#endif
#ifndef NWL
#define NWL 4
#endif
constexpr size_t MiB = 1u << 20;
constexpr size_t WS_CTL = 0, CTL_ZERO_BYTES = 1 * MiB;
constexpr size_t WS_W = 1 * MiB, WL_BYTES = 121 * MiB;
constexpr size_t WL_IN = 0, WL_OUT = 16 * MiB, WL_XQ = 24 * MiB, WL_XK = 32 * MiB, WL_XV = 40 * MiB, WL_XO = 48 * MiB, WL_UP = 56 * MiB, WL_DOWN = 88 * MiB, WL_Z = 120 * MiB, WL_LRUG = 120 * MiB + 256 * 1024;
constexpr size_t WS_XN = WS_W + NWL * WL_BYTES;
constexpr size_t WS_MEMN = WS_XN + 32 * MiB;
constexpr size_t WS_KX = WS_MEMN + 16 * MiB;
constexpr size_t WS_VT = WS_KX + 16 * MiB;
constexpr size_t WS_Y = WS_VT + 16 * MiB;
constexpr size_t WS_Z = WS_Y + 64 * MiB;
constexpr size_t WS_BIG = WS_Z + 1 * MiB;
constexpr size_t WS_PB = WS_BIG;
constexpr size_t WS_MIX = WS_BIG + 64 * MiB;
constexpr size_t WS_GLAU = WS_BIG + 96 * MiB;
constexpr size_t WS_MISC = WS_BIG + 128 * MiB;
constexpr size_t WS_H = WS_BIG;
constexpr size_t WS_Q = WS_BIG, WS_O = WS_BIG + 32 * MiB;
constexpr size_t WS_LRU = WS_BIG + 136 * MiB;
constexpr size_t WS_END = WS_LRU + 24 * MiB;
constexpr int CW_TMO = 0, CW_BAR = 4096;

constexpr int RING_OFF = 0, RING_BYTES = 131072, SCR_BYTES = 143360;
constexpr int LDSCTL_OFF = SCR_BYTES, MISC_OFF = LDSCTL_OFF + 320;
constexpr int LDS_BYTES = 147456;

#define GAS __attribute__((address_space(1)))
#define LAS __attribute__((address_space(3)))
typedef unsigned short bf16;
typedef unsigned v4u __attribute__((ext_vector_type(4)));
typedef unsigned v2u __attribute__((ext_vector_type(2)));
typedef float f32x4 __attribute__((ext_vector_type(4)));
typedef short bf16x8 __attribute__((ext_vector_type(8)));
typedef short s16x4 __attribute__((ext_vector_type(4)));
#define LDS_WAIT() asm volatile("s_waitcnt lgkmcnt(0)" ::: "memory")
#define VM_WAIT() asm volatile("s_waitcnt vmcnt(0)" ::: "memory")
__device__ __forceinline__ unsigned f2bf(float f) { unsigned u = __builtin_bit_cast(unsigned, f); return (u + 0x7fffu + ((u >> 16) & 1u)) >> 16; }
__device__ __forceinline__ unsigned pk2(float lo, float hi) { return f2bf(lo) | (f2bf(hi) << 16); }
__device__ __forceinline__ float bf2f(unsigned short b) { return __builtin_bit_cast(float, (unsigned)b << 16); }
__device__ __forceinline__ float wave_sum(float v, int lane) {
#pragma unroll
    for (int o = 1; o < 64; o <<= 1) v += lane_xor_f(v, o, lane);
    return v;
}
__device__ __forceinline__ float wave_max(float v, int lane) {
#pragma unroll
    for (int o = 1; o < 64; o <<= 1) v = fmaxf(v, lane_xor_f(v, o, lane));
    return v;
}
__device__ __forceinline__ float sigmoidf_(float x) { return __builtin_amdgcn_rcpf(1.f + __builtin_amdgcn_exp2f(-1.4426950408889634f * x)); }
__device__ __forceinline__ float softplusf_(float x) { return fmaxf(x, 0.f) + 0.6931471805599453f * __builtin_amdgcn_logf(1.f + __builtin_amdgcn_exp2f(-1.4426950408889634f * fabsf(x))); }
__device__ __forceinline__ float gelu_tanh(float x) { return x * sigmoidf_(1.5957691216057308f * (x + 0.044715f * x * x * x)); }
__device__ __forceinline__ int t5_bucket(int rel) {
    const int ret = rel > 0 ? 16 : 0; const int n = rel < 0 ? -rel : rel;
    if (n < 8) return ret + n;
    int k = 0; while (k < 7 && (64 << (k + 1)) <= n * n) ++k;
    return ret + 8 + k;
}

struct Frame {
    LAS unsigned char* lds;
    int tid, lane, wave, G, bx;
};

__device__ __forceinline__ void p0_transpose_item(const float* W, int K, int N, int c0, bf16* WT, int r0, int nblk, const float* gk, LAS float* scr, int item, int lane) {
    const int kb = item / nblk, nb = item % nblk, k0 = 64 * kb, n0 = 32 * nb;
    const int c = lane & 7;
    f32x4 g0 = {1.f, 1.f, 1.f, 1.f}, g1 = {1.f, 1.f, 1.f, 1.f};
    if (gk) { g0 = *(const GAS f32x4*)(gk + k0 + 8 * c); g1 = *(const GAS f32x4*)(gk + k0 + 8 * c + 4); }
    f32x4 wv[8];
#pragma unroll
    for (int i = 0; i < 8; ++i) wv[i] = *(const GAS f32x4*)(W + (size_t)(k0 + 8 * i + (lane >> 3)) * N + c0 + n0 + 4 * (lane & 7));
#pragma unroll
    for (int i = 0; i < 8; ++i) { LAS float* d = scr + (8 * i + (lane >> 3)) * 33 + 4 * (lane & 7); d[0] = wv[i].x; d[1] = wv[i].y; d[2] = wv[i].z; d[3] = wv[i].w; }
    LDS_WAIT(); asm volatile("" ::: "memory");
#pragma unroll
    for (int j = 0; j < 4; ++j) { const int n = (lane >> 3) + 8 * j; const LAS float* s = scr + (8 * c) * 33 + n;
        v4u o; o.x = pk2(s[0 * 33] * g0.x, s[1 * 33] * g0.y); o.y = pk2(s[2 * 33] * g0.z, s[3 * 33] * g0.w); o.z = pk2(s[4 * 33] * g1.x, s[5 * 33] * g1.y); o.w = pk2(s[6 * 33] * g1.z, s[7 * 33] * g1.w);
        *(GAS v4u*)(WT + (size_t)(r0 + n0 + n) * K + k0 + 8 * c) = o; }
    LDS_WAIT(); asm volatile("" ::: "memory");
}
struct ConvSeg { const float* W; int K, N, c0, ncols; bf16* WT; int r0; const float* gain; };
__device__ __forceinline__ int seg_items(const ConvSeg& s) { return (s.K / 64) * (s.ncols / 32); }

__device__ __forceinline__ void norm_row(int lane, const float* src, const float* g, bf16* xn, float* copy_dst) {
    const GAS f32x4* xr = (const GAS f32x4*)src + lane; const GAS f32x4* gr = (const GAS f32x4*)g + lane;
    f32x4 v[8]; float s = 0.f;
#pragma unroll
    for (int j = 0; j < 8; ++j) { v[j] = xr[64 * j]; s += (v[j].x * v[j].x + v[j].y * v[j].y) + (v[j].z * v[j].z + v[j].w * v[j].w); }
    const float r = rsqrtf(wave_sum(s, lane) * (1.f / D) + EPS);
    GAS v2u* o8 = (GAS v2u*)xn + lane;
#pragma unroll
    for (int j = 0; j < 8; ++j) { const f32x4 gg = gr[64 * j]; v2u w; w.x = pk2(v[j].x * r * gg.x, v[j].y * r * gg.y); w.y = pk2(v[j].z * r * gg.z, v[j].w * r * gg.w); o8[64 * j] = w;
        if (copy_dst) ((GAS f32x4*)copy_dst + lane)[64 * j] = v[j]; }
}
__device__ __forceinline__ void init_row(int lane, const float* x, bf16* xb, float* rs) {
    const GAS f32x4* xr = (const GAS f32x4*)x; GAS v4u* ob = (GAS v4u*)xb;
    float s = 0.f;
#pragma unroll
    for (int j = 0; j < 4; ++j) { const int ch = lane + 64 * j; const f32x4 a = xr[2 * ch], b = xr[2 * ch + 1];
        s += (a.x * a.x + a.y * a.y) + (a.z * a.z + a.w * a.w) + (b.x * b.x + b.y * b.y) + (b.z * b.z + b.w * b.w);
        v4u w; w.x = pk2(a.x, a.y); w.y = pk2(a.z, a.w); w.z = pk2(b.x, b.y); w.w = pk2(b.z, b.w); ob[ch] = w; }
    s = wave_sum(s, lane);
    if (lane == 0) *rs = rsqrtf(s * (1.f / D) + EPS);
}
__device__ __forceinline__ void resid_row(int lane, bf16* xb, const bf16* y, const float* g1, float* rs, float* outf) {
    GAS v4u* xr = (GAS v4u*)xb; const GAS v4u* yr = (const GAS v4u*)y; const GAS f32x4* gr = (const GAS f32x4*)g1;
    v4u xv[4], yv[4]; float s = 0.f;
#pragma unroll
    for (int j = 0; j < 4; ++j) { const int ch = lane + 64 * j; xv[j] = xr[ch]; yv[j] = yr[ch]; }
#pragma unroll
    for (int j = 0; j < 4; ++j) { const unsigned yy[4] = {yv[j].x, yv[j].y, yv[j].z, yv[j].w};
#pragma unroll
        for (int e = 0; e < 4; ++e) { const float a = bf2f((unsigned short)(yy[e] & 0xffffu)), b = bf2f((unsigned short)(yy[e] >> 16)); s += a * a + b * b; } }
    const float r = rsqrtf(wave_sum(s, lane) * (1.f / D) + EPS);
    float s2 = 0.f;
#pragma unroll
    for (int j = 0; j < 4; ++j) { const int ch = lane + 64 * j; const f32x4 ga = gr[2 * ch], gb = gr[2 * ch + 1];
        const float gg[8] = {ga.x, ga.y, ga.z, ga.w, gb.x, gb.y, gb.z, gb.w};
        const unsigned yy[4] = {yv[j].x, yv[j].y, yv[j].z, yv[j].w}, xx[4] = {xv[j].x, xv[j].y, xv[j].z, xv[j].w};
        float xn[8];
#pragma unroll
        for (int e = 0; e < 4; ++e) {
            xn[2 * e] = bf2f((unsigned short)(xx[e] & 0xffffu)) + bf2f((unsigned short)(yy[e] & 0xffffu)) * r * gg[2 * e];
            xn[2 * e + 1] = bf2f((unsigned short)(xx[e] >> 16)) + bf2f((unsigned short)(yy[e] >> 16)) * r * gg[2 * e + 1];
            s2 += xn[2 * e] * xn[2 * e] + xn[2 * e + 1] * xn[2 * e + 1]; }
        v4u w; w.x = pk2(xn[0], xn[1]); w.y = pk2(xn[2], xn[3]); w.z = pk2(xn[4], xn[5]); w.w = pk2(xn[6], xn[7]); xr[ch] = w;
        if (outf) { GAS f32x4* of = (GAS f32x4*)outf; of[2 * ch] = (f32x4){xn[0], xn[1], xn[2], xn[3]}; of[2 * ch + 1] = (f32x4){xn[4], xn[5], xn[6], xn[7]}; } }
    s2 = wave_sum(s2, lane);
    if (lane == 0) *rs = rsqrtf(s2 * (1.f / D) + EPS);
}
template <int NR>
__device__ __forceinline__ void resid_rows(int lane, bf16* xb0, const bf16* y0, size_t stride_el, const float* g1, float* rs0, size_t rs_stride, float* outf0) {
    v4u xv[NR][4], yv[NR][4];
#pragma unroll
    for (int i = 0; i < NR; ++i)
#pragma unroll
        for (int j = 0; j < 4; ++j) { const int ch = lane + 64 * j; xv[i][j] = ((const GAS v4u*)(xb0 + i * stride_el))[ch]; yv[i][j] = ((const GAS v4u*)(y0 + i * stride_el))[ch]; }
    f32x4 ga[4], gb[4];
#pragma unroll
    for (int j = 0; j < 4; ++j) { const int ch = lane + 64 * j; ga[j] = ((const GAS f32x4*)g1)[2 * ch]; gb[j] = ((const GAS f32x4*)g1)[2 * ch + 1]; }
#pragma unroll
    for (int i = 0; i < NR; ++i) {
        float s = 0.f;
#pragma unroll
        for (int j = 0; j < 4; ++j) { const unsigned yy[4] = {yv[i][j].x, yv[i][j].y, yv[i][j].z, yv[i][j].w};
#pragma unroll
            for (int e = 0; e < 4; ++e) { const float a = bf2f((unsigned short)(yy[e] & 0xffffu)), b = bf2f((unsigned short)(yy[e] >> 16)); s += a * a + b * b; } }
        const float r = rsqrtf(wave_sum(s, lane) * (1.f / D) + EPS);
        float s2 = 0.f;
        GAS v4u* xr = (GAS v4u*)(xb0 + i * stride_el);
#pragma unroll
        for (int j = 0; j < 4; ++j) { const int ch = lane + 64 * j;
            const float gg[8] = {ga[j].x, ga[j].y, ga[j].z, ga[j].w, gb[j].x, gb[j].y, gb[j].z, gb[j].w};
            const unsigned yy[4] = {yv[i][j].x, yv[i][j].y, yv[i][j].z, yv[i][j].w}, xx[4] = {xv[i][j].x, xv[i][j].y, xv[i][j].z, xv[i][j].w};
            float xn[8];
#pragma unroll
            for (int e = 0; e < 4; ++e) {
                xn[2 * e] = bf2f((unsigned short)(xx[e] & 0xffffu)) + bf2f((unsigned short)(yy[e] & 0xffffu)) * r * gg[2 * e];
                xn[2 * e + 1] = bf2f((unsigned short)(xx[e] >> 16)) + bf2f((unsigned short)(yy[e] >> 16)) * r * gg[2 * e + 1];
                s2 += xn[2 * e] * xn[2 * e] + xn[2 * e + 1] * xn[2 * e + 1]; }
            v4u w; w.x = pk2(xn[0], xn[1]); w.y = pk2(xn[2], xn[3]); w.z = pk2(xn[4], xn[5]); w.w = pk2(xn[6], xn[7]); xr[ch] = w;
            if (outf0) { GAS f32x4* of = (GAS f32x4*)(outf0 + i * stride_el); of[2 * ch] = (f32x4){xn[0], xn[1], xn[2], xn[3]}; of[2 * ch + 1] = (f32x4){xn[4], xn[5], xn[6], xn[7]}; } }
        s2 = wave_sum(s2, lane);
        if (lane == 0) rs0[i * rs_stride] = rsqrtf(s2 * (1.f / D) + EPS);
    }
}
__device__ __forceinline__ void zgemm(const Frame& F, const bf16* XN, const bf16* WZ, const float* RS, float* Z) {
    const int lane = F.lane, g = lane >> 4, c = lane & 15, w = F.wave, kq = w & 3;
    LAS f32x4* red = (LAS f32x4*)F.lds;
    for (int rb = F.bx; rb < M / 32; rb += F.G) {
        const int rt = rb * 2 + (w >> 2);
        const bf16* ap = XN + (size_t)(rt * 16 + c) * D + kq * 512 + g * 8;
        const bf16* b0 = WZ + (size_t)c * D + kq * 512 + g * 8; const bf16* b1p = WZ + (size_t)(16 + c) * D + kq * 512 + g * 8;
        f32x4 acc0 = {0.f, 0.f, 0.f, 0.f}, acc1 = {0.f, 0.f, 0.f, 0.f};
#pragma unroll 8
        for (int ks = 0; ks < 16; ++ks) { const bf16x8 a = *(const GAS bf16x8*)(ap + ks * 32), x = *(const GAS bf16x8*)(b0 + ks * 32), y = *(const GAS bf16x8*)(b1p + ks * 32);
            acc0 = __builtin_amdgcn_mfma_f32_16x16x32_bf16(a, x, acc0, 0, 0, 0); acc1 = __builtin_amdgcn_mfma_f32_16x16x32_bf16(a, y, acc1, 0, 0, 0); }
        __syncthreads();
        red[(w * 2 + 0) * 64 + lane] = acc0; red[(w * 2 + 1) * 64 + lane] = acc1;
        __syncthreads();
        if (kq == 0) {
#pragma unroll
            for (int ct = 0; ct < 2; ++ct) { f32x4 s = red[(w * 2 + ct) * 64 + lane];
#pragma unroll
                for (int q = 1; q < 4; ++q) s += red[((w + q) * 2 + ct) * 64 + lane];
#pragma unroll
                for (int r = 0; r < 4; ++r) { const int m = rt * 16 + 4 * g + r; Z[(size_t)m * 32 + ct * 16 + c] = s[r] * RS[m]; } }
        }
    }
}

#define XB_TMO      128
#define XB_XCNT(j)  (256  + 64 * (j))
#define XB_XSUB(j)  (1280 + 64 * (j))
#define XB_XGEN(j)  (2304 + 64 * (j))
#define XB_TOP      3328
#define XB_TOPGEN   3392
#define XCD_BAR_WORDS 3456
#define XB_SPIN_CAP (1u << 18)
#define LAS __attribute__((address_space(3)))

__device__ __forceinline__ unsigned xb_ld(unsigned* p)              { return __hip_atomic_load(p, __ATOMIC_RELAXED, __HIP_MEMORY_SCOPE_AGENT); }
__device__ __forceinline__ unsigned xb_add(unsigned* p, unsigned v) { return __hip_atomic_fetch_add(p, v, __ATOMIC_RELAXED, __HIP_MEMORY_SCOPE_AGENT); }
__device__ __forceinline__ unsigned xb_xcc_id() { return (unsigned)__builtin_amdgcn_s_getreg((3 << 11) | 20) & 0xFu; }
#define XB_SPIN(cond, bar) do { unsigned _sp = 0; while (cond) { __builtin_amdgcn_s_sleep(1); \
    if ((++_sp & 255u) == 0u) { if (xb_ld(&(bar)[XB_TMO])) break; if (_sp > XB_SPIN_CAP) { atomicAdd(&(bar)[XB_TMO], 1u); break; } } } } while (0)

struct XcdBarrier {
    unsigned* bar; unsigned x;
    volatile LAS unsigned* st;
};

__device__ __forceinline__ XcdBarrier xcd_barrier_post(unsigned* bar, volatile LAS unsigned* st) {
    XcdBarrier b; b.bar = bar; b.x = xb_xcc_id(); b.st = st;
    if (threadIdx.x == 0) (void)xb_add(&bar[XB_XCNT(b.x)], 1u);
    return b;
}
__device__ __forceinline__ void xcd_barrier_complete(unsigned* bar, unsigned x, unsigned& nloc, unsigned& nx) {
    const unsigned G = gridDim.x * gridDim.y * gridDim.z;
    unsigned sum, cnt, mine, sp = 0u;
    for (;;) {
        sum = 0u; cnt = 0u; mine = 0u;
#pragma unroll
        for (unsigned j = 0; j < 16; ++j) { const unsigned c = xb_ld(&bar[XB_XCNT(j)]); sum += c; cnt += (c > 0u) ? 1u : 0u; mine = (j == x) ? c : mine; }
        if (sum == G) break;
        __builtin_amdgcn_s_sleep(1);
        if ((++sp & 255u) == 0u) { if (xb_ld(&bar[XB_TMO])) break; if (sp > XB_SPIN_CAP) { atomicAdd(&bar[XB_TMO], 1u); break; } }
    }
    nloc = mine > 0u ? mine : 1u; nx = cnt > 0u ? cnt : 1u;
}

__device__ __forceinline__ void xcd_barrier(const XcdBarrier& b) {
    asm volatile("s_waitcnt vmcnt(0)" ::: "memory");
    __syncthreads();
    if (threadIdx.x == 0) {
        unsigned* bar = b.bar;
        __builtin_amdgcn_s_waitcnt(0);
        unsigned nloc = b.st[0], nx = b.st[1];
        if (nloc == 0u) { xcd_barrier_complete(bar, b.x, nloc, nx); b.st[0] = nloc; b.st[1] = nx; }
        const unsigned old = xb_add(&bar[XB_XSUB(b.x)], 1u);
        const unsigned gen = old / nloc;
        if (old + 1u == (gen + 1u) * nloc) {
            __builtin_amdgcn_fence(__ATOMIC_RELEASE, "agent");
            asm volatile("s_waitcnt vmcnt(0)" ::: "memory");
            const unsigned og = xb_add(&bar[XB_TOP], 1u);
            const unsigned tg = og / nx;
            if (og + 1u == (tg + 1u) * nx) xb_add(&bar[XB_TOPGEN], 1u);
            else XB_SPIN(xb_ld(&bar[XB_TOPGEN]) == tg, bar);
            __builtin_amdgcn_fence(__ATOMIC_ACQUIRE, "agent");
            xb_add(&bar[XB_XGEN(b.x)], 1u);
            asm volatile("s_waitcnt vmcnt(0)" ::: "memory");
        } else {
            XB_SPIN(xb_ld(&bar[XB_XGEN(b.x)]) == gen, bar);
            __builtin_amdgcn_fence(__ATOMIC_ACQUIRE, "agent");
            asm volatile("s_waitcnt vmcnt(0)" ::: "memory");
        }
    }
    __syncthreads();
}
constexpr size_t MISC_DEC = 3 * MiB;
constexpr int GL_Z = 0, GL_TF = 8192, GL_TB = 10240, GL_VI = 12288, GL_A = 30720, GL_B = 39936, GL_P = 49152, GL_SI = 58368, GL_OF = 76800, GL_VS = 288;
__device__ __forceinline__ bf16x8 tr_frag(LAS unsigned char* p, int stride4) {
    const s16x4 lo = __builtin_amdgcn_ds_read_tr16_b64_v4i16((LAS s16x4*)p);
    const s16x4 hi = __builtin_amdgcn_ds_read_tr16_b64_v4i16((LAS s16x4*)(p + stride4));
    return __builtin_shufflevector(lo, hi, 0, 1, 2, 3, 4, 5, 6, 7);
}
struct GlaW { float wf[16], wb[16], bfv, bbv; };
__device__ __forceinline__ void gla_load_w(GlaW& W, int k, int h, const float* __restrict__ w2f, const float* __restrict__ b2f, const float* __restrict__ w2b, const float* __restrict__ b2b) {
#pragma unroll
    for (int r = 0; r < 16; ++r) { W.wf[r] = w2f[r * 256 + h * 64 + k]; W.wb[r] = w2b[r * 256 + h * 64 + k]; }
    W.bfv = b2f[h * 64 + k]; W.bbv = b2b[h * 64 + k];
}
__device__ __forceinline__ void gla_gates(const Frame& F, const f32x4 zreg, const GlaW& W, float (&cf)[8], float (&cb)[8], float& totf, float& totb) {
    LAS float* ZS = (LAS float*)(F.lds + GL_Z); LAS float* TF = (LAS float*)(F.lds + GL_TF); LAS float* TB = (LAS float*)(F.lds + GL_TB);
    const int tid = F.tid, k = tid & 63, tg = F.wave;
    ((LAS f32x4*)ZS)[tid] = zreg;
    __syncthreads();
#pragma unroll
    for (int i = 0; i < 8; ++i) { const int t = tg * 8 + i; float af = W.bfv, ab = W.bbv;
#pragma unroll
        for (int r = 0; r < 16; ++r) { af += ZS[t * 32 + r] * W.wf[r]; ab += ZS[t * 32 + 16 + r] * W.wb[r]; }
        cf[i] = -softplusf_(-af) * 0.0625f; cb[i] = -softplusf_(-ab) * 0.0625f; }
#pragma unroll
    for (int i = 1; i < 8; ++i) cf[i] += cf[i - 1];
#pragma unroll
    for (int i = 6; i >= 0; --i) cb[i] += cb[i + 1];
    TF[tg * 64 + k] = cf[7]; TB[tg * 64 + k] = cb[0];
    __syncthreads();
    float ef = 0.f, eb = 0.f; totf = 0.f; totb = 0.f;
#pragma unroll
    for (int g2 = 0; g2 < 8; ++g2) { const float a = TF[g2 * 64 + k], bq = TB[g2 * 64 + k]; totf += a; totb += bq; ef += (g2 < tg) ? a : 0.f; eb += (g2 > tg) ? bq : 0.f; }
#pragma unroll
    for (int i = 0; i < 8; ++i) { cf[i] += ef; cb[i] += eb; }
}
__device__ __forceinline__ void gla_load_v(const Frame& F, const bf16* __restrict__ PB, size_t m0, int h, v4u (&vr)[2]) {
#pragma unroll
    for (int i = 0; i < 2; ++i) { const int ch = F.tid + NTHREADS * i, row = ch >> 4, col = ch & 15; vr[i] = *(const GAS v4u*)(PB + (m0 + row) * NPB + O_BV + h * 128 + col * 8); }
}
__device__ __forceinline__ void gla_store_v(const Frame& F, const v4u (&vr)[2]) {
    LAS unsigned char* VI = F.lds + GL_VI;
#pragma unroll
    for (int i = 0; i < 2; ++i) { const int ch = F.tid + NTHREADS * i, row = ch >> 4, col = ch & 15; *(LAS v4u*)(VI + row * GL_VS + col * 16) = vr[i]; }
}
__device__ __forceinline__ void gla_u_phase(const Frame& F, const bf16* __restrict__ PB, const float* __restrict__ Z, const float* __restrict__ w2f, const float* __restrict__ b2f,
                                            const float* __restrict__ w2b, const float* __restrict__ b2b, float* __restrict__ U, float* __restrict__ DEC) {
    const int tid = F.tid, lane = F.lane, g = lane >> 4, c = lane & 15, w = F.wave, k = tid & 63, tg = F.wave;
    LAS unsigned char* VI = F.lds + GL_VI;
    GlaW W; int h_loaded = -1;
    for (int unit = F.bx; unit < BATCH * 4 * 32; unit += F.G) {
        const int b = unit >> 7, h = (unit >> 5) & 3, n = unit & 31;
        const size_t m0 = (size_t)b * SEQ + n * 64;
        if (h != h_loaded) { gla_load_w(W, k, h, w2f, b2f, w2b, b2b); h_loaded = h; }
        const f32x4 zreg = ((const GAS f32x4*)(Z + m0 * 32))[tid];
        unsigned short kraw[8];
#pragma unroll
        for (int i = 0; i < 8; ++i) kraw[i] = PB[(m0 + tg * 8 + i) * NPB + O_BK + h * 64 + k];
        v4u vr[2]; gla_load_v(F, PB, m0, h, vr);
        __syncthreads();
        float cf[8], cb[8], totf, totb;
        gla_gates(F, zreg, W, cf, cb, totf, totb);
#pragma unroll
        for (int i = 0; i < 8; ++i) { const int t = tg * 8 + i; const float kk = bf2f(kraw[i]);
            *(LAS unsigned short*)(F.lds + GL_A + t * 144 + k * 2) = (unsigned short)f2bf(kk * __expf(totf - cf[i]));
            *(LAS unsigned short*)(F.lds + GL_B + t * 144 + k * 2) = (unsigned short)f2bf(kk * __expf(totb - cb[i])); }
        const size_t ub = (size_t)(b * 4 + h) * 32 + n;
        if (tg == 0) { DEC[ub * 64 + k] = __expf(totf); DEC[(ub + 512) * 64 + k] = __expf(totb); }
        gla_store_v(F, vr);
        __syncthreads();
        bf16x8 vf[2];
#pragma unroll
        for (int ts = 0; ts < 2; ++ts) vf[ts] = tr_frag(VI + (32 * ts + 8 * g + (c >> 2)) * GL_VS + (16 * w + 4 * (c & 3)) * 2, 4 * GL_VS);
#pragma unroll
        for (int d = 0; d < 2; ++d) {
            LAS unsigned char* KS = F.lds + (d ? GL_B : GL_A);
            float* Ud = U + (ub + (size_t)d * 512) * 8192;
#pragma unroll
            for (int kt = 0; kt < 4; ++kt) {
                f32x4 acc = {0.f, 0.f, 0.f, 0.f};
#pragma unroll
                for (int ts = 0; ts < 2; ++ts) { const bf16x8 af = tr_frag(KS + (32 * ts + 8 * g + (c >> 2)) * 144 + (16 * kt + 4 * (c & 3)) * 2, 4 * 144);
                    acc = __builtin_amdgcn_mfma_f32_16x16x32_bf16(vf[ts], af, acc, 0, 0, 0); }
                *(GAS f32x4*)(Ud + (16 * kt + c) * 128 + 16 * w + 4 * g) = acc;
            }
        }
    }
}
__device__ __forceinline__ void gla_state_phase(const Frame& F, float* __restrict__ U, const float* __restrict__ DEC) {
    typedef float f32x2 __attribute__((ext_vector_type(2)));
    for (int id = F.bx * NTHREADS + F.tid; id < 32 * 64 * 64; id += F.G * NTHREADS) {
        const int seq = id >> 12, k = (id >> 6) & 63, e2 = id & 63, d = seq >> 4, bh = seq & 15;
        GAS f32x2* p0 = (GAS f32x2*)(U + ((size_t)d * 512 + bh * 32) * 8192 + k * 128) + e2;
        const float* d0 = DEC + ((size_t)d * 512 + bh * 32) * 64 + k;
        f32x2 u[32]; float dc[32];
#pragma unroll
        for (int n = 0; n < 32; ++n) { u[n] = p0[(size_t)n * 4096]; dc[n] = d0[n * 64]; }
        f32x2 S = {0.f, 0.f};
        if (d == 0) {
#pragma unroll
            for (int n = 0; n < 32; ++n) { const f32x2 t = u[n]; u[n] = S; S = S * dc[n] + t; }
        } else {
#pragma unroll
            for (int n = 31; n >= 0; --n) { const f32x2 t = u[n]; u[n] = S; S = S * dc[n] + t; }
        }
#pragma unroll
        for (int n = 0; n < 32; ++n) p0[(size_t)n * 4096] = u[n];
    }
}
__device__ __forceinline__ void gla_o_phase(const Frame& F, const bf16* __restrict__ PB, const float* __restrict__ Z, const float* __restrict__ w2f, const float* __restrict__ b2f,
                                            const float* __restrict__ w2b, const float* __restrict__ b2b, const float* __restrict__ U, const float* __restrict__ gn, bf16* __restrict__ MIX) {
    const int tid = F.tid, lane = F.lane, g = lane >> 4, c = lane & 15, w = F.wave, k = tid & 63, tg = F.wave;
    LAS unsigned char* VI = F.lds + GL_VI; LAS unsigned char* QI = F.lds + GL_A; LAS unsigned char* KI = F.lds + GL_B; LAS unsigned char* PI = F.lds + GL_P; LAS unsigned char* SI = F.lds + GL_SI;
    LAS float* OF = (LAS float*)(F.lds + GL_OF);
    GlaW W; int h_loaded = -1;
    for (int unit = F.bx; unit < BATCH * 4 * 32; unit += F.G) {
        const int b = unit >> 7, h = (unit >> 5) & 3, n = unit & 31;
        const size_t m0 = (size_t)b * SEQ + n * 64;
        const size_t ub = (size_t)(b * 4 + h) * 32 + n;
        if (h != h_loaded) { gla_load_w(W, k, h, w2f, b2f, w2b, b2b); h_loaded = h; }
        const f32x4 zreg = ((const GAS f32x4*)(Z + m0 * 32))[tid];
        unsigned short qraw[8], kraw[8];
#pragma unroll
        for (int i = 0; i < 8; ++i) { qraw[i] = PB[(m0 + tg * 8 + i) * NPB + O_BQ + h * 64 + k]; kraw[i] = PB[(m0 + tg * 8 + i) * NPB + O_BK + h * 64 + k]; }
        v4u vr[2]; gla_load_v(F, PB, m0, h, vr);
        f32x4 sreg[2][4];
#pragma unroll
        for (int d = 0; d < 2; ++d) { const GAS f32x4* sp = (const GAS f32x4*)(U + (ub + (size_t)d * 512) * 8192 + (tid >> 3) * 128 + (tid & 7) * 16);
#pragma unroll
            for (int q4 = 0; q4 < 4; ++q4) sreg[d][q4] = sp[q4]; }
        const v4u g0 = *(const GAS v4u*)(PB + (m0 + (tid >> 3)) * NPB + O_BG + h * 128 + (tid & 7) * 16), g1 = *(const GAS v4u*)(PB + (m0 + (tid >> 3)) * NPB + O_BG + h * 128 + (tid & 7) * 16 + 8);
        __syncthreads();
        float cf[8], cb[8], totf, totb;
        gla_gates(F, zreg, W, cf, cb, totf, totb);
        float qv[8], kv[8];
#pragma unroll
        for (int i = 0; i < 8; ++i) { qv[i] = bf2f(qraw[i]) * 0.125f; kv[i] = bf2f(kraw[i]); }
        gla_store_v(F, vr);
        f32x4 acc[4];
#pragma unroll
        for (int tt = 0; tt < 4; ++tt) acc[tt] = (f32x4){0.f, 0.f, 0.f, 0.f};
#pragma unroll
        for (int d = 0; d < 2; ++d) {
            __syncthreads();
#pragma unroll
            for (int i = 0; i < 8; ++i) { const int t = tg * 8 + i; const float cc = d ? cb[i] : cf[i];
                *(LAS unsigned short*)(QI + t * 144 + k * 2) = (unsigned short)f2bf(qv[i] * __expf(cc));
                *(LAS unsigned short*)(KI + t * 144 + k * 2) = (unsigned short)f2bf(kv[i] * __expf(-cc)); }
            {   const int row = tid >> 3, c16 = (tid & 7) * 16;
                const f32x4 s0 = sreg[d][0], s1 = sreg[d][1], s2 = sreg[d][2], s3 = sreg[d][3];
                v4u o0, o1; o0.x = pk2(s0.x, s0.y); o0.y = pk2(s0.z, s0.w); o0.z = pk2(s1.x, s1.y); o0.w = pk2(s1.z, s1.w); o1.x = pk2(s2.x, s2.y); o1.y = pk2(s2.z, s2.w); o1.z = pk2(s3.x, s3.y); o1.w = pk2(s3.z, s3.w);
                *(LAS v4u*)(SI + row * GL_VS + c16 * 2) = o0; *(LAS v4u*)(SI + row * GL_VS + c16 * 2 + 16) = o1; }
            __syncthreads();
#pragma unroll
            for (int q2 = 0; q2 < 2; ++q2) {
                const int id = 2 * w + q2, tt = id >> 2, jt = id & 3;
                f32x4 p = {0.f, 0.f, 0.f, 0.f};
#pragma unroll
                for (int ks = 0; ks < 2; ++ks) { const bf16x8 a = *(const LAS bf16x8*)(QI + (16 * tt + c) * 144 + ks * 64 + g * 16), bb = *(const LAS bf16x8*)(KI + (16 * jt + c) * 144 + ks * 64 + g * 16);
                    p = __builtin_amdgcn_mfma_f32_16x16x32_bf16(a, bb, p, 0, 0, 0); }
#pragma unroll
                for (int r = 0; r < 4; ++r) { const int t = 16 * tt + 4 * g + r, j = 16 * jt + c; const bool keep = d ? (j > t) : (j <= t);
                    *(LAS unsigned short*)(PI + t * 144 + j * 2) = (unsigned short)f2bf(keep ? p[r] : 0.f); }
            }
            __syncthreads();
            bf16x8 vf[2], sf[2];
#pragma unroll
            for (int s2 = 0; s2 < 2; ++s2) { vf[s2] = tr_frag(VI + (32 * s2 + 8 * g + (c >> 2)) * GL_VS + (16 * w + 4 * (c & 3)) * 2, 4 * GL_VS);
                sf[s2] = tr_frag(SI + (32 * s2 + 8 * g + (c >> 2)) * GL_VS + (16 * w + 4 * (c & 3)) * 2, 4 * GL_VS); }
#pragma unroll
            for (int tt = 0; tt < 4; ++tt)
#pragma unroll
                for (int s2 = 0; s2 < 2; ++s2) { const bf16x8 pa = *(const LAS bf16x8*)(PI + (16 * tt + c) * 144 + s2 * 64 + g * 16), qa = *(const LAS bf16x8*)(QI + (16 * tt + c) * 144 + s2 * 64 + g * 16);
                    acc[tt] = __builtin_amdgcn_mfma_f32_16x16x32_bf16(pa, vf[s2], acc[tt], 0, 0, 0);
                    acc[tt] = __builtin_amdgcn_mfma_f32_16x16x32_bf16(qa, sf[s2], acc[tt], 0, 0, 0); }
        }
#pragma unroll
        for (int tt = 0; tt < 4; ++tt)
#pragma unroll
            for (int r = 0; r < 4; ++r) OF[(16 * tt + 4 * g + r) * 132 + 16 * w + c] = acc[tt][r];
        __syncthreads();
        {   const int t = tid >> 3, c16 = (tid & 7) * 16;
            float o[16]; float ss = 0.f;
#pragma unroll
            for (int e = 0; e < 16; ++e) { o[e] = OF[t * 132 + c16 + e]; ss += o[e] * o[e]; }
            ss += lane_xor_f(ss, 1, lane); ss += lane_xor_f(ss, 2, lane); ss += lane_xor_f(ss, 4, lane);
            const float rs = rsqrtf(ss * (1.f / 128.f) + EPS);
            const unsigned gg[8] = {g0.x, g0.y, g0.z, g0.w, g1.x, g1.y, g1.z, g1.w};
            unsigned oo[8];
#pragma unroll
            for (int e = 0; e < 8; ++e) { const float ga = bf2f((unsigned short)(gg[e] & 0xffffu)), gb = bf2f((unsigned short)(gg[e] >> 16));
                oo[e] = pk2(o[2 * e] * rs * gn[h * 128 + c16 + 2 * e] * (ga * sigmoidf_(ga)), o[2 * e + 1] * rs * gn[h * 128 + c16 + 2 * e + 1] * (gb * sigmoidf_(gb))); }
            v4u o0, o1; o0.x = oo[0]; o0.y = oo[1]; o0.z = oo[2]; o0.w = oo[3]; o1.x = oo[4]; o1.y = oo[5]; o1.z = oo[6]; o1.w = oo[7];
            *(GAS v4u*)(MIX + (m0 + t) * D + 1024 + h * 128 + c16) = o0; *(GAS v4u*)(MIX + (m0 + t) * D + 1024 + h * 128 + c16 + 8) = o1;
        }
    }
}
constexpr int LRU_LD = 132;
constexpr size_t MISC_CAR_A = 0, MISC_CAR_H = 1 * MiB, MISC_CIN = 2 * MiB, MISC_RS = 4 * MiB;
__device__ __forceinline__ void lru_phase(const Frame& F, const bf16* __restrict__ PB, const bf16* __restrict__ LRUG, const float* __restrict__ cw, const float* __restrict__ cb,
                                          const float* __restrict__ ba, const float* __restrict__ bx, const float* __restrict__ lam, float* __restrict__ CAR_A, float* __restrict__ CAR_H,
                                          bf16* __restrict__ LS, bf16* __restrict__ LPF, bf16* __restrict__ LPB) {
    LAS float* XF = (LAS float*)(F.lds);
    LAS float* AS = (LAS float*)(F.lds + 33792);
    LAS float* US = (LAS float*)(F.lds + 2 * 33792);
    LAS unsigned char* XB = F.lds + 3 * 33792;
    LAS unsigned short* PT = (LAS unsigned short*)(F.lds + 3 * 33792 + 17408);
    const int tid = F.tid, lane = F.lane, g4 = lane >> 4, c = lane & 15, w = F.wave;
    const bool g_const = (F.G & 3) == 0;
    int g_loaded = -1;
    bf16x8 waf[2][4], wxf[2][4]; float bav[2], bxv[2], spv[2], w0[4], w1[4], cb0 = 0.f, cb1 = 0.f;
    for (int unit = F.bx; unit < BATCH * 32 * 4; unit += F.G) {
        const int b = unit >> 7, n = (unit >> 2) & 31, g = unit & 3, t0 = n * 64;
        if (!g_const || g != g_loaded) {
            const int j = 16 * w + c, chj = g * 128 + j;
#pragma unroll
            for (int s = 0; s < 2; ++s) {
                const bf16* wap = LRUG + ((size_t)((s * 2 + 0) * 4 + g) * 128 + j) * 128 + g4 * 8;
                const bf16* wxp = LRUG + ((size_t)((s * 2 + 1) * 4 + g) * 128 + j) * 128 + g4 * 8;
#pragma unroll
                for (int ks = 0; ks < 4; ++ks) { waf[s][ks] = *(const GAS bf16x8*)(wap + ks * 32); wxf[s][ks] = *(const GAS bf16x8*)(wxp + ks * 32); }
                bav[s] = ba[s * 512 + chj]; bxv[s] = bx[s * 512 + chj]; spv[s] = softplusf_(-lam[s * 512 + chj]);
            }
            const int ch = g * 128 + 2 * (tid & 63);
#pragma unroll
            for (int jj = 0; jj < 4; ++jj) { w0[jj] = cw[jj * 512 + ch]; w1[jj] = cw[jj * 512 + ch + 1]; }
            cb0 = cb[ch]; cb1 = cb[ch + 1];
            g_loaded = g;
        }
        __syncthreads();
        {
            const int ch2 = tid & 63, tb = (tid >> 6) * 8, ch = g * 128 + 2 * ch2;
            const float b0 = cb0, b1 = cb1;
            float x0[11], x1[11];
#pragma unroll
            for (int i = 0; i < 11; ++i) { const int t = t0 + tb - 2 + i; unsigned v = 0u; if (t >= 0 && t < SEQ) v = *(const GAS unsigned*)(PB + (size_t)(b * SEQ + t) * NPB + PB_CX + ch);
                x0[i] = bf2f((unsigned short)(v & 0xffffu)); x1[i] = bf2f((unsigned short)(v >> 16)); }
#pragma unroll
            for (int r = 0; r < 8; ++r) { float y0 = b0, y1 = b1;
#pragma unroll
                for (int j = 0; j < 4; ++j) { y0 += x0[r + j] * w0[j]; y1 += x1[r + j] * w1[j]; }
                XF[(tb + r) * LRU_LD + 2 * ch2] = y0; XF[(tb + r) * LRU_LD + 2 * ch2 + 1] = y1;
                *(LAS unsigned*)(XB + (tb + r) * 272 + ch2 * 4) = pk2(y0, y1); }
        }
        __syncthreads();
#pragma unroll
        for (int s = 0; s < 2; ++s) {
            if (s == 1) {
                const int t = tid >> 3, c16 = (tid & 7) * 16; const size_t m = (size_t)b * SEQ + t0 + t;
                const v4u p0 = *(const LAS v4u*)(PT + t * 128 + c16), p1 = *(const LAS v4u*)(PT + t * 128 + c16 + 8);
                *(GAS v4u*)(LPF + m * 512 + g * 128 + c16) = p0; *(GAS v4u*)(LPF + m * 512 + g * 128 + c16 + 8) = p1; }
            {
                const int j = 16 * w + c;
                LAS float* U = s == 0 ? US : XF;
#pragma unroll
                for (int tt = 0; tt < 4; ++tt) {
                    f32x4 ga = {0.f, 0.f, 0.f, 0.f}, gx = {0.f, 0.f, 0.f, 0.f};
#pragma unroll
                    for (int ks = 0; ks < 4; ++ks) { const bf16x8 xf = *(const LAS bf16x8*)(XB + (16 * tt + c) * 272 + ks * 64 + g4 * 16);
                        ga = __builtin_amdgcn_mfma_f32_16x16x32_bf16(xf, waf[s][ks], ga, 0, 0, 0); gx = __builtin_amdgcn_mfma_f32_16x16x32_bf16(xf, wxf[s][ks], gx, 0, 0, 0); }
#pragma unroll
                    for (int r = 0; r < 4; ++r) { const int t = 16 * tt + 4 * g4 + r;
                        const float rg = sigmoidf_(ga[r] + bav[s]), ig = sigmoidf_(gx[r] + bxv[s]);
                        const float a = __builtin_amdgcn_exp2f(-8.f * 1.4426950408889634f * rg * spv[s]);
                        const float xv = XF[t * LRU_LD + j];
                        AS[t * LRU_LD + j] = a; U[t * LRU_LD + j] = __builtin_amdgcn_sqrtf(fmaxf(1.f - a * a, 0.f)) * (ig * xv); }
                }
            }
            __syncthreads();
            if (tid < 128) {
                LAS float* U = s == 0 ? US : XF;
                const size_t ci = ((size_t)((s * BATCH + b) * 32 + n)) * 512 + g * 128 + tid;
                float h = 0.f, ap = 1.f;
#pragma unroll 8
                for (int st = 0; st < 64; ++st) { const int t = s ? 63 - st : st; const float a = AS[t * LRU_LD + tid], u = U[t * LRU_LD + tid]; h = a * h + u; ap *= a;
                    PT[t * 128 + tid] = (unsigned short)f2bf(ap);
                    if (s == 0) US[t * LRU_LD + tid] = h; else US[t * LRU_LD + tid] += h; }
                CAR_A[ci] = ap; CAR_H[ci] = h;
            }
            __syncthreads();
        }
        {
            const int t = tid >> 3, c16 = (tid & 7) * 16;
            const size_t m = (size_t)b * SEQ + t0 + t;
            unsigned oo[8];
#pragma unroll
            for (int e = 0; e < 8; ++e) oo[e] = pk2(US[t * LRU_LD + c16 + 2 * e], US[t * LRU_LD + c16 + 2 * e + 1]);
            v4u o0, o1; o0.x = oo[0]; o0.y = oo[1]; o0.z = oo[2]; o0.w = oo[3]; o1.x = oo[4]; o1.y = oo[5]; o1.z = oo[6]; o1.w = oo[7];
            *(GAS v4u*)(LS + m * 512 + g * 128 + c16) = o0; *(GAS v4u*)(LS + m * 512 + g * 128 + c16 + 8) = o1;
            const v4u p0 = *(const LAS v4u*)(PT + t * 128 + c16), p1 = *(const LAS v4u*)(PT + t * 128 + c16 + 8);
            *(GAS v4u*)(LPB + m * 512 + g * 128 + c16) = p0; *(GAS v4u*)(LPB + m * 512 + g * 128 + c16 + 8) = p1;
        }
    }
}
__device__ __forceinline__ void lru_out_phase(const Frame& F, const bf16* __restrict__ PB, const bf16* __restrict__ LS, const bf16* __restrict__ LPF, const bf16* __restrict__ LPB, const float* __restrict__ CIN, bf16* __restrict__ MIX) {
    for (int task = F.bx * NTHREADS + F.tid; task < M * 64; task += F.G * NTHREADS) {
        const int m = task >> 6, c8 = (task & 63) * 8, b = m / SEQ, n = (m % SEQ) >> 6;
        const v4u sv = *(const GAS v4u*)(LS + (size_t)m * 512 + c8), pf = *(const GAS v4u*)(LPF + (size_t)m * 512 + c8), pb = *(const GAS v4u*)(LPB + (size_t)m * 512 + c8);
        const v4u yv = *(const GAS v4u*)(PB + (size_t)m * NPB + PB_CY + c8);
        const GAS f32x4* cfp = (const GAS f32x4*)(CIN + ((size_t)((0 * BATCH + b) * 32 + n)) * 512 + c8); const GAS f32x4* cbp = (const GAS f32x4*)(CIN + ((size_t)((1 * BATCH + b) * 32 + n)) * 512 + c8);
        const f32x4 cf0 = cfp[0], cf1 = cfp[1], cb0 = cbp[0], cb1 = cbp[1];
        const float cf[8] = {cf0.x, cf0.y, cf0.z, cf0.w, cf1.x, cf1.y, cf1.z, cf1.w}, cbv[8] = {cb0.x, cb0.y, cb0.z, cb0.w, cb1.x, cb1.y, cb1.z, cb1.w};
        const unsigned ss[4] = {sv.x, sv.y, sv.z, sv.w}, pp[4] = {pf.x, pf.y, pf.z, pf.w}, qq[4] = {pb.x, pb.y, pb.z, pb.w}, yy[4] = {yv.x, yv.y, yv.z, yv.w};
        unsigned oo[4];
#pragma unroll
        for (int e = 0; e < 4; ++e) {
            const float h0 = bf2f((unsigned short)(ss[e] & 0xffffu)) + bf2f((unsigned short)(pp[e] & 0xffffu)) * cf[2 * e] + bf2f((unsigned short)(qq[e] & 0xffffu)) * cbv[2 * e];
            const float h1 = bf2f((unsigned short)(ss[e] >> 16)) + bf2f((unsigned short)(pp[e] >> 16)) * cf[2 * e + 1] + bf2f((unsigned short)(qq[e] >> 16)) * cbv[2 * e + 1];
            oo[e] = pk2(h0 * gelu_tanh(bf2f((unsigned short)(yy[e] & 0xffffu))), h1 * gelu_tanh(bf2f((unsigned short)(yy[e] >> 16)))); }
        v4u o; o.x = oo[0]; o.y = oo[1]; o.z = oo[2]; o.w = oo[3];
        *(GAS v4u*)(MIX + (size_t)m * D + 1536 + c8) = o;
    }
}
__device__ __forceinline__ void lru_carry_phase(const Frame& F, const float* __restrict__ CAR_A, const float* __restrict__ CAR_H, float* __restrict__ CIN) {
    const int id = F.bx * NTHREADS + F.tid;
    if (id < 2 * BATCH * 512) {
        const int s = id >> 11, b = (id >> 9) & 3, ch = id & 511;
        const size_t base = ((size_t)((s * BATCH + b) * 32)) * 512 + ch;
        float av[32], hv[32];
#pragma unroll
        for (int n = 0; n < 32; ++n) { av[n] = CAR_A[base + (size_t)n * 512]; hv[n] = CAR_H[base + (size_t)n * 512]; }
        float h = 0.f;
        if (s == 0) {
#pragma unroll
            for (int n = 0; n < 32; ++n) { const float t = hv[n]; hv[n] = h; h = av[n] * h + t; }
        } else {
#pragma unroll
            for (int n = 31; n >= 0; --n) { const float t = hv[n]; hv[n] = h; h = av[n] * h + t; }
        }
#pragma unroll
        for (int n = 0; n < 32; ++n) CIN[base + (size_t)n * 512] = hv[n];
    }
}
#define WA_LOAD(colbase, u_) do { const int b_ = (u_) >> 7, hkv_ = (((u_) >> 4) & 7) >> 2, q0_ = ((u_) & 15) * 128; \
    _Pragma("unroll") for (int i_ = 0; i_ < 12; ++i_) { const int ch_ = tid + NTHREADS * i_, r_ = ch_ >> 4, col_ = ch_ & 15; int j_ = q0_ - 128 + r_; j_ = j_ < 0 ? 0 : (j_ > SEQ - 1 ? SEQ - 1 : j_); \
        kreg[i_] = *(const GAS v4u*)(PB + (size_t)(b_ * SEQ + j_) * NPB + (colbase) + hkv_ * 128 + col_ * 8); } } while (0)
#define WA_STORE(stride_) do { _Pragma("unroll") for (int i_ = 0; i_ < 12; ++i_) { const int ch_ = tid + NTHREADS * i_, r_ = ch_ >> 4, col_ = ch_ & 15; \
        *(LAS v4u*)(KS + r_ * (stride_) + col_ * 16) = kreg[i_]; } } while (0)
__device__ __forceinline__ void wattn_phase(const Frame& F, const bf16* __restrict__ PB, const float* __restrict__ rel_bias, const float* __restrict__ sink, bf16* __restrict__ MIX) {
    LAS unsigned char* KS = F.lds;
    LAS float* btab = (LAS float*)(F.lds + 384 * 288);
    const int lane = F.lane, g = lane >> 4, c = lane & 15, w = F.wave, tid = F.tid;
    constexpr int NUNITS = BATCH * 8 * (SEQ / 128);
    v4u kreg[12];
    int unit = F.bx, bias_hq = -1; float snk = 0.f;
    if (unit < NUNITS) WA_LOAD(O_AK, unit);
    while (unit < NUNITS) {
        const int b = unit >> 7, hq = (unit >> 4) & 7, qb = unit & 15;
        const int q0 = qb * 128;
        __syncthreads();
        WA_STORE(272);
        if (hq != bias_hq) { if (tid < 304) { const int rel = tid - 143; btab[tid] = (rel >= -128 && rel <= 128) ? rel_bias[t5_bucket(rel) * 8 + hq] : -1e30f; } snk = sink[hq]; bias_hq = hq; }
        __syncthreads();
        const bf16* qrow = PB + (size_t)(b * SEQ + q0 + 16 * w + c) * NPB + O_AQ + hq * 128 + g * 8;
        bf16x8 qfr[4];
#pragma unroll
        for (int ks = 0; ks < 4; ++ks) qfr[ks] = *(const GAS bf16x8*)(qrow + ks * 32);
        WA_LOAD(O_AV, unit);
        f32x4 S[17];
#pragma unroll
        for (int kt = 0; kt < 17; ++kt) S[kt] = (f32x4){0.f, 0.f, 0.f, 0.f};
#pragma unroll
        for (int ks = 0; ks < 4; ++ks) {
            const bf16x8 qf = qfr[ks];
#pragma unroll
            for (int kt = 0; kt < 17; ++kt) { const bf16x8 kf = *(const LAS bf16x8*)(KS + (16 * w + 16 * kt + c) * 272 + ks * 64 + g * 16); S[kt] = __builtin_amdgcn_mfma_f32_16x16x32_bf16(kf, qf, S[kt], 0, 0, 0);
                if (kt == 8 || kt == 16) __builtin_amdgcn_sched_barrier(0); }
        }
        float mx = snk;
        const int row_lo = (qb == 0) ? 128 : 0, row_n = ((qb == SEQ / 128 - 1) ? 256 : 384) - row_lo;
#pragma unroll
        for (int kt = 0; kt < 17; ++kt)
#pragma unroll
            for (int r = 0; r < 4; ++r) {
                const int row = 16 * w + 16 * kt + 4 * g + r;
                const float bias = btab[(4 * g - c + 15) + 16 * kt + r];
                const float s = ((unsigned)(row - row_lo) < (unsigned)row_n) ? S[kt][r] * 0.08838834764831845f + bias : -1e30f;
                S[kt][r] = s; mx = fmaxf(mx, s);
                if (r == 3 && (kt & 1)) __builtin_amdgcn_sched_barrier(0);
            }
        mx = fmaxf(mx, lane_xor_f(mx, 16, lane)); mx = fmaxf(mx, lane_xor_f(mx, 32, lane));
        float sum = 0.f;
#pragma unroll
        for (int kt = 0; kt < 17; ++kt)
#pragma unroll
            for (int r = 0; r < 4; ++r) { const float p = __builtin_amdgcn_exp2f((S[kt][r] - mx) * 1.4426950408889634f); S[kt][r] = p; sum += p; }
        sum += lane_xor_f(sum, 16, lane); sum += lane_xor_f(sum, 32, lane);
        sum += __builtin_amdgcn_exp2f((snk - mx) * 1.4426950408889634f);
        const float inv = 1.f / sum;
        bf16x8 pf[9];
#pragma unroll
        for (int s = 0; s < 9; ++s) { v4u t; t.x = pk2(S[2 * s][0] * inv, S[2 * s][1] * inv); t.y = pk2(S[2 * s][2] * inv, S[2 * s][3] * inv);
            if (s < 8) { t.z = pk2(S[2 * s + 1][0] * inv, S[2 * s + 1][1] * inv); t.w = pk2(S[2 * s + 1][2] * inv, S[2 * s + 1][3] * inv); } else { t.z = 0u; t.w = 0u; }
            pf[s] = __builtin_bit_cast(bf16x8, t); }
        __syncthreads();
        WA_STORE(288);
        __syncthreads();
        const int nxt = unit + F.G;
        if (nxt < NUNITS) WA_LOAD(O_AK, nxt);
        for (int dt = 0; dt < 8; ++dt) {
            f32x4 acc = {0.f, 0.f, 0.f, 0.f};
#pragma unroll
            for (int s = 0; s < 9; ++s) {
                LAS unsigned char* vp = KS + (16 * w + 32 * s + 4 * g + (c >> 2)) * 288 + (16 * dt + 4 * (c & 3)) * 2;
                const s16x4 lo = __builtin_amdgcn_ds_read_tr16_b64_v4i16((LAS s16x4*)vp);
                const s16x4 hi = __builtin_amdgcn_ds_read_tr16_b64_v4i16((LAS s16x4*)(vp + (s < 8 ? 16 * 288 : 0)));
                const bf16x8 vf = __builtin_shufflevector(lo, hi, 0, 1, 2, 3, 4, 5, 6, 7);
                acc = __builtin_amdgcn_mfma_f32_16x16x32_bf16(vf, pf[s], acc, 0, 0, 0);
            }
            v2u o; o.x = pk2(acc[0], acc[1]); o.y = pk2(acc[2], acc[3]);
            *(GAS v2u*)(MIX + (size_t)(b * SEQ + q0 + 16 * w + c) * D + hq * 128 + dt * 16 + 4 * g) = o;
        }
        unit = nxt;
    }
}
#undef WA_LOAD
#undef WA_STORE
#define XA_LOAD(u_, st_) do { const int b_ = (u_) >> 6, h_ = ((u_) >> 4) & 3; \
    if ((st_) < 4) { _Pragma("unroll") for (int i_ = 0; i_ < 8; ++i_) { const int row_ = (tid >> 4) + 32 * i_, col_ = tid & 15; \
            R[i_] = *(const GAS v4u*)(KX + (size_t)(b_ * MEM_LEN + row_) * D + h_ * 512 + (st_) * 128 + col_ * 8); } } \
    else { _Pragma("unroll") for (int i_ = 0; i_ < 8; ++i_) { const int row_ = (tid >> 5) + 16 * i_, col_ = tid & 31; \
            R[i_] = *(const GAS v4u*)(VT + (size_t)(h_ * 512 + ((st_) - 4) * 128 + row_) * MM + b_ * MEM_LEN + col_ * 8); } } } while (0)
#define XA_STORE(st_) do { if ((st_) < 4) { _Pragma("unroll") for (int i_ = 0; i_ < 8; ++i_) { const int row_ = (tid >> 4) + 32 * i_, col_ = tid & 15; *(LAS v4u*)(KS + row_ * 272 + col_ * 16) = R[i_]; } } \
    else { _Pragma("unroll") for (int i_ = 0; i_ < 8; ++i_) { const int row_ = (tid >> 5) + 16 * i_, col_ = tid & 31; *(LAS v4u*)(KS + row_ * 528 + col_ * 16) = R[i_]; } } } while (0)
__device__ __forceinline__ void xattn_phase(const Frame& F, const bf16* __restrict__ Q, const bf16* __restrict__ KX, const bf16* __restrict__ VT, bf16* __restrict__ O) {
    LAS unsigned char* KS = F.lds;
    const int lane = F.lane, g = lane >> 4, c = lane & 15, w = F.wave, tid = F.tid;
    constexpr int NUNITS = BATCH * 4 * (SEQ / 128);
    v4u R[8];
    int unit = F.bx;
    if (unit < NUNITS) XA_LOAD(unit, 0);
    while (unit < NUNITS) {
        const int b = unit >> 6, h = (unit >> 4) & 3, qb = unit & 15;
        const int m0 = b * SEQ + qb * 128 + w * 16;
        const int nxt = unit + F.G;
        f32x4 S[16];
#pragma unroll
        for (int kt = 0; kt < 16; ++kt) S[kt] = (f32x4){0.f, 0.f, 0.f, 0.f};
        const bf16* qrow = Q + (size_t)(m0 + c) * D + h * 512 + g * 8;
#pragma unroll
        for (int dc = 0; dc < 4; ++dc) {
            bf16x8 qf[4];
#pragma unroll
            for (int ks = 0; ks < 4; ++ks) qf[ks] = *(const GAS bf16x8*)(qrow + dc * 128 + ks * 32);
            __syncthreads();
            XA_STORE(dc);
            __syncthreads();
            XA_LOAD(unit, dc + 1);
#pragma unroll
            for (int ks = 0; ks < 4; ++ks) {
#pragma unroll
                for (int kt = 0; kt < 16; ++kt) { const bf16x8 kf = *(const LAS bf16x8*)(KS + (16 * kt + c) * 272 + ks * 64 + g * 16); S[kt] = __builtin_amdgcn_mfma_f32_16x16x32_bf16(kf, qf[ks], S[kt], 0, 0, 0); }
            }
        }
        float mx = -3.0e38f;
#pragma unroll
        for (int kt = 0; kt < 16; ++kt)
#pragma unroll
            for (int r = 0; r < 4; ++r) mx = fmaxf(mx, S[kt][r]);
        mx = fmaxf(mx, lane_xor_f(mx, 16, lane)); mx = fmaxf(mx, lane_xor_f(mx, 32, lane));
        const float sc2 = 0.044194173824159216f * 1.4426950408889634f;
        float sum = 0.f;
#pragma unroll
        for (int kt = 0; kt < 16; ++kt)
#pragma unroll
            for (int r = 0; r < 4; ++r) { const float p = __builtin_amdgcn_exp2f((S[kt][r] - mx) * sc2); S[kt][r] = p; sum += p; }
        sum += lane_xor_f(sum, 16, lane); sum += lane_xor_f(sum, 32, lane);
        const float inv = 1.f / sum;
        bf16x8 pf[8];
#pragma unroll
        for (int s = 0; s < 8; ++s) { v4u t; t.x = pk2(S[2 * s][0] * inv, S[2 * s][1] * inv); t.y = pk2(S[2 * s][2] * inv, S[2 * s][3] * inv); t.z = pk2(S[2 * s + 1][0] * inv, S[2 * s + 1][1] * inv); t.w = pk2(S[2 * s + 1][2] * inv, S[2 * s + 1][3] * inv);
            pf[s] = __builtin_bit_cast(bf16x8, t); }
#pragma unroll
        for (int dc = 0; dc < 4; ++dc) {
            __syncthreads();
            XA_STORE(4 + dc);
            __syncthreads();
            if (dc < 3) XA_LOAD(unit, 5 + dc); else if (nxt < NUNITS) XA_LOAD(nxt, 0);
            for (int dt = 0; dt < 8; ++dt) {
                f32x4 acc = {0.f, 0.f, 0.f, 0.f};
#pragma unroll
                for (int s = 0; s < 8; ++s) {
                    const LAS unsigned char* vp = KS + (16 * dt + c) * 528 + 64 * s + 8 * g;
                    const v2u lo = *(const LAS v2u*)vp, hi = *(const LAS v2u*)(vp + 32);
                    v4u t; t.x = lo.x; t.y = lo.y; t.z = hi.x; t.w = hi.y;
                    acc = __builtin_amdgcn_mfma_f32_16x16x32_bf16(__builtin_bit_cast(bf16x8, t), pf[s], acc, 0, 0, 0);
                }
                v2u o; o.x = pk2(acc[0], acc[1]); o.y = pk2(acc[2], acc[3]);
                *(GAS v2u*)(O + (size_t)(m0 + c) * D + h * 512 + dc * 128 + dt * 16 + 4 * g) = o;
            }
        }
        unit = nxt;
    }
}
#undef XA_LOAD
#undef XA_STORE
constexpr int NPL = 15;
enum Phase { PH_CONV = 0, PH_KV, PH_IN, PH_X1, PH_X2, PH_X3, PH_OUT, PH_RN1, PH_Q, PH_XA, PH_O, PH_RN2, PH_UP, PH_DOWN, PH_RN3 };
#define CAS __attribute__((address_space(4)))
struct Args { const float* in[31]; float* out; unsigned char* ws; int ph_lo, ph_hi, li, pad; };

__global__ void __launch_bounds__(NTHREADS, 2) fwd(Args args) {
    extern __shared__ __attribute__((aligned(16))) unsigned char lds[];
    Frame F;
    F.lds = (LAS unsigned char*)lds;
    const int wave_s = __builtin_amdgcn_readfirstlane(threadIdx.x >> 6);
    F.tid = threadIdx.x; F.lane = F.tid & 63; F.wave = wave_s;
    F.G = gridDim.x; F.bx = blockIdx.x;
    unsigned char* ws_top = args.ws;
    const int lo = args.ph_lo, hi = args.ph_hi;
    for (int u = F.tid; u < (LDS_BYTES - LDSCTL_OFF) / 4; u += NTHREADS) ((LAS unsigned*)(F.lds + LDSCTL_OFF))[u] = 0u;
    __syncthreads();
    XcdBarrier bar; bar.bar = (unsigned*)(ws_top + WS_CTL) + CW_BAR; bar.x = 0; bar.st = nullptr;
    const bool one_launch = (hi - lo) > 1;
    if (one_launch) bar = xcd_barrier_post((unsigned*)(ws_top + WS_CTL) + CW_BAR, (volatile LAS unsigned*)(F.lds + MISC_OFF) + 8);
#define SEAM(k) do { if (one_launch && (k) + 1 < hi) { xcd_barrier(bar); if (PROBE_REP & 512) xcd_barrier(bar); } } while (0)
#define IN(k) (lo <= (k) && (k) < hi)
#define REPS(bit) (1 + ((PROBE_REP >> (bit)) & 1))
#define PHASE_BEGIN() const CAS Args* ka_ = (const CAS Args*)__builtin_amdgcn_kernarg_segment_ptr(); asm volatile("" : "+s"(ka_)); \
    unsigned mk_ = ~0u; int l = l_it, bx_ = (int)blockIdx.x, G_ = (int)gridDim.x; asm volatile("" : "+s"(mk_), "+s"(l), "+s"(bx_), "+s"(G_)); F.bx = bx_; F.G = G_;     \
    int tz_ = (wave_s << 6) + (int)__builtin_amdgcn_mbcnt_hi(mk_, __builtin_amdgcn_mbcnt_lo(mk_, 0u)); asm volatile("" : "+v"(tz_)); F.tid = tz_; F.lane = tz_ & 63; F.wave = __builtin_amdgcn_readfirstlane(tz_ >> 6); \
    unsigned char* ws = ka_->ws; float* X = ka_->out; bf16* XN = (bf16*)(ws + WS_XN); bf16* Y = (bf16*)(ws + WS_Y); float* RS = (float*)(ws + WS_MISC + MISC_RS); unsigned char* wl = ws + WS_W + (size_t)(l % NWL) * WL_BYTES; \
    const int gw = F.bx * NWAVES + F.wave, NGW = F.G * NWAVES; (void)gw; (void)NGW; (void)X; (void)XN; (void)Y; (void)wl; (void)RS

    for (int l_it = 0; l_it < DEPTH; ++l_it) {
        const int pb = l_it * NPL;
        for (int rep_ = 0; rep_ < REPS(0); ++rep_) if (IN(pb + PH_CONV)) { PHASE_BEGIN();
            LAS float* scr = (LAS float*)(F.lds + RING_OFF + F.wave * 16384);
            const int lc0 = (NWL == 1) ? l : (l == 0 ? 0 : DEPTH), lc1 = (NWL == 1) ? l + 1 : DEPTH;
            for (int lc = lc0; lc < lc1; ++lc) {
                unsigned char* wb = ws + WS_W + (size_t)(lc % NWL) * WL_BYTES;
                const ConvSeg segs[10] = {
                    {ka_->in[3] + (size_t)lc * D * DIN, D, DIN, 0, 3072, (bf16*)(wb + WL_IN), 0, ka_->in[24] + (size_t)lc * D},
                    {ka_->in[3] + (size_t)lc * D * DIN, D, DIN, 3072, 32, (bf16*)(wb + WL_Z), 0, ka_->in[24] + (size_t)lc * D},
                    {ka_->in[3] + (size_t)lc * D * DIN, D, DIN, 3104, 1024, (bf16*)(wb + WL_IN), 3072, ka_->in[24] + (size_t)lc * D},
                    {ka_->in[4] + (size_t)lc * D * D, D, D, 0, D, (bf16*)(wb + WL_OUT), 0, nullptr},
                    {ka_->in[18] + (size_t)lc * D * D, D, D, 0, D, (bf16*)(wb + WL_XQ), 0, ka_->in[27] + (size_t)lc * D},
                    {ka_->in[19] + (size_t)lc * D * D, D, D, 0, D, (bf16*)(wb + WL_XK), 0, nullptr},
                    {ka_->in[20] + (size_t)lc * D * D, D, D, 0, D, (bf16*)(wb + WL_XV), 0, nullptr},
                    {ka_->in[21] + (size_t)lc * D * D, D, D, 0, D, (bf16*)(wb + WL_XO), 0, nullptr},
                    {ka_->in[22] + (size_t)lc * D * DFF, D, DFF, 0, DFF, (bf16*)(wb + WL_UP), 0, ka_->in[29] + (size_t)lc * D},
                    {ka_->in[23] + (size_t)lc * DFF * D, DFF, D, 0, D, (bf16*)(wb + WL_DOWN), 0, nullptr}};
                int total = 0;
#pragma unroll
                for (int s = 0; s < 10; ++s) total += seg_items(segs[s]);
                for (int it = gw; it < total; it += NGW) {
                    int r = it;
#pragma unroll
                    for (int s = 0; s < 10; ++s) { const int n = seg_items(segs[s]);
                        if (r >= 0 && r < n) p0_transpose_item(segs[s].W, segs[s].K, segs[s].N, segs[s].c0, segs[s].WT, segs[s].r0, segs[s].ncols / 32, segs[s].gain, scr, r, F.lane);
                        r -= n; }
                }
            }
            for (int lc = lc0; lc < lc1; ++lc) {
                bf16* lg = (bf16*)(ws + WS_W + (size_t)(lc % NWL) * WL_BYTES + WL_LRUG);
                for (int it = gw; it < 16 * 8; it += NGW) { const int mi = it >> 3, gate = mi >> 3, s = (mi >> 2) & 1, gg = mi & 3;
                    p0_transpose_item(ka_->in[gate ? 15 : 13] + ((size_t)lc * 8 + s * 4 + gg) * 16384, 128, 128, 0, lg + (size_t)((s * 2 + gate) * 4 + gg) * 16384, 0, 4, nullptr, scr, it & 7, F.lane); }
            }
            if (l == 0) for (int m = gw; m < M; m += NGW) init_row(F.lane, ka_->in[0] + (size_t)m * D, XN + (size_t)m * D, RS + m);
            for (int lc = lc0; lc < lc1; ++lc)
                for (int m = gw; m < MM; m += NGW) norm_row(F.lane, ka_->in[1] + (size_t)m * D, ka_->in[26] + (size_t)lc * D, (bf16*)(ws + WS_MEMN) + ((size_t)lc * MM + m) * D, nullptr);
        }
        if (l_it == 0 || NWL == 1) SEAM(pb + PH_CONV);
        for (int rep_ = 0; rep_ < REPS(1); ++rep_) if (IN(pb + PH_KV)) { PHASE_BEGIN();
            const int lc0 = (NWL == 1) ? l : (l == 0 ? 0 : DEPTH), lc1 = (NWL == 1) ? l + 1 : DEPTH;
            if (lc1 > lc0) {
                const bf16* base = (const bf16*)(ws + WS_W);
                pg8::Gemm g{base, base, 0, 0, D};
                pg8::KvOrder S; S.G = F.G; S.c = F.bx; S.NL = lc1 - lc0; S.l0 = lc0;
                S.memn_p0 = (int)((WS_MEMN - WS_W) / MiB) + 4 * lc0; S.memn_ps = 4;
                S.xk_p0 = (int)(((size_t)(lc0 % NWL) * WL_BYTES + WL_XK) / MiB); S.xv_p0 = (int)(((size_t)(lc0 % NWL) * WL_BYTES + WL_XV) / MiB); S.w_ps = (int)(WL_BYTES / MiB);
                pg8::EpiBf16<0> E{(bf16*)(ws + WS_KX), D, (bf16*)(ws + WS_VT), MM, nullptr};
                pg8::gemm_phase<pg8::EpiBf16<0>, pg8::KvOrder, true, true>(F.lds + RING_OFF, g, S, E, F.tid);
            }
        }
        if (l_it == 0 || NWL == 1) SEAM(pb + PH_KV);
        for (int rep_ = 0; rep_ < REPS(2); ++rep_) if (IN(pb + PH_IN)) { if (rep_ > 0 && (PROBE_REP & 1024)) xcd_barrier(bar); PHASE_BEGIN();
            pg8::Gemm g{XN, (const bf16*)(wl + WL_IN), M, NPB, D}; pg8::StaticOrder S; S.init(M, NPB, F.G, F.bx);
            pg8::EpiBf16<0> E{(bf16*)(ws + WS_PB), NPB, nullptr, 0, RS};
            pg8::gemm_phase<pg8::EpiBf16<0>, pg8::StaticOrder, true, true>(F.lds + RING_OFF, g, S, E, F.tid);
            for (int rz_ = 0; rz_ < 1 + ((PROBE_REP >> 12) & 1); ++rz_) zgemm(F, XN, (const bf16*)(wl + WL_Z), RS, (float*)(ws + WS_Z));
        }
        SEAM(pb + PH_IN);
        if (IN(pb + PH_X1)) { PHASE_BEGIN();
            for (int rep_ = 0; rep_ < REPS(3); ++rep_) gla_u_phase(F, (const bf16*)(ws + WS_PB), (const float*)(ws + WS_Z), ka_->in[6] + (size_t)l * 4096, ka_->in[7] + (size_t)l * 256, ka_->in[8] + (size_t)l * 4096, ka_->in[9] + (size_t)l * 256,
                        (float*)(ws + WS_GLAU), (float*)(ws + WS_MISC + MISC_DEC));
            for (int rep_ = 0; rep_ < REPS(5); ++rep_) lru_phase(F, (const bf16*)(ws + WS_PB), (const bf16*)(wl + WL_LRUG), ka_->in[11] + (size_t)l * 2048, ka_->in[12] + (size_t)l * 512, ka_->in[14] + (size_t)l * 1024, ka_->in[16] + (size_t)l * 1024, ka_->in[17] + (size_t)l * 1024,
                             (float*)(ws + WS_MISC + MISC_CAR_A), (float*)(ws + WS_MISC + MISC_CAR_H), (bf16*)(ws + WS_LRU), (bf16*)(ws + WS_LRU) + (size_t)M * 512, (bf16*)(ws + WS_LRU) + (size_t)2 * M * 512); }
        SEAM(pb + PH_X1);
        if (IN(pb + PH_X2)) { PHASE_BEGIN();
            gla_state_phase(F, (float*)(ws + WS_GLAU), (const float*)(ws + WS_MISC + MISC_DEC));
            lru_carry_phase(F, (const float*)(ws + WS_MISC + MISC_CAR_A), (const float*)(ws + WS_MISC + MISC_CAR_H), (float*)(ws + WS_MISC + MISC_CIN));
            for (int rep_ = 0; rep_ < REPS(6); ++rep_) wattn_phase(F, (const bf16*)(ws + WS_PB), ka_->in[2], ka_->in[5] + l * 8, (bf16*)(ws + WS_MIX)); }
        SEAM(pb + PH_X2);
        if (IN(pb + PH_X3)) { PHASE_BEGIN();
            for (int rep_ = 0; rep_ < REPS(7); ++rep_) gla_o_phase(F, (const bf16*)(ws + WS_PB), (const float*)(ws + WS_Z), ka_->in[6] + (size_t)l * 4096, ka_->in[7] + (size_t)l * 256, ka_->in[8] + (size_t)l * 4096, ka_->in[9] + (size_t)l * 256,
                        (const float*)(ws + WS_GLAU), ka_->in[10] + (size_t)l * 512, (bf16*)(ws + WS_MIX));
            for (int rep_ = 0; rep_ < REPS(8); ++rep_) lru_out_phase(F, (const bf16*)(ws + WS_PB), (const bf16*)(ws + WS_LRU), (const bf16*)(ws + WS_LRU) + (size_t)M * 512, (const bf16*)(ws + WS_LRU) + (size_t)2 * M * 512, (const float*)(ws + WS_MISC + MISC_CIN), (bf16*)(ws + WS_MIX)); }
        SEAM(pb + PH_X3);
        for (int rep_ = 0; rep_ < REPS(2); ++rep_) if (IN(pb + PH_OUT)) { if (rep_ > 0 && (PROBE_REP & 1024)) xcd_barrier(bar); PHASE_BEGIN();
            pg8::Gemm g{(const bf16*)(ws + WS_MIX), (const bf16*)(wl + WL_OUT), M, D, D}; pg8::StaticOrder S; S.init(M, D, F.G, F.bx);
            pg8::EpiBf16<0> E{Y, D, nullptr, 0, nullptr};
            pg8::gemm_phase<pg8::EpiBf16<0>, pg8::StaticOrder, true, true>(F.lds + RING_OFF, g, S, E, F.tid);
        }
        SEAM(pb + PH_OUT);
        if (IN(pb + PH_RN1)) { PHASE_BEGIN(); if (NGW * 4 == M) resid_rows<4>(F.lane, XN + (size_t)gw * D, Y + (size_t)gw * D, (size_t)NGW * D, ka_->in[25] + (size_t)l * D, RS + gw, (size_t)NGW, nullptr); else for (int m = gw; m < M; m += NGW) resid_row(F.lane, XN + (size_t)m * D, Y + (size_t)m * D, ka_->in[25] + (size_t)l * D, RS + m, nullptr);  if (PROBE_REP & 2048) resid_rows<4>(F.lane, XN + (size_t)gw * D, Y + (size_t)gw * D, (size_t)NGW * D, (const float*)(ws + WS_CTL + 512 * 1024), RS + gw, (size_t)NGW, nullptr); }
        SEAM(pb + PH_RN1);
        for (int rep_ = 0; rep_ < REPS(2); ++rep_) if (IN(pb + PH_Q)) { if (rep_ > 0 && (PROBE_REP & 1024)) xcd_barrier(bar); PHASE_BEGIN();
            pg8::Gemm g{XN, (const bf16*)(wl + WL_XQ), M, D, D}; pg8::StaticOrder S; S.init(M, D, F.G, F.bx);
            pg8::EpiBf16<0> E{(bf16*)(ws + WS_Q), D, nullptr, 0, RS};
            pg8::gemm_phase<pg8::EpiBf16<0>, pg8::StaticOrder, true, true>(F.lds + RING_OFF, g, S, E, F.tid);
        }
        SEAM(pb + PH_Q);
        for (int rep_ = 0; rep_ < REPS(4); ++rep_) if (IN(pb + PH_XA)) { PHASE_BEGIN(); xattn_phase(F, (const bf16*)(ws + WS_Q), (const bf16*)(ws + WS_KX) + (size_t)l * MM * D, (const bf16*)(ws + WS_VT) + (size_t)l * D * MM, (bf16*)(ws + WS_O)); }
        SEAM(pb + PH_XA);
        for (int rep_ = 0; rep_ < REPS(2); ++rep_) if (IN(pb + PH_O)) { if (rep_ > 0 && (PROBE_REP & 1024)) xcd_barrier(bar); PHASE_BEGIN();
            pg8::Gemm g{(const bf16*)(ws + WS_O), (const bf16*)(wl + WL_XO), M, D, D}; pg8::StaticOrder S; S.init(M, D, F.G, F.bx);
            pg8::EpiBf16<0> E{Y, D, nullptr, 0, nullptr};
            pg8::gemm_phase<pg8::EpiBf16<0>, pg8::StaticOrder, true, true>(F.lds + RING_OFF, g, S, E, F.tid);
        }
        SEAM(pb + PH_O);
        if (IN(pb + PH_RN2)) { PHASE_BEGIN(); if (NGW * 4 == M) resid_rows<4>(F.lane, XN + (size_t)gw * D, Y + (size_t)gw * D, (size_t)NGW * D, ka_->in[28] + (size_t)l * D, RS + gw, (size_t)NGW, nullptr); else for (int m = gw; m < M; m += NGW) resid_row(F.lane, XN + (size_t)m * D, Y + (size_t)m * D, ka_->in[28] + (size_t)l * D, RS + m, nullptr);  if (PROBE_REP & 2048) resid_rows<4>(F.lane, XN + (size_t)gw * D, Y + (size_t)gw * D, (size_t)NGW * D, (const float*)(ws + WS_CTL + 512 * 1024), RS + gw, (size_t)NGW, nullptr); }
        SEAM(pb + PH_RN2);
        for (int rep_ = 0; rep_ < REPS(2); ++rep_) if (IN(pb + PH_UP)) { if (rep_ > 0 && (PROBE_REP & 1024)) xcd_barrier(bar); PHASE_BEGIN();
            pg8::Gemm g{XN, (const bf16*)(wl + WL_UP), M, DFF, D}; pg8::StaticOrder S; S.init(M, DFF, F.G, F.bx);
            pg8::EpiBf16<1> E{(bf16*)(ws + WS_H), DFF, nullptr, 0, RS};
            pg8::gemm_phase<pg8::EpiBf16<1>, pg8::StaticOrder, true, true>(F.lds + RING_OFF, g, S, E, F.tid);
        }
        SEAM(pb + PH_UP);
        for (int rep_ = 0; rep_ < REPS(2); ++rep_) if (IN(pb + PH_DOWN)) { if (rep_ > 0 && (PROBE_REP & 1024)) xcd_barrier(bar); PHASE_BEGIN();
            pg8::Gemm g{(const bf16*)(ws + WS_H), (const bf16*)(wl + WL_DOWN), M, D, DFF}; pg8::StaticOrder S; S.init(M, D, F.G, F.bx);
            pg8::EpiBf16<0> E{Y, D, nullptr, 0, nullptr};
            pg8::gemm_phase<pg8::EpiBf16<0>, pg8::StaticOrder, true, true>(F.lds + RING_OFF, g, S, E, F.tid);
        }
        SEAM(pb + PH_DOWN);
        if (IN(pb + PH_RN3)) { PHASE_BEGIN(); if (NGW * 4 == M) resid_rows<4>(F.lane, XN + (size_t)gw * D, Y + (size_t)gw * D, (size_t)NGW * D, ka_->in[30] + (size_t)l * D, RS + gw, (size_t)NGW, (l + 1 < DEPTH) ? nullptr : X + (size_t)gw * D); else for (int m = gw; m < M; m += NGW) resid_row(F.lane, XN + (size_t)m * D, Y + (size_t)m * D, ka_->in[30] + (size_t)l * D, RS + m, (l + 1 < DEPTH) ? nullptr : X + (size_t)m * D);  if (PROBE_REP & 2048) resid_rows<4>(F.lane, XN + (size_t)gw * D, Y + (size_t)gw * D, (size_t)NGW * D, (const float*)(ws + WS_CTL + 512 * 1024), RS + gw, (size_t)NGW, nullptr); }
        SEAM(pb + PH_RN3);
    }
#undef IN
#undef SEAM
}
extern "C" void kernel_launch(void* const* d_in, const int* in_sizes, int n_in, void* d_out, int out_size, void* d_ws, size_t ws_size, hipStream_t stream) {
    static int grid = 0;
    if (grid == 0) {
        int dev = 0, cus = 0;
        if (n_in != 31 || out_size != M * D || ws_size < WS_END) { fprintf(stderr, "kernel_launch: built for 31 inputs, %d outputs, >= %zu bytes of workspace; got %d, %d, %zu\n", M * D, (size_t)WS_END, n_in, out_size, ws_size); grid = -1; return; }
        if (hipGetDevice(&dev) != hipSuccess || hipDeviceGetAttribute(&cus, hipDeviceAttributeMultiprocessorCount, dev) != hipSuccess) { fprintf(stderr, "kernel_launch: device query failed\n"); grid = -1; return; }
        if (hipFuncSetAttribute((const void*)fwd, hipFuncAttributeMaxDynamicSharedMemorySize, LDS_BYTES) != hipSuccess) { fprintf(stderr, "kernel_launch: hipFuncSetAttribute failed\n"); grid = -1; return; }
        int per_cu = 0;
        if (hipOccupancyMaxActiveBlocksPerMultiprocessor(&per_cu, (const void*)fwd, NTHREADS, LDS_BYTES) != hipSuccess || per_cu < 1) { fprintf(stderr, "kernel_launch: occupancy query reports %d workgroups per CU\n", per_cu); (void)hipGetLastError(); }
        grid = cus;
    }
    if (grid < 0) return;
    unsigned char* ws = (unsigned char*)d_ws;
    (void)hipMemsetAsync(ws + WS_CTL, 0, CTL_ZERO_BYTES, stream);
    Args a{};
    for (int i = 0; i < 31; ++i) a.in[i] = (const float*)d_in[i];
    a.out = (float*)d_out; a.ws = ws;
#if defined(MK_PER_PHASE) && MK_PER_PHASE
    for (int p = 0; p < DEPTH * NPL; ++p) { if (NWL == 4 && p >= NPL && (p % NPL) < 2) continue; a.ph_lo = p; a.ph_hi = p + 1; hipLaunchKernelGGL(fwd, dim3(grid), dim3(NTHREADS), LDS_BYTES, stream, a); }
#else
    a.ph_lo = 0; a.ph_hi = DEPTH * NPL;
    hipLaunchKernelGGL(fwd, dim3(grid), dim3(NTHREADS), LDS_BYTES, stream, a);
    const hipError_t le = hipPeekAtLastError();
    if (le != hipSuccess) fprintf(stderr, "kernel_launch: launch failed: %s\n", hipGetErrorName(le));
#endif
}
```

```cpp
#include <hip/hip_runtime.h>
#include <cstdint>
#include <cstdio>

__device__ __forceinline__ float lane_xor_f(float v, int mask, int lane) { return __builtin_bit_cast(float, __builtin_amdgcn_ds_bpermute((lane ^ mask) << 2, __builtin_bit_cast(int, v))); }
namespace pg8 {
#define PG8_LAS __attribute__((address_space(3)))
typedef unsigned short bf16_t;
typedef short bf16x8 __attribute__((ext_vector_type(8)));
typedef float f32x4 __attribute__((ext_vector_type(4)));
typedef unsigned u32x4 __attribute__((ext_vector_type(4)));
constexpr int BM = 256, BK = 64, HALF = 128, HTB = HALF * BK * 2  , STAGE_BYTES = 8 * HTB, NXCD = 8, WGM = 8;

__host__ __device__ __forceinline__ int lds_byte(int r, int c) { const int st = (r >> 4) * 2 + (c >> 5), rr = r & 15, cc = c & 31, ob = rr * 64 + cc * 2; return st * 1024 + (ob ^ (((ob >> 9) & 1) << 5)); }
__host__ __device__ __forceinline__ void stage_rc(int b, int& R, int& C) { const int st = b / 1024, sb = b % 1024, swz = sb ^ (((sb >> 9) & 1) << 5); R = (st >> 1) * 16 + swz / 64; C = (st & 1) * 32 + (swz % 64) / 2; }
__host__ __device__ __forceinline__ int perm32(int rho) { const int n = rho >> 4, i = rho & 15; return 8 * (i >> 2) + 4 * n + (i & 3); }

struct Unit { int pm, pn, om, on, kind; };
struct Gemm { const bf16_t* A; const bf16_t* Bt; int M, N, K; };

struct StaticOrder {
    int nM, nN, nwg, G, c;
    __host__ __device__ void init(int M, int N, int G_, int c_) { nM = M / BM; nN = N / BM; nwg = nM * nN; G = G_; c = c_; }
    __host__ __device__ bool next(int i, Unit& u) const {
        const long L = (long)i * G + c; if (L >= nwg) return false;
        int wgid = (int)L; { const int q = nwg / NXCD, r = nwg % NXCD, xcd = wgid % NXCD, off = wgid / NXCD; wgid = (xcd < r ? xcd * (q + 1) : r * (q + 1) + (xcd - r) * q) + off; }
        const int nig = WGM * nN, gid = wgid / nig, fm = gid * WGM, gsz = (nM - fm) < WGM ? (nM - fm) : WGM;
        u.pm = fm + ((wgid % nig) % gsz); u.pn = (wgid % nig) / gsz; u.om = u.pm; u.on = u.pn; u.kind = 0; return true;
    }
    __device__ __forceinline__ void a_ready(const Unit&) const {}
    __device__ __forceinline__ void done(const Unit&) const {}
};
struct KvOrder {
    int G, c, NL, l0, memn_p0, memn_ps, xk_p0, xv_p0, w_ps;
    __host__ __device__ bool next(int i, Unit& u) const {
        const long L = (long)i * G + c; if (L >= (long)NL * 64) return false;
        const int l = (int)L / 64, r = (int)L % 64;
        if (r < 32) { const int pm = r & 3, pn = r >> 2; u.kind = 0; u.pm = memn_p0 + l * memn_ps + pm; u.pn = xk_p0 + l * w_ps + pn; u.om = (l0 + l) * 4 + pm; u.on = pn; }
        else { const int q = r - 32, pm = q & 7, pn = q >> 3; u.kind = 1; u.pm = xv_p0 + l * w_ps + pm; u.pn = memn_p0 + l * memn_ps + pn; u.om = (l0 + l) * 8 + pm; u.on = pn; }
        return true;
    }
    __device__ __forceinline__ void a_ready(const Unit&) const {}
    __device__ __forceinline__ void done(const Unit&) const {}
};

__device__ __forceinline__ unsigned cvt_pk_bf16(float lo, float hi) { unsigned r; asm volatile("v_cvt_pk_bf16_f32 %0, %1, %2" : "=v"(r) : "v"(lo), "v"(hi)); return r; }

template <int ACT  > struct EpiBf16 {
    static constexpr bool PERM = true, AFTER_DRAIN = false;
    bf16_t* O; int ldc; bf16_t* O1; int ldc1; const float* rs;
    __device__ __forceinline__ void operator()(const f32x4 (&acc)[2][2][4][2], const Unit& u, int wr, int wc, int fr, int fq) const {
        bf16_t* base = u.kind ? O1 : O; const int ld = u.kind ? ldc1 : ldc;
        const int row0 = u.om * BM + wr * 64 + fr, col0 = u.on * BM + wc * 32 + 8 * fq;
#pragma unroll
        for (int ai = 0; ai < 2; ++ai)
#pragma unroll
            for (int m = 0; m < 4; ++m) { bf16_t* rowp = base + (size_t)(row0 + ai * HALF + m * 16) * ld + col0;
                const float sc = rs ? rs[row0 + ai * HALF + m * 16] : 1.f;
#pragma unroll
                for (int bj = 0; bj < 2; ++bj) { f32x4 v0 = acc[ai][bj][m][0] * sc, v1 = acc[ai][bj][m][1] * sc;
                    if (ACT == 1) {
#pragma unroll
                        for (int j = 0; j < 4; ++j) { const float a = fmaxf(v0[j], 0.f), b = fmaxf(v1[j], 0.f); v0[j] = a * a; v1[j] = b * b; } }
                    u32x4 w; w.x = cvt_pk_bf16(v0[0], v0[1]); w.y = cvt_pk_bf16(v0[2], v0[3]); w.z = cvt_pk_bf16(v1[0], v1[1]); w.w = cvt_pk_bf16(v1[2], v1[3]);
                    *(u32x4*)(rowp + bj * HALF) = w; } }
    }
};
struct EpiF32 {
    static constexpr bool PERM = false, AFTER_DRAIN = false;
    float* C; int ldc;
    __device__ __forceinline__ void operator()(const f32x4 (&acc)[2][2][4][2], const Unit& u, int wr, int wc, int fr, int fq) const {
        const int row0 = u.om * BM + wr * 64 + fr, col0 = u.on * BM + wc * 32 + 4 * fq;
#pragma unroll
        for (int ai = 0; ai < 2; ++ai)
#pragma unroll
            for (int m = 0; m < 4; ++m) { float* rowp = C + (size_t)(row0 + ai * HALF + m * 16) * ldc + col0;
#pragma unroll
                for (int bj = 0; bj < 2; ++bj)
#pragma unroll
                    for (int n = 0; n < 2; ++n) *(f32x4*)(rowp + bj * HALF + n * 16) = acc[ai][bj][m][n]; }
    }
};

template <class Epi, class Sched, bool ALIGN_EPI = false, bool SP2 = false>
__device__ __forceinline__ void gemm_phase(PG8_LAS unsigned char* lds, const Gemm g, const Sched& S, const Epi& E, const int tid_in) {
    int tid_ = tid_in; asm volatile("" : "+v"(tid_));
    const int tid = tid_, wid = __builtin_amdgcn_readfirstlane(tid >> 6), lane = tid & 63, wr = wid >> 2, wc = wid & 3, fr = lane & 15, fq = lane >> 4;
    const int K = g.K, nt = K / BK;
    unsigned voffA[2], voffB[2];
#pragma unroll
    for (int i = 0; i < 2; ++i) { int R, C; stage_rc(tid * 16 + i * 8192, R, C); const int Rb = Epi::PERM ? ((R & ~31) + perm32(R & 31)) : R;
        voffA[i] = (unsigned)(R * K + C) * 2u; voffB[i] = (unsigned)(Rb * K + C) * 2u; }
    const size_t kstep = (size_t)(BK * 2);
    const size_t hstep = (size_t)HALF * K * 2;
    const size_t tstep = 2 * hstep;
    const unsigned ldsw = (unsigned)wid * 1024u;
    const int aoff = lds_byte(wr * 64 + fr, fq * 8), boff = lds_byte(wc * 32 + fr, fq * 8);
#define PG8_SA(b, h) (((b) * 2 + (h)) * HTB)
#define PG8_SB(b, h) ((4 + (b) * 2 + (h)) * HTB)
#define PG8_STAGE(bufoff, gbase, voff) do { _Pragma("unroll") for (int _i = 0; _i < 2; ++_i) \
        __builtin_amdgcn_global_load_lds((const unsigned*)((const char*)(gbase) + (voff)[_i]), (PG8_LAS unsigned*)(lds + (bufoff) + ldsw + _i * 8192), 16, 0, 0); } while (0)
#define PG8_LDA(dst, b, h) do { _Pragma("unroll") for (int m = 0; m < 4; ++m) _Pragma("unroll") for (int k = 0; k < 2; ++k) dst[m][k] = *(const PG8_LAS bf16x8*)(lds + PG8_SA(b, h) + aoff + m * 2048 + k * 1024); } while (0)
#define PG8_LDB(dst, b, h) do { _Pragma("unroll") for (int n = 0; n < 2; ++n) _Pragma("unroll") for (int k = 0; k < 2; ++k) dst[n][k] = *(const PG8_LAS bf16x8*)(lds + PG8_SB(b, h) + boff + n * 2048 + k * 1024); } while (0)
#define PG8_MMA(ai, bj, At, Bt) do { __builtin_amdgcn_s_setprio(1); _Pragma("unroll") for (int m = 0; m < 4; ++m) _Pragma("unroll") for (int n = 0; n < 2; ++n) _Pragma("unroll") for (int k = 0; k < 2; ++k) \
        acc[ai][bj][m][n] = __builtin_amdgcn_mfma_f32_16x16x32_bf16(Bt[n][k], At[m][k], acc[ai][bj][m][n], 0, 0, 0); __builtin_amdgcn_s_setprio(0); } while (0)
#define PG8_WAIT_V(n) asm volatile("s_waitcnt vmcnt(" #n ")" ::: "memory")
#define PG8_WAIT_L(n) asm volatile("s_waitcnt lgkmcnt(" #n ")" ::: "memory")
#define PG8_BAR __builtin_amdgcn_s_barrier()
#define PG8_SCHED __builtin_amdgcn_sched_barrier(0)
    Unit cur, nxt; int ui = 0;
    if (!S.next(0, cur)) return;
    f32x4 acc[2][2][4][2];
#pragma unroll
    for (int a = 0; a < 2; ++a)
#pragma unroll
        for (int b = 0; b < 2; ++b)
#pragma unroll
            for (int m = 0; m < 4; ++m)
#pragma unroll
                for (int n = 0; n < 2; ++n) acc[a][b][m][n] = (f32x4){0.f, 0.f, 0.f, 0.f};
    bf16x8 At[4][2], B0[2][2], B1[2][2];
    const char* cA = (const char*)g.A + (size_t)cur.pm * tstep; const char* cB = (const char*)g.Bt + (size_t)cur.pn * tstep;
    S.a_ready(cur);
    if constexpr (SP2) {
        PG8_STAGE(PG8_SB(0, 0), cB, voffB); PG8_STAGE(PG8_SB(0, 1), cB + hstep, voffB); PG8_STAGE(PG8_SA(0, 0), cA, voffA); PG8_STAGE(PG8_SA(0, 1), cA + hstep, voffA);
        if (wr == 1) PG8_BAR;
        PG8_WAIT_V(2); PG8_BAR;
        PG8_STAGE(PG8_SB(1, 0), cB + kstep, voffB); PG8_STAGE(PG8_SA(1, 0), cA + kstep, voffA); PG8_STAGE(PG8_SB(1, 1), cB + hstep + kstep, voffB);
        PG8_WAIT_V(6); PG8_BAR;
    } else {
        PG8_STAGE(PG8_SB(0, 0), cB, voffB); PG8_STAGE(PG8_SA(0, 0), cA, voffA); PG8_STAGE(PG8_SB(0, 1), cB + hstep, voffB); PG8_STAGE(PG8_SA(0, 1), cA + hstep, voffA);
        if (wr == 1) PG8_BAR;
        PG8_WAIT_V(4); PG8_BAR;
        PG8_STAGE(PG8_SB(1, 0), cB + kstep, voffB); PG8_STAGE(PG8_SA(1, 0), cA + kstep, voffA); PG8_STAGE(PG8_SB(1, 1), cB + hstep + kstep, voffB);
        PG8_WAIT_V(6); PG8_BAR;
    }
    for (;;) {
        const bool has_next = S.next(ui + 1, nxt);
        const char* nA = has_next ? (const char*)g.A + (size_t)nxt.pm * tstep : cA; const char* nB = has_next ? (const char*)g.Bt + (size_t)nxt.pn * tstep : cB;
        for (int t = 0; t < nt; t += 2) {
            const bool last = (t == nt - 2);
            const char* a1 = cA + (size_t)(t + 1) * kstep;
            const char* a2 = last ? nA : cA + (size_t)(t + 2) * kstep; const char* b2 = last ? nB : cB + (size_t)(t + 2) * kstep;
            const char* a3 = a2 + kstep; const char* b3 = b2 + kstep;
            if (last && has_next) S.a_ready(nxt);
            if constexpr (SP2) {
            PG8_LDB(B0, 0, 0); PG8_LDB(B1, 0, 1); PG8_SCHED; PG8_LDA(At, 0, 0); PG8_STAGE(PG8_SA(1, 1), a1 + hstep, voffA);
            PG8_WAIT_V(8); PG8_WAIT_L(0); PG8_BAR; PG8_MMA(0, 0, At, B0); PG8_MMA(0, 1, At, B1); PG8_BAR; PG8_SCHED;
            PG8_LDA(At, 0, 1); PG8_STAGE(PG8_SB(0, 0), b2, voffB); PG8_STAGE(PG8_SB(0, 1), b2 + hstep, voffB); PG8_STAGE(PG8_SA(0, 0), a2, voffA);
            PG8_WAIT_V(8); PG8_WAIT_L(0); PG8_BAR; PG8_MMA(1, 0, At, B0); PG8_MMA(1, 1, At, B1); PG8_BAR; PG8_SCHED;
            PG8_LDB(B0, 1, 0); PG8_LDB(B1, 1, 1); PG8_SCHED; PG8_LDA(At, 1, 0); PG8_STAGE(PG8_SA(0, 1), a2 + hstep, voffA);
            PG8_WAIT_V(8); PG8_WAIT_L(0); PG8_BAR; PG8_MMA(0, 0, At, B0); PG8_MMA(0, 1, At, B1); PG8_BAR; PG8_SCHED;
            PG8_LDA(At, 1, 1); PG8_STAGE(PG8_SB(1, 0), b3, voffB); PG8_STAGE(PG8_SB(1, 1), b3 + hstep, voffB); PG8_STAGE(PG8_SA(1, 0), a3, voffA);
            PG8_WAIT_V(8); PG8_WAIT_L(0); PG8_BAR; PG8_MMA(1, 0, At, B0); PG8_MMA(1, 1, At, B1); PG8_BAR; PG8_SCHED;
            } else {
            PG8_LDB(B0, 0, 0); PG8_SCHED; PG8_LDA(At, 0, 0); PG8_STAGE(PG8_SA(1, 1), a1 + hstep, voffA);
            PG8_WAIT_L(8); PG8_BAR; PG8_WAIT_L(0); PG8_MMA(0, 0, At, B0); PG8_BAR; PG8_SCHED;
            PG8_LDB(B1, 0, 1); PG8_STAGE(PG8_SB(0, 0), b2, voffB);
            PG8_BAR; PG8_WAIT_L(0); PG8_MMA(0, 1, At, B1); PG8_BAR;
            PG8_LDA(At, 0, 1); PG8_STAGE(PG8_SA(0, 0), a2, voffA);
            PG8_BAR; PG8_WAIT_L(0); PG8_MMA(1, 0, At, B0); PG8_BAR; PG8_SCHED;
            PG8_STAGE(PG8_SB(0, 1), b2 + hstep, voffB);
            PG8_WAIT_V(6); PG8_BAR; PG8_MMA(1, 1, At, B1); PG8_BAR;
            PG8_LDB(B0, 1, 0); PG8_SCHED; PG8_LDA(At, 1, 0); PG8_STAGE(PG8_SA(0, 1), a2 + hstep, voffA);
            PG8_WAIT_L(8); PG8_BAR; PG8_WAIT_L(0); PG8_MMA(0, 0, At, B0); PG8_BAR; PG8_SCHED;
            PG8_LDB(B1, 1, 1); PG8_STAGE(PG8_SB(1, 0), b3, voffB);
            PG8_BAR; PG8_WAIT_L(0); PG8_MMA(0, 1, At, B1); PG8_BAR;
            PG8_LDA(At, 1, 1); PG8_STAGE(PG8_SA(1, 0), a3, voffA);
            PG8_BAR; PG8_WAIT_L(0); PG8_MMA(1, 0, At, B0); PG8_BAR; PG8_SCHED;
            PG8_STAGE(PG8_SB(1, 1), b3 + hstep, voffB);
            PG8_WAIT_V(6); PG8_BAR; PG8_MMA(1, 1, At, B1); PG8_BAR;
            }
        }
        if constexpr (ALIGN_EPI) { if (wr == 0) PG8_BAR; }
        if constexpr (!Epi::AFTER_DRAIN) { E(acc, cur, wr, wc, fr, fq); S.done(cur); }
        if (!has_next) break;
#pragma unroll
        for (int a = 0; a < 2; ++a)
#pragma unroll
            for (int b = 0; b < 2; ++b)
#pragma unroll
                for (int m = 0; m < 4; ++m)
#pragma unroll
                    for (int n = 0; n < 2; ++n) acc[a][b][m][n] = (f32x4){0.f, 0.f, 0.f, 0.f};
        cur = nxt; cA = nA; cB = nB; ++ui;
        if constexpr (ALIGN_EPI) { if (wr == 1) PG8_BAR; }
    }
    PG8_WAIT_V(0);
    if constexpr (!ALIGN_EPI) { if (wr == 0) PG8_BAR; }
    PG8_BAR;
    if constexpr (Epi::AFTER_DRAIN) { E.fused(acc, cur, wr, wc, fr, fq, lds, wid, lane); S.done(cur); }
#undef PG8_SA
#undef PG8_SB
#undef PG8_STAGE
#undef PG8_LDA
#undef PG8_LDB
#undef PG8_MMA
#undef PG8_WAIT_V
#undef PG8_WAIT_L
#undef PG8_BAR
#undef PG8_SCHED
}
}

constexpr int D = 2048, BATCH = 4, SEQ = 2048, DEPTH = 4, M = BATCH * SEQ, MEM_LEN = 256, MM = BATCH * MEM_LEN;
constexpr int DIN = 4128, DFF = 8192;
constexpr int O_AQ = 0, O_AK = 1024, O_AV = 1280, O_BQ = 1536, O_BK = 1792, O_BV = 2048, O_BG = 2560, O_ZF = 3072, O_ZB = 3088, O_CX = 3104, O_CY = 3616;
constexpr int NPB = 4096;
constexpr int PB_CX = 3072, PB_CY = 3584;
constexpr float EPS = 1e-6f;
constexpr int NWAVES = 8, NTHREADS = 512;

#ifndef PROBE_REP
#define PROBE_REP 0
#endif
#ifndef NWL
#define NWL 4
#endif
constexpr size_t MiB = 1u << 20;
constexpr size_t WS_CTL = 0, CTL_ZERO_BYTES = 1 * MiB;
constexpr size_t WS_W = 1 * MiB, WL_BYTES = 121 * MiB;
constexpr size_t WL_IN = 0, WL_OUT = 16 * MiB, WL_XQ = 24 * MiB, WL_XK = 32 * MiB, WL_XV = 40 * MiB, WL_XO = 48 * MiB, WL_UP = 56 * MiB, WL_DOWN = 88 * MiB, WL_Z = 120 * MiB, WL_LRUG = 120 * MiB + 256 * 1024;
constexpr size_t WS_XN = WS_W + NWL * WL_BYTES;
constexpr size_t WS_MEMN = WS_XN + 32 * MiB;
constexpr size_t WS_KX = WS_MEMN + 16 * MiB;
constexpr size_t WS_VT = WS_KX + 16 * MiB;
constexpr size_t WS_Y = WS_VT + 16 * MiB;
constexpr size_t WS_Z = WS_Y + 64 * MiB;
constexpr size_t WS_BIG = WS_Z + 1 * MiB;
constexpr size_t WS_PB = WS_BIG;
constexpr size_t WS_MIX = WS_BIG + 64 * MiB;
constexpr size_t WS_GLAU = WS_BIG + 96 * MiB;
constexpr size_t WS_MISC = WS_BIG + 128 * MiB;
constexpr size_t WS_H = WS_BIG;
constexpr size_t WS_Q = WS_BIG, WS_O = WS_BIG + 32 * MiB;
constexpr size_t WS_LRU = WS_BIG + 136 * MiB;
constexpr size_t WS_END = WS_LRU + 24 * MiB;
constexpr int CW_TMO = 0, CW_BAR = 4096;

constexpr int RING_OFF = 0, RING_BYTES = 131072, SCR_BYTES = 143360;
constexpr int LDSCTL_OFF = SCR_BYTES, MISC_OFF = LDSCTL_OFF + 320;
constexpr int LDS_BYTES = 147456;

#define GAS __attribute__((address_space(1)))
#define CAS __attribute__((address_space(4)))
#define LAS __attribute__((address_space(3)))
typedef unsigned short bf16;
typedef unsigned v4u __attribute__((ext_vector_type(4)));
typedef unsigned v2u __attribute__((ext_vector_type(2)));
typedef float f32x4 __attribute__((ext_vector_type(4)));
typedef short bf16x8 __attribute__((ext_vector_type(8)));
typedef short s16x4 __attribute__((ext_vector_type(4)));
#define LDS_WAIT() asm volatile("s_waitcnt lgkmcnt(0)" ::: "memory")
#define LBAR() do { asm volatile("s_waitcnt lgkmcnt(0)" ::: "memory"); __builtin_amdgcn_s_barrier(); asm volatile("" ::: "memory"); } while (0)
#define VM_WAIT() asm volatile("s_waitcnt vmcnt(0)" ::: "memory")
__device__ __forceinline__ unsigned f2bf(float f) { unsigned u = __builtin_bit_cast(unsigned, f); return (u + 0x7fffu + ((u >> 16) & 1u)) >> 16; }
__device__ __forceinline__ unsigned pk2(float lo, float hi) { return f2bf(lo) | (f2bf(hi) << 16); }
__device__ __forceinline__ float bf2f(unsigned short b) { return __builtin_bit_cast(float, (unsigned)b << 16); }
__device__ __forceinline__ float wave_sum(float v, int lane) {
#pragma unroll
    for (int o = 1; o < 64; o <<= 1) v += lane_xor_f(v, o, lane);
    return v;
}
__device__ __forceinline__ float wave_max(float v, int lane) {
#pragma unroll
    for (int o = 1; o < 64; o <<= 1) v = fmaxf(v, lane_xor_f(v, o, lane));
    return v;
}
__device__ __forceinline__ float sigmoidf_(float x) { return __builtin_amdgcn_rcpf(1.f + __builtin_amdgcn_exp2f(-1.4426950408889634f * x)); }
__device__ __forceinline__ float softplusf_(float x) { return fmaxf(x, 0.f) + 0.6931471805599453f * __builtin_amdgcn_logf(1.f + __builtin_amdgcn_exp2f(-1.4426950408889634f * fabsf(x))); }
__device__ __forceinline__ float gelu_tanh(float x) { return x * sigmoidf_(1.5957691216057308f * (x + 0.044715f * x * x * x)); }
__device__ __forceinline__ int t5_bucket(int rel) {
    const int ret = rel > 0 ? 16 : 0; const int n = rel < 0 ? -rel : rel;
    if (n < 8) return ret + n;
    int k = 0; while (k < 7 && (64 << (k + 1)) <= n * n) ++k;
    return ret + 8 + k;
}

struct Frame {
    LAS unsigned char* lds;
    int tid, lane, wave, G, bx;
};

__device__ __forceinline__ void p0_transpose_item(const float* W, int K, int N, int c0, bf16* WT, int r0, int nblk, const float* gk, LAS float* scr, int item, int lane) {
    const int kb = item / nblk, nb = item % nblk, k0 = 64 * kb, n0 = 32 * nb;
    const int c = lane & 7;
    f32x4 g0 = {1.f, 1.f, 1.f, 1.f}, g1 = {1.f, 1.f, 1.f, 1.f};
    if (gk) { g0 = *(const GAS f32x4*)(gk + k0 + 8 * c); g1 = *(const GAS f32x4*)(gk + k0 + 8 * c + 4); }
    f32x4 wv[8];
#pragma unroll
    for (int i = 0; i < 8; ++i) wv[i] = *(const GAS f32x4*)(W + (size_t)(k0 + 8 * i + (lane >> 3)) * N + c0 + n0 + 4 * (lane & 7));
#pragma unroll
    for (int i = 0; i < 8; ++i) { LAS float* d = scr + (8 * i + (lane >> 3)) * 33 + 4 * (lane & 7); d[0] = wv[i].x; d[1] = wv[i].y; d[2] = wv[i].z; d[3] = wv[i].w; }
    LDS_WAIT(); asm volatile("" ::: "memory");
#pragma unroll
    for (int j = 0; j < 4; ++j) { const int n = (lane >> 3) + 8 * j; const LAS float* s = scr + (8 * c) * 33 + n;
        v4u o; o.x = pk2(s[0 * 33] * g0.x, s[1 * 33] * g0.y); o.y = pk2(s[2 * 33] * g0.z, s[3 * 33] * g0.w); o.z = pk2(s[4 * 33] * g1.x, s[5 * 33] * g1.y); o.w = pk2(s[6 * 33] * g1.z, s[7 * 33] * g1.w);
        *(GAS v4u*)(WT + (size_t)(r0 + n0 + n) * K + k0 + 8 * c) = o; }
    LDS_WAIT(); asm volatile("" ::: "memory");
}
struct ConvSeg { const float* W; int K, N, c0, ncols; bf16* WT; int r0; const float* gain; };
__device__ __forceinline__ int seg_items(const ConvSeg& s) { return (s.K / 64) * (s.ncols / 32); }
struct SegC { int in_idx, K, N, c0, ncols, r0, gain_idx; unsigned wl_off; unsigned lstride; };
__device__ const SegC SEGC[10] = {
    {3, D, DIN, 0, 3072, 0, 24, (unsigned)WL_IN, (unsigned)(D * DIN)}, {3, D, DIN, 3072, 32, 0, 24, (unsigned)WL_Z, (unsigned)(D * DIN)}, {3, D, DIN, 3104, 1024, 3072, 24, (unsigned)WL_IN, (unsigned)(D * DIN)},
    {4, D, D, 0, D, 0, -1, (unsigned)WL_OUT, (unsigned)(D * D)}, {18, D, D, 0, D, 0, 27, (unsigned)WL_XQ, (unsigned)(D * D)}, {19, D, D, 0, D, 0, -1, (unsigned)WL_XK, (unsigned)(D * D)},
    {20, D, D, 0, D, 0, -1, (unsigned)WL_XV, (unsigned)(D * D)}, {21, D, D, 0, D, 0, -1, (unsigned)WL_XO, (unsigned)(D * D)}, {22, D, DFF, 0, DFF, 0, 29, (unsigned)WL_UP, (unsigned)(D * DFF)},
    {23, DFF, D, 0, D, 0, -1, (unsigned)WL_DOWN, (unsigned)(DFF * D)}};
__device__ const int SEG_START[11] = {0, 3072, 3104, 4128, 6176, 8224, 10272, 12320, 14368, 22560, 30752};
constexpr int CONV_ITEMS_PER_LAYER = 30752;
struct ConvDesc { const float* src; const float* gk; bf16* dst; int N, K; };

__device__ __forceinline__ void norm_row(int lane, const float* src, const float* g, bf16* xn, float* copy_dst) {
    const GAS f32x4* xr = (const GAS f32x4*)src + lane; const GAS f32x4* gr = (const GAS f32x4*)g + lane;
    f32x4 v[8]; float s = 0.f;
#pragma unroll
    for (int j = 0; j < 8; ++j) { v[j] = xr[64 * j]; s += (v[j].x * v[j].x + v[j].y * v[j].y) + (v[j].z * v[j].z + v[j].w * v[j].w); }
    const float r = rsqrtf(wave_sum(s, lane) * (1.f / D) + EPS);
    GAS v2u* o8 = (GAS v2u*)xn + lane;
#pragma unroll
    for (int j = 0; j < 8; ++j) { const f32x4 gg = gr[64 * j]; v2u w; w.x = pk2(v[j].x * r * gg.x, v[j].y * r * gg.y); w.y = pk2(v[j].z * r * gg.z, v[j].w * r * gg.w); o8[64 * j] = w;
        if (copy_dst) ((GAS f32x4*)copy_dst + lane)[64 * j] = v[j]; }
}
template <int NR>
__device__ __forceinline__ void init_rows(int lane, const float* x0, bf16* xb0, float* rs0, size_t row_stride) {
    f32x4 a[NR][4], b[NR][4];
#pragma unroll
    for (int i = 0; i < NR; ++i)
#pragma unroll
        for (int j = 0; j < 4; ++j) { const int ch = lane + 64 * j; const GAS f32x4* xr = (const GAS f32x4*)(x0 + i * row_stride * D); a[i][j] = xr[2 * ch]; b[i][j] = xr[2 * ch + 1]; }
#pragma unroll
    for (int i = 0; i < NR; ++i) { float s = 0.f; GAS v4u* ob = (GAS v4u*)(xb0 + i * row_stride * D);
#pragma unroll
        for (int j = 0; j < 4; ++j) { const int ch = lane + 64 * j; const f32x4 p = a[i][j], q = b[i][j];
            s += (p.x * p.x + p.y * p.y) + (p.z * p.z + p.w * p.w) + (q.x * q.x + q.y * q.y) + (q.z * q.z + q.w * q.w);
            v4u w; w.x = pk2(p.x, p.y); w.y = pk2(p.z, p.w); w.z = pk2(q.x, q.y); w.w = pk2(q.z, q.w); ob[ch] = w; }
        s = wave_sum(s, lane);
        if (lane == 0) rs0[i * row_stride] = rsqrtf(s * (1.f / D) + EPS); }
}
__device__ __forceinline__ void init_row(int lane, const float* x, bf16* xb, float* rs) {
    const GAS f32x4* xr = (const GAS f32x4*)x; GAS v4u* ob = (GAS v4u*)xb;
    float s = 0.f;
#pragma unroll
    for (int j = 0; j < 4; ++j) { const int ch = lane + 64 * j; const f32x4 a = xr[2 * ch], b = xr[2 * ch + 1];
        s += (a.x * a.x + a.y * a.y) + (a.z * a.z + a.w * a.w) + (b.x * b.x + b.y * b.y) + (b.z * b.z + b.w * b.w);
        v4u w; w.x = pk2(a.x, a.y); w.y = pk2(a.z, a.w); w.z = pk2(b.x, b.y); w.w = pk2(b.z, b.w); ob[ch] = w; }
    s = wave_sum(s, lane);
    if (lane == 0) *rs = rsqrtf(s * (1.f / D) + EPS);
}
__device__ __forceinline__ void resid_row(int lane, bf16* xb, const bf16* y, const float* g1, float* rs, float* outf) {
    GAS v4u* xr = (GAS v4u*)xb; const GAS v4u* yr = (const GAS v4u*)y; const GAS f32x4* gr = (const GAS f32x4*)g1;
    v4u xv[4], yv[4]; float s = 0.f;
#pragma unroll
    for (int j = 0; j < 4; ++j) { const int ch = lane + 64 * j; xv[j] = xr[ch]; yv[j] = yr[ch]; }
#pragma unroll
    for (int j = 0; j < 4; ++j) { const unsigned yy[4] = {yv[j].x, yv[j].y, yv[j].z, yv[j].w};
#pragma unroll
        for (int e = 0; e < 4; ++e) { const float a = bf2f((unsigned short)(yy[e] & 0xffffu)), b = bf2f((unsigned short)(yy[e] >> 16)); s += a * a + b * b; } }
    const float r = rsqrtf(wave_sum(s, lane) * (1.f / D) + EPS);
    float s2 = 0.f;
#pragma unroll
    for (int j = 0; j < 4; ++j) { const int ch = lane + 64 * j; const f32x4 ga = gr[2 * ch], gb = gr[2 * ch + 1];
        const float gg[8] = {ga.x, ga.y, ga.z, ga.w, gb.x, gb.y, gb.z, gb.w};
        const unsigned yy[4] = {yv[j].x, yv[j].y, yv[j].z, yv[j].w}, xx[4] = {xv[j].x, xv[j].y, xv[j].z, xv[j].w};
        float xn[8];
#pragma unroll
        for (int e = 0; e < 4; ++e) {
            xn[2 * e] = bf2f((unsigned short)(xx[e] & 0xffffu)) + bf2f((unsigned short)(yy[e] & 0xffffu)) * r * gg[2 * e];
            xn[2 * e + 1] = bf2f((unsigned short)(xx[e] >> 16)) + bf2f((unsigned short)(yy[e] >> 16)) * r * gg[2 * e + 1];
            s2 += xn[2 * e] * xn[2 * e] + xn[2 * e + 1] * xn[2 * e + 1]; }
        v4u w; w.x = pk2(xn[0], xn[1]); w.y = pk2(xn[2], xn[3]); w.z = pk2(xn[4], xn[5]); w.w = pk2(xn[6], xn[7]); xr[ch] = w;
        if (outf) { GAS f32x4* of = (GAS f32x4*)outf; of[2 * ch] = (f32x4){xn[0], xn[1], xn[2], xn[3]}; of[2 * ch + 1] = (f32x4){xn[4], xn[5], xn[6], xn[7]}; } }
    s2 = wave_sum(s2, lane);
    if (lane == 0) *rs = rsqrtf(s2 * (1.f / D) + EPS);
}
template <int NR>
__device__ __forceinline__ void resid_rows(int lane, bf16* xb0, const bf16* y0, size_t stride_el, const float* g1, float* rs0, size_t rs_stride, float* outf0) {
    v4u xv[NR][4], yv[NR][4];
#pragma unroll
    for (int i = 0; i < NR; ++i)
#pragma unroll
        for (int j = 0; j < 4; ++j) { const int ch = lane + 64 * j; xv[i][j] = ((const GAS v4u*)(xb0 + i * stride_el))[ch]; yv[i][j] = ((const GAS v4u*)(y0 + i * stride_el))[ch]; }
    f32x4 ga[4], gb[4];
#pragma unroll
    for (int j = 0; j < 4; ++j) { const int ch = lane + 64 * j; ga[j] = ((const GAS f32x4*)g1)[2 * ch]; gb[j] = ((const GAS f32x4*)g1)[2 * ch + 1]; }
#pragma unroll
    for (int i = 0; i < NR; ++i) {
        float s = 0.f;
#pragma unroll
        for (int j = 0; j < 4; ++j) { const unsigned yy[4] = {yv[i][j].x, yv[i][j].y, yv[i][j].z, yv[i][j].w};
#pragma unroll
            for (int e = 0; e < 4; ++e) { const float a = bf2f((unsigned short)(yy[e] & 0xffffu)), b = bf2f((unsigned short)(yy[e] >> 16)); s += a * a + b * b; } }
        const float r = rsqrtf(wave_sum(s, lane) * (1.f / D) + EPS);
        float s2 = 0.f;
        GAS v4u* xr = (GAS v4u*)(xb0 + i * stride_el);
#pragma unroll
        for (int j = 0; j < 4; ++j) { const int ch = lane + 64 * j;
            const float gg[8] = {ga[j].x, ga[j].y, ga[j].z, ga[j].w, gb[j].x, gb[j].y, gb[j].z, gb[j].w};
            const unsigned yy[4] = {yv[i][j].x, yv[i][j].y, yv[i][j].z, yv[i][j].w}, xx[4] = {xv[i][j].x, xv[i][j].y, xv[i][j].z, xv[i][j].w};
            float xn[8];
#pragma unroll
            for (int e = 0; e < 4; ++e) {
                xn[2 * e] = bf2f((unsigned short)(xx[e] & 0xffffu)) + bf2f((unsigned short)(yy[e] & 0xffffu)) * r * gg[2 * e];
                xn[2 * e + 1] = bf2f((unsigned short)(xx[e] >> 16)) + bf2f((unsigned short)(yy[e] >> 16)) * r * gg[2 * e + 1];
                s2 += xn[2 * e] * xn[2 * e] + xn[2 * e + 1] * xn[2 * e + 1]; }
            v4u w; w.x = pk2(xn[0], xn[1]); w.y = pk2(xn[2], xn[3]); w.z = pk2(xn[4], xn[5]); w.w = pk2(xn[6], xn[7]); xr[ch] = w;
            if (outf0) { GAS f32x4* of = (GAS f32x4*)(outf0 + i * stride_el); of[2 * ch] = (f32x4){xn[0], xn[1], xn[2], xn[3]}; of[2 * ch + 1] = (f32x4){xn[4], xn[5], xn[6], xn[7]}; } }
        s2 = wave_sum(s2, lane);
        if (lane == 0) rs0[i * rs_stride] = rsqrtf(s2 * (1.f / D) + EPS);
    }
}
__device__ __forceinline__ void zgemm(const Frame& F, const bf16* XN, const bf16* WZ, const float* RS, float* Z) {
    const int lane = F.lane, g = lane >> 4, c = lane & 15, w = F.wave, kq = w & 3;
    LAS f32x4* red = (LAS f32x4*)F.lds;
    for (int rb = F.bx; rb < M / 32; rb += F.G) {
        const int rt = rb * 2 + (w >> 2);
        const bf16* ap = XN + (size_t)(rt * 16 + c) * D + kq * 512 + g * 8;
        const bf16* b0 = WZ + (size_t)c * D + kq * 512 + g * 8; const bf16* b1p = WZ + (size_t)(16 + c) * D + kq * 512 + g * 8;
        f32x4 acc0 = {0.f, 0.f, 0.f, 0.f}, acc1 = {0.f, 0.f, 0.f, 0.f};
#pragma unroll 8
        for (int ks = 0; ks < 16; ++ks) { const bf16x8 a = *(const GAS bf16x8*)(ap + ks * 32), x = *(const GAS bf16x8*)(b0 + ks * 32), y = *(const GAS bf16x8*)(b1p + ks * 32);
            acc0 = __builtin_amdgcn_mfma_f32_16x16x32_bf16(a, x, acc0, 0, 0, 0); acc1 = __builtin_amdgcn_mfma_f32_16x16x32_bf16(a, y, acc1, 0, 0, 0); }
        LBAR();
        red[(w * 2 + 0) * 64 + lane] = acc0; red[(w * 2 + 1) * 64 + lane] = acc1;
        LBAR();
        if (kq == 0) {
#pragma unroll
            for (int ct = 0; ct < 2; ++ct) { f32x4 s = red[(w * 2 + ct) * 64 + lane];
#pragma unroll
                for (int q = 1; q < 4; ++q) s += red[((w + q) * 2 + ct) * 64 + lane];
#pragma unroll
                for (int r = 0; r < 4; ++r) { const int m = rt * 16 + 4 * g + r; Z[(size_t)m * 32 + ct * 16 + c] = s[r] * RS[m]; } }
        }
    }
}

#define XB_TMO      128
#define XB_XCNT(j)  (256  + 64 * (j))
#define XB_XSUB(j)  (1280 + 64 * (j))
#define XB_XGEN(j)  (2304 + 64 * (j))
#define XB_TOP      3328
#define XB_TOPGEN   3392
#define XCD_BAR_WORDS 3456
#define XB_SPIN_CAP (1u << 18)
#define LAS __attribute__((address_space(3)))

__device__ __forceinline__ unsigned xb_ld(unsigned* p)              { return __hip_atomic_load(p, __ATOMIC_RELAXED, __HIP_MEMORY_SCOPE_AGENT); }
__device__ __forceinline__ unsigned xb_add(unsigned* p, unsigned v) { return __hip_atomic_fetch_add(p, v, __ATOMIC_RELAXED, __HIP_MEMORY_SCOPE_AGENT); }
__device__ __forceinline__ unsigned xb_xcc_id() { return (unsigned)__builtin_amdgcn_s_getreg((3 << 11) | 20) & 0xFu; }
#define XB_SPIN(cond, bar) do { unsigned _sp = 0; while (cond) { __builtin_amdgcn_s_sleep(1); \
    if ((++_sp & 255u) == 0u) { if (xb_ld(&(bar)[XB_TMO])) break; if (_sp > XB_SPIN_CAP) { atomicAdd(&(bar)[XB_TMO], 1u); break; } } } } while (0)

struct XcdBarrier {
    unsigned* bar; unsigned x;
    volatile LAS unsigned* st;
};

__device__ __forceinline__ XcdBarrier xcd_barrier_post(unsigned* bar, volatile LAS unsigned* st) {
    XcdBarrier b; b.bar = bar; b.x = xb_xcc_id(); b.st = st;
    if (threadIdx.x == 0) (void)xb_add(&bar[XB_XCNT(b.x)], 1u);
    return b;
}
__device__ __forceinline__ void xcd_barrier_complete(unsigned* bar, unsigned x, unsigned& nloc, unsigned& nx) {
    const unsigned G = gridDim.x * gridDim.y * gridDim.z;
    unsigned sum, cnt, mine, sp = 0u;
    for (;;) {
        sum = 0u; cnt = 0u; mine = 0u;
#pragma unroll
        for (unsigned j = 0; j < 16; ++j) { const unsigned c = xb_ld(&bar[XB_XCNT(j)]); sum += c; cnt += (c > 0u) ? 1u : 0u; mine = (j == x) ? c : mine; }
        if (sum == G) break;
        __builtin_amdgcn_s_sleep(1);
        if ((++sp & 255u) == 0u) { if (xb_ld(&bar[XB_TMO])) break; if (sp > XB_SPIN_CAP) { atomicAdd(&bar[XB_TMO], 1u); break; } }
    }
    nloc = mine > 0u ? mine : 1u; nx = cnt > 0u ? cnt : 1u;
}

__device__ __forceinline__ void xcd_barrier(const XcdBarrier& b) {
    asm volatile("s_waitcnt vmcnt(0)" ::: "memory");
    __syncthreads();
    if (threadIdx.x == 0) {
        unsigned* bar = b.bar;
        __builtin_amdgcn_s_waitcnt(0);
        unsigned nloc = b.st[0], nx = b.st[1];
        if (nloc == 0u) { xcd_barrier_complete(bar, b.x, nloc, nx); b.st[0] = nloc; b.st[1] = nx; }
        const unsigned old = xb_add(&bar[XB_XSUB(b.x)], 1u);
        const unsigned gen = old / nloc;
        if (old + 1u == (gen + 1u) * nloc) {
            __builtin_amdgcn_fence(__ATOMIC_RELEASE, "agent");
            asm volatile("s_waitcnt vmcnt(0)" ::: "memory");
            const unsigned og = xb_add(&bar[XB_TOP], 1u);
            const unsigned tg = og / nx;
            if (og + 1u == (tg + 1u) * nx) xb_add(&bar[XB_TOPGEN], 1u);
            else XB_SPIN(xb_ld(&bar[XB_TOPGEN]) == tg, bar);
            __builtin_amdgcn_fence(__ATOMIC_ACQUIRE, "agent");
            xb_add(&bar[XB_XGEN(b.x)], 1u);
            asm volatile("s_waitcnt vmcnt(0)" ::: "memory");
        } else {
            XB_SPIN(xb_ld(&bar[XB_XGEN(b.x)]) == gen, bar);
            __builtin_amdgcn_fence(__ATOMIC_ACQUIRE, "agent");
            asm volatile("s_waitcnt vmcnt(0)" ::: "memory");
        }
    }
    __syncthreads();
}
__device__ __forceinline__ void conv_weights_phase(const Frame& F, const float* const CAS* inp, unsigned char* ws, int lc0, int lc1, LAS float* scr, int gw, int NGW) {
    {
                const int nflat = (lc1 - lc0) * CONV_ITEMS_PER_LAYER;
#define CONV_DESC(f_, d_) do { const int lc_ = lc0 + (f_) / CONV_ITEMS_PER_LAYER, r_ = (f_) % CONV_ITEMS_PER_LAYER; int s_ = 0; \
        _Pragma("unroll") for (int q_ = 1; q_ < 10; ++q_) s_ += (r_ >= SEG_START[q_]) ? 1 : 0; \
        const SegC sc_ = SEGC[s_]; const int it_ = r_ - SEG_START[s_], nblk_ = sc_.ncols / 32, kb_ = it_ / nblk_, nb_ = it_ % nblk_, k0_ = 64 * kb_, n0_ = 32 * nb_, c_ = F.lane & 7; \
        (d_).N = sc_.N; (d_).K = sc_.K; \
        (d_).src = inp[sc_.in_idx] + (size_t)lc_ * sc_.lstride + (size_t)(k0_ + (F.lane >> 3)) * sc_.N + sc_.c0 + n0_ + 4 * c_; \
        (d_).gk = sc_.gain_idx >= 0 ? inp[sc_.gain_idx] + (size_t)lc_ * D + k0_ + 8 * c_ : nullptr; \
        (d_).dst = (bf16*)(ws + WS_W + (size_t)(lc_ % NWL) * WL_BYTES + sc_.wl_off) + (size_t)(sc_.r0 + n0_ + (F.lane >> 3)) * sc_.K + k0_ + 8 * c_; } while (0)
#define CONV_LOAD(d_, wv_, g0_, g1_) do { _Pragma("unroll") for (int i_ = 0; i_ < 8; ++i_) wv_[i_] = *(const GAS f32x4*)((d_).src + (size_t)(8 * i_) * (d_).N); \
        g0_ = (f32x4){1.f, 1.f, 1.f, 1.f}; g1_ = g0_; if ((d_).gk) { g0_ = *(const GAS f32x4*)(d_).gk; g1_ = *(const GAS f32x4*)((d_).gk + 4); } } while (0)
#define CONV_STORE(d_, wv_, g0_, g1_) do { _Pragma("unroll") for (int i_ = 0; i_ < 8; ++i_) { LAS float* p_ = scr + (8 * i_ + (F.lane >> 3)) * 33 + 4 * (F.lane & 7); p_[0] = wv_[i_].x; p_[1] = wv_[i_].y; p_[2] = wv_[i_].z; p_[3] = wv_[i_].w; } \
        LDS_WAIT(); asm volatile("" ::: "memory"); \
        _Pragma("unroll") for (int j_ = 0; j_ < 4; ++j_) { const LAS float* s_ = scr + (8 * (F.lane & 7)) * 33 + (F.lane >> 3) + 8 * j_; \
            v4u o_; o_.x = pk2(s_[0 * 33] * g0_.x, s_[1 * 33] * g0_.y); o_.y = pk2(s_[2 * 33] * g0_.z, s_[3 * 33] * g0_.w); o_.z = pk2(s_[4 * 33] * g1_.x, s_[5 * 33] * g1_.y); o_.w = pk2(s_[6 * 33] * g1_.z, s_[7 * 33] * g1_.w); \
            *(GAS v4u*)((d_).dst + (size_t)(8 * j_) * (d_).K) = o_; } \
        LDS_WAIT(); asm volatile("" ::: "memory"); } while (0)
                ConvDesc dA, dB; f32x4 wA[8], wB[8], gA0, gA1, gB0, gB1;
                int f = gw;
                if (f < nflat) { CONV_DESC(f, dA); CONV_LOAD(dA, wA, gA0, gA1); }
                while (f < nflat) {
                    const int f1 = f + NGW;
                    if (f1 < nflat) { CONV_DESC(f1, dB); CONV_LOAD(dB, wB, gB0, gB1); }
                    CONV_STORE(dA, wA, gA0, gA1);
                    if (f1 >= nflat) break;
                    const int f2 = f1 + NGW;
                    if (f2 < nflat) { CONV_DESC(f2, dA); CONV_LOAD(dA, wA, gA0, gA1); }
                    CONV_STORE(dB, wB, gB0, gB1);
                    f = f2;
                }
#undef CONV_DESC
#undef CONV_LOAD
#undef CONV_STORE
            }
}
constexpr size_t MISC_DEC = 3 * MiB;
constexpr int GL_Z = 0, GL_TF = 8192, GL_TB = 10240, GL_VI = 12288, GL_A = 30720, GL_B = 39936, GL_P = 49152, GL_SI = 58368, GL_OF = 76800, GL_VS = 288;
__device__ __forceinline__ bf16x8 tr_frag(LAS unsigned char* p, int stride4) {
    const s16x4 lo = __builtin_amdgcn_ds_read_tr16_b64_v4i16((LAS s16x4*)p);
    const s16x4 hi = __builtin_amdgcn_ds_read_tr16_b64_v4i16((LAS s16x4*)(p + stride4));
    return __builtin_shufflevector(lo, hi, 0, 1, 2, 3, 4, 5, 6, 7);
}
struct GlaW { float wf[16], wb[16], bfv, bbv; };
__device__ __forceinline__ void gla_load_w(GlaW& W, int k, int h, const float* __restrict__ w2f, const float* __restrict__ b2f, const float* __restrict__ w2b, const float* __restrict__ b2b) {
#pragma unroll
    for (int r = 0; r < 16; ++r) { W.wf[r] = w2f[r * 256 + h * 64 + k]; W.wb[r] = w2b[r * 256 + h * 64 + k]; }
    W.bfv = b2f[h * 64 + k]; W.bbv = b2b[h * 64 + k];
}
__device__ __forceinline__ void gla_gates(const Frame& F, const f32x4 zreg, const GlaW& W, float (&cf)[8], float (&cb)[8], float& totf, float& totb) {
    LAS float* ZS = (LAS float*)(F.lds + GL_Z); LAS float* TF = (LAS float*)(F.lds + GL_TF); LAS float* TB = (LAS float*)(F.lds + GL_TB);
    const int tid = F.tid, k = tid & 63, tg = F.wave;
    ((LAS f32x4*)ZS)[tid] = zreg;
    LBAR();
#pragma unroll
    for (int i = 0; i < 8; ++i) { const int t = tg * 8 + i; float af = W.bfv, ab = W.bbv;
#pragma unroll
        for (int r = 0; r < 16; ++r) { af += ZS[t * 32 + r] * W.wf[r]; ab += ZS[t * 32 + 16 + r] * W.wb[r]; }
        cf[i] = -softplusf_(-af) * 0.0625f; cb[i] = -softplusf_(-ab) * 0.0625f; }
#pragma unroll
    for (int i = 1; i < 8; ++i) cf[i] += cf[i - 1];
#pragma unroll
    for (int i = 6; i >= 0; --i) cb[i] += cb[i + 1];
    TF[tg * 64 + k] = cf[7]; TB[tg * 64 + k] = cb[0];
    LBAR();
    float ef = 0.f, eb = 0.f; totf = 0.f; totb = 0.f;
#pragma unroll
    for (int g2 = 0; g2 < 8; ++g2) { const float a = TF[g2 * 64 + k], bq = TB[g2 * 64 + k]; totf += a; totb += bq; ef += (g2 < tg) ? a : 0.f; eb += (g2 > tg) ? bq : 0.f; }
#pragma unroll
    for (int i = 0; i < 8; ++i) { cf[i] += ef; cb[i] += eb; }
}
__device__ __forceinline__ void gla_load_v(const Frame& F, const bf16* __restrict__ PB, size_t m0, int h, v4u (&vr)[2]) {
#pragma unroll
    for (int i = 0; i < 2; ++i) { const int ch = F.tid + NTHREADS * i, row = ch >> 4, col = ch & 15; vr[i] = *(const GAS v4u*)(PB + (m0 + row) * NPB + O_BV + h * 128 + col * 8); }
}
__device__ __forceinline__ void gla_store_v(const Frame& F, const v4u (&vr)[2]) {
    LAS unsigned char* VI = F.lds + GL_VI;
#pragma unroll
    for (int i = 0; i < 2; ++i) { const int ch = F.tid + NTHREADS * i, row = ch >> 4, col = ch & 15; *(LAS v4u*)(VI + row * GL_VS + col * 16) = vr[i]; }
}
__device__ __forceinline__ void gla_u_phase(const Frame& F, const bf16* __restrict__ PB, const float* __restrict__ Z, const float* __restrict__ w2f, const float* __restrict__ b2f,
                                            const float* __restrict__ w2b, const float* __restrict__ b2b, float* __restrict__ U, float* __restrict__ DEC) {
    const int tid = F.tid, lane = F.lane, g = lane >> 4, c = lane & 15, w = F.wave, k = tid & 63, tg = F.wave;
    LAS unsigned char* VI = F.lds + GL_VI;
    GlaW W; int h_loaded = -1;
    for (int unit = F.bx; unit < BATCH * 4 * 32; unit += F.G) {
        const int b = unit >> 7, h = (unit >> 5) & 3, n = unit & 31;
        const size_t m0 = (size_t)b * SEQ + n * 64;
        if (h != h_loaded) { gla_load_w(W, k, h, w2f, b2f, w2b, b2b); h_loaded = h; }
        const f32x4 zreg = ((const GAS f32x4*)(Z + m0 * 32))[tid];
        unsigned short kraw[8];
#pragma unroll
        for (int i = 0; i < 8; ++i) kraw[i] = PB[(m0 + tg * 8 + i) * NPB + O_BK + h * 64 + k];
        v4u vr[2]; gla_load_v(F, PB, m0, h, vr);
        LBAR();
        float cf[8], cb[8], totf, totb;
        gla_gates(F, zreg, W, cf, cb, totf, totb);
#pragma unroll
        for (int i = 0; i < 8; ++i) { const int t = tg * 8 + i; const float kk = bf2f(kraw[i]);
            *(LAS unsigned short*)(F.lds + GL_A + t * 144 + k * 2) = (unsigned short)f2bf(kk * __expf(totf - cf[i]));
            *(LAS unsigned short*)(F.lds + GL_B + t * 144 + k * 2) = (unsigned short)f2bf(kk * __expf(totb - cb[i])); }
        const size_t ub = (size_t)(b * 4 + h) * 32 + n;
        if (tg == 0) { DEC[ub * 64 + k] = __expf(totf); DEC[(ub + 512) * 64 + k] = __expf(totb); }
        gla_store_v(F, vr);
        LBAR();
        bf16x8 vf[2];
#pragma unroll
        for (int ts = 0; ts < 2; ++ts) vf[ts] = tr_frag(VI + (32 * ts + 8 * g + (c >> 2)) * GL_VS + (16 * w + 4 * (c & 3)) * 2, 4 * GL_VS);
#pragma unroll
        for (int d = 0; d < 2; ++d) {
            LAS unsigned char* KS = F.lds + (d ? GL_B : GL_A);
            float* Ud = U + (ub + (size_t)d * 512) * 8192;
#pragma unroll
            for (int kt = 0; kt < 4; ++kt) {
                f32x4 acc = {0.f, 0.f, 0.f, 0.f};
#pragma unroll
                for (int ts = 0; ts < 2; ++ts) { const bf16x8 af = tr_frag(KS + (32 * ts + 8 * g + (c >> 2)) * 144 + (16 * kt + 4 * (c & 3)) * 2, 4 * 144);
                    acc = __builtin_amdgcn_mfma_f32_16x16x32_bf16(vf[ts], af, acc, 0, 0, 0); }
                *(GAS f32x4*)(Ud + (16 * kt + c) * 128 + 16 * w + 4 * g) = acc;
            }
        }
    }
}
__device__ __forceinline__ void gla_state_phase(const Frame& F, float* __restrict__ U, const float* __restrict__ DEC) {
    typedef float f32x2 __attribute__((ext_vector_type(2)));
    for (int id = F.bx * NTHREADS + F.tid; id < 32 * 64 * 64; id += F.G * NTHREADS) {
        const int seq = id >> 12, k = (id >> 6) & 63, e2 = id & 63, d = seq >> 4, bh = seq & 15;
        GAS f32x2* p0 = (GAS f32x2*)(U + ((size_t)d * 512 + bh * 32) * 8192 + k * 128) + e2;
        const float* d0 = DEC + ((size_t)d * 512 + bh * 32) * 64 + k;
        f32x2 u[32]; float dc[32];
#pragma unroll
        for (int n = 0; n < 32; ++n) { u[n] = p0[(size_t)n * 4096]; dc[n] = d0[n * 64]; }
        f32x2 S = {0.f, 0.f};
        if (d == 0) {
#pragma unroll
            for (int n = 0; n < 32; ++n) { const f32x2 t = u[n]; u[n] = S; S = S * dc[n] + t; }
        } else {
#pragma unroll
            for (int n = 31; n >= 0; --n) { const f32x2 t = u[n]; u[n] = S; S = S * dc[n] + t; }
        }
#pragma unroll
        for (int n = 0; n < 32; ++n) p0[(size_t)n * 4096] = u[n];
    }
}
__device__ __forceinline__ void gla_o_phase(const Frame& F, const bf16* __restrict__ PB, const float* __restrict__ Z, const float* __restrict__ w2f, const float* __restrict__ b2f,
                                            const float* __restrict__ w2b, const float* __restrict__ b2b, const float* __restrict__ U, const float* __restrict__ gn, bf16* __restrict__ MIX) {
    const int tid = F.tid, lane = F.lane, g = lane >> 4, c = lane & 15, w = F.wave, k = tid & 63, tg = F.wave;
    LAS unsigned char* VI = F.lds + GL_VI; LAS unsigned char* QI = F.lds + GL_A; LAS unsigned char* KI = F.lds + GL_B; LAS unsigned char* PI = F.lds + GL_P; LAS unsigned char* SI = F.lds + GL_SI;
    LAS float* OF = (LAS float*)(F.lds + GL_OF);
    GlaW W; int h_loaded = -1;
    for (int unit = F.bx; unit < BATCH * 4 * 32; unit += F.G) {
        const int b = unit >> 7, h = (unit >> 5) & 3, n = unit & 31;
        const size_t m0 = (size_t)b * SEQ + n * 64;
        const size_t ub = (size_t)(b * 4 + h) * 32 + n;
        if (h != h_loaded) { gla_load_w(W, k, h, w2f, b2f, w2b, b2b); h_loaded = h; }
        const f32x4 zreg = ((const GAS f32x4*)(Z + m0 * 32))[tid];
        unsigned short qraw[8], kraw[8];
#pragma unroll
        for (int i = 0; i < 8; ++i) { qraw[i] = PB[(m0 + tg * 8 + i) * NPB + O_BQ + h * 64 + k]; kraw[i] = PB[(m0 + tg * 8 + i) * NPB + O_BK + h * 64 + k]; }
        v4u vr[2]; gla_load_v(F, PB, m0, h, vr);
        f32x4 sreg[2][4];
#pragma unroll
        for (int d = 0; d < 2; ++d) { const GAS f32x4* sp = (const GAS f32x4*)(U + (ub + (size_t)d * 512) * 8192 + (tid >> 3) * 128 + (tid & 7) * 16);
#pragma unroll
            for (int q4 = 0; q4 < 4; ++q4) sreg[d][q4] = sp[q4]; }
        const v4u g0 = *(const GAS v4u*)(PB + (m0 + (tid >> 3)) * NPB + O_BG + h * 128 + (tid & 7) * 16), g1 = *(const GAS v4u*)(PB + (m0 + (tid >> 3)) * NPB + O_BG + h * 128 + (tid & 7) * 16 + 8);
        LBAR();
        float cf[8], cb[8], totf, totb;
        gla_gates(F, zreg, W, cf, cb, totf, totb);
        float qv[8], kv[8];
#pragma unroll
        for (int i = 0; i < 8; ++i) { qv[i] = bf2f(qraw[i]) * 0.125f; kv[i] = bf2f(kraw[i]); }
        gla_store_v(F, vr);
        f32x4 acc[4];
#pragma unroll
        for (int tt = 0; tt < 4; ++tt) acc[tt] = (f32x4){0.f, 0.f, 0.f, 0.f};
#pragma unroll
        for (int d = 0; d < 2; ++d) {
            LBAR();
#pragma unroll
            for (int i = 0; i < 8; ++i) { const int t = tg * 8 + i; const float cc = d ? cb[i] : cf[i];
                *(LAS unsigned short*)(QI + t * 144 + k * 2) = (unsigned short)f2bf(qv[i] * __expf(cc));
                *(LAS unsigned short*)(KI + t * 144 + k * 2) = (unsigned short)f2bf(kv[i] * __expf(-cc)); }
            {   const int row = tid >> 3, c16 = (tid & 7) * 16;
                const f32x4 s0 = sreg[d][0], s1 = sreg[d][1], s2 = sreg[d][2], s3 = sreg[d][3];
                v4u o0, o1; o0.x = pk2(s0.x, s0.y); o0.y = pk2(s0.z, s0.w); o0.z = pk2(s1.x, s1.y); o0.w = pk2(s1.z, s1.w); o1.x = pk2(s2.x, s2.y); o1.y = pk2(s2.z, s2.w); o1.z = pk2(s3.x, s3.y); o1.w = pk2(s3.z, s3.w);
                *(LAS v4u*)(SI + row * GL_VS + c16 * 2) = o0; *(LAS v4u*)(SI + row * GL_VS + c16 * 2 + 16) = o1; }
            LBAR();
#pragma unroll
            for (int q2 = 0; q2 < 2; ++q2) {
                const int id = 2 * w + q2, tt = id >> 2, jt = id & 3;
                f32x4 p = {0.f, 0.f, 0.f, 0.f};
#pragma unroll
                for (int ks = 0; ks < 2; ++ks) { const bf16x8 a = *(const LAS bf16x8*)(QI + (16 * tt + c) * 144 + ks * 64 + g * 16), bb = *(const LAS bf16x8*)(KI + (16 * jt + c) * 144 + ks * 64 + g * 16);
                    p = __builtin_amdgcn_mfma_f32_16x16x32_bf16(a, bb, p, 0, 0, 0); }
#pragma unroll
                for (int r = 0; r < 4; ++r) { const int t = 16 * tt + 4 * g + r, j = 16 * jt + c; const bool keep = d ? (j > t) : (j <= t);
                    *(LAS unsigned short*)(PI + t * 144 + j * 2) = (unsigned short)f2bf(keep ? p[r] : 0.f); }
            }
            LBAR();
            bf16x8 vf[2], sf[2];
#pragma unroll
            for (int s2 = 0; s2 < 2; ++s2) { vf[s2] = tr_frag(VI + (32 * s2 + 8 * g + (c >> 2)) * GL_VS + (16 * w + 4 * (c & 3)) * 2, 4 * GL_VS);
                sf[s2] = tr_frag(SI + (32 * s2 + 8 * g + (c >> 2)) * GL_VS + (16 * w + 4 * (c & 3)) * 2, 4 * GL_VS); }
#pragma unroll
            for (int tt = 0; tt < 4; ++tt)
#pragma unroll
                for (int s2 = 0; s2 < 2; ++s2) { const bf16x8 pa = *(const LAS bf16x8*)(PI + (16 * tt + c) * 144 + s2 * 64 + g * 16), qa = *(const LAS bf16x8*)(QI + (16 * tt + c) * 144 + s2 * 64 + g * 16);
                    acc[tt] = __builtin_amdgcn_mfma_f32_16x16x32_bf16(pa, vf[s2], acc[tt], 0, 0, 0);
                    acc[tt] = __builtin_amdgcn_mfma_f32_16x16x32_bf16(qa, sf[s2], acc[tt], 0, 0, 0); }
        }
#pragma unroll
        for (int tt = 0; tt < 4; ++tt)
#pragma unroll
            for (int r = 0; r < 4; ++r) OF[(16 * tt + 4 * g + r) * 132 + 16 * w + c] = acc[tt][r];
        LBAR();
        {   const int t = tid >> 3, c16 = (tid & 7) * 16;
            float o[16]; float ss = 0.f;
#pragma unroll
            for (int e = 0; e < 16; ++e) { o[e] = OF[t * 132 + c16 + e]; ss += o[e] * o[e]; }
            ss += lane_xor_f(ss, 1, lane); ss += lane_xor_f(ss, 2, lane); ss += lane_xor_f(ss, 4, lane);
            const float rs = rsqrtf(ss * (1.f / 128.f) + EPS);
            const unsigned gg[8] = {g0.x, g0.y, g0.z, g0.w, g1.x, g1.y, g1.z, g1.w};
            unsigned oo[8];
#pragma unroll
            for (int e = 0; e < 8; ++e) { const float ga = bf2f((unsigned short)(gg[e] & 0xffffu)), gb = bf2f((unsigned short)(gg[e] >> 16));
                oo[e] = pk2(o[2 * e] * rs * gn[h * 128 + c16 + 2 * e] * (ga * sigmoidf_(ga)), o[2 * e + 1] * rs * gn[h * 128 + c16 + 2 * e + 1] * (gb * sigmoidf_(gb))); }
            v4u o0, o1; o0.x = oo[0]; o0.y = oo[1]; o0.z = oo[2]; o0.w = oo[3]; o1.x = oo[4]; o1.y = oo[5]; o1.z = oo[6]; o1.w = oo[7];
            *(GAS v4u*)(MIX + (m0 + t) * D + 1024 + h * 128 + c16) = o0; *(GAS v4u*)(MIX + (m0 + t) * D + 1024 + h * 128 + c16 + 8) = o1;
        }
    }
}
constexpr int LRU_LD = 132;
constexpr size_t MISC_CAR_A = 0, MISC_CAR_H = 1 * MiB, MISC_CIN = 2 * MiB, MISC_RS = 4 * MiB;
__device__ __forceinline__ void lru_phase(const Frame& F, const bf16* __restrict__ PB, const bf16* __restrict__ LRUG, const float* __restrict__ cw, const float* __restrict__ cb,
                                          const float* __restrict__ ba, const float* __restrict__ bx, const float* __restrict__ lam, float* __restrict__ CAR_A, float* __restrict__ CAR_H,
                                          bf16* __restrict__ LS, bf16* __restrict__ LPF, bf16* __restrict__ LPB) {
    LAS float* XF = (LAS float*)(F.lds);
    LAS float* AS = (LAS float*)(F.lds + 33792);
    LAS float* US = (LAS float*)(F.lds + 2 * 33792);
    LAS unsigned char* XB = F.lds + 3 * 33792;
    LAS unsigned short* PT = (LAS unsigned short*)(F.lds + 3 * 33792 + 17408);
    const int tid = F.tid, lane = F.lane, g4 = lane >> 4, c = lane & 15, w = F.wave;
    const bool g_const = (F.G & 3) == 0;
    int g_loaded = -1;
    bf16x8 waf[2][4], wxf[2][4]; float bav[2], bxv[2], spv[2], w0[4], w1[4], cb0 = 0.f, cb1 = 0.f;
    for (int unit = F.bx; unit < BATCH * 32 * 4; unit += F.G) {
        const int b = unit >> 7, n = (unit >> 2) & 31, g = unit & 3, t0 = n * 64;
        if (!g_const || g != g_loaded) {
            const int j = 16 * w + c, chj = g * 128 + j;
#pragma unroll
            for (int s = 0; s < 2; ++s) {
                const bf16* wap = LRUG + ((size_t)((s * 2 + 0) * 4 + g) * 128 + j) * 128 + g4 * 8;
                const bf16* wxp = LRUG + ((size_t)((s * 2 + 1) * 4 + g) * 128 + j) * 128 + g4 * 8;
#pragma unroll
                for (int ks = 0; ks < 4; ++ks) { waf[s][ks] = *(const GAS bf16x8*)(wap + ks * 32); wxf[s][ks] = *(const GAS bf16x8*)(wxp + ks * 32); }
                bav[s] = ba[s * 512 + chj]; bxv[s] = bx[s * 512 + chj]; spv[s] = softplusf_(-lam[s * 512 + chj]);
            }
            const int ch = g * 128 + 2 * (tid & 63);
#pragma unroll
            for (int jj = 0; jj < 4; ++jj) { w0[jj] = cw[jj * 512 + ch]; w1[jj] = cw[jj * 512 + ch + 1]; }
            cb0 = cb[ch]; cb1 = cb[ch + 1];
            g_loaded = g;
        }
        LBAR();
        {
            const int ch2 = tid & 63, tb = (tid >> 6) * 8, ch = g * 128 + 2 * ch2;
            const float b0 = cb0, b1 = cb1;
            float x0[11], x1[11];
#pragma unroll
            for (int i = 0; i < 11; ++i) { const int t = t0 + tb - 2 + i; unsigned v = 0u; if (t >= 0 && t < SEQ) v = *(const GAS unsigned*)(PB + (size_t)(b * SEQ + t) * NPB + PB_CX + ch);
                x0[i] = bf2f((unsigned short)(v & 0xffffu)); x1[i] = bf2f((unsigned short)(v >> 16)); }
#pragma unroll
            for (int r = 0; r < 8; ++r) { float y0 = b0, y1 = b1;
#pragma unroll
                for (int j = 0; j < 4; ++j) { y0 += x0[r + j] * w0[j]; y1 += x1[r + j] * w1[j]; }
                XF[(tb + r) * LRU_LD + 2 * ch2] = y0; XF[(tb + r) * LRU_LD + 2 * ch2 + 1] = y1;
                *(LAS unsigned*)(XB + (tb + r) * 272 + ch2 * 4) = pk2(y0, y1); }
        }
        LBAR();
#pragma unroll
        for (int s = 0; s < 2; ++s) {
            if (s == 1) {
                const int t = tid >> 3, c16 = (tid & 7) * 16; const size_t m = (size_t)b * SEQ + t0 + t;
                const v4u p0 = *(const LAS v4u*)(PT + t * 128 + c16), p1 = *(const LAS v4u*)(PT + t * 128 + c16 + 8);
                *(GAS v4u*)(LPF + m * 512 + g * 128 + c16) = p0; *(GAS v4u*)(LPF + m * 512 + g * 128 + c16 + 8) = p1; }
            {
                const int j = 16 * w + c;
                LAS float* U = s == 0 ? US : XF;
#pragma unroll
                for (int tt = 0; tt < 4; ++tt) {
                    f32x4 ga = {0.f, 0.f, 0.f, 0.f}, gx = {0.f, 0.f, 0.f, 0.f};
#pragma unroll
                    for (int ks = 0; ks < 4; ++ks) { const bf16x8 xf = *(const LAS bf16x8*)(XB + (16 * tt + c) * 272 + ks * 64 + g4 * 16);
                        ga = __builtin_amdgcn_mfma_f32_16x16x32_bf16(xf, waf[s][ks], ga, 0, 0, 0); gx = __builtin_amdgcn_mfma_f32_16x16x32_bf16(xf, wxf[s][ks], gx, 0, 0, 0); }
#pragma unroll
                    for (int r = 0; r < 4; ++r) { const int t = 16 * tt + 4 * g4 + r;
                        const float rg = sigmoidf_(ga[r] + bav[s]), ig = sigmoidf_(gx[r] + bxv[s]);
                        const float a = __builtin_amdgcn_exp2f(-8.f * 1.4426950408889634f * rg * spv[s]);
                        const float xv = XF[t * LRU_LD + j];
                        AS[t * LRU_LD + j] = a; U[t * LRU_LD + j] = __builtin_amdgcn_sqrtf(fmaxf(1.f - a * a, 0.f)) * (ig * xv); }
                }
            }
            LBAR();
            if (tid < 128) {
                LAS float* U = s == 0 ? US : XF;
                const size_t ci = ((size_t)((s * BATCH + b) * 32 + n)) * 512 + g * 128 + tid;
                float h = 0.f, ap = 1.f;
#pragma unroll 8
                for (int st = 0; st < 64; ++st) { const int t = s ? 63 - st : st; const float a = AS[t * LRU_LD + tid], u = U[t * LRU_LD + tid]; h = a * h + u; ap *= a;
                    PT[t * 128 + tid] = (unsigned short)f2bf(ap);
                    if (s == 0) US[t * LRU_LD + tid] = h; else US[t * LRU_LD + tid] += h; }
                CAR_A[ci] = ap; CAR_H[ci] = h;
            }
            LBAR();
        }
        {
            const int t = tid >> 3, c16 = (tid & 7) * 16;
            const size_t m = (size_t)b * SEQ + t0 + t;
            unsigned oo[8];
#pragma unroll
            for (int e = 0; e < 8; ++e) oo[e] = pk2(US[t * LRU_LD + c16 + 2 * e], US[t * LRU_LD + c16 + 2 * e + 1]);
            v4u o0, o1; o0.x = oo[0]; o0.y = oo[1]; o0.z = oo[2]; o0.w = oo[3]; o1.x = oo[4]; o1.y = oo[5]; o1.z = oo[6]; o1.w = oo[7];
            *(GAS v4u*)(LS + m * 512 + g * 128 + c16) = o0; *(GAS v4u*)(LS + m * 512 + g * 128 + c16 + 8) = o1;
            const v4u p0 = *(const LAS v4u*)(PT + t * 128 + c16), p1 = *(const LAS v4u*)(PT + t * 128 + c16 + 8);
            *(GAS v4u*)(LPB + m * 512 + g * 128 + c16) = p0; *(GAS v4u*)(LPB + m * 512 + g * 128 + c16 + 8) = p1;
        }
    }
}
__device__ __forceinline__ void lru_out_phase(const Frame& F, const bf16* __restrict__ PB, const bf16* __restrict__ LS, const bf16* __restrict__ LPF, const bf16* __restrict__ LPB, const float* __restrict__ CIN, bf16* __restrict__ MIX) {
    for (int task = F.bx * NTHREADS + F.tid; task < M * 64; task += F.G * NTHREADS) {
        const int m = task >> 6, c8 = (task & 63) * 8, b = m / SEQ, n = (m % SEQ) >> 6;
        const v4u sv = *(const GAS v4u*)(LS + (size_t)m * 512 + c8), pf = *(const GAS v4u*)(LPF + (size_t)m * 512 + c8), pb = *(const GAS v4u*)(LPB + (size_t)m * 512 + c8);
        const v4u yv = *(const GAS v4u*)(PB + (size_t)m * NPB + PB_CY + c8);
        const GAS f32x4* cfp = (const GAS f32x4*)(CIN + ((size_t)((0 * BATCH + b) * 32 + n)) * 512 + c8); const GAS f32x4* cbp = (const GAS f32x4*)(CIN + ((size_t)((1 * BATCH + b) * 32 + n)) * 512 + c8);
        const f32x4 cf0 = cfp[0], cf1 = cfp[1], cb0 = cbp[0], cb1 = cbp[1];
        const float cf[8] = {cf0.x, cf0.y, cf0.z, cf0.w, cf1.x, cf1.y, cf1.z, cf1.w}, cbv[8] = {cb0.x, cb0.y, cb0.z, cb0.w, cb1.x, cb1.y, cb1.z, cb1.w};
        const unsigned ss[4] = {sv.x, sv.y, sv.z, sv.w}, pp[4] = {pf.x, pf.y, pf.z, pf.w}, qq[4] = {pb.x, pb.y, pb.z, pb.w}, yy[4] = {yv.x, yv.y, yv.z, yv.w};
        unsigned oo[4];
#pragma unroll
        for (int e = 0; e < 4; ++e) {
            const float h0 = bf2f((unsigned short)(ss[e] & 0xffffu)) + bf2f((unsigned short)(pp[e] & 0xffffu)) * cf[2 * e] + bf2f((unsigned short)(qq[e] & 0xffffu)) * cbv[2 * e];
            const float h1 = bf2f((unsigned short)(ss[e] >> 16)) + bf2f((unsigned short)(pp[e] >> 16)) * cf[2 * e + 1] + bf2f((unsigned short)(qq[e] >> 16)) * cbv[2 * e + 1];
            oo[e] = pk2(h0 * gelu_tanh(bf2f((unsigned short)(yy[e] & 0xffffu))), h1 * gelu_tanh(bf2f((unsigned short)(yy[e] >> 16)))); }
        v4u o; o.x = oo[0]; o.y = oo[1]; o.z = oo[2]; o.w = oo[3];
        *(GAS v4u*)(MIX + (size_t)m * D + 1536 + c8) = o;
    }
}
__device__ __forceinline__ void lru_carry_phase(const Frame& F, const float* __restrict__ CAR_A, const float* __restrict__ CAR_H, float* __restrict__ CIN) {
    const int id = F.bx * NTHREADS + F.tid;
    if (id < 2 * BATCH * 512) {
        const int s = id >> 11, b = (id >> 9) & 3, ch = id & 511;
        const size_t base = ((size_t)((s * BATCH + b) * 32)) * 512 + ch;
        float av[32], hv[32];
#pragma unroll
        for (int n = 0; n < 32; ++n) { av[n] = CAR_A[base + (size_t)n * 512]; hv[n] = CAR_H[base + (size_t)n * 512]; }
        float h = 0.f;
        if (s == 0) {
#pragma unroll
            for (int n = 0; n < 32; ++n) { const float t = hv[n]; hv[n] = h; h = av[n] * h + t; }
        } else {
#pragma unroll
            for (int n = 31; n >= 0; --n) { const float t = hv[n]; hv[n] = h; h = av[n] * h + t; }
        }
#pragma unroll
        for (int n = 0; n < 32; ++n) CIN[base + (size_t)n * 512] = hv[n];
    }
}
#define WA_LOAD(colbase, u_) do { const int b_ = (u_) >> 7, hkv_ = (((u_) >> 4) & 7) >> 2, q0_ = ((u_) & 15) * 128; \
    _Pragma("unroll") for (int i_ = 0; i_ < 12; ++i_) { const int ch_ = tid + NTHREADS * i_, r_ = ch_ >> 4, col_ = ch_ & 15; int j_ = q0_ - 128 + r_; j_ = j_ < 0 ? 0 : (j_ > SEQ - 1 ? SEQ - 1 : j_); \
        kreg[i_] = *(const GAS v4u*)(PB + (size_t)(b_ * SEQ + j_) * NPB + (colbase) + hkv_ * 128 + col_ * 8); } } while (0)
#define WA_STORE(stride_) do { _Pragma("unroll") for (int i_ = 0; i_ < 12; ++i_) { const int ch_ = tid + NTHREADS * i_, r_ = ch_ >> 4, col_ = ch_ & 15; \
        *(LAS v4u*)(KS + r_ * (stride_) + col_ * 16) = kreg[i_]; } } while (0)
__device__ __forceinline__ void wattn_phase(const Frame& F, const bf16* __restrict__ PB, const float* __restrict__ rel_bias, const float* __restrict__ sink, bf16* __restrict__ MIX) {
    LAS unsigned char* KS = F.lds;
    LAS float* btab = (LAS float*)(F.lds + 384 * 288);
    const int lane = F.lane, g = lane >> 4, c = lane & 15, w = F.wave, tid = F.tid;
    constexpr int NUNITS = BATCH * 8 * (SEQ / 128);
    v4u kreg[12];
    int unit = F.bx, bias_hq = -1; float snk = 0.f;
    if (unit < NUNITS) WA_LOAD(O_AK, unit);
    while (unit < NUNITS) {
        const int b = unit >> 7, hq = (unit >> 4) & 7, qb = unit & 15;
        const int q0 = qb * 128;
        LBAR();
        WA_STORE(272);
        if (hq != bias_hq) { if (tid < 304) { const int rel = tid - 143; btab[tid] = (rel >= -128 && rel <= 128) ? rel_bias[t5_bucket(rel) * 8 + hq] : -1e30f; } snk = sink[hq]; bias_hq = hq; }
        LBAR();
        const bf16* qrow = PB + (size_t)(b * SEQ + q0 + 16 * w + c) * NPB + O_AQ + hq * 128 + g * 8;
        bf16x8 qfr[4];
#pragma unroll
        for (int ks = 0; ks < 4; ++ks) qfr[ks] = *(const GAS bf16x8*)(qrow + ks * 32);
        WA_LOAD(O_AV, unit);
        f32x4 S[17];
#pragma unroll
        for (int kt = 0; kt < 17; ++kt) S[kt] = (f32x4){0.f, 0.f, 0.f, 0.f};
#pragma unroll
        for (int ks = 0; ks < 4; ++ks) {
            const bf16x8 qf = qfr[ks];
#pragma unroll
            for (int kt = 0; kt < 17; ++kt) { const bf16x8 kf = *(const LAS bf16x8*)(KS + (16 * w + 16 * kt + c) * 272 + ks * 64 + g * 16); S[kt] = __builtin_amdgcn_mfma_f32_16x16x32_bf16(kf, qf, S[kt], 0, 0, 0);
                if (kt == 8 || kt == 16) __builtin_amdgcn_sched_barrier(0); }
        }
        float mx = snk;
        const int row_lo = (qb == 0) ? 128 : 0, row_n = ((qb == SEQ / 128 - 1) ? 256 : 384) - row_lo;
#pragma unroll
        for (int kt = 0; kt < 17; ++kt)
#pragma unroll
            for (int r = 0; r < 4; ++r) {
                const int row = 16 * w + 16 * kt + 4 * g + r;
                const float bias = btab[(4 * g - c + 15) + 16 * kt + r];
                const float s = ((unsigned)(row - row_lo) < (unsigned)row_n) ? S[kt][r] * 0.08838834764831845f + bias : -1e30f;
                S[kt][r] = s; mx = fmaxf(mx, s);
                if (r == 3 && (kt & 1)) __builtin_amdgcn_sched_barrier(0);
            }
        mx = fmaxf(mx, lane_xor_f(mx, 16, lane)); mx = fmaxf(mx, lane_xor_f(mx, 32, lane));
        float sum = 0.f;
#pragma unroll
        for (int kt = 0; kt < 17; ++kt)
#pragma unroll
            for (int r = 0; r < 4; ++r) { const float p = __builtin_amdgcn_exp2f((S[kt][r] - mx) * 1.4426950408889634f); S[kt][r] = p; sum += p; }
        sum += lane_xor_f(sum, 16, lane); sum += lane_xor_f(sum, 32, lane);
        sum += __builtin_amdgcn_exp2f((snk - mx) * 1.4426950408889634f);
        const float inv = 1.f / sum;
        bf16x8 pf[9];
#pragma unroll
        for (int s = 0; s < 9; ++s) { v4u t; t.x = pk2(S[2 * s][0] * inv, S[2 * s][1] * inv); t.y = pk2(S[2 * s][2] * inv, S[2 * s][3] * inv);
            if (s < 8) { t.z = pk2(S[2 * s + 1][0] * inv, S[2 * s + 1][1] * inv); t.w = pk2(S[2 * s + 1][2] * inv, S[2 * s + 1][3] * inv); } else { t.z = 0u; t.w = 0u; }
            pf[s] = __builtin_bit_cast(bf16x8, t); }
        LBAR();
        WA_STORE(288);
        LBAR();
        const int nxt = unit + F.G;
        if (nxt < NUNITS) WA_LOAD(O_AK, nxt);
        for (int dt = 0; dt < 8; ++dt) {
            f32x4 acc = {0.f, 0.f, 0.f, 0.f};
#pragma unroll
            for (int s = 0; s < 9; ++s) {
                LAS unsigned char* vp = KS + (16 * w + 32 * s + 4 * g + (c >> 2)) * 288 + (16 * dt + 4 * (c & 3)) * 2;
                const s16x4 lo = __builtin_amdgcn_ds_read_tr16_b64_v4i16((LAS s16x4*)vp);
                const s16x4 hi = __builtin_amdgcn_ds_read_tr16_b64_v4i16((LAS s16x4*)(vp + (s < 8 ? 16 * 288 : 0)));
                const bf16x8 vf = __builtin_shufflevector(lo, hi, 0, 1, 2, 3, 4, 5, 6, 7);
                acc = __builtin_amdgcn_mfma_f32_16x16x32_bf16(vf, pf[s], acc, 0, 0, 0);
            }
            v2u o; o.x = pk2(acc[0], acc[1]); o.y = pk2(acc[2], acc[3]);
            *(GAS v2u*)(MIX + (size_t)(b * SEQ + q0 + 16 * w + c) * D + hq * 128 + dt * 16 + 4 * g) = o;
        }
        unit = nxt;
    }
}
#undef WA_LOAD
#undef WA_STORE
#define XA_LOAD(u_, st_) do { const int b_ = (u_) >> 6, h_ = ((u_) >> 4) & 3; \
    if ((st_) < 4) { _Pragma("unroll") for (int i_ = 0; i_ < 8; ++i_) { const int row_ = (tid >> 4) + 32 * i_, col_ = tid & 15; \
            R[i_] = *(const GAS v4u*)(KX + (size_t)(b_ * MEM_LEN + row_) * D + h_ * 512 + (st_) * 128 + col_ * 8); } } \
    else { _Pragma("unroll") for (int i_ = 0; i_ < 8; ++i_) { const int row_ = (tid >> 5) + 16 * i_, col_ = tid & 31; \
            R[i_] = *(const GAS v4u*)(VT + (size_t)(h_ * 512 + ((st_) - 4) * 128 + row_) * MM + b_ * MEM_LEN + col_ * 8); } } } while (0)
#define XA_STORE(st_) do { if ((st_) < 4) { _Pragma("unroll") for (int i_ = 0; i_ < 8; ++i_) { const int row_ = (tid >> 4) + 32 * i_, col_ = tid & 15; *(LAS v4u*)(KS + row_ * 272 + col_ * 16) = R[i_]; } } \
    else { _Pragma("unroll") for (int i_ = 0; i_ < 8; ++i_) { const int row_ = (tid >> 5) + 16 * i_, col_ = tid & 31; *(LAS v4u*)(KS + row_ * 528 + col_ * 16) = R[i_]; } } } while (0)
__device__ __forceinline__ void xattn_phase(const Frame& F, const bf16* __restrict__ Q, const bf16* __restrict__ KX, const bf16* __restrict__ VT, bf16* __restrict__ O) {
    LAS unsigned char* KS = F.lds;
    const int lane = F.lane, g = lane >> 4, c = lane & 15, w = F.wave, tid = F.tid;
    constexpr int NUNITS = BATCH * 4 * (SEQ / 128);
    v4u R[8];
    int unit = F.bx;
    if (unit < NUNITS) XA_LOAD(unit, 0);
    while (unit < NUNITS) {
        const int b = unit >> 6, h = (unit >> 4) & 3, qb = unit & 15;
        const int m0 = b * SEQ + qb * 128 + w * 16;
        const int nxt = unit + F.G;
        f32x4 S[16];
#pragma unroll
        for (int kt = 0; kt < 16; ++kt) S[kt] = (f32x4){0.f, 0.f, 0.f, 0.f};
        const bf16* qrow = Q + (size_t)(m0 + c) * D + h * 512 + g * 8;
#pragma unroll
        for (int dc = 0; dc < 4; ++dc) {
            bf16x8 qf[4];
#pragma unroll
            for (int ks = 0; ks < 4; ++ks) qf[ks] = *(const GAS bf16x8*)(qrow + dc * 128 + ks * 32);
            LBAR();
            XA_STORE(dc);
            LBAR();
            XA_LOAD(unit, dc + 1);
#pragma unroll
            for (int ks = 0; ks < 4; ++ks) {
#pragma unroll
                for (int kt = 0; kt < 16; ++kt) { const bf16x8 kf = *(const LAS bf16x8*)(KS + (16 * kt + c) * 272 + ks * 64 + g * 16); S[kt] = __builtin_amdgcn_mfma_f32_16x16x32_bf16(kf, qf[ks], S[kt], 0, 0, 0); }
            }
        }
        float mx = -3.0e38f;
#pragma unroll
        for (int kt = 0; kt < 16; ++kt)
#pragma unroll
            for (int r = 0; r < 4; ++r) mx = fmaxf(mx, S[kt][r]);
        mx = fmaxf(mx, lane_xor_f(mx, 16, lane)); mx = fmaxf(mx, lane_xor_f(mx, 32, lane));
        const float sc2 = 0.044194173824159216f * 1.4426950408889634f;
        float sum = 0.f;
#pragma unroll
        for (int kt = 0; kt < 16; ++kt)
#pragma unroll
            for (int r = 0; r < 4; ++r) { const float p = __builtin_amdgcn_exp2f((S[kt][r] - mx) * sc2); S[kt][r] = p; sum += p; }
        sum += lane_xor_f(sum, 16, lane); sum += lane_xor_f(sum, 32, lane);
        const float inv = 1.f / sum;
        bf16x8 pf[8];
#pragma unroll
        for (int s = 0; s < 8; ++s) { v4u t; t.x = pk2(S[2 * s][0] * inv, S[2 * s][1] * inv); t.y = pk2(S[2 * s][2] * inv, S[2 * s][3] * inv); t.z = pk2(S[2 * s + 1][0] * inv, S[2 * s + 1][1] * inv); t.w = pk2(S[2 * s + 1][2] * inv, S[2 * s + 1][3] * inv);
            pf[s] = __builtin_bit_cast(bf16x8, t); }
#pragma unroll
        for (int dc = 0; dc < 4; ++dc) {
            LBAR();
            XA_STORE(4 + dc);
            LBAR();
            if (dc < 3) XA_LOAD(unit, 5 + dc); else if (nxt < NUNITS) XA_LOAD(nxt, 0);
            for (int dt = 0; dt < 8; ++dt) {
                f32x4 acc = {0.f, 0.f, 0.f, 0.f};
#pragma unroll
                for (int s = 0; s < 8; ++s) {
                    const LAS unsigned char* vp = KS + (16 * dt + c) * 528 + 64 * s + 8 * g;
                    const v2u lo = *(const LAS v2u*)vp, hi = *(const LAS v2u*)(vp + 32);
                    v4u t; t.x = lo.x; t.y = lo.y; t.z = hi.x; t.w = hi.y;
                    acc = __builtin_amdgcn_mfma_f32_16x16x32_bf16(__builtin_bit_cast(bf16x8, t), pf[s], acc, 0, 0, 0);
                }
                v2u o; o.x = pk2(acc[0], acc[1]); o.y = pk2(acc[2], acc[3]);
                *(GAS v2u*)(O + (size_t)(m0 + c) * D + h * 512 + dc * 128 + dt * 16 + 4 * g) = o;
            }
        }
        unit = nxt;
    }
}
#undef XA_LOAD
#undef XA_STORE
constexpr int NPL = 15;
enum Phase { PH_CONV = 0, PH_KV, PH_IN, PH_X1, PH_X2, PH_X3, PH_OUT, PH_RN1, PH_Q, PH_XA, PH_O, PH_RN2, PH_UP, PH_DOWN, PH_RN3 };
struct Args { const float* in[31]; float* out; unsigned char* ws; int ph_lo, ph_hi, li, pad; };

__global__ void __launch_bounds__(NTHREADS, 2) fwd(Args args) {
    extern __shared__ __attribute__((aligned(16))) unsigned char lds[];
    Frame F;
    F.lds = (LAS unsigned char*)lds;
    const int wave_s = __builtin_amdgcn_readfirstlane(threadIdx.x >> 6);
    F.tid = threadIdx.x; F.lane = F.tid & 63; F.wave = wave_s;
    F.G = gridDim.x; F.bx = blockIdx.x;
    unsigned char* ws_top = args.ws;
    const int lo = args.ph_lo, hi = args.ph_hi;
    for (int u = F.tid; u < (LDS_BYTES - LDSCTL_OFF) / 4; u += NTHREADS) ((LAS unsigned*)(F.lds + LDSCTL_OFF))[u] = 0u;
    __syncthreads();
    XcdBarrier bar; bar.bar = (unsigned*)(ws_top + WS_CTL) + CW_BAR; bar.x = 0; bar.st = nullptr;
    const bool one_launch = (hi - lo) > 1;
    if (one_launch) bar = xcd_barrier_post((unsigned*)(ws_top + WS_CTL) + CW_BAR, (volatile LAS unsigned*)(F.lds + MISC_OFF) + 8);
#define SEAM(k) do { if (one_launch && (k) + 1 < hi) { xcd_barrier(bar); if (PROBE_REP & 512) xcd_barrier(bar); } } while (0)
#define IN(k) (lo <= (k) && (k) < hi)
#define REPS(bit) (1 + ((PROBE_REP >> (bit)) & 1))
#define PHASE_BEGIN() const CAS Args* ka_ = (const CAS Args*)__builtin_amdgcn_kernarg_segment_ptr(); asm volatile("" : "+s"(ka_)); \
    unsigned mk_ = ~0u; int l = l_it, bx_ = (int)blockIdx.x, G_ = (int)gridDim.x; asm volatile("" : "+s"(mk_), "+s"(l), "+s"(bx_), "+s"(G_)); F.bx = bx_; F.G = G_;     \
    int tz_ = (wave_s << 6) + (int)__builtin_amdgcn_mbcnt_hi(mk_, __builtin_amdgcn_mbcnt_lo(mk_, 0u)); asm volatile("" : "+v"(tz_)); F.tid = tz_; F.lane = tz_ & 63; F.wave = __builtin_amdgcn_readfirstlane(tz_ >> 6); \
    unsigned char* ws = ka_->ws; float* X = ka_->out; bf16* XN = (bf16*)(ws + WS_XN); bf16* Y = (bf16*)(ws + WS_Y); float* RS = (float*)(ws + WS_MISC + MISC_RS); unsigned char* wl = ws + WS_W + (size_t)(l % NWL) * WL_BYTES; \
    const int gw = F.bx * NWAVES + F.wave, NGW = F.G * NWAVES; (void)gw; (void)NGW; (void)X; (void)XN; (void)Y; (void)wl; (void)RS

    for (int l_it = 0; l_it < DEPTH; ++l_it) {
        const int pb = l_it * NPL;
        for (int rep_ = 0; rep_ < REPS(0); ++rep_) if (IN(pb + PH_CONV)) { PHASE_BEGIN();
            LAS float* scr = (LAS float*)(F.lds + RING_OFF + F.wave * 16384);
            const int lc0 = (NWL == 1) ? l : (l == 0 ? 0 : DEPTH), lc1 = (NWL == 1) ? l + 1 : DEPTH;
            conv_weights_phase(F, ka_->in, ws, lc0, lc1, scr, gw, NGW);
            for (int lc = lc0; lc < lc1; ++lc) {
                bf16* lg = (bf16*)(ws + WS_W + (size_t)(lc % NWL) * WL_BYTES + WL_LRUG);
                for (int it = gw; it < 16 * 8; it += NGW) { const int mi = it >> 3, gate = mi >> 3, s = (mi >> 2) & 1, gg = mi & 3;
                    p0_transpose_item(ka_->in[gate ? 15 : 13] + ((size_t)lc * 8 + s * 4 + gg) * 16384, 128, 128, 0, lg + (size_t)((s * 2 + gate) * 4 + gg) * 16384, 0, 4, nullptr, scr, it & 7, F.lane); }
            }
            if (l == 0) { if (NGW * 4 == M) init_rows<4>(F.lane, ka_->in[0] + (size_t)gw * D, XN + (size_t)gw * D, RS + gw, (size_t)NGW); else for (int m = gw; m < M; m += NGW) init_row(F.lane, ka_->in[0] + (size_t)m * D, XN + (size_t)m * D, RS + m); }
            for (int lc = lc0; lc < lc1; ++lc)
                for (int m = gw; m < MM; m += NGW) norm_row(F.lane, ka_->in[1] + (size_t)m * D, ka_->in[26] + (size_t)lc * D, (bf16*)(ws + WS_MEMN) + ((size_t)lc * MM + m) * D, nullptr);
        }
        if (l_it == 0 || NWL == 1) SEAM(pb + PH_CONV);
        for (int rep_ = 0; rep_ < REPS(1); ++rep_) if (IN(pb + PH_KV)) { PHASE_BEGIN();
            const int lc0 = (NWL == 1) ? l : (l == 0 ? 0 : DEPTH), lc1 = (NWL == 1) ? l + 1 : DEPTH;
            if (lc1 > lc0) {
                const bf16* base = (const bf16*)(ws + WS_W);
                pg8::Gemm g{base, base, 0, 0, D};
                pg8::KvOrder S; S.G = F.G; S.c = F.bx; S.NL = lc1 - lc0; S.l0 = lc0;
                S.memn_p0 = (int)((WS_MEMN - WS_W) / MiB) + 4 * lc0; S.memn_ps = 4;
                S.xk_p0 = (int)(((size_t)(lc0 % NWL) * WL_BYTES + WL_XK) / MiB); S.xv_p0 = (int)(((size_t)(lc0 % NWL) * WL_BYTES + WL_XV) / MiB); S.w_ps = (int)(WL_BYTES / MiB);
                pg8::EpiBf16<0> E{(bf16*)(ws + WS_KX), D, (bf16*)(ws + WS_VT), MM, nullptr};
                pg8::gemm_phase<pg8::EpiBf16<0>, pg8::KvOrder, true, true>(F.lds + RING_OFF, g, S, E, F.tid);
            }
        }
        if (l_it == 0 || NWL == 1) SEAM(pb + PH_KV);
        for (int rep_ = 0; rep_ < REPS(2); ++rep_) if (IN(pb + PH_IN)) { if (rep_ > 0 && (PROBE_REP & 1024)) xcd_barrier(bar); PHASE_BEGIN();
            pg8::Gemm g{XN, (const bf16*)(wl + WL_IN), M, NPB, D}; pg8::StaticOrder S; S.init(M, NPB, F.G, F.bx);
            pg8::EpiBf16<0> E{(bf16*)(ws + WS_PB), NPB, nullptr, 0, RS};
            pg8::gemm_phase<pg8::EpiBf16<0>, pg8::StaticOrder, true, true>(F.lds + RING_OFF, g, S, E, F.tid);
            for (int rz_ = 0; rz_ < 1 + ((PROBE_REP >> 12) & 1); ++rz_) zgemm(F, XN, (const bf16*)(wl + WL_Z), RS, (float*)(ws + WS_Z));
        }
        SEAM(pb + PH_IN);
        if (IN(pb + PH_X1)) { PHASE_BEGIN();
            for (int rep_ = 0; rep_ < REPS(3); ++rep_) gla_u_phase(F, (const bf16*)(ws + WS_PB), (const float*)(ws + WS_Z), ka_->in[6] + (size_t)l * 4096, ka_->in[7] + (size_t)l * 256, ka_->in[8] + (size_t)l * 4096, ka_->in[9] + (size_t)l * 256,
                        (float*)(ws + WS_GLAU), (float*)(ws + WS_MISC + MISC_DEC));
            for (int rep_ = 0; rep_ < REPS(5); ++rep_) lru_phase(F, (const bf16*)(ws + WS_PB), (const bf16*)(wl + WL_LRUG), ka_->in[11] + (size_t)l * 2048, ka_->in[12] + (size_t)l * 512, ka_->in[14] + (size_t)l * 1024, ka_->in[16] + (size_t)l * 1024, ka_->in[17] + (size_t)l * 1024,
                             (float*)(ws + WS_MISC + MISC_CAR_A), (float*)(ws + WS_MISC + MISC_CAR_H), (bf16*)(ws + WS_LRU), (bf16*)(ws + WS_LRU) + (size_t)M * 512, (bf16*)(ws + WS_LRU) + (size_t)2 * M * 512); }
        SEAM(pb + PH_X1);
        if (IN(pb + PH_X2)) { PHASE_BEGIN();
            gla_state_phase(F, (float*)(ws + WS_GLAU), (const float*)(ws + WS_MISC + MISC_DEC));
            lru_carry_phase(F, (const float*)(ws + WS_MISC + MISC_CAR_A), (const float*)(ws + WS_MISC + MISC_CAR_H), (float*)(ws + WS_MISC + MISC_CIN));
            for (int rep_ = 0; rep_ < REPS(6); ++rep_) wattn_phase(F, (const bf16*)(ws + WS_PB), ka_->in[2], ka_->in[5] + l * 8, (bf16*)(ws + WS_MIX)); }
        SEAM(pb + PH_X2);
        if (IN(pb + PH_X3)) { PHASE_BEGIN();
            for (int rep_ = 0; rep_ < REPS(7); ++rep_) gla_o_phase(F, (const bf16*)(ws + WS_PB), (const float*)(ws + WS_Z), ka_->in[6] + (size_t)l * 4096, ka_->in[7] + (size_t)l * 256, ka_->in[8] + (size_t)l * 4096, ka_->in[9] + (size_t)l * 256,
                        (const float*)(ws + WS_GLAU), ka_->in[10] + (size_t)l * 512, (bf16*)(ws + WS_MIX));
            for (int rep_ = 0; rep_ < REPS(8); ++rep_) lru_out_phase(F, (const bf16*)(ws + WS_PB), (const bf16*)(ws + WS_LRU), (const bf16*)(ws + WS_LRU) + (size_t)M * 512, (const bf16*)(ws + WS_LRU) + (size_t)2 * M * 512, (const float*)(ws + WS_MISC + MISC_CIN), (bf16*)(ws + WS_MIX)); }
        SEAM(pb + PH_X3);
        for (int rep_ = 0; rep_ < REPS(2); ++rep_) if (IN(pb + PH_OUT)) { if (rep_ > 0 && (PROBE_REP & 1024)) xcd_barrier(bar); PHASE_BEGIN();
            pg8::Gemm g{(const bf16*)(ws + WS_MIX), (const bf16*)(wl + WL_OUT), M, D, D}; pg8::StaticOrder S; S.init(M, D, F.G, F.bx);
            pg8::EpiBf16<0> E{Y, D, nullptr, 0, nullptr};
            pg8::gemm_phase<pg8::EpiBf16<0>, pg8::StaticOrder, true, true>(F.lds + RING_OFF, g, S, E, F.tid);
        }
        SEAM(pb + PH_OUT);
        if (IN(pb + PH_RN1)) { PHASE_BEGIN(); if (NGW * 4 == M) resid_rows<4>(F.lane, XN + (size_t)gw * D, Y + (size_t)gw * D, (size_t)NGW * D, ka_->in[25] + (size_t)l * D, RS + gw, (size_t)NGW, nullptr); else for (int m = gw; m < M; m += NGW) resid_row(F.lane, XN + (size_t)m * D, Y + (size_t)m * D, ka_->in[25] + (size_t)l * D, RS + m, nullptr);  if (PROBE_REP & 2048) resid_rows<4>(F.lane, XN + (size_t)gw * D, Y + (size_t)gw * D, (size_t)NGW * D, (const float*)(ws + WS_CTL + 512 * 1024), RS + gw, (size_t)NGW, nullptr); }
        SEAM(pb + PH_RN1);
        for (int rep_ = 0; rep_ < REPS(2); ++rep_) if (IN(pb + PH_Q)) { if (rep_ > 0 && (PROBE_REP & 1024)) xcd_barrier(bar); PHASE_BEGIN();
            pg8::Gemm g{XN, (const bf16*)(wl + WL_XQ), M, D, D}; pg8::StaticOrder S; S.init(M, D, F.G, F.bx);
            pg8::EpiBf16<0> E{(bf16*)(ws + WS_Q), D, nullptr, 0, RS};
            pg8::gemm_phase<pg8::EpiBf16<0>, pg8::StaticOrder, true, true>(F.lds + RING_OFF, g, S, E, F.tid);
        }
        SEAM(pb + PH_Q);
        for (int rep_ = 0; rep_ < REPS(4); ++rep_) if (IN(pb + PH_XA)) { PHASE_BEGIN(); xattn_phase(F, (const bf16*)(ws + WS_Q), (const bf16*)(ws + WS_KX) + (size_t)l * MM * D, (const bf16*)(ws + WS_VT) + (size_t)l * D * MM, (bf16*)(ws + WS_O)); }
        SEAM(pb + PH_XA);
        for (int rep_ = 0; rep_ < REPS(2); ++rep_) if (IN(pb + PH_O)) { if (rep_ > 0 && (PROBE_REP & 1024)) xcd_barrier(bar); PHASE_BEGIN();
            pg8::Gemm g{(const bf16*)(ws + WS_O), (const bf16*)(wl + WL_XO), M, D, D}; pg8::StaticOrder S; S.init(M, D, F.G, F.bx);
            pg8::EpiBf16<0> E{Y, D, nullptr, 0, nullptr};
            pg8::gemm_phase<pg8::EpiBf16<0>, pg8::StaticOrder, true, true>(F.lds + RING_OFF, g, S, E, F.tid);
        }
        SEAM(pb + PH_O);
        if (IN(pb + PH_RN2)) { PHASE_BEGIN(); if (NGW * 4 == M) resid_rows<4>(F.lane, XN + (size_t)gw * D, Y + (size_t)gw * D, (size_t)NGW * D, ka_->in[28] + (size_t)l * D, RS + gw, (size_t)NGW, nullptr); else for (int m = gw; m < M; m += NGW) resid_row(F.lane, XN + (size_t)m * D, Y + (size_t)m * D, ka_->in[28] + (size_t)l * D, RS + m, nullptr);  if (PROBE_REP & 2048) resid_rows<4>(F.lane, XN + (size_t)gw * D, Y + (size_t)gw * D, (size_t)NGW * D, (const float*)(ws + WS_CTL + 512 * 1024), RS + gw, (size_t)NGW, nullptr); }
        SEAM(pb + PH_RN2);
        for (int rep_ = 0; rep_ < REPS(2); ++rep_) if (IN(pb + PH_UP)) { if (rep_ > 0 && (PROBE_REP & 1024)) xcd_barrier(bar); PHASE_BEGIN();
            pg8::Gemm g{XN, (const bf16*)(wl + WL_UP), M, DFF, D}; pg8::StaticOrder S; S.init(M, DFF, F.G, F.bx);
            pg8::EpiBf16<1> E{(bf16*)(ws + WS_H), DFF, nullptr, 0, RS};
            pg8::gemm_phase<pg8::EpiBf16<1>, pg8::StaticOrder, true, true>(F.lds + RING_OFF, g, S, E, F.tid);
        }
        SEAM(pb + PH_UP);
        for (int rep_ = 0; rep_ < REPS(2); ++rep_) if (IN(pb + PH_DOWN)) { if (rep_ > 0 && (PROBE_REP & 1024)) xcd_barrier(bar); PHASE_BEGIN();
            pg8::Gemm g{(const bf16*)(ws + WS_H), (const bf16*)(wl + WL_DOWN), M, D, DFF}; pg8::StaticOrder S; S.init(M, D, F.G, F.bx);
            pg8::EpiBf16<0> E{Y, D, nullptr, 0, nullptr};
            pg8::gemm_phase<pg8::EpiBf16<0>, pg8::StaticOrder, true, true>(F.lds + RING_OFF, g, S, E, F.tid);
        }
        SEAM(pb + PH_DOWN);
        if (IN(pb + PH_RN3)) { PHASE_BEGIN(); if (NGW * 4 == M) resid_rows<4>(F.lane, XN + (size_t)gw * D, Y + (size_t)gw * D, (size_t)NGW * D, ka_->in[30] + (size_t)l * D, RS + gw, (size_t)NGW, (l + 1 < DEPTH) ? nullptr : X + (size_t)gw * D); else for (int m = gw; m < M; m += NGW) resid_row(F.lane, XN + (size_t)m * D, Y + (size_t)m * D, ka_->in[30] + (size_t)l * D, RS + m, (l + 1 < DEPTH) ? nullptr : X + (size_t)m * D);  if (PROBE_REP & 2048) resid_rows<4>(F.lane, XN + (size_t)gw * D, Y + (size_t)gw * D, (size_t)NGW * D, (const float*)(ws + WS_CTL + 512 * 1024), RS + gw, (size_t)NGW, nullptr); }
        SEAM(pb + PH_RN3);
    }
#undef IN
#undef SEAM
}
extern "C" void kernel_launch(void* const* d_in, const int* in_sizes, int n_in, void* d_out, int out_size, void* d_ws, size_t ws_size, hipStream_t stream) {
    static int grid = 0;
    if (grid == 0) {
        int dev = 0, cus = 0;
        if (n_in != 31 || out_size != M * D || ws_size < WS_END) { fprintf(stderr, "kernel_launch: built for 31 inputs, %d outputs, >= %zu bytes of workspace; got %d, %d, %zu\n", M * D, (size_t)WS_END, n_in, out_size, ws_size); grid = -1; return; }
        if (hipGetDevice(&dev) != hipSuccess || hipDeviceGetAttribute(&cus, hipDeviceAttributeMultiprocessorCount, dev) != hipSuccess) { fprintf(stderr, "kernel_launch: device query failed\n"); grid = -1; return; }
        if (hipFuncSetAttribute((const void*)fwd, hipFuncAttributeMaxDynamicSharedMemorySize, LDS_BYTES) != hipSuccess) { fprintf(stderr, "kernel_launch: hipFuncSetAttribute failed\n"); grid = -1; return; }
        int per_cu = 0;
        if (hipOccupancyMaxActiveBlocksPerMultiprocessor(&per_cu, (const void*)fwd, NTHREADS, LDS_BYTES) != hipSuccess || per_cu < 1) { fprintf(stderr, "kernel_launch: occupancy query reports %d workgroups per CU\n", per_cu); (void)hipGetLastError(); }
        grid = cus;
    }
    if (grid < 0) return;
    unsigned char* ws = (unsigned char*)d_ws;
    (void)hipMemsetAsync(ws + WS_CTL, 0, CTL_ZERO_BYTES, stream);
    Args a{};
    for (int i = 0; i < 31; ++i) a.in[i] = (const float*)d_in[i];
    a.out = (float*)d_out; a.ws = ws;
#if defined(MK_PER_PHASE) && MK_PER_PHASE
    for (int p = 0; p < DEPTH * NPL; ++p) { if (NWL == 4 && p >= NPL && (p % NPL) < 2) continue; a.ph_lo = p; a.ph_hi = p + 1; hipLaunchKernelGGL(fwd, dim3(grid), dim3(NTHREADS), LDS_BYTES, stream, a); }
#else
    a.ph_lo = 0; a.ph_hi = DEPTH * NPL;
    hipLaunchKernelGGL(fwd, dim3(grid), dim3(NTHREADS), LDS_BYTES, stream, a);
    const hipError_t le = hipPeekAtLastError();
    if (le != hipSuccess) fprintf(stderr, "kernel_launch: launch failed: %s\n", hipGetErrorName(le));
#endif
}
```

```cpp
#include <hip/hip_runtime.h>
#include <cstdint>
#include <cstdio>

__device__ __forceinline__ float lane_xor_f(float v, int mask, int lane) { return __builtin_bit_cast(float, __builtin_amdgcn_ds_bpermute((lane ^ mask) << 2, __builtin_bit_cast(int, v))); }
namespace pg8 {
#define PG8_LAS __attribute__((address_space(3)))
typedef unsigned short bf16_t;
typedef short bf16x8 __attribute__((ext_vector_type(8)));
typedef float f32x4 __attribute__((ext_vector_type(4)));
typedef float f32x2 __attribute__((ext_vector_type(2)));
typedef unsigned u32x4 __attribute__((ext_vector_type(4)));
constexpr int BM = 256, BK = 64, HALF = 128, HTB = HALF * BK * 2  , STAGE_BYTES = 8 * HTB, NXCD = 8, WGM = 8;

__host__ __device__ __forceinline__ int lds_byte(int r, int c) { const int st = (r >> 4) * 2 + (c >> 5), rr = r & 15, cc = c & 31, ob = rr * 64 + cc * 2; return st * 1024 + (ob ^ (((ob >> 9) & 1) << 5)); }
__host__ __device__ __forceinline__ void stage_rc(int b, int& R, int& C) { const int st = b / 1024, sb = b % 1024, swz = sb ^ (((sb >> 9) & 1) << 5); R = (st >> 1) * 16 + swz / 64; C = (st & 1) * 32 + (swz % 64) / 2; }
__host__ __device__ __forceinline__ int perm32(int rho) { const int n = rho >> 4, i = rho & 15; return 8 * (i >> 2) + 4 * n + (i & 3); }

struct Unit { int pm, pn, om, on, kind; size_t aoff, boff; int nt = 0, flags = 0; };
struct Gemm { const bf16_t* A; const bf16_t* Bt; int M, N, K, lda, ldb; };

struct StaticOrder {
    static constexpr bool MIXED = false;
    int nM, nN, nwg, G, c, r0, nr;
    __host__ __device__ void init(int M, int N, int G_, int c_) { nM = M / BM; nN = N / BM; nwg = nM * nN; G = G_; c = c_; r0 = 0; nr = 1 << 20; }
    __host__ __device__ bool next(int i, Unit& u) const {
        if (i >= nr) return false;
        const long L = (long)(i + r0) * G + c; if (L >= nwg) return false;
        int wgid = (int)L; { const int q = nwg / NXCD, r = nwg % NXCD, xcd = wgid % NXCD, off = wgid / NXCD; wgid = (xcd < r ? xcd * (q + 1) : r * (q + 1) + (xcd - r) * q) + off; }
        const int nig = WGM * nN, gid = wgid / nig, fm = gid * WGM, gsz = (nM - fm) < WGM ? (nM - fm) : WGM;
        u.pm = fm + ((wgid % nig) % gsz); u.pn = (wgid % nig) / gsz; u.om = u.pm; u.on = u.pn; u.kind = 0; u.aoff = 0; u.boff = 0; return true;
    }
    __device__ __forceinline__ void a_ready(const Unit&) const {}
    __device__ __forceinline__ void done(const Unit&) const {}
};
template <int SPLITK> struct BatchBOrder : StaticOrder {
    int bp0, per_b; size_t khalf_bytes;
    __host__ __device__ bool next(int i, Unit& u) const {
        if (!StaticOrder::next(i, u)) return false;
        const int b = u.pm >> 3, slot = u.pn, pn = SPLITK == 2 ? slot >> 1 : slot, kh = SPLITK == 2 ? (slot & 1) : 0;
        u.pn = bp0 + b * per_b + pn; u.on = pn; u.om = kh * nM + u.pm; u.aoff = kh * khalf_bytes; u.boff = kh * khalf_bytes;
        return true;
    }
};
struct DownOrder : StaticOrder {
    static constexpr bool MIXED = true;
    int nt8, ntb; size_t jump;
    __host__ __device__ bool next(int i, Unit& u) const { if (!StaticOrder::next(i, u)) return false; u.nt = nt8 + ntb; return true; }
};
struct KvOrder {
    static constexpr bool MIXED = false;
    int G, c, NL, l0, memn_p0, memn_ps, xk_p0, xv_p0, w_ps;
    __host__ __device__ bool next(int i, Unit& u) const {
        const long L = (long)i * G + c; if (L >= (long)NL * 64) return false;
        const int l = (int)L / 64, r = (int)L % 64, q = r & 31, pm = q & 3, pn = q >> 2;
        u.kind = r >> 5; u.pm = memn_p0 + l * memn_ps + pm; u.pn = (u.kind ? xv_p0 : xk_p0) + l * w_ps + pn; u.om = (l0 + l) * 4 + pm; u.on = pn; u.aoff = 0; u.boff = 0;
        return true;
    }
    __device__ __forceinline__ void a_ready(const Unit&) const {}
    __device__ __forceinline__ void done(const Unit&) const {}
};
struct ProdOrder {
    static constexpr bool MIXED = false;
    int G, c, NL, kx_p0, vx_p0, xq_p0, xo_p0, w_ps;
    __host__ __device__ bool next(int i, Unit& u) const {
        const long L = (long)i * G + c; if (L >= (long)NL * 256) return false;
        const int l = (int)L / 256, r = (int)L % 256, r2 = r & 127, b = r2 >> 5, h = (r2 >> 3) & 3, t = r2 & 7;
        u.kind = r >> 7; u.aoff = (size_t)h * 1024; u.boff = (size_t)h * 1024;
        if (u.kind == 0) { u.pm = kx_p0 + l * 4 + b; u.pn = xq_p0 + l * w_ps + t; u.om = (l * 4 + b) * 4 + h; u.on = t; }
        else { u.pm = xo_p0 + l * w_ps + t; u.pn = vx_p0 + l * 4 + b; u.om = (l * 4 + b) * 8 + t; u.on = h; }
        return true;
    }
    __device__ __forceinline__ void a_ready(const Unit&) const {}
    __device__ __forceinline__ void done(const Unit&) const {}
};
__device__ __forceinline__ unsigned cvt_pk_bf16(float lo, float hi) { unsigned r; asm volatile("v_cvt_pk_bf16_f32 %0, %1, %2" : "=v"(r) : "v"(lo), "v"(hi)); return r; }

template <int ACT  > struct EpiBf16 {
    static constexpr bool PERM = true, AFTER_DRAIN = false;
    bf16_t* O; int ldc; bf16_t* O1; int ldc1; const float* rs; int rs_stride; float rs_scale, rs_eps; PG8_LAS float* rtab; int n8 = 0;
    __device__ __forceinline__ void operator()(const f32x4 (&acc)[2][2][4][2], const Unit& u, int wr, int wc, int fr, int fq) const {
        bf16_t* base = u.kind ? O1 : O; const int ld = u.kind ? ldc1 : ldc;
        const int row0 = u.om * BM + wr * 64 + fr, col0 = u.on * BM + wc * 32 + 8 * fq;
        if (rs) {
            const int tid = (wr * 4 + wc) * 64 + fq * 16 + fr;
            if (tid < 256) { float t = 0.f;
#pragma unroll
                for (int q = 0; q < 8; ++q) t += rs[(size_t)q * rs_stride + u.om * BM + tid];
                rtab[tid] = rsqrtf(t * rs_scale + rs_eps); }
            asm volatile("s_waitcnt lgkmcnt(0)" ::: "memory"); __builtin_amdgcn_s_barrier(); asm volatile("" ::: "memory");
        }
        if (ACT == 1 && u.on < n8) {
#pragma unroll
            for (int ai = 0; ai < 2; ++ai)
#pragma unroll
                for (int m = 0; m < 4; ++m) { unsigned char* rowp = (unsigned char*)base + (size_t)(row0 + ai * HALF + m * 16) * ld * 2 + col0;
                    const float sc = rs ? rtab[ai * HALF + wr * 64 + m * 16 + fr] : 1.f;
#pragma unroll
                    for (int bj = 0; bj < 2; ++bj) { f32x4 v0 = acc[ai][bj][m][0] * sc, v1 = acc[ai][bj][m][1] * sc;
#pragma unroll
                        for (int j = 0; j < 4; ++j) { const float a = fmaxf(v0[j], 0.f), b = fmaxf(v1[j], 0.f); v0[j] = fminf(a * a * 16.f, 448.f); v1[j] = fminf(b * b * 16.f, 448.f); }
                        int w0 = __builtin_amdgcn_cvt_pk_fp8_f32(v0[0], v0[1], 0, false); w0 = __builtin_amdgcn_cvt_pk_fp8_f32(v0[2], v0[3], w0, true);
                        int w1 = __builtin_amdgcn_cvt_pk_fp8_f32(v1[0], v1[1], 0, false); w1 = __builtin_amdgcn_cvt_pk_fp8_f32(v1[2], v1[3], w1, true);
                        typedef int i32x2_ __attribute__((ext_vector_type(2))); *(i32x2_*)(rowp + bj * HALF) = (i32x2_){w0, w1}; }
                    __builtin_amdgcn_sched_barrier(0); }
            return;
        }
#pragma unroll
        for (int ai = 0; ai < 2; ++ai)
#pragma unroll
            for (int m = 0; m < 4; ++m) { bf16_t* rowp = base + (size_t)(row0 + ai * HALF + m * 16) * ld + col0;
                const float sc = rs ? rtab[ai * HALF + wr * 64 + m * 16 + fr] : 1.f;
#pragma unroll
                for (int bj = 0; bj < 2; ++bj) { f32x4 v0 = acc[ai][bj][m][0] * sc, v1 = acc[ai][bj][m][1] * sc;
                    if (ACT == 1) {
#pragma unroll
                        for (int j = 0; j < 4; ++j) { const float a = fmaxf(v0[j], 0.f), b = fmaxf(v1[j], 0.f); v0[j] = a * a; v1[j] = b * b; } }
                    u32x4 w; w.x = cvt_pk_bf16(v0[0], v0[1]); w.y = cvt_pk_bf16(v0[2], v0[3]); w.z = cvt_pk_bf16(v1[0], v1[1]); w.w = cvt_pk_bf16(v1[2], v1[3]);
                    *(u32x4*)(rowp + bj * HALF) = w; } }
    }
};
__device__ __forceinline__ void st16_wt(void* p, f32x4 v) { asm volatile("global_store_dwordx4 %0, %1, off sc1\n\ts_nop 1" :: "v"(p), "v"(v) : "memory"); }
struct EpiScoreSm {
    static constexpr bool PERM = true, AFTER_DRAIN = true;
    float* SC; bf16_t* P; const float* rs; int rs_stride; float rs_scale, rs_eps, alpha; int nM; unsigned* cnt;
    __device__ __forceinline__ void operator()(const f32x4 (&)[2][2][4][2], const Unit&, int, int, int, int) const {}
    __device__ __forceinline__ void fused(f32x4 (&acc)[2][2][4][2], const Unit& u, int wr, int wc, int fr, int fq, PG8_LAS unsigned char* lds, int wid, int lane) const {
        PG8_LAS float* rtab = (PG8_LAS float*)lds;
        PG8_LAS float* Pms = (PG8_LAS float*)(lds + 4096);
        const int tid = wid * 64 + lane, kh = u.om >= nM ? 1 : 0, pm = u.om - kh * nM;
        if (tid < 256) { float t = 0.f;
#pragma unroll
            for (int q = 0; q < 8; ++q) t += rs[(size_t)q * rs_stride + pm * BM + tid];
            rtab[tid] = rsqrtf(t * rs_scale + rs_eps) * alpha; }
        __syncthreads();
        unsigned* c = cnt + (size_t)(pm * 4 + u.on) * 64;
        int lr0 = wr * 64 + fr; asm volatile("" : "+v"(lr0));
        int so = (pm * BM + wr * 64 + fr) * 1024 + u.on * BM + wc * 32 + 8 * fq; asm volatile("" : "+v"(so));
        constexpr float L2E = 1.4426950408889634f;
        if (kh == 0) {
#pragma unroll
            for (int ai = 0; ai < 2; ++ai)
#pragma unroll
                for (int m = 0; m < 4; ++m) { int ro = (ai * HALF + m * 16) * 1024; asm volatile("" : "+s"(ro)); float* rowp = SC + (size_t)(unsigned)(so + ro); const float sc = rtab[ai * HALF + m * 16 + lr0];
#pragma unroll
                    for (int bj = 0; bj < 2; ++bj) { st16_wt(rowp + bj * HALF, acc[ai][bj][m][0] * sc); st16_wt(rowp + bj * HALF + 4, acc[ai][bj][m][1] * sc); }
                    __builtin_amdgcn_sched_barrier(0); }
            asm volatile("s_waitcnt vmcnt(0)" ::: "memory");
            if (lane == 0) __hip_atomic_fetch_add(c, 1u, __ATOMIC_RELAXED, __HIP_MEMORY_SCOPE_AGENT);
            return;
        }
        if (wid == 0) { unsigned spins = 0;
            while ((unsigned)__builtin_amdgcn_readfirstlane(__hip_atomic_load(c, __ATOMIC_RELAXED, __HIP_MEMORY_SCOPE_AGENT)) < 8u) { __builtin_amdgcn_s_sleep(2); if (++spins > (1u << 22)) break; }
            asm volatile("s_waitcnt vmcnt(0)" ::: "memory"); }
        __syncthreads();
#pragma unroll
        for (int ai = 0; ai < 2; ++ai)
#pragma unroll
            for (int m = 0; m < 4; ++m) { int ro = (ai * HALF + m * 16) * 1024; asm volatile("" : "+s"(ro)); const float* rowp = SC + (size_t)(unsigned)(so + ro); const int lr = ai * HALF + m * 16 + lr0; const float sc = rtab[lr];
                f32x4 x[2][2]; float mx = -3.0e38f;
#pragma unroll
                for (int bj = 0; bj < 2; ++bj)
#pragma unroll
                    for (int n = 0; n < 2; ++n) { x[bj][n] = acc[ai][bj][m][n] * sc + *(const f32x4*)(rowp + bj * HALF + 4 * n); mx = fmaxf(mx, fmaxf(fmaxf(x[bj][n][0], x[bj][n][1]), fmaxf(x[bj][n][2], x[bj][n][3]))); }
                mx = fmaxf(mx, lane_xor_f(mx, 16, lane)); mx = fmaxf(mx, lane_xor_f(mx, 32, lane));
                const float nm = -mx * L2E; float s = 0.f;
#pragma unroll
                for (int bj = 0; bj < 2; ++bj)
#pragma unroll
                    for (int n = 0; n < 2; ++n)
#pragma unroll
                        for (int j = 0; j < 4; ++j) s += __builtin_amdgcn_exp2f(fmaf(x[bj][n][j], L2E, nm));
                s += lane_xor_f(s, 16, lane); s += lane_xor_f(s, 32, lane);
                if (fq == 0) *(PG8_LAS f32x2*)(Pms + (lr * 4 + wc) * 2) = (f32x2){mx, s};
                __builtin_amdgcn_sched_barrier(0); }
        __syncthreads();
        asm volatile("" : "+v"(lr0)); asm volatile("" : "+v"(so));
#pragma unroll
        for (int ai = 0; ai < 2; ++ai)
#pragma unroll
            for (int m = 0; m < 4; ++m) { int ro = (ai * HALF + m * 16) * 1024; asm volatile("" : "+s"(ro)); const float* rowp = SC + (size_t)(unsigned)(so + ro); bf16_t* prow = P + (size_t)(unsigned)(so + ro); const int lr = ai * HALF + m * 16 + lr0; const float sc = rtab[lr];
                const f32x4 a4 = *(PG8_LAS const f32x4*)(Pms + lr * 8), b4 = *(PG8_LAS const f32x4*)(Pms + lr * 8 + 4);
                const float mx = fmaxf(fmaxf(a4[0], a4[2]), fmaxf(b4[0], b4[2])), nm = -mx * L2E;
                const float S = (a4[1] * __builtin_amdgcn_exp2f(fmaf(a4[0], L2E, nm)) + a4[3] * __builtin_amdgcn_exp2f(fmaf(a4[2], L2E, nm))) + (b4[1] * __builtin_amdgcn_exp2f(fmaf(b4[0], L2E, nm)) + b4[3] * __builtin_amdgcn_exp2f(fmaf(b4[2], L2E, nm)));
                const float inv = 1.f / S;
#pragma unroll
                for (int bj = 0; bj < 2; ++bj) { f32x4 e[2];
#pragma unroll
                    for (int n = 0; n < 2; ++n) { const f32x4 x = acc[ai][bj][m][n] * sc + *(const f32x4*)(rowp + bj * HALF + 4 * n);
#pragma unroll
                        for (int j = 0; j < 4; ++j) e[n][j] = __builtin_amdgcn_exp2f(fmaf(x[j], L2E, nm)) * inv; }
                    u32x4 w; w.x = cvt_pk_bf16(e[0][0], e[0][1]); w.y = cvt_pk_bf16(e[0][2], e[0][3]); w.z = cvt_pk_bf16(e[1][0], e[1][1]); w.w = cvt_pk_bf16(e[1][2], e[1][3]);
                    *(u32x4*)(prow + bj * HALF) = w; }
                __builtin_amdgcn_sched_barrier(0); }
    }
};
struct EpiResid {
    static constexpr bool PERM = true, AFTER_DRAIN = true;
    bf16_t* XB; const float* g1; float* SSQ; int ssq_stride; float* outf; float* slots; unsigned* cnt; float inv_n, eps;
    __device__ __forceinline__ void operator()(const f32x4 (&)[2][2][4][2], const Unit&, int, int, int, int) const {}
    __device__ __forceinline__ void fused(f32x4 (&acc)[2][2][4][2], const Unit& u, int wr, int wc, int fr, int fq, PG8_LAS unsigned char* lds, int wid, int lane) const {
        PG8_LAS float* P = (PG8_LAS float*)lds;
        PG8_LAS float* RY = (PG8_LAS float*)(lds + 4096);
        const int tid = wid * 64 + lane;
        const int row0 = u.om * BM + wr * 64 + fr, col0 = u.on * BM + wc * 32 + 8 * fq;
        u32x4 xo[4][2]; f32x4 gv[2][2];
#pragma unroll
        for (int m = 0; m < 4; ++m)
#pragma unroll
            for (int bj = 0; bj < 2; ++bj) xo[m][bj] = *(const u32x4*)(XB + (size_t)(row0 + m * 16) * 2048 + col0 + bj * HALF);
#pragma unroll
        for (int bj = 0; bj < 2; ++bj) { gv[bj][0] = *(const f32x4*)(g1 + col0 + bj * HALF); gv[bj][1] = *(const f32x4*)(g1 + col0 + bj * HALF + 4); }
#pragma unroll
        for (int ai = 0; ai < 2; ++ai)
#pragma unroll
            for (int m = 0; m < 4; ++m) { float s = 0.f;
#pragma unroll
                for (int bj = 0; bj < 2; ++bj)
#pragma unroll
                    for (int n = 0; n < 2; ++n) { const f32x4 v = acc[ai][bj][m][n]; s += (v[0] * v[0] + v[1] * v[1]) + (v[2] * v[2] + v[3] * v[3]); }
                s += lane_xor_f(s, 16, lane); s += lane_xor_f(s, 32, lane);
                if (fq == 0) P[(ai * HALF + wr * 64 + m * 16 + fr) * 4 + wc] = s; }
        __syncthreads();
        float* slot = slots + ((size_t)u.om * 8 + u.on) * 256;
        if (tid < 256) {
            const float t = (P[tid * 4 + 0] + P[tid * 4 + 1]) + (P[tid * 4 + 2] + P[tid * 4 + 3]);
            __hip_atomic_store(slot + tid, t, __ATOMIC_RELAXED, __HIP_MEMORY_SCOPE_AGENT);
            asm volatile("s_waitcnt vmcnt(0)" ::: "memory");
            if (lane == 0) __hip_atomic_fetch_add(cnt + 64 * u.om, 1u, __ATOMIC_RELAXED, __HIP_MEMORY_SCOPE_AGENT);
        }
        if (wid == 0) {
            unsigned spins = 0;
            while ((unsigned)__builtin_amdgcn_readfirstlane(__hip_atomic_load(cnt + 64 * u.om, __ATOMIC_RELAXED, __HIP_MEMORY_SCOPE_AGENT)) < 32u) { __builtin_amdgcn_s_sleep(2); if (++spins > (1u << 22)) break; }
            asm volatile("s_waitcnt vmcnt(0)" ::: "memory");
        }
        __syncthreads();
        if (tid < 256) { float t = 0.f; const float* sp = slots + (size_t)u.om * 8 * 256 + tid;
#pragma unroll
            for (int q = 0; q < 8; ++q) t += __hip_atomic_load(sp + q * 256, __ATOMIC_RELAXED, __HIP_MEMORY_SCOPE_AGENT);
            RY[tid] = rsqrtf(t * inv_n + eps); }
        __syncthreads();
#pragma unroll
        for (int ai = 0; ai < 2; ++ai)
#pragma unroll
            for (int m = 0; m < 4; ++m) { const int lr = ai * HALF + wr * 64 + m * 16 + fr; const float r = RY[lr];
                bf16_t* rowp = XB + (size_t)(row0 + ai * HALF + m * 16) * 2048 + col0; float s2 = 0.f;
#pragma unroll
                for (int bj = 0; bj < 2; ++bj) { const u32x4 xq = (ai == 0) ? xo[m][bj] : *(const u32x4*)(rowp + bj * HALF);
                    const unsigned xx[4] = {xq.x, xq.y, xq.z, xq.w}; float xn[8];
#pragma unroll
                    for (int e = 0; e < 4; ++e) { const int n = e >> 1, j = (e & 1) * 2;
                        xn[2 * e] = __builtin_bit_cast(float, xx[e] << 16) + acc[ai][bj][m][n][j] * r * gv[bj][n][j];
                        xn[2 * e + 1] = __builtin_bit_cast(float, xx[e] & 0xffff0000u) + acc[ai][bj][m][n][j + 1] * r * gv[bj][n][j + 1];
                        s2 += xn[2 * e] * xn[2 * e] + xn[2 * e + 1] * xn[2 * e + 1]; }
                    u32x4 w; w.x = cvt_pk_bf16(xn[0], xn[1]); w.y = cvt_pk_bf16(xn[2], xn[3]); w.z = cvt_pk_bf16(xn[4], xn[5]); w.w = cvt_pk_bf16(xn[6], xn[7]);
                    *(u32x4*)(rowp + bj * HALF) = w;
                    if (outf) { float* op = outf + (size_t)(row0 + ai * HALF + m * 16) * 2048 + col0 + bj * HALF; *(f32x4*)op = (f32x4){xn[0], xn[1], xn[2], xn[3]}; *(f32x4*)(op + 4) = (f32x4){xn[4], xn[5], xn[6], xn[7]}; } }
                s2 += lane_xor_f(s2, 16, lane); s2 += lane_xor_f(s2, 32, lane);
                if (fq == 0) P[lr * 4 + wc] = s2; }
        __syncthreads();
        if (tid < 256) SSQ[(size_t)u.on * ssq_stride + u.om * BM + tid] = (P[tid * 4 + 0] + P[tid * 4 + 1]) + (P[tid * 4 + 2] + P[tid * 4 + 3]);
    }
};

template <class Epi, class Sched, bool ALIGN_EPI = false, bool SP2 = false>
__device__ __forceinline__ void gemm_phase(PG8_LAS unsigned char* lds, const Gemm g, const Sched& S, const Epi& E, const int tid_in) {
    int tid_ = tid_in; asm volatile("" : "+v"(tid_));
    const int tid = tid_, wid = __builtin_amdgcn_readfirstlane(tid >> 6), lane = tid & 63, wr = wid >> 2, wc = wid & 3, fr = lane & 15, fq = lane >> 4;
    const int K = g.K, nt = K / BK, lda = g.lda ? g.lda : K, ldb = g.ldb ? g.ldb : K;
    unsigned voffA[2], voffB[2];
#pragma unroll
    for (int i = 0; i < 2; ++i) { int R, C; stage_rc(tid * 16 + i * 8192, R, C); const int Rb = Epi::PERM ? ((R & ~31) + perm32(R & 31)) : R;
        voffA[i] = (unsigned)(R * lda + C) * 2u; voffB[i] = (unsigned)(Rb * ldb + C) * 2u; }
    const size_t kstep = (size_t)(BK * 2);
    const size_t hstepA = (size_t)HALF * lda * 2, hstepB = (size_t)HALF * ldb * 2;
    const size_t tstepA = 2 * hstepA, tstepB = 2 * hstepB;
    const unsigned ldsw = (unsigned)wid * 1024u;
    const int aoff = lds_byte(wr * 64 + fr, fq * 8), boff = lds_byte(wc * 32 + fr, fq * 8);
#define PG8_SA(b, h) (((b) * 2 + (h)) * HTB)
#define PG8_SB(b, h) ((4 + (b) * 2 + (h)) * HTB)
#define PG8_STAGE(bufoff, gbase, voff) do { _Pragma("unroll") for (int _i = 0; _i < 2; ++_i) \
        __builtin_amdgcn_global_load_lds((const unsigned*)((const char*)(gbase) + (voff)[_i]), (PG8_LAS unsigned*)(lds + (bufoff) + ldsw + _i * 8192), 16, 0, 0); } while (0)
#define PG8_LDA(dst, b, h) do { _Pragma("unroll") for (int m = 0; m < 4; ++m) _Pragma("unroll") for (int k = 0; k < 2; ++k) dst[m][k] = *(const PG8_LAS bf16x8*)(lds + PG8_SA(b, h) + aoff + m * 2048 + k * 1024); } while (0)
#define PG8_LDB(dst, b, h) do { _Pragma("unroll") for (int n = 0; n < 2; ++n) _Pragma("unroll") for (int k = 0; k < 2; ++k) dst[n][k] = *(const PG8_LAS bf16x8*)(lds + PG8_SB(b, h) + boff + n * 2048 + k * 1024); } while (0)
#define PG8_MMA(ai, bj, At, Bt) do { __builtin_amdgcn_s_setprio(1); _Pragma("unroll") for (int m = 0; m < 4; ++m) _Pragma("unroll") for (int n = 0; n < 2; ++n) _Pragma("unroll") for (int k = 0; k < 2; ++k) \
        acc[ai][bj][m][n] = __builtin_amdgcn_mfma_f32_16x16x32_bf16(Bt[n][k], At[m][k], acc[ai][bj][m][n], 0, 0, 0); __builtin_amdgcn_s_setprio(0); } while (0)
    typedef int pg8_i32x4 __attribute__((ext_vector_type(4)));
#define PG8_CAT(x) __builtin_shufflevector(__builtin_bit_cast(pg8_i32x4, (x)[0]), __builtin_bit_cast(pg8_i32x4, (x)[1]), 0, 1, 2, 3, 4, 5, 6, 7)
#define PG8_MMA8(ai, bj, At, Bt) do { __builtin_amdgcn_s_setprio(1); _Pragma("unroll") for (int m = 0; m < 4; ++m) _Pragma("unroll") for (int n = 0; n < 2; ++n) \
        asm volatile("v_mfma_scale_f32_16x16x128_f8f6f4 %0, %1, %2, %0, %3, %4 op_sel_hi:[0,0,0]" : "+v"(acc[ai][bj][m][n]) : "v"(PG8_CAT(Bt[n])), "v"(PG8_CAT(At[m])), "v"(sclB), "v"(sclA)); __builtin_amdgcn_s_setprio(0); } while (0)
#define PG8_MMAT(ai, bj, At, Bt) do { __builtin_amdgcn_s_setprio(1); _Pragma("unroll") for (int k = 0; k < 2; ++k) _Pragma("unroll") for (int m = 0; m < 4; ++m) _Pragma("unroll") for (int n = 0; n < 2; ++n)   \
        asm volatile("v_mfma_f32_16x16x32_bf16 %0, %1, %2, %0" : "+v"(acc[ai][bj][m][n]) : "v"(Bt[n][k]), "v"(At[m][k])); __builtin_amdgcn_s_setprio(0); } while (0)
#define PG8_MMAB(ai, bj, At, Bt) do { if constexpr (Sched::MIXED) PG8_MMAT(ai, bj, At, Bt); else PG8_MMA(ai, bj, At, Bt); } while (0)
#define PG8_WAIT_V(n) asm volatile("s_waitcnt vmcnt(" #n ")" ::: "memory")
#define PG8_WAIT_L(n) asm volatile("s_waitcnt lgkmcnt(" #n ")" ::: "memory")
#define PG8_BAR __builtin_amdgcn_s_barrier()
#define PG8_SCHED __builtin_amdgcn_sched_barrier(0)
    Unit cur, nxt; int ui = 0;
    if (!S.next(0, cur)) return;
    f32x4 acc[2][2][4][2];
#pragma unroll
    for (int a = 0; a < 2; ++a)
#pragma unroll
        for (int b = 0; b < 2; ++b)
#pragma unroll
            for (int m = 0; m < 4; ++m)
#pragma unroll
                for (int n = 0; n < 2; ++n) acc[a][b][m][n] = (f32x4){0.f, 0.f, 0.f, 0.f};
    bf16x8 At[4][2], B0[2][2], B1[2][2];
    const char* cA = (const char*)g.A + (size_t)cur.pm * tstepA + cur.aoff; const char* cB = (const char*)g.Bt + (size_t)cur.pn * tstepB + cur.boff;
    S.a_ready(cur);
    if constexpr (SP2) {
        PG8_STAGE(PG8_SB(0, 0), cB, voffB); PG8_STAGE(PG8_SB(0, 1), cB + hstepB, voffB); PG8_STAGE(PG8_SA(0, 0), cA, voffA); PG8_STAGE(PG8_SA(0, 1), cA + hstepA, voffA);
        if (wr == 1) PG8_BAR;
        PG8_WAIT_V(2); PG8_BAR;
        PG8_STAGE(PG8_SB(1, 0), cB + kstep, voffB); PG8_STAGE(PG8_SA(1, 0), cA + kstep, voffA); PG8_STAGE(PG8_SB(1, 1), cB + hstepB + kstep, voffB);
        PG8_WAIT_V(6); PG8_BAR;
    } else {
        PG8_STAGE(PG8_SB(0, 0), cB, voffB); PG8_STAGE(PG8_SA(0, 0), cA, voffA); PG8_STAGE(PG8_SB(0, 1), cB + hstepB, voffB); PG8_STAGE(PG8_SA(0, 1), cA + hstepA, voffA);
        if (wr == 1) PG8_BAR;
        PG8_WAIT_V(4); PG8_BAR;
        PG8_STAGE(PG8_SB(1, 0), cB + kstep, voffB); PG8_STAGE(PG8_SA(1, 0), cA + kstep, voffA); PG8_STAGE(PG8_SB(1, 1), cB + hstepB + kstep, voffB);
        PG8_WAIT_V(6); PG8_BAR;
    }
    for (;;) {
        const bool has_next = S.next(ui + 1, nxt);
        const char* nA = has_next ? (const char*)g.A + (size_t)nxt.pm * tstepA + nxt.aoff : cA; const char* nB = has_next ? (const char*)g.Bt + (size_t)nxt.pn * tstepB + nxt.boff : cB;
        const int ntu = Sched::MIXED ? cur.nt : nt; int t0 = 0; if constexpr (Sched::MIXED) t0 = S.nt8;
        const int sclB = 0x77777777, sclA = 0x7b7b7b7b; (void)sclA; (void)sclB;
        if constexpr (Sched::MIXED && SP2) {
        for (int t = 0; t < S.nt8; t += 2) {
            constexpr bool last = false;
            asm volatile("" : "+v"(voffA[0]), "+v"(voffA[1]), "+v"(voffB[0]), "+v"(voffB[1]));
            const size_t j2 = (t + 2 >= S.nt8) ? S.jump : 0;
            const char* a1 = cA + (size_t)(t + 1) * kstep;
            const char* a2 = cA + (size_t)(t + 2) * kstep + j2; const char* b2 = cB + (size_t)(t + 2) * kstep + j2;
            const char* a3 = a2 + kstep; const char* b3 = b2 + kstep;
            if (last && has_next) S.a_ready(nxt);
            PG8_LDB(B0, 0, 0); PG8_LDB(B1, 0, 1); PG8_SCHED; PG8_LDA(At, 0, 0); PG8_STAGE(PG8_SA(1, 1), a1 + hstepA, voffA);
            PG8_WAIT_V(8); PG8_WAIT_L(0); PG8_BAR; PG8_MMA8(0, 0, At, B0); PG8_MMA8(0, 1, At, B1); PG8_BAR; PG8_SCHED;
            PG8_LDA(At, 0, 1); PG8_STAGE(PG8_SB(0, 0), b2, voffB); PG8_STAGE(PG8_SB(0, 1), b2 + hstepB, voffB); PG8_STAGE(PG8_SA(0, 0), a2, voffA);
            PG8_WAIT_V(8); PG8_WAIT_L(0); PG8_BAR; PG8_MMA8(1, 0, At, B0); PG8_MMA8(1, 1, At, B1); PG8_BAR; PG8_SCHED;
            PG8_LDB(B0, 1, 0); PG8_LDB(B1, 1, 1); PG8_SCHED; PG8_LDA(At, 1, 0); PG8_STAGE(PG8_SA(0, 1), a2 + hstepA, voffA);
            PG8_WAIT_V(8); PG8_WAIT_L(0); PG8_BAR; PG8_MMA8(0, 0, At, B0); PG8_MMA8(0, 1, At, B1); PG8_BAR; PG8_SCHED;
            PG8_LDA(At, 1, 1); PG8_STAGE(PG8_SB(1, 0), b3, voffB); PG8_STAGE(PG8_SB(1, 1), b3 + hstepB, voffB); PG8_STAGE(PG8_SA(1, 0), a3, voffA);
            PG8_WAIT_V(8); PG8_WAIT_L(0); PG8_BAR; PG8_MMA8(1, 0, At, B0); PG8_MMA8(1, 1, At, B1); PG8_BAR; PG8_SCHED;
        }
        }
        for (int t = t0; t < ntu; t += 2) {
            const bool last = (t == ntu - 2);
            if constexpr (Sched::MIXED) asm volatile("" : "+v"(voffA[0]), "+v"(voffA[1]), "+v"(voffB[0]), "+v"(voffB[1]));
            size_t j1 = 0, j2 = 0; if constexpr (Sched::MIXED) { j1 = (t >= S.nt8) ? S.jump : 0; j2 = (t + 2 >= S.nt8) ? S.jump : 0; }
            const char* a1 = cA + (size_t)(t + 1) * kstep + j1;
            const char* a2 = last ? nA : cA + (size_t)(t + 2) * kstep + j2; const char* b2 = last ? nB : cB + (size_t)(t + 2) * kstep + j2;
            const char* a3 = a2 + kstep; const char* b3 = b2 + kstep;
            if (last && has_next) S.a_ready(nxt);
            if constexpr (SP2) {
            PG8_LDB(B0, 0, 0); PG8_LDB(B1, 0, 1); PG8_SCHED; PG8_LDA(At, 0, 0); PG8_STAGE(PG8_SA(1, 1), a1 + hstepA, voffA);
            PG8_WAIT_V(8); PG8_WAIT_L(0); PG8_BAR; PG8_MMAB(0, 0, At, B0); PG8_MMAB(0, 1, At, B1); PG8_BAR; PG8_SCHED;
            PG8_LDA(At, 0, 1); PG8_STAGE(PG8_SB(0, 0), b2, voffB); PG8_STAGE(PG8_SB(0, 1), b2 + hstepB, voffB); PG8_STAGE(PG8_SA(0, 0), a2, voffA);
            PG8_WAIT_V(8); PG8_WAIT_L(0); PG8_BAR; PG8_MMAB(1, 0, At, B0); PG8_MMAB(1, 1, At, B1); PG8_BAR; PG8_SCHED;
            PG8_LDB(B0, 1, 0); PG8_LDB(B1, 1, 1); PG8_SCHED; PG8_LDA(At, 1, 0); PG8_STAGE(PG8_SA(0, 1), a2 + hstepA, voffA);
            PG8_WAIT_V(8); PG8_WAIT_L(0); PG8_BAR; PG8_MMAB(0, 0, At, B0); PG8_MMAB(0, 1, At, B1); PG8_BAR; PG8_SCHED;
            PG8_LDA(At, 1, 1); PG8_STAGE(PG8_SB(1, 0), b3, voffB); PG8_STAGE(PG8_SB(1, 1), b3 + hstepB, voffB); PG8_STAGE(PG8_SA(1, 0), a3, voffA);
            PG8_WAIT_V(8); PG8_WAIT_L(0); PG8_BAR; PG8_MMAB(1, 0, At, B0); PG8_MMAB(1, 1, At, B1); PG8_BAR; PG8_SCHED;
            } else {
            PG8_LDB(B0, 0, 0); PG8_SCHED; PG8_LDA(At, 0, 0); PG8_STAGE(PG8_SA(1, 1), a1 + hstepA, voffA);
            PG8_WAIT_L(8); PG8_BAR; PG8_WAIT_L(0); PG8_MMA(0, 0, At, B0); PG8_BAR; PG8_SCHED;
            PG8_LDB(B1, 0, 1); PG8_STAGE(PG8_SB(0, 0), b2, voffB);
            PG8_BAR; PG8_WAIT_L(0); PG8_MMA(0, 1, At, B1); PG8_BAR;
            PG8_LDA(At, 0, 1); PG8_STAGE(PG8_SA(0, 0), a2, voffA);
            PG8_BAR; PG8_WAIT_L(0); PG8_MMA(1, 0, At, B0); PG8_BAR; PG8_SCHED;
            PG8_STAGE(PG8_SB(0, 1), b2 + hstepB, voffB);
            PG8_WAIT_V(6); PG8_BAR; PG8_MMA(1, 1, At, B1); PG8_BAR;
            PG8_LDB(B0, 1, 0); PG8_SCHED; PG8_LDA(At, 1, 0); PG8_STAGE(PG8_SA(0, 1), a2 + hstepA, voffA);
            PG8_WAIT_L(8); PG8_BAR; PG8_WAIT_L(0); PG8_MMA(0, 0, At, B0); PG8_BAR; PG8_SCHED;
            PG8_LDB(B1, 1, 1); PG8_STAGE(PG8_SB(1, 0), b3, voffB);
            PG8_BAR; PG8_WAIT_L(0); PG8_MMA(0, 1, At, B1); PG8_BAR;
            PG8_LDA(At, 1, 1); PG8_STAGE(PG8_SA(1, 0), a3, voffA);
            PG8_BAR; PG8_WAIT_L(0); PG8_MMA(1, 0, At, B0); PG8_BAR; PG8_SCHED;
            PG8_STAGE(PG8_SB(1, 1), b3 + hstepB, voffB);
            PG8_WAIT_V(6); PG8_BAR; PG8_MMA(1, 1, At, B1); PG8_BAR;
            }
        }
        if constexpr (ALIGN_EPI) { if (wr == 0) PG8_BAR; }
        if constexpr (!Epi::AFTER_DRAIN) { E(acc, cur, wr, wc, fr, fq); S.done(cur); }
        if (!has_next) break;
#pragma unroll
        for (int a = 0; a < 2; ++a)
#pragma unroll
            for (int b = 0; b < 2; ++b)
#pragma unroll
                for (int m = 0; m < 4; ++m)
#pragma unroll
                    for (int n = 0; n < 2; ++n) acc[a][b][m][n] = (f32x4){0.f, 0.f, 0.f, 0.f};
        cur = nxt; cA = nA; cB = nB; ++ui;
        if constexpr (ALIGN_EPI) { if (wr == 1) PG8_BAR; }
    }
    PG8_WAIT_V(0);
    if constexpr (!ALIGN_EPI) { if (wr == 0) PG8_BAR; }
    PG8_BAR;
    if constexpr (Epi::AFTER_DRAIN) { E.fused(acc, cur, wr, wc, fr, fq, lds, wid, lane); S.done(cur); }
#undef PG8_CAT
#undef PG8_MMA8
#undef PG8_MMAT
#undef PG8_MMAB
#undef PG8_SA
#undef PG8_SB
#undef PG8_STAGE
#undef PG8_LDA
#undef PG8_LDB
#undef PG8_MMA
#undef PG8_WAIT_V
#undef PG8_WAIT_L
#undef PG8_BAR
#undef PG8_SCHED
}
}

constexpr int D = 2048, BATCH = 4, SEQ = 2048, DEPTH = 4, M = BATCH * SEQ, MEM_LEN = 256, MM = BATCH * MEM_LEN;
constexpr int DIN = 4128, DFF = 8192;
constexpr int O_AQ = 0, O_AK = 1024, O_AV = 1280, O_BQ = 1536, O_BK = 1792, O_BV = 2048, O_BG = 2560, O_ZF = 3072, O_ZB = 3088, O_CX = 3104, O_CY = 3616;
constexpr int NPB = 4096;
constexpr int PB_CX = 3072, PB_CY = 3584;
constexpr float EPS = 1e-6f;
constexpr int NWAVES = 8, NTHREADS = 512;

#ifndef PROBE_AMP
#define PROBE_AMP 0u
#endif
constexpr unsigned long long AMP_K = 3;
#ifndef NWL
#define NWL 4
#endif
constexpr size_t MiB = 1u << 20;
constexpr size_t WS_CTL = 0, CTL_ZERO_BYTES = 1 * MiB;
constexpr size_t WS_W = 1 * MiB, WL_BYTES = 121 * MiB;
constexpr size_t WL_IN = 0, WL_OUT = 16 * MiB, WL_XQ = 24 * MiB, WL_XK = 32 * MiB, WL_XV = 40 * MiB, WL_XO = 48 * MiB, WL_UP = 56 * MiB, WL_DOWN = 88 * MiB, WL_Z = 120 * MiB, WL_LRUG = 120 * MiB + 256 * 1024;
constexpr size_t WS_XN = WS_W + NWL * WL_BYTES;
constexpr size_t WS_MEMN = WS_XN + 32 * MiB;
constexpr size_t WS_KX = WS_MEMN + 16 * MiB;
constexpr size_t WS_VT = WS_KX + 16 * MiB;
constexpr size_t WS_Y = WS_VT + 16 * MiB;
constexpr size_t WS_Z = WS_Y + 64 * MiB;
constexpr size_t WS_BIG = WS_Z + 1 * MiB;
constexpr size_t WS_PB = WS_BIG;
constexpr size_t WS_MIX = WS_BIG + 64 * MiB;
constexpr size_t WS_GLAU = WS_BIG + 96 * MiB;
constexpr size_t WS_MISC = WS_BIG + 128 * MiB;
constexpr size_t WS_H = WS_BIG;
constexpr size_t WS_SC = WS_BIG;
constexpr size_t WS_PR = WS_BIG + 64 * MiB;
constexpr size_t WS_LRU = WS_BIG + 136 * MiB;
constexpr size_t WS_SLOT = WS_LRU + 24 * MiB;
constexpr size_t WS_MQK = WS_SLOT + 4 * MiB;
constexpr size_t WS_VWO = WS_MQK + 64 * MiB;
constexpr size_t WS_END = WS_VWO + 64 * MiB;
constexpr int CW_TMO = 0, CW_BAR = 4096, CW_RCNT = 65536, CW_SCNT = 131072;

constexpr int RING_OFF = 0, RING_BYTES = 131072, SCR_BYTES = 143360;
constexpr int LDSCTL_OFF = SCR_BYTES, MISC_OFF = LDSCTL_OFF + 320;
constexpr int LDS_BYTES = 147456;

#define GAS __attribute__((address_space(1)))
#define CAS __attribute__((address_space(4)))
#define LAS __attribute__((address_space(3)))
typedef unsigned short bf16;
typedef unsigned v4u __attribute__((ext_vector_type(4)));
typedef unsigned v2u __attribute__((ext_vector_type(2)));
typedef float f32x4 __attribute__((ext_vector_type(4)));
typedef short bf16x8 __attribute__((ext_vector_type(8)));
typedef short s16x4 __attribute__((ext_vector_type(4)));
#define LDS_WAIT() asm volatile("s_waitcnt lgkmcnt(0)" ::: "memory")
#define LBAR() do { asm volatile("s_waitcnt lgkmcnt(0)" ::: "memory"); __builtin_amdgcn_s_barrier(); asm volatile("" ::: "memory"); } while (0)
#define VM_WAIT() asm volatile("s_waitcnt vmcnt(0)" ::: "memory")
typedef float f32x2_t __attribute__((ext_vector_type(2)));
typedef __bf16 bf16x2_t __attribute__((ext_vector_type(2)));
__device__ __forceinline__ unsigned pk2(float lo, float hi) { const f32x2_t v = {lo, hi}; return __builtin_bit_cast(unsigned, __builtin_convertvector(v, bf16x2_t)); }
__device__ __forceinline__ unsigned f2bf(float f) { return pk2(f, f) & 0xffffu; }
__device__ __forceinline__ float bf2f(unsigned short b) { return __builtin_bit_cast(float, (unsigned)b << 16); }
__device__ __forceinline__ float wave_sum(float v, int lane) {
#pragma unroll
    for (int o = 1; o < 64; o <<= 1) v += lane_xor_f(v, o, lane);
    return v;
}
__device__ __forceinline__ float wave_max(float v, int lane) {
#pragma unroll
    for (int o = 1; o < 64; o <<= 1) v = fmaxf(v, lane_xor_f(v, o, lane));
    return v;
}
__device__ __forceinline__ float sigmoidf_(float x) { return __builtin_amdgcn_rcpf(1.f + __builtin_amdgcn_exp2f(-1.4426950408889634f * x)); }
__device__ __forceinline__ float softplusf_(float x) { return fmaxf(x, 0.f) + 0.6931471805599453f * __builtin_amdgcn_logf(1.f + __builtin_amdgcn_exp2f(-1.4426950408889634f * fabsf(x))); }
__device__ __forceinline__ float gelu_tanh(float x) { return x * sigmoidf_(1.5957691216057308f * (x + 0.044715f * x * x * x)); }
__device__ __forceinline__ int t5_bucket(int rel) {
    const int ret = rel > 0 ? 16 : 0; const int n = rel < 0 ? -rel : rel;
    if (n < 8) return ret + n;
    int k = 0; while (k < 7 && (64 << (k + 1)) <= n * n) ++k;
    return ret + 8 + k;
}

struct Frame {
    LAS unsigned char* lds;
    int tid, lane, wave, G, bx;
};

__device__ __forceinline__ void p0_transpose_item(const float* W, int K, int N, int c0, bf16* WT, int r0, int nblk, const float* gk, LAS float* scr, int item, int lane) {
    const int kb = item / nblk, nb = item % nblk, k0 = 64 * kb, n0 = 32 * nb;
    const int c = lane & 7;
    f32x4 g0 = {1.f, 1.f, 1.f, 1.f}, g1 = {1.f, 1.f, 1.f, 1.f};
    if (gk) { g0 = *(const GAS f32x4*)(gk + k0 + 8 * c); g1 = *(const GAS f32x4*)(gk + k0 + 8 * c + 4); }
    f32x4 wv[8];
#pragma unroll
    for (int i = 0; i < 8; ++i) wv[i] = *(const GAS f32x4*)(W + (size_t)(k0 + 8 * i + (lane >> 3)) * N + c0 + n0 + 4 * (lane & 7));
#pragma unroll
    for (int i = 0; i < 8; ++i) { LAS float* d = scr + (8 * i + (lane >> 3)) * 33 + 4 * (lane & 7); d[0] = wv[i].x; d[1] = wv[i].y; d[2] = wv[i].z; d[3] = wv[i].w; }
    LDS_WAIT(); asm volatile("" ::: "memory");
#pragma unroll
    for (int j = 0; j < 4; ++j) { const int n = (lane >> 3) + 8 * j; const LAS float* s = scr + (8 * c) * 33 + n;
        v4u o; o.x = pk2(s[0 * 33] * g0.x, s[1 * 33] * g0.y); o.y = pk2(s[2 * 33] * g0.z, s[3 * 33] * g0.w); o.z = pk2(s[4 * 33] * g1.x, s[5 * 33] * g1.y); o.w = pk2(s[6 * 33] * g1.z, s[7 * 33] * g1.w);
        *(GAS v4u*)(WT + (size_t)(r0 + n0 + n) * K + k0 + 8 * c) = o; }
    LDS_WAIT(); asm volatile("" ::: "memory");
}
struct ConvSeg { const float* W; int K, N, c0, ncols; bf16* WT; int r0; const float* gain; };
__device__ __forceinline__ int seg_items(const ConvSeg& s) { return (s.K / 64) * (s.ncols / 32); }
struct SegC { int in_idx, K, N, c0, ncols, r0, gain_idx; unsigned wl_off; unsigned lstride; };
__device__ const SegC SEGA[2] = {
    {19, D, D, 0, D, 0, -1, (unsigned)WL_XK, (unsigned)(D * D)}, {20, D, D, 0, D, 0, -1, (unsigned)WL_XV, (unsigned)(D * D)}};
__device__ const int SEGA_START[3] = {0, 2048, 4096};
__device__ const SegC SEGO[1] = {{21, D, D, 0, D, 0, -1, (unsigned)WL_XO, (unsigned)(D * D)}};
__device__ const int SEGO_START[2] = {0, 2048};
__device__ const SegC SEGB[6] = {
    {3, D, DIN, 0, 3072, 0, 24, (unsigned)WL_IN, (unsigned)(D * DIN)}, {3, D, DIN, 3072, 32, 0, 24, (unsigned)WL_Z, (unsigned)(D * DIN)}, {3, D, DIN, 3104, 1024, 3072, 24, (unsigned)WL_IN, (unsigned)(D * DIN)},
    {4, D, D, 0, D, 0, -1, (unsigned)WL_OUT, (unsigned)(D * D)}, {22, D, DFF, 0, DFF, 0, 29, (unsigned)WL_UP, (unsigned)(D * DFF)}, {23, DFF, D, 0, D, 0, -1, (unsigned)WL_DOWN, (unsigned)(DFF * D)}};
__device__ const int SEGB_START[7] = {0, 3072, 3104, 4128, 6176, 14368, 22560};
constexpr int SEGA_ITEMS = 4096, SEGO_ITEMS = 2048, SEGB_ITEMS = 22560;
constexpr int SEGB_SPLIT = 44700;
__device__ const int K8L[4] = {0, 7936, 7936, 7936};
struct ConvDesc { const float* src; const float* gk; bf16* dst; int N, K, q8; };

__device__ __forceinline__ void scale_row_bf16(int lane, const float* src, float s, bf16* dst) {
    const GAS f32x4* xr = (const GAS f32x4*)src; GAS v4u* ob = (GAS v4u*)dst;
#pragma unroll
    for (int j = 0; j < 4; ++j) { const int ch = lane + 64 * j; const f32x4 p = xr[2 * ch], q = xr[2 * ch + 1];
        v4u w; w.x = pk2(p.x * s, p.y * s); w.y = pk2(p.z * s, p.w * s); w.z = pk2(q.x * s, q.y * s); w.w = pk2(q.z * s, q.w * s); ob[ch] = w; }
}
__device__ __forceinline__ void norm_row(int lane, const float* src, const float* g, bf16* xn, float* copy_dst) {
    const GAS f32x4* xr = (const GAS f32x4*)src + lane; const GAS f32x4* gr = (const GAS f32x4*)g + lane;
    f32x4 v[8]; float s = 0.f;
#pragma unroll
    for (int j = 0; j < 8; ++j) { v[j] = xr[64 * j]; s += (v[j].x * v[j].x + v[j].y * v[j].y) + (v[j].z * v[j].z + v[j].w * v[j].w); }
    const float r = rsqrtf(wave_sum(s, lane) * (1.f / D) + EPS);
    GAS v2u* o8 = (GAS v2u*)xn + lane;
#pragma unroll
    for (int j = 0; j < 8; ++j) { const f32x4 gg = gr[64 * j]; v2u w; w.x = pk2(v[j].x * r * gg.x, v[j].y * r * gg.y); w.y = pk2(v[j].z * r * gg.z, v[j].w * r * gg.w); o8[64 * j] = w;
        if (copy_dst) ((GAS f32x4*)copy_dst + lane)[64 * j] = v[j]; }
}
template <int NR>
__device__ __forceinline__ void init_rows(int lane, const float* x0, bf16* xb0, float* rs0, size_t row_stride) {
    f32x4 a[NR][4], b[NR][4];
#pragma unroll
    for (int i = 0; i < NR; ++i)
#pragma unroll
        for (int j = 0; j < 4; ++j) { const int ch = lane + 64 * j; const GAS f32x4* xr = (const GAS f32x4*)(x0 + i * row_stride * D); a[i][j] = xr[2 * ch]; b[i][j] = xr[2 * ch + 1]; }
#pragma unroll
    for (int i = 0; i < NR; ++i) { float s = 0.f; GAS v4u* ob = (GAS v4u*)(xb0 + i * row_stride * D);
#pragma unroll
        for (int j = 0; j < 4; ++j) { const int ch = lane + 64 * j; const f32x4 p = a[i][j], q = b[i][j];
            s += (p.x * p.x + p.y * p.y) + (p.z * p.z + p.w * p.w) + (q.x * q.x + q.y * q.y) + (q.z * q.z + q.w * q.w);
            v4u w; w.x = pk2(p.x, p.y); w.y = pk2(p.z, p.w); w.z = pk2(q.x, q.y); w.w = pk2(q.z, q.w); ob[ch] = w; }
        s = wave_sum(s, lane);
        if (lane < 8) rs0[i * row_stride + (size_t)lane * M] = lane == 0 ? s : 0.f; }
}
__device__ __forceinline__ void init_row(int lane, const float* x, bf16* xb, float* rs) {
    const GAS f32x4* xr = (const GAS f32x4*)x; GAS v4u* ob = (GAS v4u*)xb;
    float s = 0.f;
#pragma unroll
    for (int j = 0; j < 4; ++j) { const int ch = lane + 64 * j; const f32x4 a = xr[2 * ch], b = xr[2 * ch + 1];
        s += (a.x * a.x + a.y * a.y) + (a.z * a.z + a.w * a.w) + (b.x * b.x + b.y * b.y) + (b.z * b.z + b.w * b.w);
        v4u w; w.x = pk2(a.x, a.y); w.y = pk2(a.z, a.w); w.z = pk2(b.x, b.y); w.w = pk2(b.z, b.w); ob[ch] = w; }
    s = wave_sum(s, lane);
    if (lane < 8) rs[(size_t)lane * M] = lane == 0 ? s : 0.f;
}
__device__ __forceinline__ void zgemm(const Frame& F, const bf16* XN, const bf16* WZ, const float* RS, float* Z) {
    const int lane = F.lane, g = lane >> 4, c = lane & 15, w = F.wave, kq = w & 3;
    LAS f32x4* red = (LAS f32x4*)F.lds;
    for (int rb = F.bx; rb < M / 32; rb += F.G) {
        const int rt = rb * 2 + (w >> 2);
        const bf16* ap = XN + (size_t)(rt * 16 + c) * D + kq * 512 + g * 8;
        const bf16* b0 = WZ + (size_t)c * D + kq * 512 + g * 8; const bf16* b1p = WZ + (size_t)(16 + c) * D + kq * 512 + g * 8;
        f32x4 acc0 = {0.f, 0.f, 0.f, 0.f}, acc1 = {0.f, 0.f, 0.f, 0.f};
#pragma unroll 8
        for (int ks = 0; ks < 16; ++ks) { const bf16x8 a = *(const GAS bf16x8*)(ap + ks * 32), x = *(const GAS bf16x8*)(b0 + ks * 32), y = *(const GAS bf16x8*)(b1p + ks * 32);
            acc0 = __builtin_amdgcn_mfma_f32_16x16x32_bf16(a, x, acc0, 0, 0, 0); acc1 = __builtin_amdgcn_mfma_f32_16x16x32_bf16(a, y, acc1, 0, 0, 0); }
        LBAR();
        red[(w * 2 + 0) * 64 + lane] = acc0; red[(w * 2 + 1) * 64 + lane] = acc1;
        LBAR();
        if (kq == 0) {
#pragma unroll
            for (int ct = 0; ct < 2; ++ct) { f32x4 s = red[(w * 2 + ct) * 64 + lane];
#pragma unroll
                for (int q = 1; q < 4; ++q) s += red[((w + q) * 2 + ct) * 64 + lane];
#pragma unroll
                for (int r = 0; r < 4; ++r) { const int m = rt * 16 + 4 * g + r; float t = 0.f;
#pragma unroll
                    for (int q = 0; q < 8; ++q) t += RS[(size_t)q * M + m];
                    Z[(size_t)m * 32 + ct * 16 + c] = s[r] * rsqrtf(t * (1.f / D) + EPS); } }
        }
    }
}

#define XB_TMO      128
#define XB_XCNT(j)  (256  + 64 * (j))
#define XB_XSUB(j)  (1280 + 64 * (j))
#define XB_XGEN(j)  (2304 + 64 * (j))
#define XB_TOP      3328
#define XB_TOPGEN   3392
#define XCD_BAR_WORDS 3456
#define XB_SPIN_CAP (1u << 18)
#define LAS __attribute__((address_space(3)))

__device__ __forceinline__ unsigned xb_ld(unsigned* p)              { return __hip_atomic_load(p, __ATOMIC_RELAXED, __HIP_MEMORY_SCOPE_AGENT); }
__device__ __forceinline__ unsigned xb_add(unsigned* p, unsigned v) { return __hip_atomic_fetch_add(p, v, __ATOMIC_RELAXED, __HIP_MEMORY_SCOPE_AGENT); }
__device__ __forceinline__ unsigned xb_xcc_id() { return (unsigned)__builtin_amdgcn_s_getreg((3 << 11) | 20) & 0xFu; }
#define XB_SPIN(cond, bar) do { unsigned _sp = 0; while (cond) { __builtin_amdgcn_s_sleep(1); \
    if ((++_sp & 255u) == 0u) { if (xb_ld(&(bar)[XB_TMO])) break; if (_sp > XB_SPIN_CAP) { atomicAdd(&(bar)[XB_TMO], 1u); break; } } } } while (0)

struct XcdBarrier {
    unsigned* bar; unsigned x;
    volatile LAS unsigned* st;
};

__device__ __forceinline__ XcdBarrier xcd_barrier_post(unsigned* bar, volatile LAS unsigned* st) {
    XcdBarrier b; b.bar = bar; b.x = xb_xcc_id(); b.st = st;
    if (threadIdx.x == 0) (void)xb_add(&bar[XB_XCNT(b.x)], 1u);
    return b;
}
__device__ __forceinline__ void xcd_barrier_complete(unsigned* bar, unsigned x, unsigned& nloc, unsigned& nx) {
    const unsigned G = gridDim.x * gridDim.y * gridDim.z;
    unsigned sum, cnt, mine, sp = 0u;
    for (;;) {
        sum = 0u; cnt = 0u; mine = 0u;
#pragma unroll
        for (unsigned j = 0; j < 16; ++j) { const unsigned c = xb_ld(&bar[XB_XCNT(j)]); sum += c; cnt += (c > 0u) ? 1u : 0u; mine = (j == x) ? c : mine; }
        if (sum == G) break;
        __builtin_amdgcn_s_sleep(1);
        if ((++sp & 255u) == 0u) { if (xb_ld(&bar[XB_TMO])) break; if (sp > XB_SPIN_CAP) { atomicAdd(&bar[XB_TMO], 1u); break; } }
    }
    nloc = mine > 0u ? mine : 1u; nx = cnt > 0u ? cnt : 1u;
}

__device__ __forceinline__ void xcd_barrier(const XcdBarrier& b) {
    asm volatile("s_waitcnt vmcnt(0)" ::: "memory");
    __syncthreads();
    if (threadIdx.x == 0) {
        unsigned* bar = b.bar;
        __builtin_amdgcn_s_waitcnt(0);
        unsigned nloc = b.st[0], nx = b.st[1];
        if (nloc == 0u) { xcd_barrier_complete(bar, b.x, nloc, nx); b.st[0] = nloc; b.st[1] = nx; }
        const unsigned old = xb_add(&bar[XB_XSUB(b.x)], 1u);
        const unsigned gen = old / nloc;
        if (old + 1u == (gen + 1u) * nloc) {
            __builtin_amdgcn_fence(__ATOMIC_RELEASE, "agent");
            asm volatile("s_waitcnt vmcnt(0)" ::: "memory");
            const unsigned og = xb_add(&bar[XB_TOP], 1u);
            const unsigned tg = og / nx;
            if (og + 1u == (tg + 1u) * nx) xb_add(&bar[XB_TOPGEN], 1u);
            else XB_SPIN(xb_ld(&bar[XB_TOPGEN]) == tg, bar);
            __builtin_amdgcn_fence(__ATOMIC_ACQUIRE, "agent");
            xb_add(&bar[XB_XGEN(b.x)], 1u);
            asm volatile("s_waitcnt vmcnt(0)" ::: "memory");
        } else {
            XB_SPIN(xb_ld(&bar[XB_XGEN(b.x)]) == gen, bar);
            __builtin_amdgcn_fence(__ATOMIC_ACQUIRE, "agent");
            asm volatile("s_waitcnt vmcnt(0)" ::: "memory");
        }
    }
    __syncthreads();
}
__device__ __forceinline__ void conv_weights_phase(const Frame& F, const float* const CAS* inp, unsigned char* ws, const SegC* segs, const int* starts, int nseg, int per_layer, int f_begin, int f_end, LAS float* scr, int gw, int NGW) {
    {
                const int nflat = f_end;
#define CONV_DESC(f_, d_) do { const int lc_ = (f_) / per_layer, r_ = (f_) % per_layer; int s_ = 0; \
        _Pragma("unroll") for (int q_ = 1; q_ < 6; ++q_) s_ += (q_ < nseg && r_ >= starts[q_]) ? 1 : 0; \
        const SegC sc_ = segs[s_]; const int it_ = r_ - starts[s_], nblk_ = sc_.ncols / 32, kb_ = it_ / nblk_, nb_ = it_ % nblk_, k0_ = 64 * kb_, n0_ = 32 * nb_, c_ = F.lane & 7; \
        (d_).N = sc_.N; (d_).K = sc_.K; \
        (d_).src = inp[sc_.in_idx] + (size_t)lc_ * sc_.lstride + (size_t)(k0_ + (F.lane >> 3)) * sc_.N + sc_.c0 + n0_ + 4 * c_; \
        (d_).gk = sc_.gain_idx >= 0 ? inp[sc_.gain_idx] + (size_t)lc_ * D + k0_ + 8 * c_ : nullptr; \
        (d_).q8 = (sc_.K == DFF && k0_ < K8L[lc_]) ? 1 : 0; \
        (d_).dst = (bf16*)(ws + WS_W + (size_t)(lc_ % NWL) * WL_BYTES + sc_.wl_off) + (size_t)(sc_.r0 + n0_ + (F.lane >> 3)) * sc_.K + ((d_).q8 ? (k0_ + 8 * c_) / 2 : k0_ + 8 * c_); } while (0)
#define CONV_LOAD(d_, wv_, g0_, g1_) do { _Pragma("unroll") for (int i_ = 0; i_ < 8; ++i_) wv_[i_] = *(const GAS f32x4*)((d_).src + (size_t)(8 * i_) * (d_).N); \
        g0_ = (f32x4){1.f, 1.f, 1.f, 1.f}; g1_ = g0_; if ((d_).gk) { g0_ = *(const GAS f32x4*)(d_).gk; g1_ = *(const GAS f32x4*)((d_).gk + 4); } } while (0)
#define FP8W(x_) fminf(fmaxf((x_) * 256.f, -448.f), 448.f)
#define CONV_STORE(d_, wv_, g0_, g1_) do { _Pragma("unroll") for (int i_ = 0; i_ < 8; ++i_) { LAS float* p_ = scr + (8 * i_ + (F.lane >> 3)) * 33 + 4 * (F.lane & 7); p_[0] = wv_[i_].x; p_[1] = wv_[i_].y; p_[2] = wv_[i_].z; p_[3] = wv_[i_].w; } \
        LDS_WAIT(); asm volatile("" ::: "memory"); \
        _Pragma("unroll") for (int j_ = 0; j_ < 4; ++j_) { const LAS float* s_ = scr + (8 * (F.lane & 7)) * 33 + (F.lane >> 3) + 8 * j_; \
            if ((d_).q8) { int w0_ = __builtin_amdgcn_cvt_pk_fp8_f32(FP8W(s_[0 * 33]), FP8W(s_[1 * 33]), 0, false); w0_ = __builtin_amdgcn_cvt_pk_fp8_f32(FP8W(s_[2 * 33]), FP8W(s_[3 * 33]), w0_, true); \
                int w1_ = __builtin_amdgcn_cvt_pk_fp8_f32(FP8W(s_[4 * 33]), FP8W(s_[5 * 33]), 0, false); w1_ = __builtin_amdgcn_cvt_pk_fp8_f32(FP8W(s_[6 * 33]), FP8W(s_[7 * 33]), w1_, true); \
                typedef int i32x2_ __attribute__((ext_vector_type(2))); *(GAS i32x2_*)((d_).dst + (size_t)(8 * j_) * (d_).K) = (i32x2_){w0_, w1_}; } else { \
            v4u o_; o_.x = pk2(s_[0 * 33] * g0_.x, s_[1 * 33] * g0_.y); o_.y = pk2(s_[2 * 33] * g0_.z, s_[3 * 33] * g0_.w); o_.z = pk2(s_[4 * 33] * g1_.x, s_[5 * 33] * g1_.y); o_.w = pk2(s_[6 * 33] * g1_.z, s_[7 * 33] * g1_.w); \
            *(GAS v4u*)((d_).dst + (size_t)(8 * j_) * (d_).K) = o_; } } \
        LDS_WAIT(); asm volatile("" ::: "memory"); } while (0)
                ConvDesc dA, dB; f32x4 wA[8], wB[8], gA0, gA1, gB0, gB1;
                int f = f_begin + gw;
                if (f < nflat) { CONV_DESC(f, dA); CONV_LOAD(dA, wA, gA0, gA1); }
                while (f < nflat) {
                    const int f1 = f + NGW;
                    if (f1 < nflat) { CONV_DESC(f1, dB); CONV_LOAD(dB, wB, gB0, gB1); }
                    CONV_STORE(dA, wA, gA0, gA1);
                    if (f1 >= nflat) break;
                    const int f2 = f1 + NGW;
                    if (f2 < nflat) { CONV_DESC(f2, dA); CONV_LOAD(dA, wA, gA0, gA1); }
                    CONV_STORE(dB, wB, gB0, gB1);
                    f = f2;
                }
#undef CONV_DESC
#undef CONV_LOAD
#undef CONV_STORE
#undef FP8W
            }
}
constexpr size_t MISC_DEC = 3 * MiB;
constexpr int GL_Z = 0, GL_TF = 8192, GL_TB = 10240, GL_VI = 12288, GL_A = 30720, GL_B = 39936, GL_P = 49152, GL_SI = 58368, GL_OF = 76800, GL_VS = 288;
__device__ __forceinline__ bf16x8 tr_frag(LAS unsigned char* p, int stride4) {
    const s16x4 lo = __builtin_amdgcn_ds_read_tr16_b64_v4i16((LAS s16x4*)p);
    const s16x4 hi = __builtin_amdgcn_ds_read_tr16_b64_v4i16((LAS s16x4*)(p + stride4));
    return __builtin_shufflevector(lo, hi, 0, 1, 2, 3, 4, 5, 6, 7);
}
struct GlaW { float wf[16], wb[16], bfv, bbv; };
__device__ __forceinline__ void gla_load_w(GlaW& W, int k, int h, const float* __restrict__ w2f, const float* __restrict__ b2f, const float* __restrict__ w2b, const float* __restrict__ b2b) {
#pragma unroll
    for (int r = 0; r < 16; ++r) { W.wf[r] = w2f[r * 256 + h * 64 + k]; W.wb[r] = w2b[r * 256 + h * 64 + k]; }
    W.bfv = b2f[h * 64 + k]; W.bbv = b2b[h * 64 + k];
}
__device__ __forceinline__ void gla_gates(const Frame& F, const f32x4 zreg, const GlaW& W, float (&cf)[8], float (&cb)[8], float& totf, float& totb) {
    LAS float* ZS = (LAS float*)(F.lds + GL_Z); LAS float* TF = (LAS float*)(F.lds + GL_TF); LAS float* TB = (LAS float*)(F.lds + GL_TB);
    const int tid = F.tid, k = tid & 63, tg = F.wave;
    ((LAS f32x4*)ZS)[tid] = zreg;
    LBAR();
#pragma unroll
    for (int i = 0; i < 8; ++i) { const int t = tg * 8 + i; float af = W.bfv, ab = W.bbv;
#pragma unroll
        for (int r = 0; r < 16; ++r) { af += ZS[t * 32 + r] * W.wf[r]; ab += ZS[t * 32 + 16 + r] * W.wb[r]; }
        cf[i] = -softplusf_(-af) * 0.0625f; cb[i] = -softplusf_(-ab) * 0.0625f; }
#pragma unroll
    for (int i = 1; i < 8; ++i) cf[i] += cf[i - 1];
#pragma unroll
    for (int i = 6; i >= 0; --i) cb[i] += cb[i + 1];
    TF[tg * 64 + k] = cf[7]; TB[tg * 64 + k] = cb[0];
    LBAR();
    float ef = 0.f, eb = 0.f; totf = 0.f; totb = 0.f;
#pragma unroll
    for (int g2 = 0; g2 < 8; ++g2) { const float a = TF[g2 * 64 + k], bq = TB[g2 * 64 + k]; totf += a; totb += bq; ef += (g2 < tg) ? a : 0.f; eb += (g2 > tg) ? bq : 0.f; }
#pragma unroll
    for (int i = 0; i < 8; ++i) { cf[i] += ef; cb[i] += eb; }
}
__device__ __forceinline__ void gla_load_v(const Frame& F, const bf16* __restrict__ PB, size_t m0, int h, v4u (&vr)[2]) {
#pragma unroll
    for (int i = 0; i < 2; ++i) { const int ch = F.tid + NTHREADS * i, row = ch >> 4, col = ch & 15; vr[i] = *(const GAS v4u*)(PB + (m0 + row) * NPB + O_BV + h * 128 + col * 8); }
}
__device__ __forceinline__ void gla_store_v(const Frame& F, const v4u (&vr)[2]) {
    LAS unsigned char* VI = F.lds + GL_VI;
#pragma unroll
    for (int i = 0; i < 2; ++i) { const int ch = F.tid + NTHREADS * i, row = ch >> 4, col = ch & 15; *(LAS v4u*)(VI + row * GL_VS + col * 16) = vr[i]; }
}
__device__ __forceinline__ void gla_u_phase(const Frame& F, const bf16* __restrict__ PB, const float* __restrict__ Z, const float* __restrict__ w2f, const float* __restrict__ b2f,
                                            const float* __restrict__ w2b, const float* __restrict__ b2b, bf16* __restrict__ U, float* __restrict__ DEC) {
    const int tid = F.tid, lane = F.lane, g = lane >> 4, c = lane & 15, w = F.wave, k = tid & 63, tg = F.wave;
    LAS unsigned char* VI = F.lds + GL_VI;
    GlaW W; int h_loaded = -1;
    for (int unit = F.bx; unit < BATCH * 4 * 32; unit += F.G) {
        const int b = unit >> 7, h = (unit >> 5) & 3, n = unit & 31;
        const size_t m0 = (size_t)b * SEQ + n * 64;
        if (h != h_loaded) { gla_load_w(W, k, h, w2f, b2f, w2b, b2b); h_loaded = h; }
        const f32x4 zreg = ((const GAS f32x4*)(Z + m0 * 32))[tid];
        unsigned short kraw[8];
#pragma unroll
        for (int i = 0; i < 8; ++i) kraw[i] = PB[(m0 + tg * 8 + i) * NPB + O_BK + h * 64 + k];
        v4u vr[2]; gla_load_v(F, PB, m0, h, vr);
        LBAR();
        float cf[8], cb[8], totf, totb;
        gla_gates(F, zreg, W, cf, cb, totf, totb);
#pragma unroll
        for (int i = 0; i < 8; ++i) { const int t = tg * 8 + i; const float kk = bf2f(kraw[i]);
            *(LAS unsigned short*)(F.lds + GL_A + t * 144 + k * 2) = (unsigned short)f2bf(kk * __expf(totf - cf[i]));
            *(LAS unsigned short*)(F.lds + GL_B + t * 144 + k * 2) = (unsigned short)f2bf(kk * __expf(totb - cb[i])); }
        const size_t ub = (size_t)(b * 4 + h) * 32 + n;
        if (tg == 0) { DEC[ub * 64 + k] = __expf(totf); DEC[(ub + 512) * 64 + k] = __expf(totb); }
        gla_store_v(F, vr);
        LBAR();
        bf16x8 vf[2];
#pragma unroll
        for (int ts = 0; ts < 2; ++ts) vf[ts] = tr_frag(VI + (32 * ts + 8 * g + (c >> 2)) * GL_VS + (16 * w + 4 * (c & 3)) * 2, 4 * GL_VS);
#pragma unroll
        for (int d = 0; d < 2; ++d) {
            LAS unsigned char* KS = F.lds + (d ? GL_B : GL_A);
            bf16* Ud = U + (ub + (size_t)d * 512) * 8192;
#pragma unroll
            for (int kt = 0; kt < 4; ++kt) {
                f32x4 acc = {0.f, 0.f, 0.f, 0.f};
#pragma unroll
                for (int ts = 0; ts < 2; ++ts) { const bf16x8 af = tr_frag(KS + (32 * ts + 8 * g + (c >> 2)) * 144 + (16 * kt + 4 * (c & 3)) * 2, 4 * 144);
                    acc = __builtin_amdgcn_mfma_f32_16x16x32_bf16(vf[ts], af, acc, 0, 0, 0); }
                { v2u o; o.x = pk2(acc[0], acc[1]); o.y = pk2(acc[2], acc[3]); *(GAS v2u*)(Ud + (16 * kt + c) * 128 + 16 * w + 4 * g) = o; }
            }
        }
    }
}
__device__ __forceinline__ void gla_state_phase(const Frame& F, bf16* __restrict__ U, const float* __restrict__ DEC) {
    for (int id = F.bx * NTHREADS + F.tid; id < 32 * 64 * 64; id += F.G * NTHREADS) {
        const int seq = id >> 12, k = (id >> 6) & 63, e2 = id & 63, d = seq >> 4, bh = seq & 15;
        GAS unsigned* p0 = (GAS unsigned*)(U + ((size_t)d * 512 + bh * 32) * 8192 + k * 128) + e2;
        const float* d0 = DEC + ((size_t)d * 512 + bh * 32) * 64 + k;
        unsigned u[32]; float dc[32];
#pragma unroll
        for (int n = 0; n < 32; ++n) { u[n] = p0[(size_t)n * 4096]; dc[n] = d0[n * 64]; }
        float s0 = 0.f, s1 = 0.f;
        if (d == 0) {
#pragma unroll
            for (int n = 0; n < 32; ++n) { const float t0 = bf2f((unsigned short)(u[n] & 0xffffu)), t1 = bf2f((unsigned short)(u[n] >> 16)); u[n] = pk2(s0, s1); s0 = s0 * dc[n] + t0; s1 = s1 * dc[n] + t1; }
        } else {
#pragma unroll
            for (int n = 31; n >= 0; --n) { const float t0 = bf2f((unsigned short)(u[n] & 0xffffu)), t1 = bf2f((unsigned short)(u[n] >> 16)); u[n] = pk2(s0, s1); s0 = s0 * dc[n] + t0; s1 = s1 * dc[n] + t1; }
        }
#pragma unroll
        for (int n = 0; n < 32; ++n) p0[(size_t)n * 4096] = u[n];
    }
}
__device__ __forceinline__ void gla_o_phase(const Frame& F, const bf16* __restrict__ PB, const float* __restrict__ Z, const float* __restrict__ w2f, const float* __restrict__ b2f,
                                            const float* __restrict__ w2b, const float* __restrict__ b2b, const bf16* __restrict__ U, const float* __restrict__ gn, bf16* __restrict__ MIX) {
    const int tid = F.tid, lane = F.lane, g = lane >> 4, c = lane & 15, w = F.wave, k = tid & 63, tg = F.wave;
    LAS unsigned char* VI = F.lds + GL_VI; LAS unsigned char* QI = F.lds + GL_A; LAS unsigned char* KI = F.lds + GL_B; LAS unsigned char* PI = F.lds + GL_P; LAS unsigned char* SI = F.lds + GL_SI;
    LAS float* OF = (LAS float*)(F.lds + GL_OF);
    GlaW W; int h_loaded = -1;
    for (int unit = F.bx; unit < BATCH * 4 * 32; unit += F.G) {
        const int b = unit >> 7, h = (unit >> 5) & 3, n = unit & 31;
        const size_t m0 = (size_t)b * SEQ + n * 64;
        const size_t ub = (size_t)(b * 4 + h) * 32 + n;
        if (h != h_loaded) { gla_load_w(W, k, h, w2f, b2f, w2b, b2b); h_loaded = h; }
        const f32x4 zreg = ((const GAS f32x4*)(Z + m0 * 32))[tid];
        unsigned short qraw[8], kraw[8];
#pragma unroll
        for (int i = 0; i < 8; ++i) { qraw[i] = PB[(m0 + tg * 8 + i) * NPB + O_BQ + h * 64 + k]; kraw[i] = PB[(m0 + tg * 8 + i) * NPB + O_BK + h * 64 + k]; }
        v4u vr[2]; gla_load_v(F, PB, m0, h, vr);
        v4u sreg[2][2];
#pragma unroll
        for (int d = 0; d < 2; ++d) { const GAS v4u* sp = (const GAS v4u*)(U + (ub + (size_t)d * 512) * 8192 + (tid >> 3) * 128 + (tid & 7) * 16); sreg[d][0] = sp[0]; sreg[d][1] = sp[1]; }
        const v4u g0 = *(const GAS v4u*)(PB + (m0 + (tid >> 3)) * NPB + O_BG + h * 128 + (tid & 7) * 16), g1 = *(const GAS v4u*)(PB + (m0 + (tid >> 3)) * NPB + O_BG + h * 128 + (tid & 7) * 16 + 8);
        LBAR();
        float cf[8], cb[8], totf, totb;
        gla_gates(F, zreg, W, cf, cb, totf, totb);
        float qv[8], kv[8];
#pragma unroll
        for (int i = 0; i < 8; ++i) { qv[i] = bf2f(qraw[i]) * 0.125f; kv[i] = bf2f(kraw[i]); }
        gla_store_v(F, vr);
        f32x4 acc[4];
#pragma unroll
        for (int tt = 0; tt < 4; ++tt) acc[tt] = (f32x4){0.f, 0.f, 0.f, 0.f};
#pragma unroll
        for (int d = 0; d < 2; ++d) {
            LBAR();
#pragma unroll
            for (int i = 0; i < 8; ++i) { const int t = tg * 8 + i; const float cc = d ? cb[i] : cf[i];
                *(LAS unsigned short*)(QI + t * 144 + k * 2) = (unsigned short)f2bf(qv[i] * __expf(cc));
                *(LAS unsigned short*)(KI + t * 144 + k * 2) = (unsigned short)f2bf(kv[i] * __expf(-cc)); }
            {   const int row = tid >> 3, c16 = (tid & 7) * 16;
                const v4u o0 = sreg[d][0], o1 = sreg[d][1];
                *(LAS v4u*)(SI + row * GL_VS + c16 * 2) = o0; *(LAS v4u*)(SI + row * GL_VS + c16 * 2 + 16) = o1; }
            LBAR();
#pragma unroll
            for (int q2 = 0; q2 < 2; ++q2) {
                const int id = 2 * w + q2, tt = id >> 2, jt = id & 3;
                f32x4 p = {0.f, 0.f, 0.f, 0.f};
#pragma unroll
                for (int ks = 0; ks < 2; ++ks) { const bf16x8 a = *(const LAS bf16x8*)(QI + (16 * tt + c) * 144 + ks * 64 + g * 16), bb = *(const LAS bf16x8*)(KI + (16 * jt + c) * 144 + ks * 64 + g * 16);
                    p = __builtin_amdgcn_mfma_f32_16x16x32_bf16(a, bb, p, 0, 0, 0); }
#pragma unroll
                for (int r = 0; r < 4; ++r) { const int t = 16 * tt + 4 * g + r, j = 16 * jt + c; const bool keep = d ? (j > t) : (j <= t);
                    *(LAS unsigned short*)(PI + t * 144 + j * 2) = (unsigned short)f2bf(keep ? p[r] : 0.f); }
            }
            LBAR();
            bf16x8 vf[2], sf[2];
#pragma unroll
            for (int s2 = 0; s2 < 2; ++s2) { vf[s2] = tr_frag(VI + (32 * s2 + 8 * g + (c >> 2)) * GL_VS + (16 * w + 4 * (c & 3)) * 2, 4 * GL_VS);
                sf[s2] = tr_frag(SI + (32 * s2 + 8 * g + (c >> 2)) * GL_VS + (16 * w + 4 * (c & 3)) * 2, 4 * GL_VS); }
#pragma unroll
            for (int tt = 0; tt < 4; ++tt)
#pragma unroll
                for (int s2 = 0; s2 < 2; ++s2) { const bf16x8 pa = *(const LAS bf16x8*)(PI + (16 * tt + c) * 144 + s2 * 64 + g * 16), qa = *(const LAS bf16x8*)(QI + (16 * tt + c) * 144 + s2 * 64 + g * 16);
                    acc[tt] = __builtin_amdgcn_mfma_f32_16x16x32_bf16(pa, vf[s2], acc[tt], 0, 0, 0);
                    acc[tt] = __builtin_amdgcn_mfma_f32_16x16x32_bf16(qa, sf[s2], acc[tt], 0, 0, 0); }
        }
#pragma unroll
        for (int tt = 0; tt < 4; ++tt)
#pragma unroll
            for (int r = 0; r < 4; ++r) OF[(16 * tt + 4 * g + r) * 132 + 16 * w + c] = acc[tt][r];
        LBAR();
        {   const int t = tid >> 3, c16 = (tid & 7) * 16;
            float o[16]; float ss = 0.f;
#pragma unroll
            for (int e = 0; e < 16; ++e) { o[e] = OF[t * 132 + c16 + e]; ss += o[e] * o[e]; }
            ss += lane_xor_f(ss, 1, lane); ss += lane_xor_f(ss, 2, lane); ss += lane_xor_f(ss, 4, lane);
            const float rs = rsqrtf(ss * (1.f / 128.f) + EPS);
            const unsigned gg[8] = {g0.x, g0.y, g0.z, g0.w, g1.x, g1.y, g1.z, g1.w};
            unsigned oo[8];
#pragma unroll
            for (int e = 0; e < 8; ++e) { const float ga = bf2f((unsigned short)(gg[e] & 0xffffu)), gb = bf2f((unsigned short)(gg[e] >> 16));
                oo[e] = pk2(o[2 * e] * rs * gn[h * 128 + c16 + 2 * e] * (ga * sigmoidf_(ga)), o[2 * e + 1] * rs * gn[h * 128 + c16 + 2 * e + 1] * (gb * sigmoidf_(gb))); }
            v4u o0, o1; o0.x = oo[0]; o0.y = oo[1]; o0.z = oo[2]; o0.w = oo[3]; o1.x = oo[4]; o1.y = oo[5]; o1.z = oo[6]; o1.w = oo[7];
            *(GAS v4u*)(MIX + (m0 + t) * D + 1024 + h * 128 + c16) = o0; *(GAS v4u*)(MIX + (m0 + t) * D + 1024 + h * 128 + c16 + 8) = o1;
        }
    }
}
constexpr int LRU_LD = 132;
constexpr size_t MISC_CAR_A = 0, MISC_CAR_H = 1 * MiB, MISC_CIN = 2 * MiB, MISC_RS = 4 * MiB;
template <bool REV>
__device__ __forceinline__ void lru_scan16(const float (&a)[4][4], const float (&u)[4][4], float (&h)[4][4], float (&p)[4][4], float& Atot, float& Hend, int lane) {
    const int g4 = lane >> 4;
    float As[4], Hs[4];
#pragma unroll
    for (int tt = 0; tt < 4; ++tt) { float hh = 0.f, pp = 1.f;
#pragma unroll
        for (int q = 0; q < 4; ++q) { const int r = REV ? 3 - q : q; hh = a[tt][r] * hh + u[tt][r]; pp *= a[tt][r]; h[tt][r] = hh; p[tt][r] = pp; }
        As[tt] = pp; Hs[tt] = hh; }
    float Ai[4], Hi[4];
#pragma unroll
    for (int tt = 0; tt < 4; ++tt) { Ai[tt] = As[tt]; Hi[tt] = Hs[tt]; }
#pragma unroll
    for (int dist = 1; dist <= 2; dist <<= 1) {
        const int src = REV ? lane + 16 * dist : lane - 16 * dist; const bool ok = REV ? (g4 + dist <= 3) : (g4 >= dist);
#pragma unroll
        for (int tt = 0; tt < 4; ++tt) {
            const float Ap = __builtin_bit_cast(float, __builtin_amdgcn_ds_bpermute((src & 63) << 2, __builtin_bit_cast(int, Ai[tt])));
            const float Hp = __builtin_bit_cast(float, __builtin_amdgcn_ds_bpermute((src & 63) << 2, __builtin_bit_cast(int, Hi[tt])));
            if (ok) { Hi[tt] = Ai[tt] * Hp + Hi[tt]; Ai[tt] = Ai[tt] * Ap; } }
    }
    const int prv = REV ? lane + 16 : lane - 16; const bool first = REV ? (g4 == 3) : (g4 == 0);
    const int lastl = REV ? (lane & 15) : (lane & 15) + 48;
    float carry = 0.f, prod = 1.f;
#pragma unroll
    for (int q = 0; q < 4; ++q) { const int tt = REV ? 3 - q : q;
        float Aex = __builtin_bit_cast(float, __builtin_amdgcn_ds_bpermute((prv & 63) << 2, __builtin_bit_cast(int, Ai[tt])));
        float Hex = __builtin_bit_cast(float, __builtin_amdgcn_ds_bpermute((prv & 63) << 2, __builtin_bit_cast(int, Hi[tt])));
        if (first) { Aex = 1.f; Hex = 0.f; }
        const float Ab = __builtin_bit_cast(float, __builtin_amdgcn_ds_bpermute(lastl << 2, __builtin_bit_cast(int, Ai[tt])));
        const float Hb = __builtin_bit_cast(float, __builtin_amdgcn_ds_bpermute(lastl << 2, __builtin_bit_cast(int, Hi[tt])));
        const float e = Aex * carry + Hex, qq = prod * Aex;
#pragma unroll
        for (int r = 0; r < 4; ++r) { h[tt][r] += p[tt][r] * e; p[tt][r] *= qq; }
        carry = Ab * carry + Hb; prod *= Ab; }
    Atot = prod; Hend = carry;
}
__device__ __forceinline__ void lru_phase(const Frame& F, const bf16* __restrict__ PB, const bf16* __restrict__ LRUG, const float* __restrict__ cw, const float* __restrict__ cb,
                                          const float* __restrict__ ba, const float* __restrict__ bx, const float* __restrict__ lam, float* __restrict__ CAR_A, float* __restrict__ CAR_H,
                                          bf16* __restrict__ LS, bf16* __restrict__ LPF, bf16* __restrict__ LPB) {
    LAS float* XF = (LAS float*)(F.lds);
    LAS unsigned char* XB = F.lds + 33792;
    LAS unsigned short* ST = (LAS unsigned short*)(F.lds + 33792 + 17408);
    const int tid = F.tid, lane = F.lane, g4 = lane >> 4, c = lane & 15, w = F.wave;
    const bool g_const = (F.G & 3) == 0;
    int g_loaded = -1;
    float w0[4], w1[4], cb0 = 0.f, cb1 = 0.f;
    for (int unit = F.bx; unit < BATCH * 32 * 4; unit += F.G) {
        const int b = unit >> 7, n = (unit >> 2) & 31, g = unit & 3, t0 = n * 64;
        if (!g_const || g != g_loaded) {
            const int ch = g * 128 + 2 * (tid & 63);
#pragma unroll
            for (int jj = 0; jj < 4; ++jj) { w0[jj] = cw[jj * 512 + ch]; w1[jj] = cw[jj * 512 + ch + 1]; }
            cb0 = cb[ch]; cb1 = cb[ch + 1];
            g_loaded = g;
        }
        LBAR();
        {
            const int ch2 = tid & 63, tb = (tid >> 6) * 8, ch = g * 128 + 2 * ch2;
            const float b0 = cb0, b1 = cb1;
            float x0[11], x1[11];
#pragma unroll
            for (int i = 0; i < 11; ++i) { const int t = t0 + tb - 2 + i; unsigned v = 0u; if (t >= 0 && t < SEQ) v = *(const GAS unsigned*)(PB + (size_t)(b * SEQ + t) * NPB + PB_CX + ch);
                x0[i] = bf2f((unsigned short)(v & 0xffffu)); x1[i] = bf2f((unsigned short)(v >> 16)); }
#pragma unroll
            for (int r = 0; r < 8; ++r) { float y0 = b0, y1 = b1;
#pragma unroll
                for (int j = 0; j < 4; ++j) { y0 += x0[r + j] * w0[j]; y1 += x1[r + j] * w1[j]; }
                XF[(tb + r) * LRU_LD + 2 * ch2] = y0; XF[(tb + r) * LRU_LD + 2 * ch2 + 1] = y1;
                *(LAS unsigned*)(XB + (tb + r) * 272 + ch2 * 4) = pk2(y0, y1); }
        }
        LBAR();
        {
            const int j = 16 * w + c;
            float hs[4][4];
#pragma unroll 1
            for (int s = 0; s < 2; ++s) {
                const int chj = g * 128 + j;
                const bf16* wap = LRUG + ((size_t)((s * 2 + 0) * 4 + g) * 128 + j) * 128 + g4 * 8;
                const bf16* wxp = LRUG + ((size_t)((s * 2 + 1) * 4 + g) * 128 + j) * 128 + g4 * 8;
                bf16x8 waf[4], wxf[4];
#pragma unroll
                for (int ks = 0; ks < 4; ++ks) { waf[ks] = *(const GAS bf16x8*)(wap + ks * 32); wxf[ks] = *(const GAS bf16x8*)(wxp + ks * 32); }
                const float bav = ba[s * 512 + chj], bxv = bx[s * 512 + chj], spv = softplusf_(-lam[s * 512 + chj]);
                float a[4][4], u[4][4];
#pragma unroll
                for (int tt = 0; tt < 4; ++tt) {
                    f32x4 ga = {0.f, 0.f, 0.f, 0.f}, gx = {0.f, 0.f, 0.f, 0.f};
#pragma unroll
                    for (int ks = 0; ks < 4; ++ks) { const bf16x8 xf = *(const LAS bf16x8*)(XB + (16 * tt + c) * 272 + ks * 64 + g4 * 16);
                        ga = __builtin_amdgcn_mfma_f32_16x16x32_bf16(xf, waf[ks], ga, 0, 0, 0); gx = __builtin_amdgcn_mfma_f32_16x16x32_bf16(xf, wxf[ks], gx, 0, 0, 0); }
#pragma unroll
                    for (int r = 0; r < 4; ++r) { const int t = 16 * tt + 4 * g4 + r;
                        const float rg = sigmoidf_(ga[r] + bav), ig = sigmoidf_(gx[r] + bxv);
                        const float av = __builtin_amdgcn_exp2f(-8.f * 1.4426950408889634f * rg * spv);
                        a[tt][r] = av; u[tt][r] = __builtin_amdgcn_sqrtf(fmaxf(1.f - av * av, 0.f)) * (ig * XF[t * LRU_LD + j]); }
                }
                float h[4][4], p[4][4], Atot, Hend;
                if (s == 0) lru_scan16<false>(a, u, h, p, Atot, Hend, lane); else lru_scan16<true>(a, u, h, p, Atot, Hend, lane);
                if (g4 == 0) { const size_t ci = ((size_t)((s * BATCH + b) * 32 + n)) * 512 + g * 128 + j; CAR_A[ci] = Atot; CAR_H[ci] = Hend; }
#pragma unroll
                for (int tt = 0; tt < 4; ++tt)
#pragma unroll
                    for (int r = 0; r < 4; ++r) { const int t = 16 * tt + 4 * g4 + r;
                        ST[(1 + s) * 8192 + t * 128 + j] = (unsigned short)f2bf(p[tt][r]);
                        if (s == 0) hs[tt][r] = h[tt][r]; else ST[t * 128 + j] = (unsigned short)f2bf(hs[tt][r] + h[tt][r]); }
            }
        }
        LBAR();
        {
            const int t = tid >> 3, c16 = (tid & 7) * 16;
            const size_t m = (size_t)b * SEQ + t0 + t;
            bf16* const outp[3] = {LS, LPF, LPB};
#pragma unroll
            for (int q = 0; q < 3; ++q) { const v4u p0 = *(const LAS v4u*)(ST + q * 8192 + t * 128 + c16), p1 = *(const LAS v4u*)(ST + q * 8192 + t * 128 + c16 + 8);
                *(GAS v4u*)(outp[q] + m * 512 + g * 128 + c16) = p0; *(GAS v4u*)(outp[q] + m * 512 + g * 128 + c16 + 8) = p1; }
        }
    }
}
__device__ __forceinline__ void lru_out_phase(const Frame& F, const bf16* __restrict__ PB, const bf16* __restrict__ LS, const bf16* __restrict__ LPF, const bf16* __restrict__ LPB, const float* __restrict__ CIN, bf16* __restrict__ MIX) {
    for (int task = F.bx * NTHREADS + F.tid; task < M * 64; task += F.G * NTHREADS) {
        const int m = task >> 6, c8 = (task & 63) * 8, b = m / SEQ, n = (m % SEQ) >> 6;
        const v4u sv = *(const GAS v4u*)(LS + (size_t)m * 512 + c8), pf = *(const GAS v4u*)(LPF + (size_t)m * 512 + c8), pb = *(const GAS v4u*)(LPB + (size_t)m * 512 + c8);
        const v4u yv = *(const GAS v4u*)(PB + (size_t)m * NPB + PB_CY + c8);
        const GAS f32x4* cfp = (const GAS f32x4*)(CIN + ((size_t)((0 * BATCH + b) * 32 + n)) * 512 + c8); const GAS f32x4* cbp = (const GAS f32x4*)(CIN + ((size_t)((1 * BATCH + b) * 32 + n)) * 512 + c8);
        const f32x4 cf0 = cfp[0], cf1 = cfp[1], cb0 = cbp[0], cb1 = cbp[1];
        const float cf[8] = {cf0.x, cf0.y, cf0.z, cf0.w, cf1.x, cf1.y, cf1.z, cf1.w}, cbv[8] = {cb0.x, cb0.y, cb0.z, cb0.w, cb1.x, cb1.y, cb1.z, cb1.w};
        const unsigned ss[4] = {sv.x, sv.y, sv.z, sv.w}, pp[4] = {pf.x, pf.y, pf.z, pf.w}, qq[4] = {pb.x, pb.y, pb.z, pb.w}, yy[4] = {yv.x, yv.y, yv.z, yv.w};
        unsigned oo[4];
#pragma unroll
        for (int e = 0; e < 4; ++e) {
            const float h0 = bf2f((unsigned short)(ss[e] & 0xffffu)) + bf2f((unsigned short)(pp[e] & 0xffffu)) * cf[2 * e] + bf2f((unsigned short)(qq[e] & 0xffffu)) * cbv[2 * e];
            const float h1 = bf2f((unsigned short)(ss[e] >> 16)) + bf2f((unsigned short)(pp[e] >> 16)) * cf[2 * e + 1] + bf2f((unsigned short)(qq[e] >> 16)) * cbv[2 * e + 1];
            oo[e] = pk2(h0 * gelu_tanh(bf2f((unsigned short)(yy[e] & 0xffffu))), h1 * gelu_tanh(bf2f((unsigned short)(yy[e] >> 16)))); }
        v4u o; o.x = oo[0]; o.y = oo[1]; o.z = oo[2]; o.w = oo[3];
        *(GAS v4u*)(MIX + (size_t)m * D + 1536 + c8) = o;
    }
}
__device__ __forceinline__ void lru_carry_phase(const Frame& F, const float* __restrict__ CAR_A, const float* __restrict__ CAR_H, float* __restrict__ CIN) {
    const int id = F.bx * NTHREADS + F.tid;
    if (id < 2 * BATCH * 512) {
        const int s = id >> 11, b = (id >> 9) & 3, ch = id & 511;
        const size_t base = ((size_t)((s * BATCH + b) * 32)) * 512 + ch;
        float av[32], hv[32];
#pragma unroll
        for (int n = 0; n < 32; ++n) { av[n] = CAR_A[base + (size_t)n * 512]; hv[n] = CAR_H[base + (size_t)n * 512]; }
        float h = 0.f;
        if (s == 0) {
#pragma unroll
            for (int n = 0; n < 32; ++n) { const float t = hv[n]; hv[n] = h; h = av[n] * h + t; }
        } else {
#pragma unroll
            for (int n = 31; n >= 0; --n) { const float t = hv[n]; hv[n] = h; h = av[n] * h + t; }
        }
#pragma unroll
        for (int n = 0; n < 32; ++n) CIN[base + (size_t)n * 512] = hv[n];
    }
}
#define WA_LOAD(colbase, u_) do { const int b_ = (u_) >> 6, hkv_ = ((u_) >> 5) & 1, q0_ = ((u_) & 31) * 64; \
    _Pragma("unroll") for (int i_ = 0; i_ < 10; ++i_) { const int ch_ = tl + NTHREADS * i_, r_ = ch_ >> 4, col_ = ch_ & 15; int j_ = q0_ - 128 + r_; j_ = j_ < 0 ? 0 : (j_ > SEQ - 1 ? SEQ - 1 : j_); \
        kreg[i_] = *(const GAS v4u*)(PB + (size_t)(b_ * SEQ + j_) * NPB + (colbase) + hkv_ * 128 + col_ * 8); } } while (0)
#define WA_STORE(stride_) do { _Pragma("unroll") for (int i_ = 0; i_ < 10; ++i_) { const int ch_ = tl + NTHREADS * i_, r_ = ch_ >> 4, col_ = ch_ & 15; \
        *(LAS v4u*)(KS + r_ * (stride_) + col_ * 16) = kreg[i_]; } } while (0)
__device__ __forceinline__ void wattn_phase(const Frame& F, const bf16* __restrict__ PB, const float* __restrict__ rel_bias, const float* __restrict__ sink, bf16* __restrict__ MIX) {
    LAS unsigned char* KS = F.lds;
    LAS float* rb = (LAS float*)(F.lds + 320 * 288 + 4 * 304 * 4);
    LAS float* btab = (LAS float*)(F.lds + 320 * 288);
    const int lane = F.lane, g = lane >> 4, c = lane & 15, w = F.wave, tid = F.tid, rt = w >> 1, hp = w & 1;
    constexpr int NUNITS = BATCH * 2 * (SEQ / 64);
    v4u kreg[10];
    int unit = F.bx, bias_hkv = -1; float snk[2] = {0.f, 0.f};
    int tl = tid;
    if (unit < NUNITS) WA_LOAD(O_AK, unit);
    while (unit < NUNITS) {
        asm volatile("" : "+v"(tl));
        const int b = unit >> 6, hkv = (unit >> 5) & 1, qb = unit & 31;
        const int q0 = qb * 64;
        LBAR();
        WA_STORE(272);
        if (tid < 336) { const int pos = q0 - 128 + tid; rb[tid] = (pos >= 0 && pos < SEQ && tid < 320) ? 0.f : -1e30f; }
        if (hkv != bias_hkv) {
            for (int e = tid; e < 4 * 304; e += NTHREADS) { const int hh = e / 304, rel = e % 304 - 143; btab[e] = (rel >= -128 && rel <= 128) ? rel_bias[t5_bucket(rel) * 8 + hkv * 4 + hh] : -1e30f; }
            snk[0] = sink[hkv * 4 + hp * 2]; snk[1] = sink[hkv * 4 + hp * 2 + 1]; bias_hkv = hkv; }
        LBAR();
        const size_t qoff = (size_t)(b * SEQ + q0 + 16 * rt + c) * NPB + O_AQ + (hkv * 4 + hp * 2) * 128 + g * 8;
        bf16x8 qfr[4];
#pragma unroll
        for (int ks = 0; ks < 4; ++ks) qfr[ks] = *(const GAS bf16x8*)(PB + qoff + ks * 32);
        WA_LOAD(O_AV, unit);
        bf16x8 pf0[9], pf1[9];
#pragma unroll 1
        for (int hh = 0; hh < 2; ++hh) {
            f32x4 S[17];
#pragma unroll
            for (int kt = 0; kt < 17; ++kt) S[kt] = (f32x4){0.f, 0.f, 0.f, 0.f};
#pragma unroll
            for (int ks = 0; ks < 4; ++ks) {
                const bf16x8 qf = qfr[ks];
#pragma unroll
                for (int kt = 0; kt < 17; ++kt) { const bf16x8 kf = *(const LAS bf16x8*)(KS + (16 * rt + 16 * kt + c) * 272 + ks * 64 + g * 16); S[kt] = __builtin_amdgcn_mfma_f32_16x16x32_bf16(kf, qf, S[kt], 0, 0, 0);
                    if (kt == 5 || kt == 11 || kt == 16) __builtin_amdgcn_sched_barrier(0); }
            }
            if (hh == 0) {
#pragma unroll
                for (int ks = 0; ks < 4; ++ks) qfr[ks] = *(const GAS bf16x8*)(PB + qoff + 128 + ks * 32); }
            const LAS float* bt = btab + (hp * 2 + hh) * 304;
#pragma unroll
            for (int kt = 0; kt < 17; ++kt)
#pragma unroll
                for (int r = 0; r < 4; ++r) {
                    S[kt][r] = S[kt][r] * 0.08838834764831845f + (bt[(4 * g - c + 15) + 16 * kt + r] + rb[(16 * rt + 4 * g) + 16 * kt + r]);
                    if (r == 3 && (kt & 1)) __builtin_amdgcn_sched_barrier(0);
                }
            const float sk = hh ? snk[1] : snk[0];
            float mx = sk;
#pragma unroll
            for (int kt = 0; kt < 17; ++kt)
#pragma unroll
                for (int r = 0; r < 4; ++r) mx = fmaxf(mx, S[kt][r]);
            mx = fmaxf(mx, lane_xor_f(mx, 16, lane)); mx = fmaxf(mx, lane_xor_f(mx, 32, lane));
            float sum = 0.f;
#pragma unroll
            for (int kt = 0; kt < 17; ++kt)
#pragma unroll
                for (int r = 0; r < 4; ++r) { const float p = __builtin_amdgcn_exp2f((S[kt][r] - mx) * 1.4426950408889634f); S[kt][r] = p; sum += p; }
            sum += lane_xor_f(sum, 16, lane); sum += lane_xor_f(sum, 32, lane);
            sum += __builtin_amdgcn_exp2f((sk - mx) * 1.4426950408889634f);
            const float inv = 1.f / sum;
            bf16x8 pfc[9];
#pragma unroll
            for (int s = 0; s < 9; ++s) { v4u t; t.x = pk2(S[2 * s][0] * inv, S[2 * s][1] * inv); t.y = pk2(S[2 * s][2] * inv, S[2 * s][3] * inv);
                if (s < 8) { t.z = pk2(S[2 * s + 1][0] * inv, S[2 * s + 1][1] * inv); t.w = pk2(S[2 * s + 1][2] * inv, S[2 * s + 1][3] * inv); } else { t.z = 0u; t.w = 0u; }
                pfc[s] = __builtin_bit_cast(bf16x8, t); }
            if (hh == 0) {
#pragma unroll
                for (int s = 0; s < 9; ++s) pf0[s] = pfc[s];
            } else {
#pragma unroll
                for (int s = 0; s < 9; ++s) pf1[s] = pfc[s]; }
        }
        LBAR();
        WA_STORE(288);
        LBAR();
        const int nxt = unit + F.G;
        if (nxt < NUNITS) WA_LOAD(O_AK, nxt);
        for (int dt = 0; dt < 8; ++dt) {
            f32x4 acc0 = {0.f, 0.f, 0.f, 0.f}, acc1 = {0.f, 0.f, 0.f, 0.f};
#pragma unroll
            for (int s = 0; s < 9; ++s) {
                LAS unsigned char* vp = KS + (16 * rt + 32 * s + 4 * g + (c >> 2)) * 288 + (16 * dt + 4 * (c & 3)) * 2;
                const s16x4 lo = __builtin_amdgcn_ds_read_tr16_b64_v4i16((LAS s16x4*)vp);
                const s16x4 hi = __builtin_amdgcn_ds_read_tr16_b64_v4i16((LAS s16x4*)(vp + (s < 8 ? 16 * 288 : 0)));
                const bf16x8 vf = __builtin_shufflevector(lo, hi, 0, 1, 2, 3, 4, 5, 6, 7);
                acc0 = __builtin_amdgcn_mfma_f32_16x16x32_bf16(vf, pf0[s], acc0, 0, 0, 0);
                acc1 = __builtin_amdgcn_mfma_f32_16x16x32_bf16(vf, pf1[s], acc1, 0, 0, 0);
            }
            bf16* op = MIX + (size_t)(b * SEQ + q0 + 16 * rt + c) * D + (hkv * 4 + hp * 2) * 128 + dt * 16 + 4 * g;
            v2u o; o.x = pk2(acc0[0], acc0[1]); o.y = pk2(acc0[2], acc0[3]); *(GAS v2u*)op = o;
            o.x = pk2(acc1[0], acc1[1]); o.y = pk2(acc1[2], acc1[3]); *(GAS v2u*)(op + 128) = o;
        }
        unit = nxt;
    }
}
#undef WA_LOAD
#undef WA_STORE
__device__ __forceinline__ void xsoftmax_phase(const Frame& F, const float* __restrict__ SC, bf16* __restrict__ P) {
    const int lane = F.lane, gw = F.bx * NWAVES + F.wave, NGW = F.G * NWAVES;
    for (int m0 = gw; m0 < M; m0 += 4 * NGW) {
        f32x4 s[4][4];
#pragma unroll
        for (int i = 0; i < 4; ++i) { const int m = m0 + i * NGW; const bool ok = m < M; const size_t mm = ok ? m : m0;
#pragma unroll
            for (int h = 0; h < 4; ++h) { const f32x4 a = *(const GAS f32x4*)(SC + mm * 1024 + h * 256 + 4 * lane), b2 = *(const GAS f32x4*)(SC + ((size_t)M + mm) * 1024 + h * 256 + 4 * lane); s[i][h] = a + b2; } }
#pragma unroll
        for (int i = 0; i < 4; ++i) { const int m = m0 + i * NGW; if (m >= M) break;
#pragma unroll
            for (int h = 0; h < 4; ++h) { const f32x4 v = s[i][h];
                const float mx = wave_max(fmaxf(fmaxf(v.x, v.y), fmaxf(v.z, v.w)), lane);
                const float e0 = __builtin_amdgcn_exp2f((v.x - mx) * 1.4426950408889634f), e1 = __builtin_amdgcn_exp2f((v.y - mx) * 1.4426950408889634f), e2 = __builtin_amdgcn_exp2f((v.z - mx) * 1.4426950408889634f), e3 = __builtin_amdgcn_exp2f((v.w - mx) * 1.4426950408889634f);
                const float inv = 1.f / wave_sum((e0 + e1) + (e2 + e3), lane);
                v2u o; o.x = pk2(e0 * inv, e1 * inv); o.y = pk2(e2 * inv, e3 * inv);
                *(GAS v2u*)(P + (size_t)m * 1024 + h * 256 + 4 * lane) = o; } }
    }
}
constexpr int NPL = 15;
enum Phase { PH_CONV = 0, PH_KV, PH_IN, PH_X1, PH_X2, PH_X3, PH_OUT, PH_RN1  , PH_Q  , PH_XA  , PH_O, PH_RN2  , PH_UP, PH_DOWN, PH_RN3   };
struct Args { const float* in[31]; float* out; unsigned char* ws; int ph_lo, ph_hi, li, pad; };

__global__ void __launch_bounds__(NTHREADS, 2) fwd(Args args) {
    extern __shared__ __attribute__((aligned(16))) unsigned char lds[];
    Frame F;
    F.lds = (LAS unsigned char*)lds;
    const int wave_s = __builtin_amdgcn_readfirstlane(threadIdx.x >> 6);
    F.tid = threadIdx.x; F.lane = F.tid & 63; F.wave = wave_s;
    F.G = gridDim.x; F.bx = blockIdx.x;
    unsigned char* ws_top = args.ws;
    const int lo = args.ph_lo, hi = args.ph_hi;
    for (int u = F.tid; u < (LDS_BYTES - LDSCTL_OFF) / 4; u += NTHREADS) ((LAS unsigned*)(F.lds + LDSCTL_OFF))[u] = 0u;
    __syncthreads();
    XcdBarrier bar; bar.bar = (unsigned*)(ws_top + WS_CTL) + CW_BAR; bar.x = 0; bar.st = nullptr;
    const bool one_launch = (hi - lo) > 1;
    if (one_launch) bar = xcd_barrier_post((unsigned*)(ws_top + WS_CTL) + CW_BAR, (volatile LAS unsigned*)(F.lds + MISC_OFF) + 8);
#define IN(k) (lo <= (k) && (k) < hi)
#define AMP_T0() const unsigned long long at0_ = (PROBE_AMP != 0) ? __builtin_amdgcn_s_memrealtime() : 0ull
#define AMP_END(bit) do { if (PROBE_AMP & (1u << (bit))) { __syncthreads(); const unsigned long long at1_ = __builtin_amdgcn_s_memrealtime(), tgt_ = at1_ + AMP_K * (at1_ - at0_); \
        while (__builtin_amdgcn_s_memrealtime() < tgt_) __builtin_amdgcn_s_sleep(16); } } while (0)
#define SEAM(k) do { if (one_launch && (k) + 1 < hi) { AMP_T0(); xcd_barrier(bar); if (PROBE_AMP & (1u << 16)) xcd_barrier(bar); AMP_END(17); } } while (0)
#define PHASE_BEGIN() const CAS Args* ka_ = (const CAS Args*)__builtin_amdgcn_kernarg_segment_ptr(); asm volatile("" : "+s"(ka_)); \
    unsigned mk_ = ~0u; int l = l_it, bx_ = (int)blockIdx.x, G_ = (int)gridDim.x; asm volatile("" : "+s"(mk_), "+s"(l), "+s"(bx_), "+s"(G_)); F.bx = bx_; F.G = G_;     \
    int tz_ = (wave_s << 6) + (int)__builtin_amdgcn_mbcnt_hi(mk_, __builtin_amdgcn_mbcnt_lo(mk_, 0u)); asm volatile("" : "+v"(tz_)); F.tid = tz_; F.lane = tz_ & 63; F.wave = __builtin_amdgcn_readfirstlane(tz_ >> 6); \
    unsigned char* ws = ka_->ws; float* X = ka_->out; bf16* XN = (bf16*)(ws + WS_XN); float* RS = (float*)(ws + WS_MISC + MISC_RS); unsigned char* wl = ws + WS_W + (size_t)(l % NWL) * WL_BYTES; \
    const int gw = F.bx * NWAVES + F.wave, NGW = F.G * NWAVES; (void)gw; (void)NGW; (void)X; (void)XN; (void)wl; (void)RS

    for (int l_it = 0; l_it < DEPTH; ++l_it) {
        const int pb = l_it * NPL;
        if (IN(pb + PH_CONV)) { PHASE_BEGIN(); AMP_T0();
            LAS float* scr = (LAS float*)(F.lds + RING_OFF + F.wave * 16384);
            const int lc0 = (NWL == 1) ? l : (l == 0 ? 0 : DEPTH), lc1 = (NWL == 1) ? l + 1 : DEPTH;
            if (lc1 > lc0) conv_weights_phase(F, ka_->in, ws, SEGA, SEGA_START, 2, SEGA_ITEMS, 0, DEPTH * SEGA_ITEMS, scr, gw, NGW);
            for (int lc = lc0; lc < lc1; ++lc)
                for (int m = gw; m < MM; m += NGW) norm_row(F.lane, ka_->in[1] + (size_t)m * D, ka_->in[26] + (size_t)lc * D, (bf16*)(ws + WS_MEMN) + ((size_t)lc * MM + m) * D, nullptr); AMP_END(0);
        }
        if (l_it == 0 || NWL == 1) SEAM(pb + PH_CONV);
        if (IN(pb + PH_KV)) { PHASE_BEGIN(); AMP_T0();
            const int lc0 = (NWL == 1) ? l : (l == 0 ? 0 : DEPTH), lc1 = (NWL == 1) ? l + 1 : DEPTH;
            if (lc1 > lc0) {
                const int GA = F.G >> 1;
                if (F.bx < GA) {
                    const bf16* base = (const bf16*)(ws + WS_W);
                    pg8::Gemm g{base, base, 0, 0, D, 0, 0};
                    pg8::KvOrder S; S.G = GA; S.c = F.bx; S.NL = lc1 - lc0; S.l0 = lc0;
                    S.memn_p0 = (int)((WS_MEMN - WS_W) / MiB) + 4 * lc0; S.memn_ps = 4;
                    S.xk_p0 = (int)(((size_t)(lc0 % NWL) * WL_BYTES + WL_XK) / MiB); S.xv_p0 = (int)(((size_t)(lc0 % NWL) * WL_BYTES + WL_XV) / MiB); S.w_ps = (int)(WL_BYTES / MiB);
                    pg8::EpiBf16<0> E{(bf16*)(ws + WS_KX), D, (bf16*)(ws + WS_VT), D, nullptr, 0, 0.f, 0.f, nullptr};
                    pg8::gemm_phase<pg8::EpiBf16<0>, pg8::KvOrder, true, true>(F.lds + RING_OFF, g, S, E, F.tid);
                } else {
                    LAS float* scrB = (LAS float*)(F.lds + RING_OFF + F.wave * 16384); const int gwB = (F.bx - GA) * NWAVES + F.wave, NGWB = (F.G - GA) * NWAVES;
                    conv_weights_phase(F, ka_->in, ws, SEGO, SEGO_START, 1, SEGO_ITEMS, 0, DEPTH * SEGO_ITEMS, scrB, gwB, NGWB);
                    for (int r = gwB; r < DEPTH * D; r += NGWB) { const int lc = r / D, k = r % D;
                        scale_row_bf16(F.lane, ka_->in[18] + ((size_t)lc * D + k) * D, ka_->in[27][(size_t)lc * D + k], (bf16*)(ws + WS_W + (size_t)(lc % NWL) * WL_BYTES + WL_XQ) + (size_t)k * D); }
                    conv_weights_phase(F, ka_->in, ws, SEGB, SEGB_START, 6, SEGB_ITEMS, 0, SEGB_SPLIT, scrB, gwB, NGWB);
                }
            }
            AMP_END(1);
        }
        if (l_it == 0 || NWL == 1) SEAM(pb + PH_KV);
        if (l_it == 0 && IN(PH_RN1)) { PHASE_BEGIN(); AMP_T0();
            const int GA = F.G >> 1;
            if (F.bx < GA) {
                const bf16* base = (const bf16*)(ws + WS_W);
                pg8::Gemm g{base, base, 0, 0, 512, D, D};
                pg8::ProdOrder S; S.G = GA; S.c = F.bx; S.NL = DEPTH; S.kx_p0 = (int)((WS_KX - WS_W) / MiB); S.vx_p0 = (int)((WS_VT - WS_W) / MiB); S.xq_p0 = (int)(WL_XQ / MiB); S.xo_p0 = (int)(WL_XO / MiB); S.w_ps = (int)(WL_BYTES / MiB);
                pg8::EpiBf16<0> E{(bf16*)(ws + WS_MQK), D, (bf16*)(ws + WS_VWO), 1024, nullptr, 0, 0.f, 0.f, nullptr};
                pg8::gemm_phase<pg8::EpiBf16<0>, pg8::ProdOrder, true, true>(F.lds + RING_OFF, g, S, E, F.tid);
            } else {
                LAS float* scrB = (LAS float*)(F.lds + RING_OFF + F.wave * 16384); const int gwB = (F.bx - GA) * NWAVES + F.wave, NGWB = (F.G - GA) * NWAVES;
                conv_weights_phase(F, ka_->in, ws, SEGB, SEGB_START, 6, SEGB_ITEMS, SEGB_SPLIT, DEPTH * SEGB_ITEMS, scrB, gwB, NGWB);
                for (int it = gwB; it < DEPTH * 16 * 8; it += NGWB) { const int lc = it >> 7, mi = (it >> 3) & 15, gate = mi >> 3, s = (mi >> 2) & 1, gg = mi & 3;
                    p0_transpose_item(ka_->in[gate ? 15 : 13] + ((size_t)lc * 8 + s * 4 + gg) * 16384, 128, 128, 0, (bf16*)(ws + WS_W + (size_t)(lc % NWL) * WL_BYTES + WL_LRUG) + (size_t)((s * 2 + gate) * 4 + gg) * 16384, 0, 4, nullptr, scrB, it & 7, F.lane); }
                if (NGWB * 8 == M) { init_rows<4>(F.lane, ka_->in[0] + (size_t)gwB * D, XN + (size_t)gwB * D, RS + gwB, (size_t)NGWB);
                    init_rows<4>(F.lane, ka_->in[0] + (size_t)(gwB + 4 * NGWB) * D, XN + (size_t)(gwB + 4 * NGWB) * D, RS + gwB + 4 * NGWB, (size_t)NGWB); }
                else for (int m = gwB; m < M; m += NGWB) init_row(F.lane, ka_->in[0] + (size_t)m * D, XN + (size_t)m * D, RS + m);
            }
            AMP_END(19);
        }
        if (l_it == 0) SEAM(PH_RN1);
        if (IN(pb + PH_IN)) { PHASE_BEGIN(); AMP_T0();
            pg8::Gemm g{XN, (const bf16*)(wl + WL_IN), M, NPB, D, 0, 0}; pg8::StaticOrder S; S.init(M, NPB, F.G, F.bx);
            pg8::EpiBf16<0> E{(bf16*)(ws + WS_PB), NPB, nullptr, 0, RS, M, 1.f / D, EPS, (LAS float*)(F.lds + RING_BYTES)};
            pg8::gemm_phase<pg8::EpiBf16<0>, pg8::StaticOrder, true, true>(F.lds + RING_OFF, g, S, E, F.tid);
            zgemm(F, XN, (const bf16*)(wl + WL_Z), RS, (float*)(ws + WS_Z)); AMP_END(2);
        }
        SEAM(pb + PH_IN);
        if (IN(pb + PH_X1)) { PHASE_BEGIN();
            { AMP_T0(); gla_u_phase(F, (const bf16*)(ws + WS_PB), (const float*)(ws + WS_Z), ka_->in[6] + (size_t)l * 4096, ka_->in[7] + (size_t)l * 256, ka_->in[8] + (size_t)l * 4096, ka_->in[9] + (size_t)l * 256,
                        (bf16*)(ws + WS_GLAU), (float*)(ws + WS_MISC + MISC_DEC)); AMP_END(3); }
            { AMP_T0(); lru_phase(F, (const bf16*)(ws + WS_PB), (const bf16*)(wl + WL_LRUG), ka_->in[11] + (size_t)l * 2048, ka_->in[12] + (size_t)l * 512, ka_->in[14] + (size_t)l * 1024, ka_->in[16] + (size_t)l * 1024, ka_->in[17] + (size_t)l * 1024,
                             (float*)(ws + WS_MISC + MISC_CAR_A), (float*)(ws + WS_MISC + MISC_CAR_H), (bf16*)(ws + WS_LRU), (bf16*)(ws + WS_LRU) + (size_t)M * 512, (bf16*)(ws + WS_LRU) + (size_t)2 * M * 512); AMP_END(5); } }
        SEAM(pb + PH_X1);
        if (IN(pb + PH_X2)) { PHASE_BEGIN();
            { AMP_T0();
            gla_state_phase(F, (bf16*)(ws + WS_GLAU), (const float*)(ws + WS_MISC + MISC_DEC));
            lru_carry_phase(F, (const float*)(ws + WS_MISC + MISC_CAR_A), (const float*)(ws + WS_MISC + MISC_CAR_H), (float*)(ws + WS_MISC + MISC_CIN));
            AMP_END(14); }
            { AMP_T0(); wattn_phase(F, (const bf16*)(ws + WS_PB), ka_->in[2], ka_->in[5] + l * 8, (bf16*)(ws + WS_MIX)); AMP_END(6); } }
        SEAM(pb + PH_X2);
        if (IN(pb + PH_X3)) { PHASE_BEGIN();
            { AMP_T0(); gla_o_phase(F, (const bf16*)(ws + WS_PB), (const float*)(ws + WS_Z), ka_->in[6] + (size_t)l * 4096, ka_->in[7] + (size_t)l * 256, ka_->in[8] + (size_t)l * 4096, ka_->in[9] + (size_t)l * 256,
                        (const bf16*)(ws + WS_GLAU), ka_->in[10] + (size_t)l * 512, (bf16*)(ws + WS_MIX)); AMP_END(7); }
            { AMP_T0(); lru_out_phase(F, (const bf16*)(ws + WS_PB), (const bf16*)(ws + WS_LRU), (const bf16*)(ws + WS_LRU) + (size_t)M * 512, (const bf16*)(ws + WS_LRU) + (size_t)2 * M * 512, (const float*)(ws + WS_MISC + MISC_CIN), (bf16*)(ws + WS_MIX)); AMP_END(8); } }
        SEAM(pb + PH_X3);
        if (IN(pb + PH_OUT)) { PHASE_BEGIN(); AMP_T0();
            pg8::Gemm g{(const bf16*)(ws + WS_MIX), (const bf16*)(wl + WL_OUT), M, D, D, 0, 0}; pg8::StaticOrder S; S.init(M, D, F.G, F.bx);
            pg8::EpiResid E{XN, ka_->in[25] + (size_t)l * D, RS, M, nullptr, (float*)(ws + WS_SLOT) + (size_t)(l * 3 + 0) * 32 * 8 * 256, (unsigned*)(ws + WS_CTL) + CW_RCNT + (l * 3 + 0) * 32 * 64, 1.f / D, EPS};
            pg8::gemm_phase<pg8::EpiResid, pg8::StaticOrder, false, true>(F.lds + RING_OFF, g, S, E, F.tid); AMP_END(9);
        }
        SEAM(pb + PH_RN1);
        if (IN(pb + PH_Q)) { PHASE_BEGIN(); AMP_T0();
            pg8::Gemm g{XN, (const bf16*)(ws + WS_MQK), M, 2048, 1024, D, D}; pg8::BatchBOrder<2> S; S.init(M, 2048, F.G, F.bx); S.bp0 = l * 16; S.per_b = 4; S.khalf_bytes = 2048;
            pg8::EpiScoreSm E{(float*)(ws + WS_SC), (bf16*)(ws + WS_PR), RS, M, 1.f / D, EPS, 0.044194173824159216f, 32, (unsigned*)(ws + WS_CTL) + CW_SCNT + l * 128 * 64};
            pg8::gemm_phase<pg8::EpiScoreSm, pg8::BatchBOrder<2>, false, true>(F.lds + RING_OFF, g, S, E, F.tid); AMP_END(10);
        }
        SEAM(pb + PH_Q);
        if (IN(pb + PH_O)) { PHASE_BEGIN(); AMP_T0();
            pg8::Gemm g{(const bf16*)(ws + WS_PR), (const bf16*)(ws + WS_VWO), M, D, 1024, 1024, 1024}; pg8::BatchBOrder<1> S; S.init(M, D, F.G, F.bx); S.bp0 = l * 32; S.per_b = 8; S.khalf_bytes = 0;
            pg8::EpiResid E{XN, ka_->in[28] + (size_t)l * D, RS, M, nullptr, (float*)(ws + WS_SLOT) + (size_t)(l * 3 + 1) * 32 * 8 * 256, (unsigned*)(ws + WS_CTL) + CW_RCNT + (l * 3 + 1) * 32 * 64, 1.f / D, EPS};
            pg8::gemm_phase<pg8::EpiResid, pg8::BatchBOrder<1>, false, true>(F.lds + RING_OFF, g, S, E, F.tid); AMP_END(11);
        }
        SEAM(pb + PH_RN2);
        if (IN(pb + PH_UP)) { PHASE_BEGIN(); AMP_T0();
            pg8::Gemm g{XN, (const bf16*)(wl + WL_UP), M, DFF, D, 0, 0}; pg8::StaticOrder S; S.init(M, DFF, F.G, F.bx);
            pg8::EpiBf16<1> E{(bf16*)(ws + WS_H), DFF, nullptr, 0, RS, M, 1.f / D, EPS, (LAS float*)(F.lds + RING_BYTES), K8L[l] / 256};
            if (PROBE_AMP & (1u << 18)) {
                for (int rr = 0; rr < 4; ++rr) { S.r0 = rr; S.nr = 1; pg8::gemm_phase<pg8::EpiBf16<1>, pg8::StaticOrder, true, true>(F.lds + RING_OFF, g, S, E, F.tid); if (rr < 3) xcd_barrier(bar); }
            } else
            pg8::gemm_phase<pg8::EpiBf16<1>, pg8::StaticOrder, true, true>(F.lds + RING_OFF, g, S, E, F.tid); AMP_END(12);
        }
        SEAM(pb + PH_UP);
        if (IN(pb + PH_DOWN)) { PHASE_BEGIN(); AMP_T0();
            pg8::Gemm g{(const bf16*)(ws + WS_H), (const bf16*)(wl + WL_DOWN), M, D, DFF, 0, 0}; pg8::DownOrder S; S.init(M, D, F.G, F.bx); const int k8 = K8L[l]; S.nt8 = k8 / 128; S.ntb = (DFF - k8) / 64; S.jump = (size_t)k8;
            pg8::EpiResid E{XN, ka_->in[30] + (size_t)l * D, RS, M, (l + 1 < DEPTH) ? nullptr : X, (float*)(ws + WS_SLOT) + (size_t)(l * 3 + 2) * 32 * 8 * 256, (unsigned*)(ws + WS_CTL) + CW_RCNT + (l * 3 + 2) * 32 * 64, 1.f / D, EPS};
            pg8::gemm_phase<pg8::EpiResid, pg8::DownOrder, false, true>(F.lds + RING_OFF, g, S, E, F.tid); AMP_END(13);
        }
        SEAM(pb + PH_RN3);
    }
#undef IN
#undef SEAM
}
extern "C" void kernel_launch(void* const* d_in, const int* in_sizes, int n_in, void* d_out, int out_size, void* d_ws, size_t ws_size, hipStream_t stream) {
    static int grid = 0;
    if (grid == 0) {
        int dev = 0, cus = 0;
        if (n_in != 31 || out_size != M * D || ws_size < WS_END) { fprintf(stderr, "kernel_launch: built for 31 inputs, %d outputs, >= %zu bytes of workspace; got %d, %d, %zu\n", M * D, (size_t)WS_END, n_in, out_size, ws_size); grid = -1; return; }
        if (hipGetDevice(&dev) != hipSuccess || hipDeviceGetAttribute(&cus, hipDeviceAttributeMultiprocessorCount, dev) != hipSuccess) { fprintf(stderr, "kernel_launch: device query failed\n"); grid = -1; return; }
        if (hipFuncSetAttribute((const void*)fwd, hipFuncAttributeMaxDynamicSharedMemorySize, LDS_BYTES) != hipSuccess) { fprintf(stderr, "kernel_launch: hipFuncSetAttribute failed\n"); grid = -1; return; }
        int per_cu = 0;
        if (hipOccupancyMaxActiveBlocksPerMultiprocessor(&per_cu, (const void*)fwd, NTHREADS, LDS_BYTES) != hipSuccess || per_cu < 1) { fprintf(stderr, "kernel_launch: occupancy query reports %d workgroups per CU\n", per_cu); (void)hipGetLastError(); }
        if (cus != 256) { fprintf(stderr, "kernel_launch: built for a 256-CU device (one 256x256 GEMM unit per workgroup in the fused-epilogue phases); found %d CUs\n", cus); grid = -1; return; }
        grid = cus;
    }
    if (grid < 0) return;
    unsigned char* ws = (unsigned char*)d_ws;
    (void)hipMemsetAsync(ws + WS_CTL, 0, CTL_ZERO_BYTES, stream);
    Args a{};
    for (int i = 0; i < 31; ++i) a.in[i] = (const float*)d_in[i];
    a.out = (float*)d_out; a.ws = ws;
#if defined(MK_PER_PHASE) && MK_PER_PHASE
    for (int p = 0; p < DEPTH * NPL; ++p) { if (NWL == 4 && p >= NPL && (p % NPL) < 2) continue; if ((p % NPL) == PH_RN1 || (p % NPL) == PH_RN2 || (p % NPL) == PH_RN3) continue; a.ph_lo = p; a.ph_hi = p + 1; hipLaunchKernelGGL(fwd, dim3(grid), dim3(NTHREADS), LDS_BYTES, stream, a); }
#else
    a.ph_lo = 0; a.ph_hi = DEPTH * NPL;
    hipLaunchKernelGGL(fwd, dim3(grid), dim3(NTHREADS), LDS_BYTES, stream, a);
    const hipError_t le = hipPeekAtLastError();
    if (le != hipSuccess) fprintf(stderr, "kernel_launch: launch failed: %s\n", hipGetErrorName(le));
#endif
}
```

```cpp
#include <hip/hip_runtime.h>
#include <cstdint>
#include <cstdio>

__device__ __forceinline__ float lane_xor_f(float v, int mask, int lane) { return __builtin_bit_cast(float, __builtin_amdgcn_ds_bpermute((lane ^ mask) << 2, __builtin_bit_cast(int, v))); }
namespace pg8 {
#define PG8_LAS __attribute__((address_space(3)))
typedef unsigned short bf16_t;
typedef short bf16x8 __attribute__((ext_vector_type(8)));
typedef float f32x4 __attribute__((ext_vector_type(4)));
typedef unsigned u32x4 __attribute__((ext_vector_type(4)));
constexpr int BM = 256, BK = 64, HALF = 128, HTB = HALF * BK * 2  , STAGE_BYTES = 8 * HTB, NXCD = 8, WGM = 8;

__host__ __device__ __forceinline__ int lds_byte(int r, int c) { const int st = (r >> 4) * 2 + (c >> 5), rr = r & 15, cc = c & 31, ob = rr * 64 + cc * 2; return st * 1024 + (ob ^ (((ob >> 9) & 1) << 5)); }
__host__ __device__ __forceinline__ void stage_rc(int b, int& R, int& C) { const int st = b / 1024, sb = b % 1024, swz = sb ^ (((sb >> 9) & 1) << 5); R = (st >> 1) * 16 + swz / 64; C = (st & 1) * 32 + (swz % 64) / 2; }
__host__ __device__ __forceinline__ int perm32(int rho) { const int n = rho >> 4, i = rho & 15; return 8 * (i >> 2) + 4 * n + (i & 3); }

struct Unit { int pm, pn, om, on, kind; size_t aoff, boff; int nt = 0, flags = 0; };
struct Gemm { const bf16_t* A; const bf16_t* Bt; int M, N, K, lda, ldb; };

struct StaticOrder {
    static constexpr bool MIXED = false;
    int nM, nN, nwg, G, c, r0, nr;
    __host__ __device__ void init(int M, int N, int G_, int c_) { nM = M / BM; nN = N / BM; nwg = nM * nN; G = G_; c = c_; r0 = 0; nr = 1 << 20; }
    __host__ __device__ bool next(int i, Unit& u) const {
        if (i >= nr) return false;
        const long L = (long)(i + r0) * G + c; if (L >= nwg) return false;
        int wgid = (int)L; { const int q = nwg / NXCD, r = nwg % NXCD, xcd = wgid % NXCD, off = wgid / NXCD; wgid = (xcd < r ? xcd * (q + 1) : r * (q + 1) + (xcd - r) * q) + off; }
        const int nig = WGM * nN, gid = wgid / nig, fm = gid * WGM, gsz = (nM - fm) < WGM ? (nM - fm) : WGM;
        u.pm = fm + ((wgid % nig) % gsz); u.pn = (wgid % nig) / gsz; u.om = u.pm; u.on = u.pn; u.kind = 0; u.aoff = 0; u.boff = 0; return true;
    }
    __device__ __forceinline__ void a_ready(const Unit&) const {}
    __device__ __forceinline__ void done(const Unit&) const {}
};
template <int SPLITK> struct BatchBOrder : StaticOrder {
    int bp0, per_b; size_t khalf_bytes;
    __host__ __device__ bool next(int i, Unit& u) const {
        if (!StaticOrder::next(i, u)) return false;
        const int b = u.pm >> 3, slot = u.pn, pn = SPLITK == 2 ? slot >> 1 : slot, kh = SPLITK == 2 ? (slot & 1) : 0;
        u.pn = bp0 + b * per_b + pn; u.on = pn; u.om = kh * nM + u.pm; u.aoff = kh * khalf_bytes; u.boff = kh * khalf_bytes;
        return true;
    }
};
struct MixedOrder : StaticOrder {
    static constexpr bool MIXED = true;
    int nt8, ntb; long long jumpA, jumpB; int sclA, sclB;
    __host__ __device__ bool next(int i, Unit& u) const { if (!StaticOrder::next(i, u)) return false; u.nt = nt8 + ntb; return true; }
};
struct KvOrder {
    static constexpr bool MIXED = false;
    int G, c, NL, l0, memn_p0, memn_ps, xk_p0, xv_p0, w_ps;
    __host__ __device__ bool next(int i, Unit& u) const {
        const long L = (long)i * G + c; if (L >= (long)NL * 64) return false;
        const int l = (int)L / 64, r = (int)L % 64, q = r & 31, pm = q & 3, pn = q >> 2;
        u.kind = r >> 5; u.pm = memn_p0 + l * memn_ps + pm; u.pn = (u.kind ? xv_p0 : xk_p0) + l * w_ps + pn; u.om = (l0 + l) * 4 + pm; u.on = pn; u.aoff = 0; u.boff = 0;
        return true;
    }
    __device__ __forceinline__ void a_ready(const Unit&) const {}
    __device__ __forceinline__ void done(const Unit&) const {}
};
struct ProdOrder {
    static constexpr bool MIXED = false;
    int G, c, NL, kx_p0, vx_p0, xq_p0, xo_p0, w_ps;
    __host__ __device__ bool next(int i, Unit& u) const {
        const long L = (long)i * G + c; if (L >= (long)NL * 256) return false;
        const int l = (int)L / 256, r = (int)L % 256, r2 = r & 127, b = r2 >> 5, h = (r2 >> 3) & 3, t = r2 & 7;
        u.kind = r >> 7; u.aoff = (size_t)h * 1024; u.boff = (size_t)h * 1024;
        if (u.kind == 0) { u.pm = kx_p0 + l * 4 + b; u.pn = xq_p0 + l * w_ps + t; u.om = (l * 4 + b) * 4 + h; u.on = t; }
        else { u.pm = xo_p0 + l * w_ps + t; u.pn = vx_p0 + l * 4 + b; u.om = (l * 4 + b) * 8 + t; u.on = h; }
        return true;
    }
    __device__ __forceinline__ void a_ready(const Unit&) const {}
    __device__ __forceinline__ void done(const Unit&) const {}
};
__device__ __forceinline__ unsigned cvt_pk_bf16(float lo, float hi) { unsigned r; asm volatile("v_cvt_pk_bf16_f32 %0, %1, %2" : "=v"(r) : "v"(lo), "v"(hi)); return r; }

template <int ACT  > struct EpiBf16 {
    static constexpr bool PERM = true, AFTER_DRAIN = false;
    bf16_t* O; int ldc; bf16_t* O1; int ldc1; const float* rs; int rs_stride; float rs_scale, rs_eps; PG8_LAS float* rtab; int n8 = 0;
    __device__ __forceinline__ void operator()(const f32x4 (&acc)[2][2][4][2], const Unit& u, int wr, int wc, int fr, int fq) const {
        bf16_t* base = u.kind ? O1 : O; const int ld = u.kind ? ldc1 : ldc;
        const int row0 = u.om * BM + wr * 64 + fr, col0 = u.on * BM + wc * 32 + 8 * fq;
        if (rs) {
            const int tid = (wr * 4 + wc) * 64 + fq * 16 + fr;
            if (tid < 256) { float t = 0.f;
#pragma unroll
                for (int q = 0; q < 8; ++q) t += rs[(size_t)q * rs_stride + u.om * BM + tid];
                rtab[tid] = rsqrtf(t * rs_scale + rs_eps); }
            asm volatile("s_waitcnt lgkmcnt(0)" ::: "memory"); __builtin_amdgcn_s_barrier(); asm volatile("" ::: "memory");
        }
        if (ACT == 1 && u.on < n8) {
#pragma unroll
            for (int ai = 0; ai < 2; ++ai)
#pragma unroll
                for (int m = 0; m < 4; ++m) { unsigned char* rowp = (unsigned char*)base + (size_t)(row0 + ai * HALF + m * 16) * ld * 2 + col0;
                    const float sc = rs ? rtab[ai * HALF + wr * 64 + m * 16 + fr] : 1.f;
#pragma unroll
                    for (int bj = 0; bj < 2; ++bj) { f32x4 v0 = acc[ai][bj][m][0] * sc, v1 = acc[ai][bj][m][1] * sc;
#pragma unroll
                        for (int j = 0; j < 4; ++j) { const float a = fmaxf(v0[j], 0.f), b = fmaxf(v1[j], 0.f); v0[j] = fminf(a * a * 16.f, 448.f); v1[j] = fminf(b * b * 16.f, 448.f); }
                        int w0 = __builtin_amdgcn_cvt_pk_fp8_f32(v0[0], v0[1], 0, false); w0 = __builtin_amdgcn_cvt_pk_fp8_f32(v0[2], v0[3], w0, true);
                        int w1 = __builtin_amdgcn_cvt_pk_fp8_f32(v1[0], v1[1], 0, false); w1 = __builtin_amdgcn_cvt_pk_fp8_f32(v1[2], v1[3], w1, true);
                        typedef int i32x2_ __attribute__((ext_vector_type(2))); *(i32x2_*)(rowp + bj * HALF) = (i32x2_){w0, w1}; }
                    __builtin_amdgcn_sched_barrier(0); }
            return;
        }
#pragma unroll
        for (int ai = 0; ai < 2; ++ai)
#pragma unroll
            for (int m = 0; m < 4; ++m) { bf16_t* rowp = base + (size_t)(row0 + ai * HALF + m * 16) * ld + col0;
                const float sc = rs ? rtab[ai * HALF + wr * 64 + m * 16 + fr] : 1.f;
#pragma unroll
                for (int bj = 0; bj < 2; ++bj) { f32x4 v0 = acc[ai][bj][m][0] * sc, v1 = acc[ai][bj][m][1] * sc;
                    if (ACT == 1) {
#pragma unroll
                        for (int j = 0; j < 4; ++j) { const float a = fmaxf(v0[j], 0.f), b = fmaxf(v1[j], 0.f); v0[j] = a * a; v1[j] = b * b; } }
                    u32x4 w; w.x = cvt_pk_bf16(v0[0], v0[1]); w.y = cvt_pk_bf16(v0[2], v0[3]); w.z = cvt_pk_bf16(v1[0], v1[1]); w.w = cvt_pk_bf16(v1[2], v1[3]);
                    *(u32x4*)(rowp + bj * HALF) = w; } }
    }
};
struct EpiF32s {
    static constexpr bool PERM = false, AFTER_DRAIN = false;
    float* C; int ldc; const float* rs; int rs_stride; float rs_scale, rs_eps, alpha; int rowmod; PG8_LAS float* rtab;
    __device__ __forceinline__ void operator()(const f32x4 (&acc)[2][2][4][2], const Unit& u, int wr, int wc, int fr, int fq) const {
        const int row0 = u.om * BM + wr * 64 + fr, col0 = u.on * BM + wc * 32 + 4 * fq;
        {   const int tid = (wr * 4 + wc) * 64 + fq * 16 + fr;
            if (tid < 256) { float t = 0.f;
#pragma unroll
                for (int q = 0; q < 8; ++q) t += rs[(size_t)q * rs_stride + (u.om % rowmod) * BM + tid];
                rtab[tid] = rsqrtf(t * rs_scale + rs_eps) * alpha; }
            asm volatile("s_waitcnt lgkmcnt(0)" ::: "memory"); __builtin_amdgcn_s_barrier(); asm volatile("" ::: "memory"); }
#pragma unroll
        for (int ai = 0; ai < 2; ++ai)
#pragma unroll
            for (int m = 0; m < 4; ++m) { float* rowp = C + (size_t)(row0 + ai * HALF + m * 16) * ldc + col0; const float sc = rtab[ai * HALF + wr * 64 + m * 16 + fr];
#pragma unroll
                for (int bj = 0; bj < 2; ++bj)
#pragma unroll
                    for (int n = 0; n < 2; ++n) *(f32x4*)(rowp + bj * HALF + n * 16) = acc[ai][bj][m][n] * sc; }
    }
};
struct EpiResid {
    static constexpr bool PERM = true, AFTER_DRAIN = true;
    bf16_t* XB; const float* g1; float* SSQ; int ssq_stride; float* outf; float* slots; unsigned* cnt; float inv_n, eps; unsigned char* x8 = nullptr;
    __device__ __forceinline__ void operator()(const f32x4 (&)[2][2][4][2], const Unit&, int, int, int, int) const {}
    __device__ __forceinline__ void fused(f32x4 (&acc)[2][2][4][2], const Unit& u, int wr, int wc, int fr, int fq, PG8_LAS unsigned char* lds, int wid, int lane) const {
        PG8_LAS float* P = (PG8_LAS float*)lds;
        PG8_LAS float* RY = (PG8_LAS float*)(lds + 4096);
        const int tid = wid * 64 + lane;
        const int row0 = u.om * BM + wr * 64 + fr, col0 = u.on * BM + wc * 32 + 8 * fq;
        u32x4 xo[4][2]; f32x4 gv[2][2];
#pragma unroll
        for (int m = 0; m < 4; ++m)
#pragma unroll
            for (int bj = 0; bj < 2; ++bj) xo[m][bj] = *(const u32x4*)(XB + (size_t)(row0 + m * 16) * 2048 + col0 + bj * HALF);
#pragma unroll
        for (int bj = 0; bj < 2; ++bj) { gv[bj][0] = *(const f32x4*)(g1 + col0 + bj * HALF); gv[bj][1] = *(const f32x4*)(g1 + col0 + bj * HALF + 4); }
#pragma unroll
        for (int ai = 0; ai < 2; ++ai)
#pragma unroll
            for (int m = 0; m < 4; ++m) { float s = 0.f;
#pragma unroll
                for (int bj = 0; bj < 2; ++bj)
#pragma unroll
                    for (int n = 0; n < 2; ++n) { const f32x4 v = acc[ai][bj][m][n]; s += (v[0] * v[0] + v[1] * v[1]) + (v[2] * v[2] + v[3] * v[3]); }
                s += lane_xor_f(s, 16, lane); s += lane_xor_f(s, 32, lane);
                if (fq == 0) P[(ai * HALF + wr * 64 + m * 16 + fr) * 4 + wc] = s; }
        __syncthreads();
        float* slot = slots + ((size_t)u.om * 8 + u.on) * 256;
        if (tid < 256) {
            const float t = (P[tid * 4 + 0] + P[tid * 4 + 1]) + (P[tid * 4 + 2] + P[tid * 4 + 3]);
            __hip_atomic_store(slot + tid, t, __ATOMIC_RELAXED, __HIP_MEMORY_SCOPE_AGENT);
            asm volatile("s_waitcnt vmcnt(0)" ::: "memory");
            if (lane == 0) __hip_atomic_fetch_add(cnt + 64 * u.om, 1u, __ATOMIC_RELAXED, __HIP_MEMORY_SCOPE_AGENT);
        }
        if (wid == 0) {
            unsigned spins = 0;
            while ((unsigned)__builtin_amdgcn_readfirstlane(__hip_atomic_load(cnt + 64 * u.om, __ATOMIC_RELAXED, __HIP_MEMORY_SCOPE_AGENT)) < 32u) { __builtin_amdgcn_s_sleep(2); if (++spins > (1u << 22)) break; }
            asm volatile("s_waitcnt vmcnt(0)" ::: "memory");
        }
        __syncthreads();
        if (tid < 256) { float t = 0.f; const float* sp = slots + (size_t)u.om * 8 * 256 + tid;
#pragma unroll
            for (int q = 0; q < 8; ++q) t += __hip_atomic_load(sp + q * 256, __ATOMIC_RELAXED, __HIP_MEMORY_SCOPE_AGENT);
            RY[tid] = rsqrtf(t * inv_n + eps); }
        __syncthreads();
#pragma unroll
        for (int ai = 0; ai < 2; ++ai)
#pragma unroll
            for (int m = 0; m < 4; ++m) { const int lr = ai * HALF + wr * 64 + m * 16 + fr; const float r = RY[lr];
                bf16_t* rowp = XB + (size_t)(row0 + ai * HALF + m * 16) * 2048 + col0; float s2 = 0.f;
#pragma unroll
                for (int bj = 0; bj < 2; ++bj) { const u32x4 xq = (ai == 0) ? xo[m][bj] : *(const u32x4*)(rowp + bj * HALF);
                    const unsigned xx[4] = {xq.x, xq.y, xq.z, xq.w}; float xn[8];
#pragma unroll
                    for (int e = 0; e < 4; ++e) { const int n = e >> 1, j = (e & 1) * 2;
                        xn[2 * e] = __builtin_bit_cast(float, xx[e] << 16) + acc[ai][bj][m][n][j] * r * gv[bj][n][j];
                        xn[2 * e + 1] = __builtin_bit_cast(float, xx[e] & 0xffff0000u) + acc[ai][bj][m][n][j + 1] * r * gv[bj][n][j + 1];
                        s2 += xn[2 * e] * xn[2 * e] + xn[2 * e + 1] * xn[2 * e + 1]; }
                    u32x4 w; w.x = cvt_pk_bf16(xn[0], xn[1]); w.y = cvt_pk_bf16(xn[2], xn[3]); w.z = cvt_pk_bf16(xn[4], xn[5]); w.w = cvt_pk_bf16(xn[6], xn[7]);
                    *(u32x4*)(rowp + bj * HALF) = w;
                    if (x8) { float t8[8];
#pragma unroll
                        for (int e = 0; e < 8; ++e) t8[e] = fminf(fmaxf(xn[e] * 16.f, -448.f), 448.f);
                        int w0 = __builtin_amdgcn_cvt_pk_fp8_f32(t8[0], t8[1], 0, false); w0 = __builtin_amdgcn_cvt_pk_fp8_f32(t8[2], t8[3], w0, true);
                        int w1 = __builtin_amdgcn_cvt_pk_fp8_f32(t8[4], t8[5], 0, false); w1 = __builtin_amdgcn_cvt_pk_fp8_f32(t8[6], t8[7], w1, true);
                        typedef int i32x2_ __attribute__((ext_vector_type(2))); *(i32x2_*)(x8 + (size_t)(row0 + ai * HALF + m * 16) * 4096 + col0 + bj * HALF) = (i32x2_){w0, w1}; }
                    if (outf) { float* op = outf + (size_t)(row0 + ai * HALF + m * 16) * 2048 + col0 + bj * HALF; *(f32x4*)op = (f32x4){xn[0], xn[1], xn[2], xn[3]}; *(f32x4*)(op + 4) = (f32x4){xn[4], xn[5], xn[6], xn[7]}; } }
                s2 += lane_xor_f(s2, 16, lane); s2 += lane_xor_f(s2, 32, lane);
                if (fq == 0) P[lr * 4 + wc] = s2; }
        __syncthreads();
        if (tid < 256) SSQ[(size_t)u.on * ssq_stride + u.om * BM + tid] = (P[tid * 4 + 0] + P[tid * 4 + 1]) + (P[tid * 4 + 2] + P[tid * 4 + 3]);
    }
};

template <class Epi, class Sched, bool ALIGN_EPI = false, bool SP2 = false>
__device__ __forceinline__ void gemm_phase(PG8_LAS unsigned char* lds, const Gemm g, const Sched& S, const Epi& E, const int tid_in) {
    int tid_ = tid_in; asm volatile("" : "+v"(tid_));
    const int tid = tid_, wid = __builtin_amdgcn_readfirstlane(tid >> 6), lane = tid & 63, wr = wid >> 2, wc = wid & 3, fr = lane & 15, fq = lane >> 4;
    const int K = g.K, nt = K / BK, lda = g.lda ? g.lda : K, ldb = g.ldb ? g.ldb : K;
    unsigned voffA[2], voffB[2];
#pragma unroll
    for (int i = 0; i < 2; ++i) { int R, C; stage_rc(tid * 16 + i * 8192, R, C); const int Rb = Epi::PERM ? ((R & ~31) + perm32(R & 31)) : R;
        voffA[i] = (unsigned)(R * lda + C) * 2u; voffB[i] = (unsigned)(Rb * ldb + C) * 2u; }
    const size_t kstep = (size_t)(BK * 2);
    const size_t hstepA = (size_t)HALF * lda * 2, hstepB = (size_t)HALF * ldb * 2;
    const size_t tstepA = 2 * hstepA, tstepB = 2 * hstepB;
    const unsigned ldsw = (unsigned)wid * 1024u;
    const int aoff = lds_byte(wr * 64 + fr, fq * 8), boff = lds_byte(wc * 32 + fr, fq * 8);
#define PG8_SA(b, h) (((b) * 2 + (h)) * HTB)
#define PG8_SB(b, h) ((4 + (b) * 2 + (h)) * HTB)
#define PG8_STAGE(bufoff, gbase, voff) do { _Pragma("unroll") for (int _i = 0; _i < 2; ++_i) \
        __builtin_amdgcn_global_load_lds((const unsigned*)((const char*)(gbase) + (voff)[_i]), (PG8_LAS unsigned*)(lds + (bufoff) + ldsw + _i * 8192), 16, 0, 0); } while (0)
#define PG8_LDA(dst, b, h) do { _Pragma("unroll") for (int m = 0; m < 4; ++m) _Pragma("unroll") for (int k = 0; k < 2; ++k) dst[m][k] = *(const PG8_LAS bf16x8*)(lds + PG8_SA(b, h) + aoff + m * 2048 + k * 1024); } while (0)
#define PG8_LDB(dst, b, h) do { _Pragma("unroll") for (int n = 0; n < 2; ++n) _Pragma("unroll") for (int k = 0; k < 2; ++k) dst[n][k] = *(const PG8_LAS bf16x8*)(lds + PG8_SB(b, h) + boff + n * 2048 + k * 1024); } while (0)
#define PG8_MMA(ai, bj, At, Bt) do { __builtin_amdgcn_s_setprio(1); _Pragma("unroll") for (int m = 0; m < 4; ++m) _Pragma("unroll") for (int n = 0; n < 2; ++n) _Pragma("unroll") for (int k = 0; k < 2; ++k) \
        acc[ai][bj][m][n] = __builtin_amdgcn_mfma_f32_16x16x32_bf16(Bt[n][k], At[m][k], acc[ai][bj][m][n], 0, 0, 0); __builtin_amdgcn_s_setprio(0); } while (0)
    typedef int pg8_i32x4 __attribute__((ext_vector_type(4)));
#define PG8_CAT(x) __builtin_shufflevector(__builtin_bit_cast(pg8_i32x4, (x)[0]), __builtin_bit_cast(pg8_i32x4, (x)[1]), 0, 1, 2, 3, 4, 5, 6, 7)
#define PG8_MMA8(ai, bj, At, Bt) do { __builtin_amdgcn_s_setprio(1); _Pragma("unroll") for (int m = 0; m < 4; ++m) _Pragma("unroll") for (int n = 0; n < 2; ++n) \
        asm volatile("v_mfma_scale_f32_16x16x128_f8f6f4 %0, %1, %2, %0, %3, %4 op_sel_hi:[0,0,0]" : "+v"(acc[ai][bj][m][n]) : "v"(PG8_CAT(Bt[n])), "v"(PG8_CAT(At[m])), "v"(sclB), "v"(sclA)); __builtin_amdgcn_s_setprio(0); } while (0)
#define PG8_MMAT(ai, bj, At, Bt) do { __builtin_amdgcn_s_setprio(1); _Pragma("unroll") for (int k = 0; k < 2; ++k) _Pragma("unroll") for (int m = 0; m < 4; ++m) _Pragma("unroll") for (int n = 0; n < 2; ++n)   \
        asm volatile("v_mfma_f32_16x16x32_bf16 %0, %1, %2, %0" : "+v"(acc[ai][bj][m][n]) : "v"(Bt[n][k]), "v"(At[m][k])); __builtin_amdgcn_s_setprio(0); } while (0)
#define PG8_MMAB(ai, bj, At, Bt) do { if constexpr (Sched::MIXED) PG8_MMAT(ai, bj, At, Bt); else PG8_MMA(ai, bj, At, Bt); } while (0)
#define PG8_WAIT_V(n) asm volatile("s_waitcnt vmcnt(" #n ")" ::: "memory")
#define PG8_WAIT_L(n) asm volatile("s_waitcnt lgkmcnt(" #n ")" ::: "memory")
#define PG8_BAR __builtin_amdgcn_s_barrier()
#define PG8_SCHED __builtin_amdgcn_sched_barrier(0)
    Unit cur, nxt; int ui = 0;
    if (!S.next(0, cur)) return;
    f32x4 acc[2][2][4][2];
#pragma unroll
    for (int a = 0; a < 2; ++a)
#pragma unroll
        for (int b = 0; b < 2; ++b)
#pragma unroll
            for (int m = 0; m < 4; ++m)
#pragma unroll
                for (int n = 0; n < 2; ++n) acc[a][b][m][n] = (f32x4){0.f, 0.f, 0.f, 0.f};
    bf16x8 At[4][2], B0[2][2], B1[2][2];
    const char* cA = (const char*)g.A + (size_t)cur.pm * tstepA + cur.aoff; const char* cB = (const char*)g.Bt + (size_t)cur.pn * tstepB + cur.boff;
    S.a_ready(cur);
    if constexpr (SP2) {
        PG8_STAGE(PG8_SB(0, 0), cB, voffB); PG8_STAGE(PG8_SB(0, 1), cB + hstepB, voffB); PG8_STAGE(PG8_SA(0, 0), cA, voffA); PG8_STAGE(PG8_SA(0, 1), cA + hstepA, voffA);
        if (wr == 1) PG8_BAR;
        PG8_WAIT_V(2); PG8_BAR;
        PG8_STAGE(PG8_SB(1, 0), cB + kstep, voffB); PG8_STAGE(PG8_SA(1, 0), cA + kstep, voffA); PG8_STAGE(PG8_SB(1, 1), cB + hstepB + kstep, voffB);
        PG8_WAIT_V(6); PG8_BAR;
    } else {
        PG8_STAGE(PG8_SB(0, 0), cB, voffB); PG8_STAGE(PG8_SA(0, 0), cA, voffA); PG8_STAGE(PG8_SB(0, 1), cB + hstepB, voffB); PG8_STAGE(PG8_SA(0, 1), cA + hstepA, voffA);
        if (wr == 1) PG8_BAR;
        PG8_WAIT_V(4); PG8_BAR;
        PG8_STAGE(PG8_SB(1, 0), cB + kstep, voffB); PG8_STAGE(PG8_SA(1, 0), cA + kstep, voffA); PG8_STAGE(PG8_SB(1, 1), cB + hstepB + kstep, voffB);
        PG8_WAIT_V(6); PG8_BAR;
    }
    for (;;) {
        const bool has_next = S.next(ui + 1, nxt);
        const char* nA = has_next ? (const char*)g.A + (size_t)nxt.pm * tstepA + nxt.aoff : cA; const char* nB = has_next ? (const char*)g.Bt + (size_t)nxt.pn * tstepB + nxt.boff : cB;
        const int ntu = Sched::MIXED ? cur.nt : nt; int t0 = 0; if constexpr (Sched::MIXED) t0 = S.nt8;
        int sclB = 0, sclA = 0; if constexpr (Sched::MIXED) { sclB = S.sclB; sclA = S.sclA; } (void)sclA; (void)sclB;
        if constexpr (Sched::MIXED && SP2) {
        for (int t = 0; t < S.nt8; t += 2) {
            constexpr bool last = false;
            asm volatile("" : "+v"(voffA[0]), "+v"(voffA[1]), "+v"(voffB[0]), "+v"(voffB[1]));
            const bool cross = (t + 2 >= S.nt8);
            const char* a1 = cA + (size_t)(t + 1) * kstep;
            const char* a2 = cA + (size_t)(t + 2) * kstep + (cross ? S.jumpA : 0); const char* b2 = cB + (size_t)(t + 2) * kstep + (cross ? S.jumpB : 0);
            const char* a3 = a2 + kstep; const char* b3 = b2 + kstep;
            if (last && has_next) S.a_ready(nxt);
            PG8_LDB(B0, 0, 0); PG8_LDB(B1, 0, 1); PG8_SCHED; PG8_LDA(At, 0, 0); PG8_STAGE(PG8_SA(1, 1), a1 + hstepA, voffA);
            PG8_WAIT_V(8); PG8_WAIT_L(0); PG8_BAR; PG8_MMA8(0, 0, At, B0); PG8_MMA8(0, 1, At, B1); PG8_BAR; PG8_SCHED;
            PG8_LDA(At, 0, 1); PG8_STAGE(PG8_SB(0, 0), b2, voffB); PG8_STAGE(PG8_SB(0, 1), b2 + hstepB, voffB); PG8_STAGE(PG8_SA(0, 0), a2, voffA);
            PG8_WAIT_V(8); PG8_WAIT_L(0); PG8_BAR; PG8_MMA8(1, 0, At, B0); PG8_MMA8(1, 1, At, B1); PG8_BAR; PG8_SCHED;
            PG8_LDB(B0, 1, 0); PG8_LDB(B1, 1, 1); PG8_SCHED; PG8_LDA(At, 1, 0); PG8_STAGE(PG8_SA(0, 1), a2 + hstepA, voffA);
            PG8_WAIT_V(8); PG8_WAIT_L(0); PG8_BAR; PG8_MMA8(0, 0, At, B0); PG8_MMA8(0, 1, At, B1); PG8_BAR; PG8_SCHED;
            PG8_LDA(At, 1, 1); PG8_STAGE(PG8_SB(1, 0), b3, voffB); PG8_STAGE(PG8_SB(1, 1), b3 + hstepB, voffB); PG8_STAGE(PG8_SA(1, 0), a3, voffA);
            PG8_WAIT_V(8); PG8_WAIT_L(0); PG8_BAR; PG8_MMA8(1, 0, At, B0); PG8_MMA8(1, 1, At, B1); PG8_BAR; PG8_SCHED;
        }
        }
        for (int t = t0; t < ntu; t += 2) {
            const bool last = (t == ntu - 2);
            if constexpr (Sched::MIXED) asm volatile("" : "+v"(voffA[0]), "+v"(voffA[1]), "+v"(voffB[0]), "+v"(voffB[1]));
            long long jA = 0, jB = 0; if constexpr (Sched::MIXED) { jA = S.jumpA; jB = S.jumpB; }
            const char* a1 = cA + (size_t)(t + 1) * kstep + jA;
            const char* a2 = last ? nA : cA + (size_t)(t + 2) * kstep + jA; const char* b2 = last ? nB : cB + (size_t)(t + 2) * kstep + jB;
            const char* a3 = a2 + kstep; const char* b3 = b2 + kstep;
            if (last && has_next) S.a_ready(nxt);
            if constexpr (SP2) {
            PG8_LDB(B0, 0, 0); PG8_LDB(B1, 0, 1); PG8_SCHED; PG8_LDA(At, 0, 0); PG8_STAGE(PG8_SA(1, 1), a1 + hstepA, voffA);
            PG8_WAIT_V(8); PG8_WAIT_L(0); PG8_BAR; PG8_MMAB(0, 0, At, B0); PG8_MMAB(0, 1, At, B1); PG8_BAR; PG8_SCHED;
            PG8_LDA(At, 0, 1); PG8_STAGE(PG8_SB(0, 0), b2, voffB); PG8_STAGE(PG8_SB(0, 1), b2 + hstepB, voffB); PG8_STAGE(PG8_SA(0, 0), a2, voffA);
            PG8_WAIT_V(8); PG8_WAIT_L(0); PG8_BAR; PG8_MMAB(1, 0, At, B0); PG8_MMAB(1, 1, At, B1); PG8_BAR; PG8_SCHED;
            PG8_LDB(B0, 1, 0); PG8_LDB(B1, 1, 1); PG8_SCHED; PG8_LDA(At, 1, 0); PG8_STAGE(PG8_SA(0, 1), a2 + hstepA, voffA);
            PG8_WAIT_V(8); PG8_WAIT_L(0); PG8_BAR; PG8_MMAB(0, 0, At, B0); PG8_MMAB(0, 1, At, B1); PG8_BAR; PG8_SCHED;
            PG8_LDA(At, 1, 1); PG8_STAGE(PG8_SB(1, 0), b3, voffB); PG8_STAGE(PG8_SB(1, 1), b3 + hstepB, voffB); PG8_STAGE(PG8_SA(1, 0), a3, voffA);
            PG8_WAIT_V(8); PG8_WAIT_L(0); PG8_BAR; PG8_MMAB(1, 0, At, B0); PG8_MMAB(1, 1, At, B1); PG8_BAR; PG8_SCHED;
            } else {
            PG8_LDB(B0, 0, 0); PG8_SCHED; PG8_LDA(At, 0, 0); PG8_STAGE(PG8_SA(1, 1), a1 + hstepA, voffA);
            PG8_WAIT_L(8); PG8_BAR; PG8_WAIT_L(0); PG8_MMA(0, 0, At, B0); PG8_BAR; PG8_SCHED;
            PG8_LDB(B1, 0, 1); PG8_STAGE(PG8_SB(0, 0), b2, voffB);
            PG8_BAR; PG8_WAIT_L(0); PG8_MMA(0, 1, At, B1); PG8_BAR;
            PG8_LDA(At, 0, 1); PG8_STAGE(PG8_SA(0, 0), a2, voffA);
            PG8_BAR; PG8_WAIT_L(0); PG8_MMA(1, 0, At, B0); PG8_BAR; PG8_SCHED;
            PG8_STAGE(PG8_SB(0, 1), b2 + hstepB, voffB);
            PG8_WAIT_V(6); PG8_BAR; PG8_MMA(1, 1, At, B1); PG8_BAR;
            PG8_LDB(B0, 1, 0); PG8_SCHED; PG8_LDA(At, 1, 0); PG8_STAGE(PG8_SA(0, 1), a2 + hstepA, voffA);
            PG8_WAIT_L(8); PG8_BAR; PG8_WAIT_L(0); PG8_MMA(0, 0, At, B0); PG8_BAR; PG8_SCHED;
            PG8_LDB(B1, 1, 1); PG8_STAGE(PG8_SB(1, 0), b3, voffB);
            PG8_BAR; PG8_WAIT_L(0); PG8_MMA(0, 1, At, B1); PG8_BAR;
            PG8_LDA(At, 1, 1); PG8_STAGE(PG8_SA(1, 0), a3, voffA);
            PG8_BAR; PG8_WAIT_L(0); PG8_MMA(1, 0, At, B0); PG8_BAR; PG8_SCHED;
            PG8_STAGE(PG8_SB(1, 1), b3 + hstepB, voffB);
            PG8_WAIT_V(6); PG8_BAR; PG8_MMA(1, 1, At, B1); PG8_BAR;
            }
        }
        if constexpr (ALIGN_EPI) { if (wr == 0) PG8_BAR; }
        if constexpr (!Epi::AFTER_DRAIN) { E(acc, cur, wr, wc, fr, fq); S.done(cur); }
        if (!has_next) break;
#pragma unroll
        for (int a = 0; a < 2; ++a)
#pragma unroll
            for (int b = 0; b < 2; ++b)
#pragma unroll
                for (int m = 0; m < 4; ++m)
#pragma unroll
                    for (int n = 0; n < 2; ++n) acc[a][b][m][n] = (f32x4){0.f, 0.f, 0.f, 0.f};
        cur = nxt; cA = nA; cB = nB; ++ui;
        if constexpr (ALIGN_EPI) { if (wr == 1) PG8_BAR; }
    }
    PG8_WAIT_V(0);
    if constexpr (!ALIGN_EPI) { if (wr == 0) PG8_BAR; }
    PG8_BAR;
    if constexpr (Epi::AFTER_DRAIN) { E.fused(acc, cur, wr, wc, fr, fq, lds, wid, lane); S.done(cur); }
#undef PG8_CAT
#undef PG8_MMA8
#undef PG8_MMAT
#undef PG8_MMAB
#undef PG8_SA
#undef PG8_SB
#undef PG8_STAGE
#undef PG8_LDA
#undef PG8_LDB
#undef PG8_MMA
#undef PG8_WAIT_V
#undef PG8_WAIT_L
#undef PG8_BAR
#undef PG8_SCHED
}
}

constexpr int D = 2048, BATCH = 4, SEQ = 2048, DEPTH = 4, M = BATCH * SEQ, MEM_LEN = 256, MM = BATCH * MEM_LEN;
constexpr int DIN = 4128, DFF = 8192;
constexpr int O_AQ = 0, O_AK = 1024, O_AV = 1280, O_BQ = 1536, O_BK = 1792, O_BV = 2048, O_BG = 2560, O_ZF = 3072, O_ZB = 3088, O_CX = 3104, O_CY = 3616;
constexpr int NPB = 4096;
constexpr int PB_CX = 3072, PB_CY = 3584;
constexpr float EPS = 1e-6f;
constexpr int NWAVES = 8, NTHREADS = 512;

#ifndef PROBE_AMP
#define PROBE_AMP 0u
#endif
constexpr unsigned long long AMP_K = 3;
#ifndef NWL
#define NWL 4
#endif
constexpr size_t MiB = 1u << 20;
constexpr size_t WS_CTL = 0, CTL_ZERO_BYTES = 1 * MiB;
constexpr size_t WS_W = 1 * MiB, WL_BYTES = 121 * MiB;
constexpr size_t WL_IN = 0, WL_OUT = 16 * MiB, WL_XQ = 24 * MiB, WL_XK = 32 * MiB, WL_XV = 40 * MiB, WL_XO = 48 * MiB, WL_UP = 56 * MiB, WL_DOWN = 88 * MiB, WL_Z = 120 * MiB, WL_LRUG = 120 * MiB + 256 * 1024;
constexpr size_t WS_XN = WS_W + NWL * WL_BYTES;
constexpr size_t WS_MEMN = WS_XN + 32 * MiB;
constexpr size_t WS_KX = WS_MEMN + 16 * MiB;
constexpr size_t WS_VT = WS_KX + 16 * MiB;
constexpr size_t WS_Y = WS_VT + 16 * MiB;
constexpr size_t WS_Z = WS_Y + 64 * MiB;
constexpr size_t WS_BIG = WS_Z + 1 * MiB;
constexpr size_t WS_PB = WS_BIG;
constexpr size_t WS_MIX = WS_BIG + 64 * MiB;
constexpr size_t WS_GLAU = WS_BIG + 96 * MiB;
constexpr size_t WS_MISC = WS_BIG + 128 * MiB;
constexpr size_t WS_H = WS_BIG;
constexpr size_t WS_SC = WS_BIG;
constexpr size_t WS_PR = WS_BIG + 64 * MiB;
constexpr size_t WS_LRU = WS_BIG + 136 * MiB;
constexpr size_t WS_SLOT = WS_LRU + 24 * MiB;
constexpr size_t WS_MQK = WS_SLOT + 4 * MiB;
constexpr size_t WS_VWO = WS_MQK + 64 * MiB;
constexpr size_t WS_END = WS_VWO + 64 * MiB;
constexpr int CW_TMO = 0, CW_BAR = 4096, CW_RCNT = 65536;

constexpr int RING_OFF = 0, RING_BYTES = 131072, SCR_BYTES = 143360;
constexpr int LDSCTL_OFF = SCR_BYTES, MISC_OFF = LDSCTL_OFF + 320;
constexpr int LDS_BYTES = 147456;

#define GAS __attribute__((address_space(1)))
#define CAS __attribute__((address_space(4)))
#define LAS __attribute__((address_space(3)))
typedef unsigned short bf16;
typedef unsigned v4u __attribute__((ext_vector_type(4)));
typedef unsigned v2u __attribute__((ext_vector_type(2)));
typedef float f32x4 __attribute__((ext_vector_type(4)));
typedef short bf16x8 __attribute__((ext_vector_type(8)));
typedef short s16x4 __attribute__((ext_vector_type(4)));
#define LDS_WAIT() asm volatile("s_waitcnt lgkmcnt(0)" ::: "memory")
#define LBAR() do { asm volatile("s_waitcnt lgkmcnt(0)" ::: "memory"); __builtin_amdgcn_s_barrier(); asm volatile("" ::: "memory"); } while (0)
#define VM_WAIT() asm volatile("s_waitcnt vmcnt(0)" ::: "memory")
typedef float f32x2_t __attribute__((ext_vector_type(2)));
typedef __bf16 bf16x2_t __attribute__((ext_vector_type(2)));
__device__ __forceinline__ unsigned pk2(float lo, float hi) { const f32x2_t v = {lo, hi}; return __builtin_bit_cast(unsigned, __builtin_convertvector(v, bf16x2_t)); }
__device__ __forceinline__ unsigned f2bf(float f) { return pk2(f, f) & 0xffffu; }
__device__ __forceinline__ float bf2f(unsigned short b) { return __builtin_bit_cast(float, (unsigned)b << 16); }
__device__ __forceinline__ float wave_sum(float v, int lane) {
#pragma unroll
    for (int o = 1; o < 64; o <<= 1) v += lane_xor_f(v, o, lane);
    return v;
}
__device__ __forceinline__ float wave_max(float v, int lane) {
#pragma unroll
    for (int o = 1; o < 64; o <<= 1) v = fmaxf(v, lane_xor_f(v, o, lane));
    return v;
}
__device__ __forceinline__ float sigmoidf_(float x) { return __builtin_amdgcn_rcpf(1.f + __builtin_amdgcn_exp2f(-1.4426950408889634f * x)); }
__device__ __forceinline__ float softplusf_(float x) { return fmaxf(x, 0.f) + 0.6931471805599453f * __builtin_amdgcn_logf(1.f + __builtin_amdgcn_exp2f(-1.4426950408889634f * fabsf(x))); }
__device__ __forceinline__ float gelu_tanh(float x) { return x * sigmoidf_(1.5957691216057308f * (x + 0.044715f * x * x * x)); }
__device__ __forceinline__ int t5_bucket(int rel) {
    const int ret = rel > 0 ? 16 : 0; const int n = rel < 0 ? -rel : rel;
    if (n < 8) return ret + n;
    int k = 0; while (k < 7 && (64 << (k + 1)) <= n * n) ++k;
    return ret + 8 + k;
}

struct Frame {
    LAS unsigned char* lds;
    int tid, lane, wave, G, bx;
};

__device__ __forceinline__ void p0_transpose_item(const float* W, int K, int N, int c0, bf16* WT, int r0, int nblk, const float* gk, LAS float* scr, int item, int lane) {
    const int kb = item / nblk, nb = item % nblk, k0 = 64 * kb, n0 = 32 * nb;
    const int c = lane & 7;
    f32x4 g0 = {1.f, 1.f, 1.f, 1.f}, g1 = {1.f, 1.f, 1.f, 1.f};
    if (gk) { g0 = *(const GAS f32x4*)(gk + k0 + 8 * c); g1 = *(const GAS f32x4*)(gk + k0 + 8 * c + 4); }
    f32x4 wv[8];
#pragma unroll
    for (int i = 0; i < 8; ++i) wv[i] = *(const GAS f32x4*)(W + (size_t)(k0 + 8 * i + (lane >> 3)) * N + c0 + n0 + 4 * (lane & 7));
#pragma unroll
    for (int i = 0; i < 8; ++i) { LAS float* d = scr + (8 * i + (lane >> 3)) * 33 + 4 * (lane & 7); d[0] = wv[i].x; d[1] = wv[i].y; d[2] = wv[i].z; d[3] = wv[i].w; }
    LDS_WAIT(); asm volatile("" ::: "memory");
#pragma unroll
    for (int j = 0; j < 4; ++j) { const int n = (lane >> 3) + 8 * j; const LAS float* s = scr + (8 * c) * 33 + n;
        v4u o; o.x = pk2(s[0 * 33] * g0.x, s[1 * 33] * g0.y); o.y = pk2(s[2 * 33] * g0.z, s[3 * 33] * g0.w); o.z = pk2(s[4 * 33] * g1.x, s[5 * 33] * g1.y); o.w = pk2(s[6 * 33] * g1.z, s[7 * 33] * g1.w);
        *(GAS v4u*)(WT + (size_t)(r0 + n0 + n) * K + k0 + 8 * c) = o; }
    LDS_WAIT(); asm volatile("" ::: "memory");
}
struct ConvSeg { const float* W; int K, N, c0, ncols; bf16* WT; int r0; const float* gain; };
__device__ __forceinline__ int seg_items(const ConvSeg& s) { return (s.K / 64) * (s.ncols / 32); }
struct SegC { int in_idx, K, N, c0, ncols, r0, gain_idx; unsigned wl_off; unsigned lstride; };
__device__ const SegC SEGA[2] = {
    {19, D, D, 0, D, 0, -1, (unsigned)WL_XK, (unsigned)(D * D)}, {20, D, D, 0, D, 0, -1, (unsigned)WL_XV, (unsigned)(D * D)}};
__device__ const int SEGA_START[3] = {0, 2048, 4096};
__device__ const SegC SEGO[1] = {{21, D, D, 0, D, 0, -1, (unsigned)WL_XO, (unsigned)(D * D)}};
__device__ const int SEGO_START[2] = {0, 2048};
__device__ const SegC SEGB[6] = {
    {3, D, DIN, 0, 3072, 0, 24, (unsigned)WL_IN, (unsigned)(D * DIN)}, {3, D, DIN, 3072, 32, 0, 24, (unsigned)WL_Z, (unsigned)(D * DIN)}, {3, D, DIN, 3104, 1024, 3072, 24, (unsigned)WL_IN, (unsigned)(D * DIN)},
    {4, D, D, 0, D, 0, -1, (unsigned)WL_OUT, (unsigned)(D * D)}, {22, D, DFF, 0, DFF, 0, 29, (unsigned)WL_UP, (unsigned)(D * DFF)}, {23, DFF, D, 0, D, 0, -1, (unsigned)WL_DOWN, (unsigned)(DFF * D)}};
__device__ const int SEGB_START[7] = {0, 3072, 3104, 4128, 6176, 14368, 22560};
constexpr int SEGA_ITEMS = 4096, SEGO_ITEMS = 2048, SEGB_ITEMS = 22560;
constexpr int SEGB_SPLIT = 44700;
__device__ const int K8L[4] = {0, 7936, 7936, 7936};
__device__ const int K8U[4] = {0, 0, 0, 1792};
constexpr size_t WS_X8 = WS_Y;
struct ConvDesc { const float* src; const float* gk; bf16* dst; int N, K, q8; };

__device__ __forceinline__ void scale_row_bf16(int lane, const float* src, float s, bf16* dst) {
    const GAS f32x4* xr = (const GAS f32x4*)src; GAS v4u* ob = (GAS v4u*)dst;
#pragma unroll
    for (int j = 0; j < 4; ++j) { const int ch = lane + 64 * j; const f32x4 p = xr[2 * ch], q = xr[2 * ch + 1];
        v4u w; w.x = pk2(p.x * s, p.y * s); w.y = pk2(p.z * s, p.w * s); w.z = pk2(q.x * s, q.y * s); w.w = pk2(q.z * s, q.w * s); ob[ch] = w; }
}
__device__ __forceinline__ void norm_row(int lane, const float* src, const float* g, bf16* xn, float* copy_dst) {
    const GAS f32x4* xr = (const GAS f32x4*)src + lane; const GAS f32x4* gr = (const GAS f32x4*)g + lane;
    f32x4 v[8]; float s = 0.f;
#pragma unroll
    for (int j = 0; j < 8; ++j) { v[j] = xr[64 * j]; s += (v[j].x * v[j].x + v[j].y * v[j].y) + (v[j].z * v[j].z + v[j].w * v[j].w); }
    const float r = rsqrtf(wave_sum(s, lane) * (1.f / D) + EPS);
    GAS v2u* o8 = (GAS v2u*)xn + lane;
#pragma unroll
    for (int j = 0; j < 8; ++j) { const f32x4 gg = gr[64 * j]; v2u w; w.x = pk2(v[j].x * r * gg.x, v[j].y * r * gg.y); w.y = pk2(v[j].z * r * gg.z, v[j].w * r * gg.w); o8[64 * j] = w;
        if (copy_dst) ((GAS f32x4*)copy_dst + lane)[64 * j] = v[j]; }
}
template <int NR>
__device__ __forceinline__ void init_rows(int lane, const float* x0, bf16* xb0, float* rs0, size_t row_stride) {
    f32x4 a[NR][4], b[NR][4];
#pragma unroll
    for (int i = 0; i < NR; ++i)
#pragma unroll
        for (int j = 0; j < 4; ++j) { const int ch = lane + 64 * j; const GAS f32x4* xr = (const GAS f32x4*)(x0 + i * row_stride * D); a[i][j] = xr[2 * ch]; b[i][j] = xr[2 * ch + 1]; }
#pragma unroll
    for (int i = 0; i < NR; ++i) { float s = 0.f; GAS v4u* ob = (GAS v4u*)(xb0 + i * row_stride * D);
#pragma unroll
        for (int j = 0; j < 4; ++j) { const int ch = lane + 64 * j; const f32x4 p = a[i][j], q = b[i][j];
            s += (p.x * p.x + p.y * p.y) + (p.z * p.z + p.w * p.w) + (q.x * q.x + q.y * q.y) + (q.z * q.z + q.w * q.w);
            v4u w; w.x = pk2(p.x, p.y); w.y = pk2(p.z, p.w); w.z = pk2(q.x, q.y); w.w = pk2(q.z, q.w); ob[ch] = w; }
        s = wave_sum(s, lane);
        if (lane < 8) rs0[i * row_stride + (size_t)lane * M] = lane == 0 ? s : 0.f; }
}
__device__ __forceinline__ void init_row(int lane, const float* x, bf16* xb, float* rs) {
    const GAS f32x4* xr = (const GAS f32x4*)x; GAS v4u* ob = (GAS v4u*)xb;
    float s = 0.f;
#pragma unroll
    for (int j = 0; j < 4; ++j) { const int ch = lane + 64 * j; const f32x4 a = xr[2 * ch], b = xr[2 * ch + 1];
        s += (a.x * a.x + a.y * a.y) + (a.z * a.z + a.w * a.w) + (b.x * b.x + b.y * b.y) + (b.z * b.z + b.w * b.w);
        v4u w; w.x = pk2(a.x, a.y); w.y = pk2(a.z, a.w); w.z = pk2(b.x, b.y); w.w = pk2(b.z, b.w); ob[ch] = w; }
    s = wave_sum(s, lane);
    if (lane < 8) rs[(size_t)lane * M] = lane == 0 ? s : 0.f;
}
__device__ __forceinline__ void zgemm(const Frame& F, const bf16* XN, const bf16* WZ, const float* RS, float* Z) {
    const int lane = F.lane, g = lane >> 4, c = lane & 15, w = F.wave, kq = w & 3;
    LAS f32x4* red = (LAS f32x4*)F.lds;
    for (int rb = F.bx; rb < M / 32; rb += F.G) {
        const int rt = rb * 2 + (w >> 2);
        const bf16* ap = XN + (size_t)(rt * 16 + c) * D + kq * 512 + g * 8;
        const bf16* b0 = WZ + (size_t)c * D + kq * 512 + g * 8; const bf16* b1p = WZ + (size_t)(16 + c) * D + kq * 512 + g * 8;
        f32x4 acc0 = {0.f, 0.f, 0.f, 0.f}, acc1 = {0.f, 0.f, 0.f, 0.f};
#pragma unroll 8
        for (int ks = 0; ks < 16; ++ks) { const bf16x8 a = *(const GAS bf16x8*)(ap + ks * 32), x = *(const GAS bf16x8*)(b0 + ks * 32), y = *(const GAS bf16x8*)(b1p + ks * 32);
            acc0 = __builtin_amdgcn_mfma_f32_16x16x32_bf16(a, x, acc0, 0, 0, 0); acc1 = __builtin_amdgcn_mfma_f32_16x16x32_bf16(a, y, acc1, 0, 0, 0); }
        LBAR();
        red[(w * 2 + 0) * 64 + lane] = acc0; red[(w * 2 + 1) * 64 + lane] = acc1;
        LBAR();
        if (kq == 0) {
#pragma unroll
            for (int ct = 0; ct < 2; ++ct) { f32x4 s = red[(w * 2 + ct) * 64 + lane];
#pragma unroll
                for (int q = 1; q < 4; ++q) s += red[((w + q) * 2 + ct) * 64 + lane];
#pragma unroll
                for (int r = 0; r < 4; ++r) { const int m = rt * 16 + 4 * g + r; float t = 0.f;
#pragma unroll
                    for (int q = 0; q < 8; ++q) t += RS[(size_t)q * M + m];
                    Z[(size_t)m * 32 + ct * 16 + c] = s[r] * rsqrtf(t * (1.f / D) + EPS); } }
        }
    }
}

#define XB_TMO      128
#define XB_XCNT(j)  (256  + 64 * (j))
#define XB_XSUB(j)  (1280 + 64 * (j))
#define XB_XGEN(j)  (2304 + 64 * (j))
#define XB_TOP      3328
#define XB_TOPGEN   3392
#define XCD_BAR_WORDS 3456
#define XB_SPIN_CAP (1u << 18)
#define LAS __attribute__((address_space(3)))

__device__ __forceinline__ unsigned xb_ld(unsigned* p)              { return __hip_atomic_load(p, __ATOMIC_RELAXED, __HIP_MEMORY_SCOPE_AGENT); }
__device__ __forceinline__ unsigned xb_add(unsigned* p, unsigned v) { return __hip_atomic_fetch_add(p, v, __ATOMIC_RELAXED, __HIP_MEMORY_SCOPE_AGENT); }
__device__ __forceinline__ unsigned xb_xcc_id() { return (unsigned)__builtin_amdgcn_s_getreg((3 << 11) | 20) & 0xFu; }
#define XB_SPIN(cond, bar) do { unsigned _sp = 0; while (cond) { __builtin_amdgcn_s_sleep(1); \
    if ((++_sp & 255u) == 0u) { if (xb_ld(&(bar)[XB_TMO])) break; if (_sp > XB_SPIN_CAP) { atomicAdd(&(bar)[XB_TMO], 1u); break; } } } } while (0)

struct XcdBarrier {
    unsigned* bar; unsigned x;
    volatile LAS unsigned* st;
};

__device__ __forceinline__ XcdBarrier xcd_barrier_post(unsigned* bar, volatile LAS unsigned* st) {
    XcdBarrier b; b.bar = bar; b.x = xb_xcc_id(); b.st = st;
    if (threadIdx.x == 0) (void)xb_add(&bar[XB_XCNT(b.x)], 1u);
    return b;
}
__device__ __forceinline__ void xcd_barrier_complete(unsigned* bar, unsigned x, unsigned& nloc, unsigned& nx) {
    const unsigned G = gridDim.x * gridDim.y * gridDim.z;
    unsigned sum, cnt, mine, sp = 0u;
    for (;;) {
        sum = 0u; cnt = 0u; mine = 0u;
#pragma unroll
        for (unsigned j = 0; j < 16; ++j) { const unsigned c = xb_ld(&bar[XB_XCNT(j)]); sum += c; cnt += (c > 0u) ? 1u : 0u; mine = (j == x) ? c : mine; }
        if (sum == G) break;
        __builtin_amdgcn_s_sleep(1);
        if ((++sp & 255u) == 0u) { if (xb_ld(&bar[XB_TMO])) break; if (sp > XB_SPIN_CAP) { atomicAdd(&bar[XB_TMO], 1u); break; } }
    }
    nloc = mine > 0u ? mine : 1u; nx = cnt > 0u ? cnt : 1u;
}

__device__ __forceinline__ void xcd_barrier(const XcdBarrier& b) {
    asm volatile("s_waitcnt vmcnt(0)" ::: "memory");
    __syncthreads();
    if (threadIdx.x == 0) {
        unsigned* bar = b.bar;
        __builtin_amdgcn_s_waitcnt(0);
        unsigned nloc = b.st[0], nx = b.st[1];
        if (nloc == 0u) { xcd_barrier_complete(bar, b.x, nloc, nx); b.st[0] = nloc; b.st[1] = nx; }
        const unsigned old = xb_add(&bar[XB_XSUB(b.x)], 1u);
        const unsigned gen = old / nloc;
        if (old + 1u == (gen + 1u) * nloc) {
            __builtin_amdgcn_fence(__ATOMIC_RELEASE, "agent");
            asm volatile("s_waitcnt vmcnt(0)" ::: "memory");
            const unsigned og = xb_add(&bar[XB_TOP], 1u);
            const unsigned tg = og / nx;
            if (og + 1u == (tg + 1u) * nx) xb_add(&bar[XB_TOPGEN], 1u);
            else XB_SPIN(xb_ld(&bar[XB_TOPGEN]) == tg, bar);
            __builtin_amdgcn_fence(__ATOMIC_ACQUIRE, "agent");
            xb_add(&bar[XB_XGEN(b.x)], 1u);
            asm volatile("s_waitcnt vmcnt(0)" ::: "memory");
        } else {
            XB_SPIN(xb_ld(&bar[XB_XGEN(b.x)]) == gen, bar);
            __builtin_amdgcn_fence(__ATOMIC_ACQUIRE, "agent");
            asm volatile("s_waitcnt vmcnt(0)" ::: "memory");
        }
    }
    __syncthreads();
}
__device__ __forceinline__ void conv_weights_phase(const Frame& F, const float* const CAS* inp, unsigned char* ws, const SegC* segs, const int* starts, int nseg, int per_layer, int f_begin, int f_end, LAS float* scr, int gw, int NGW) {
    {
                const int nflat = f_end;
#define CONV_DESC(f_, d_) do { const int lc_ = (f_) / per_layer, r_ = (f_) % per_layer; int s_ = 0; \
        _Pragma("unroll") for (int q_ = 1; q_ < 6; ++q_) s_ += (q_ < nseg && r_ >= starts[q_]) ? 1 : 0; \
        const SegC sc_ = segs[s_]; const int it_ = r_ - starts[s_], nblk_ = sc_.ncols / 32, kb_ = it_ / nblk_, nb_ = it_ % nblk_, k0_ = 64 * kb_, n0_ = 32 * nb_, c_ = F.lane & 7; \
        (d_).N = sc_.N; (d_).K = sc_.K; \
        (d_).src = inp[sc_.in_idx] + (size_t)lc_ * sc_.lstride + (size_t)(k0_ + (F.lane >> 3)) * sc_.N + sc_.c0 + n0_ + 4 * c_; \
        (d_).gk = sc_.gain_idx >= 0 ? inp[sc_.gain_idx] + (size_t)lc_ * D + k0_ + 8 * c_ : nullptr; \
        (d_).q8 = (sc_.in_idx == 23 && k0_ < K8L[lc_]) ? 1 : ((sc_.in_idx == 22 && k0_ < K8U[lc_]) ? 2 : 0); \
        (d_).dst = (bf16*)(ws + WS_W + (size_t)(lc_ % NWL) * WL_BYTES + sc_.wl_off) + (size_t)(sc_.r0 + n0_ + (F.lane >> 3)) * sc_.K + ((d_).q8 ? (k0_ + 8 * c_) / 2 : k0_ + 8 * c_); } while (0)
#define CONV_LOAD(d_, wv_, g0_, g1_) do { _Pragma("unroll") for (int i_ = 0; i_ < 8; ++i_) wv_[i_] = *(const GAS f32x4*)((d_).src + (size_t)(8 * i_) * (d_).N); \
        g0_ = (f32x4){1.f, 1.f, 1.f, 1.f}; g1_ = g0_; if ((d_).gk) { g0_ = *(const GAS f32x4*)(d_).gk; g1_ = *(const GAS f32x4*)((d_).gk + 4); } } while (0)
#define FP8W(x_) fminf(fmaxf((x_) * fs_, -448.f), 448.f)
#define CONV_STORE(d_, wv_, g0_, g1_) do { _Pragma("unroll") for (int i_ = 0; i_ < 8; ++i_) { LAS float* p_ = scr + (8 * i_ + (F.lane >> 3)) * 33 + 4 * (F.lane & 7); p_[0] = wv_[i_].x; p_[1] = wv_[i_].y; p_[2] = wv_[i_].z; p_[3] = wv_[i_].w; } \
        LDS_WAIT(); asm volatile("" ::: "memory"); \
        _Pragma("unroll") for (int j_ = 0; j_ < 4; ++j_) { const LAS float* s_ = scr + (8 * (F.lane & 7)) * 33 + (F.lane >> 3) + 8 * j_; \
            if ((d_).q8) { const float fs_ = (d_).q8 == 1 ? 256.f : 128.f;     \
                int w0_ = __builtin_amdgcn_cvt_pk_fp8_f32(FP8W(s_[0 * 33] * g0_.x), FP8W(s_[1 * 33] * g0_.y), 0, false); w0_ = __builtin_amdgcn_cvt_pk_fp8_f32(FP8W(s_[2 * 33] * g0_.z), FP8W(s_[3 * 33] * g0_.w), w0_, true); \
                int w1_ = __builtin_amdgcn_cvt_pk_fp8_f32(FP8W(s_[4 * 33] * g1_.x), FP8W(s_[5 * 33] * g1_.y), 0, false); w1_ = __builtin_amdgcn_cvt_pk_fp8_f32(FP8W(s_[6 * 33] * g1_.z), FP8W(s_[7 * 33] * g1_.w), w1_, true); \
                typedef int i32x2_ __attribute__((ext_vector_type(2))); *(GAS i32x2_*)((d_).dst + (size_t)(8 * j_) * (d_).K) = (i32x2_){w0_, w1_}; } else { \
            v4u o_; o_.x = pk2(s_[0 * 33] * g0_.x, s_[1 * 33] * g0_.y); o_.y = pk2(s_[2 * 33] * g0_.z, s_[3 * 33] * g0_.w); o_.z = pk2(s_[4 * 33] * g1_.x, s_[5 * 33] * g1_.y); o_.w = pk2(s_[6 * 33] * g1_.z, s_[7 * 33] * g1_.w); \
            *(GAS v4u*)((d_).dst + (size_t)(8 * j_) * (d_).K) = o_; } } \
        LDS_WAIT(); asm volatile("" ::: "memory"); } while (0)
                ConvDesc dA, dB; f32x4 wA[8], wB[8], gA0, gA1, gB0, gB1;
                int f = f_begin + gw;
                if (f < nflat) { CONV_DESC(f, dA); CONV_LOAD(dA, wA, gA0, gA1); }
                while (f < nflat) {
                    const int f1 = f + NGW;
                    if (f1 < nflat) { CONV_DESC(f1, dB); CONV_LOAD(dB, wB, gB0, gB1); }
                    CONV_STORE(dA, wA, gA0, gA1);
                    if (f1 >= nflat) break;
                    const int f2 = f1 + NGW;
                    if (f2 < nflat) { CONV_DESC(f2, dA); CONV_LOAD(dA, wA, gA0, gA1); }
                    CONV_STORE(dB, wB, gB0, gB1);
                    f = f2;
                }
#undef CONV_DESC
#undef CONV_LOAD
#undef CONV_STORE
#undef FP8W
            }
}
constexpr size_t MISC_DEC = 3 * MiB;
constexpr int GL_Z = 0, GL_TF = 8192, GL_TB = 10240, GL_VI = 12288, GL_A = 30720, GL_B = 39936, GL_P = 49152, GL_SI = 58368, GL_OF = 76800, GL_VS = 288;
__device__ __forceinline__ bf16x8 tr_frag(LAS unsigned char* p, int stride4) {
    const s16x4 lo = __builtin_amdgcn_ds_read_tr16_b64_v4i16((LAS s16x4*)p);
    const s16x4 hi = __builtin_amdgcn_ds_read_tr16_b64_v4i16((LAS s16x4*)(p + stride4));
    return __builtin_shufflevector(lo, hi, 0, 1, 2, 3, 4, 5, 6, 7);
}
struct GlaW { float wf[16], wb[16], bfv, bbv; };
__device__ __forceinline__ void gla_load_w(GlaW& W, int k, int h, const float* __restrict__ w2f, const float* __restrict__ b2f, const float* __restrict__ w2b, const float* __restrict__ b2b) {
#pragma unroll
    for (int r = 0; r < 16; ++r) { W.wf[r] = w2f[r * 256 + h * 64 + k]; W.wb[r] = w2b[r * 256 + h * 64 + k]; }
    W.bfv = b2f[h * 64 + k]; W.bbv = b2b[h * 64 + k];
}
__device__ __forceinline__ void gla_gates(const Frame& F, const f32x4 zreg, const GlaW& W, float (&cf)[8], float (&cb)[8], float& totf, float& totb) {
    LAS float* ZS = (LAS float*)(F.lds + GL_Z); LAS float* TF = (LAS float*)(F.lds + GL_TF); LAS float* TB = (LAS float*)(F.lds + GL_TB);
    const int tid = F.tid, k = tid & 63, tg = F.wave;
    ((LAS f32x4*)ZS)[tid] = zreg;
    LBAR();
#pragma unroll
    for (int i = 0; i < 8; ++i) { const int t = tg * 8 + i; float af = W.bfv, ab = W.bbv;
#pragma unroll
        for (int r = 0; r < 16; ++r) { af += ZS[t * 32 + r] * W.wf[r]; ab += ZS[t * 32 + 16 + r] * W.wb[r]; }
        cf[i] = -softplusf_(-af) * 0.0625f; cb[i] = -softplusf_(-ab) * 0.0625f; }
#pragma unroll
    for (int i = 1; i < 8; ++i) cf[i] += cf[i - 1];
#pragma unroll
    for (int i = 6; i >= 0; --i) cb[i] += cb[i + 1];
    TF[tg * 64 + k] = cf[7]; TB[tg * 64 + k] = cb[0];
    LBAR();
    float ef = 0.f, eb = 0.f; totf = 0.f; totb = 0.f;
#pragma unroll
    for (int g2 = 0; g2 < 8; ++g2) { const float a = TF[g2 * 64 + k], bq = TB[g2 * 64 + k]; totf += a; totb += bq; ef += (g2 < tg) ? a : 0.f; eb += (g2 > tg) ? bq : 0.f; }
#pragma unroll
    for (int i = 0; i < 8; ++i) { cf[i] += ef; cb[i] += eb; }
}
__device__ __forceinline__ void gla_load_v(const Frame& F, const bf16* __restrict__ PB, size_t m0, int h, v4u (&vr)[2]) {
#pragma unroll
    for (int i = 0; i < 2; ++i) { const int ch = F.tid + NTHREADS * i, row = ch >> 4, col = ch & 15; vr[i] = *(const GAS v4u*)(PB + (m0 + row) * NPB + O_BV + h * 128 + col * 8); }
}
__device__ __forceinline__ void gla_store_v(const Frame& F, const v4u (&vr)[2]) {
    LAS unsigned char* VI = F.lds + GL_VI;
#pragma unroll
    for (int i = 0; i < 2; ++i) { const int ch = F.tid + NTHREADS * i, row = ch >> 4, col = ch & 15; *(LAS v4u*)(VI + row * GL_VS + col * 16) = vr[i]; }
}
__device__ __forceinline__ void gla_u_phase(const Frame& F, const bf16* __restrict__ PB, const float* __restrict__ Z, const float* __restrict__ w2f, const float* __restrict__ b2f,
                                            const float* __restrict__ w2b, const float* __restrict__ b2b, bf16* __restrict__ U, float* __restrict__ DEC) {
    const int tid = F.tid, lane = F.lane, g = lane >> 4, c = lane & 15, w = F.wave, k = tid & 63, tg = F.wave;
    LAS unsigned char* VI = F.lds + GL_VI;
    GlaW W; int h_loaded = -1;
    for (int unit = F.bx; unit < BATCH * 4 * 32; unit += F.G) {
        const int b = unit >> 7, h = (unit >> 5) & 3, n = unit & 31;
        const size_t m0 = (size_t)b * SEQ + n * 64;
        if (h != h_loaded) { gla_load_w(W, k, h, w2f, b2f, w2b, b2b); h_loaded = h; }
        const f32x4 zreg = ((const GAS f32x4*)(Z + m0 * 32))[tid];
        unsigned short kraw[8];
#pragma unroll
        for (int i = 0; i < 8; ++i) kraw[i] = PB[(m0 + tg * 8 + i) * NPB + O_BK + h * 64 + k];
        v4u vr[2]; gla_load_v(F, PB, m0, h, vr);
        LBAR();
        float cf[8], cb[8], totf, totb;
        gla_gates(F, zreg, W, cf, cb, totf, totb);
#pragma unroll
        for (int i = 0; i < 8; ++i) { const int t = tg * 8 + i; const float kk = bf2f(kraw[i]);
            *(LAS unsigned short*)(F.lds + GL_A + t * 144 + k * 2) = (unsigned short)f2bf(kk * __expf(totf - cf[i]));
            *(LAS unsigned short*)(F.lds + GL_B + t * 144 + k * 2) = (unsigned short)f2bf(kk * __expf(totb - cb[i])); }
        const size_t ub = (size_t)(b * 4 + h) * 32 + n;
        if (tg == 0) { DEC[ub * 64 + k] = __expf(totf); DEC[(ub + 512) * 64 + k] = __expf(totb); }
        gla_store_v(F, vr);
        LBAR();
        bf16x8 vf[2];
#pragma unroll
        for (int ts = 0; ts < 2; ++ts) vf[ts] = tr_frag(VI + (32 * ts + 8 * g + (c >> 2)) * GL_VS + (16 * w + 4 * (c & 3)) * 2, 4 * GL_VS);
#pragma unroll
        for (int d = 0; d < 2; ++d) {
            LAS unsigned char* KS = F.lds + (d ? GL_B : GL_A);
            bf16* Ud = U + (ub + (size_t)d * 512) * 8192;
#pragma unroll
            for (int kt = 0; kt < 4; ++kt) {
                f32x4 acc = {0.f, 0.f, 0.f, 0.f};
#pragma unroll
                for (int ts = 0; ts < 2; ++ts) { const bf16x8 af = tr_frag(KS + (32 * ts + 8 * g + (c >> 2)) * 144 + (16 * kt + 4 * (c & 3)) * 2, 4 * 144);
                    acc = __builtin_amdgcn_mfma_f32_16x16x32_bf16(vf[ts], af, acc, 0, 0, 0); }
                { v2u o; o.x = pk2(acc[0], acc[1]); o.y = pk2(acc[2], acc[3]); *(GAS v2u*)(Ud + (16 * kt + c) * 128 + 16 * w + 4 * g) = o; }
            }
        }
    }
}
__device__ __forceinline__ void gla_state_phase(const Frame& F, bf16* __restrict__ U, const float* __restrict__ DEC) {
    for (int id = F.bx * NTHREADS + F.tid; id < 32 * 64 * 64; id += F.G * NTHREADS) {
        const int seq = id >> 12, k = (id >> 6) & 63, e2 = id & 63, d = seq >> 4, bh = seq & 15;
        GAS unsigned* p0 = (GAS unsigned*)(U + ((size_t)d * 512 + bh * 32) * 8192 + k * 128) + e2;
        const float* d0 = DEC + ((size_t)d * 512 + bh * 32) * 64 + k;
        unsigned u[32]; float dc[32];
#pragma unroll
        for (int n = 0; n < 32; ++n) { u[n] = p0[(size_t)n * 4096]; dc[n] = d0[n * 64]; }
        float s0 = 0.f, s1 = 0.f;
        if (d == 0) {
#pragma unroll
            for (int n = 0; n < 32; ++n) { const float t0 = bf2f((unsigned short)(u[n] & 0xffffu)), t1 = bf2f((unsigned short)(u[n] >> 16)); u[n] = pk2(s0, s1); s0 = s0 * dc[n] + t0; s1 = s1 * dc[n] + t1; }
        } else {
#pragma unroll
            for (int n = 31; n >= 0; --n) { const float t0 = bf2f((unsigned short)(u[n] & 0xffffu)), t1 = bf2f((unsigned short)(u[n] >> 16)); u[n] = pk2(s0, s1); s0 = s0 * dc[n] + t0; s1 = s1 * dc[n] + t1; }
        }
#pragma unroll
        for (int n = 0; n < 32; ++n) p0[(size_t)n * 4096] = u[n];
    }
}
__device__ __forceinline__ void gla_o_phase(const Frame& F, const bf16* __restrict__ PB, const float* __restrict__ Z, const float* __restrict__ w2f, const float* __restrict__ b2f,
                                            const float* __restrict__ w2b, const float* __restrict__ b2b, const bf16* __restrict__ U, const float* __restrict__ gn, bf16* __restrict__ MIX) {
    const int tid = F.tid, lane = F.lane, g = lane >> 4, c = lane & 15, w = F.wave, k = tid & 63, tg = F.wave;
    LAS unsigned char* VI = F.lds + GL_VI; LAS unsigned char* QI = F.lds + GL_A; LAS unsigned char* KI = F.lds + GL_B; LAS unsigned char* PI = F.lds + GL_P; LAS unsigned char* SI = F.lds + GL_SI;
    LAS float* OF = (LAS float*)(F.lds + GL_OF);
    GlaW W; int h_loaded = -1;
    for (int unit = F.bx; unit < BATCH * 4 * 32; unit += F.G) {
        const int b = unit >> 7, h = (unit >> 5) & 3, n = unit & 31;
        const size_t m0 = (size_t)b * SEQ + n * 64;
        const size_t ub = (size_t)(b * 4 + h) * 32 + n;
        if (h != h_loaded) { gla_load_w(W, k, h, w2f, b2f, w2b, b2b); h_loaded = h; }
        const f32x4 zreg = ((const GAS f32x4*)(Z + m0 * 32))[tid];
        unsigned short qraw[8], kraw[8];
#pragma unroll
        for (int i = 0; i < 8; ++i) { qraw[i] = PB[(m0 + tg * 8 + i) * NPB + O_BQ + h * 64 + k]; kraw[i] = PB[(m0 + tg * 8 + i) * NPB + O_BK + h * 64 + k]; }
        v4u vr[2]; gla_load_v(F, PB, m0, h, vr);
        v4u sreg[2][2];
#pragma unroll
        for (int d = 0; d < 2; ++d) { const GAS v4u* sp = (const GAS v4u*)(U + (ub + (size_t)d * 512) * 8192 + (tid >> 3) * 128 + (tid & 7) * 16); sreg[d][0] = sp[0]; sreg[d][1] = sp[1]; }
        const v4u g0 = *(const GAS v4u*)(PB + (m0 + (tid >> 3)) * NPB + O_BG + h * 128 + (tid & 7) * 16), g1 = *(const GAS v4u*)(PB + (m0 + (tid >> 3)) * NPB + O_BG + h * 128 + (tid & 7) * 16 + 8);
        LBAR();
        float cf[8], cb[8], totf, totb;
        gla_gates(F, zreg, W, cf, cb, totf, totb);
        float qv[8], kv[8];
#pragma unroll
        for (int i = 0; i < 8; ++i) { qv[i] = bf2f(qraw[i]) * 0.125f; kv[i] = bf2f(kraw[i]); }
        gla_store_v(F, vr);
        f32x4 acc[4];
#pragma unroll
        for (int tt = 0; tt < 4; ++tt) acc[tt] = (f32x4){0.f, 0.f, 0.f, 0.f};
#pragma unroll
        for (int d = 0; d < 2; ++d) {
            LBAR();
#pragma unroll
            for (int i = 0; i < 8; ++i) { const int t = tg * 8 + i; const float cc = d ? cb[i] : cf[i];
                *(LAS unsigned short*)(QI + t * 144 + k * 2) = (unsigned short)f2bf(qv[i] * __expf(cc));
                *(LAS unsigned short*)(KI + t * 144 + k * 2) = (unsigned short)f2bf(kv[i] * __expf(-cc)); }
            {   const int row = tid >> 3, c16 = (tid & 7) * 16;
                const v4u o0 = sreg[d][0], o1 = sreg[d][1];
                *(LAS v4u*)(SI + row * GL_VS + c16 * 2) = o0; *(LAS v4u*)(SI + row * GL_VS + c16 * 2 + 16) = o1; }
            LBAR();
#pragma unroll
            for (int q2 = 0; q2 < 2; ++q2) {
                const int id = 2 * w + q2, tt = id >> 2, jt = id & 3;
                f32x4 p = {0.f, 0.f, 0.f, 0.f};
#pragma unroll
                for (int ks = 0; ks < 2; ++ks) { const bf16x8 a = *(const LAS bf16x8*)(QI + (16 * tt + c) * 144 + ks * 64 + g * 16), bb = *(const LAS bf16x8*)(KI + (16 * jt + c) * 144 + ks * 64 + g * 16);
                    p = __builtin_amdgcn_mfma_f32_16x16x32_bf16(a, bb, p, 0, 0, 0); }
#pragma unroll
                for (int r = 0; r < 4; ++r) { const int t = 16 * tt + 4 * g + r, j = 16 * jt + c; const bool keep = d ? (j > t) : (j <= t);
                    *(LAS unsigned short*)(PI + t * 144 + j * 2) = (unsigned short)f2bf(keep ? p[r] : 0.f); }
            }
            LBAR();
            bf16x8 vf[2], sf[2];
#pragma unroll
            for (int s2 = 0; s2 < 2; ++s2) { vf[s2] = tr_frag(VI + (32 * s2 + 8 * g + (c >> 2)) * GL_VS + (16 * w + 4 * (c & 3)) * 2, 4 * GL_VS);
                sf[s2] = tr_frag(SI + (32 * s2 + 8 * g + (c >> 2)) * GL_VS + (16 * w + 4 * (c & 3)) * 2, 4 * GL_VS); }
#pragma unroll
            for (int tt = 0; tt < 4; ++tt)
#pragma unroll
                for (int s2 = 0; s2 < 2; ++s2) { const bf16x8 pa = *(const LAS bf16x8*)(PI + (16 * tt + c) * 144 + s2 * 64 + g * 16), qa = *(const LAS bf16x8*)(QI + (16 * tt + c) * 144 + s2 * 64 + g * 16);
                    acc[tt] = __builtin_amdgcn_mfma_f32_16x16x32_bf16(pa, vf[s2], acc[tt], 0, 0, 0);
                    acc[tt] = __builtin_amdgcn_mfma_f32_16x16x32_bf16(qa, sf[s2], acc[tt], 0, 0, 0); }
        }
#pragma unroll
        for (int tt = 0; tt < 4; ++tt)
#pragma unroll
            for (int r = 0; r < 4; ++r) OF[(16 * tt + 4 * g + r) * 132 + 16 * w + c] = acc[tt][r];
        LBAR();
        {   const int t = tid >> 3, c16 = (tid & 7) * 16;
            float o[16]; float ss = 0.f;
#pragma unroll
            for (int e = 0; e < 16; ++e) { o[e] = OF[t * 132 + c16 + e]; ss += o[e] * o[e]; }
            ss += lane_xor_f(ss, 1, lane); ss += lane_xor_f(ss, 2, lane); ss += lane_xor_f(ss, 4, lane);
            const float rs = rsqrtf(ss * (1.f / 128.f) + EPS);
            const unsigned gg[8] = {g0.x, g0.y, g0.z, g0.w, g1.x, g1.y, g1.z, g1.w};
            unsigned oo[8];
#pragma unroll
            for (int e = 0; e < 8; ++e) { const float ga = bf2f((unsigned short)(gg[e] & 0xffffu)), gb = bf2f((unsigned short)(gg[e] >> 16));
                oo[e] = pk2(o[2 * e] * rs * gn[h * 128 + c16 + 2 * e] * (ga * sigmoidf_(ga)), o[2 * e + 1] * rs * gn[h * 128 + c16 + 2 * e + 1] * (gb * sigmoidf_(gb))); }
            v4u o0, o1; o0.x = oo[0]; o0.y = oo[1]; o0.z = oo[2]; o0.w = oo[3]; o1.x = oo[4]; o1.y = oo[5]; o1.z = oo[6]; o1.w = oo[7];
            *(GAS v4u*)(MIX + (m0 + t) * D + 1024 + h * 128 + c16) = o0; *(GAS v4u*)(MIX + (m0 + t) * D + 1024 + h * 128 + c16 + 8) = o1;
        }
    }
}
constexpr int LRU_LD = 132;
constexpr size_t MISC_CAR_A = 0, MISC_CAR_H = 1 * MiB, MISC_CIN = 2 * MiB, MISC_RS = 4 * MiB;
template <bool REV>
__device__ __forceinline__ void lru_scan16(const float (&a)[4][4], const float (&u)[4][4], float (&h)[4][4], float (&p)[4][4], float& Atot, float& Hend, int lane) {
    const int g4 = lane >> 4;
    float As[4], Hs[4];
#pragma unroll
    for (int tt = 0; tt < 4; ++tt) { float hh = 0.f, pp = 1.f;
#pragma unroll
        for (int q = 0; q < 4; ++q) { const int r = REV ? 3 - q : q; hh = a[tt][r] * hh + u[tt][r]; pp *= a[tt][r]; h[tt][r] = hh; p[tt][r] = pp; }
        As[tt] = pp; Hs[tt] = hh; }
    float Ai[4], Hi[4];
#pragma unroll
    for (int tt = 0; tt < 4; ++tt) { Ai[tt] = As[tt]; Hi[tt] = Hs[tt]; }
#pragma unroll
    for (int dist = 1; dist <= 2; dist <<= 1) {
        const int src = REV ? lane + 16 * dist : lane - 16 * dist; const bool ok = REV ? (g4 + dist <= 3) : (g4 >= dist);
#pragma unroll
        for (int tt = 0; tt < 4; ++tt) {
            const float Ap = __builtin_bit_cast(float, __builtin_amdgcn_ds_bpermute((src & 63) << 2, __builtin_bit_cast(int, Ai[tt])));
            const float Hp = __builtin_bit_cast(float, __builtin_amdgcn_ds_bpermute((src & 63) << 2, __builtin_bit_cast(int, Hi[tt])));
            if (ok) { Hi[tt] = Ai[tt] * Hp + Hi[tt]; Ai[tt] = Ai[tt] * Ap; } }
    }
    const int prv = REV ? lane + 16 : lane - 16; const bool first = REV ? (g4 == 3) : (g4 == 0);
    const int lastl = REV ? (lane & 15) : (lane & 15) + 48;
    float carry = 0.f, prod = 1.f;
#pragma unroll
    for (int q = 0; q < 4; ++q) { const int tt = REV ? 3 - q : q;
        float Aex = __builtin_bit_cast(float, __builtin_amdgcn_ds_bpermute((prv & 63) << 2, __builtin_bit_cast(int, Ai[tt])));
        float Hex = __builtin_bit_cast(float, __builtin_amdgcn_ds_bpermute((prv & 63) << 2, __builtin_bit_cast(int, Hi[tt])));
        if (first) { Aex = 1.f; Hex = 0.f; }
        const float Ab = __builtin_bit_cast(float, __builtin_amdgcn_ds_bpermute(lastl << 2, __builtin_bit_cast(int, Ai[tt])));
        const float Hb = __builtin_bit_cast(float, __builtin_amdgcn_ds_bpermute(lastl << 2, __builtin_bit_cast(int, Hi[tt])));
        const float e = Aex * carry + Hex, qq = prod * Aex;
#pragma unroll
        for (int r = 0; r < 4; ++r) { h[tt][r] += p[tt][r] * e; p[tt][r] *= qq; }
        carry = Ab * carry + Hb; prod *= Ab; }
    Atot = prod; Hend = carry;
}
__device__ __forceinline__ void lru_phase(const Frame& F, const bf16* __restrict__ PB, const bf16* __restrict__ LRUG, const float* __restrict__ cw, const float* __restrict__ cb,
                                          const float* __restrict__ ba, const float* __restrict__ bx, const float* __restrict__ lam, float* __restrict__ CAR_A, float* __restrict__ CAR_H,
                                          bf16* __restrict__ LS, bf16* __restrict__ LPF, bf16* __restrict__ LPB) {
    LAS float* XF = (LAS float*)(F.lds);
    LAS unsigned char* XB = F.lds + 33792;
    LAS unsigned short* ST = (LAS unsigned short*)(F.lds + 33792 + 17408);
    const int tid = F.tid, lane = F.lane, g4 = lane >> 4, c = lane & 15, w = F.wave;
    const bool g_const = (F.G & 3) == 0;
    int g_loaded = -1;
    float w0[4], w1[4], cb0 = 0.f, cb1 = 0.f;
    for (int unit = F.bx; unit < BATCH * 32 * 4; unit += F.G) {
        const int b = unit >> 7, n = (unit >> 2) & 31, g = unit & 3, t0 = n * 64;
        if (!g_const || g != g_loaded) {
            const int ch = g * 128 + 2 * (tid & 63);
#pragma unroll
            for (int jj = 0; jj < 4; ++jj) { w0[jj] = cw[jj * 512 + ch]; w1[jj] = cw[jj * 512 + ch + 1]; }
            cb0 = cb[ch]; cb1 = cb[ch + 1];
            g_loaded = g;
        }
        LBAR();
        {
            const int ch2 = tid & 63, tb = (tid >> 6) * 8, ch = g * 128 + 2 * ch2;
            const float b0 = cb0, b1 = cb1;
            float x0[11], x1[11];
#pragma unroll
            for (int i = 0; i < 11; ++i) { const int t = t0 + tb - 2 + i; unsigned v = 0u; if (t >= 0 && t < SEQ) v = *(const GAS unsigned*)(PB + (size_t)(b * SEQ + t) * NPB + PB_CX + ch);
                x0[i] = bf2f((unsigned short)(v & 0xffffu)); x1[i] = bf2f((unsigned short)(v >> 16)); }
#pragma unroll
            for (int r = 0; r < 8; ++r) { float y0 = b0, y1 = b1;
#pragma unroll
                for (int j = 0; j < 4; ++j) { y0 += x0[r + j] * w0[j]; y1 += x1[r + j] * w1[j]; }
                XF[(tb + r) * LRU_LD + 2 * ch2] = y0; XF[(tb + r) * LRU_LD + 2 * ch2 + 1] = y1;
                *(LAS unsigned*)(XB + (tb + r) * 272 + ch2 * 4) = pk2(y0, y1); }
        }
        LBAR();
        {
            const int j = 16 * w + c;
            float hs[4][4];
#pragma unroll 1
            for (int s = 0; s < 2; ++s) {
                const int chj = g * 128 + j;
                const bf16* wap = LRUG + ((size_t)((s * 2 + 0) * 4 + g) * 128 + j) * 128 + g4 * 8;
                const bf16* wxp = LRUG + ((size_t)((s * 2 + 1) * 4 + g) * 128 + j) * 128 + g4 * 8;
                bf16x8 waf[4], wxf[4];
#pragma unroll
                for (int ks = 0; ks < 4; ++ks) { waf[ks] = *(const GAS bf16x8*)(wap + ks * 32); wxf[ks] = *(const GAS bf16x8*)(wxp + ks * 32); }
                const float bav = ba[s * 512 + chj], bxv = bx[s * 512 + chj], spv = softplusf_(-lam[s * 512 + chj]);
                float a[4][4], u[4][4];
#pragma unroll
                for (int tt = 0; tt < 4; ++tt) {
                    f32x4 ga = {0.f, 0.f, 0.f, 0.f}, gx = {0.f, 0.f, 0.f, 0.f};
#pragma unroll
                    for (int ks = 0; ks < 4; ++ks) { const bf16x8 xf = *(const LAS bf16x8*)(XB + (16 * tt + c) * 272 + ks * 64 + g4 * 16);
                        ga = __builtin_amdgcn_mfma_f32_16x16x32_bf16(xf, waf[ks], ga, 0, 0, 0); gx = __builtin_amdgcn_mfma_f32_16x16x32_bf16(xf, wxf[ks], gx, 0, 0, 0); }
#pragma unroll
                    for (int r = 0; r < 4; ++r) { const int t = 16 * tt + 4 * g4 + r;
                        const float rg = sigmoidf_(ga[r] + bav), ig = sigmoidf_(gx[r] + bxv);
                        const float av = __builtin_amdgcn_exp2f(-8.f * 1.4426950408889634f * rg * spv);
                        a[tt][r] = av; u[tt][r] = __builtin_amdgcn_sqrtf(fmaxf(1.f - av * av, 0.f)) * (ig * XF[t * LRU_LD + j]); }
                }
                float h[4][4], p[4][4], Atot, Hend;
                if (s == 0) lru_scan16<false>(a, u, h, p, Atot, Hend, lane); else lru_scan16<true>(a, u, h, p, Atot, Hend, lane);
                if (g4 == 0) { const size_t ci = ((size_t)((s * BATCH + b) * 32 + n)) * 512 + g * 128 + j; CAR_A[ci] = Atot; CAR_H[ci] = Hend; }
#pragma unroll
                for (int tt = 0; tt < 4; ++tt)
#pragma unroll
                    for (int r = 0; r < 4; ++r) { const int t = 16 * tt + 4 * g4 + r;
                        ST[(1 + s) * 8192 + t * 128 + j] = (unsigned short)f2bf(p[tt][r]);
                        if (s == 0) hs[tt][r] = h[tt][r]; else ST[t * 128 + j] = (unsigned short)f2bf(hs[tt][r] + h[tt][r]); }
            }
        }
        LBAR();
        {
            const int t = tid >> 3, c16 = (tid & 7) * 16;
            const size_t m = (size_t)b * SEQ + t0 + t;
            bf16* const outp[3] = {LS, LPF, LPB};
#pragma unroll
            for (int q = 0; q < 3; ++q) { const v4u p0 = *(const LAS v4u*)(ST + q * 8192 + t * 128 + c16), p1 = *(const LAS v4u*)(ST + q * 8192 + t * 128 + c16 + 8);
                *(GAS v4u*)(outp[q] + m * 512 + g * 128 + c16) = p0; *(GAS v4u*)(outp[q] + m * 512 + g * 128 + c16 + 8) = p1; }
        }
    }
}
__device__ __forceinline__ void lru_out_phase(const Frame& F, const bf16* __restrict__ PB, const bf16* __restrict__ LS, const bf16* __restrict__ LPF, const bf16* __restrict__ LPB, const float* __restrict__ CIN, bf16* __restrict__ MIX) {
    for (int task = F.bx * NTHREADS + F.tid; task < M * 64; task += F.G * NTHREADS) {
        const int m = task >> 6, c8 = (task & 63) * 8, b = m / SEQ, n = (m % SEQ) >> 6;
        const v4u sv = *(const GAS v4u*)(LS + (size_t)m * 512 + c8), pf = *(const GAS v4u*)(LPF + (size_t)m * 512 + c8), pb = *(const GAS v4u*)(LPB + (size_t)m * 512 + c8);
        const v4u yv = *(const GAS v4u*)(PB + (size_t)m * NPB + PB_CY + c8);
        const GAS f32x4* cfp = (const GAS f32x4*)(CIN + ((size_t)((0 * BATCH + b) * 32 + n)) * 512 + c8); const GAS f32x4* cbp = (const GAS f32x4*)(CIN + ((size_t)((1 * BATCH + b) * 32 + n)) * 512 + c8);
        const f32x4 cf0 = cfp[0], cf1 = cfp[1], cb0 = cbp[0], cb1 = cbp[1];
        const float cf[8] = {cf0.x, cf0.y, cf0.z, cf0.w, cf1.x, cf1.y, cf1.z, cf1.w}, cbv[8] = {cb0.x, cb0.y, cb0.z, cb0.w, cb1.x, cb1.y, cb1.z, cb1.w};
        const unsigned ss[4] = {sv.x, sv.y, sv.z, sv.w}, pp[4] = {pf.x, pf.y, pf.z, pf.w}, qq[4] = {pb.x, pb.y, pb.z, pb.w}, yy[4] = {yv.x, yv.y, yv.z, yv.w};
        unsigned oo[4];
#pragma unroll
        for (int e = 0; e < 4; ++e) {
            const float h0 = bf2f((unsigned short)(ss[e] & 0xffffu)) + bf2f((unsigned short)(pp[e] & 0xffffu)) * cf[2 * e] + bf2f((unsigned short)(qq[e] & 0xffffu)) * cbv[2 * e];
            const float h1 = bf2f((unsigned short)(ss[e] >> 16)) + bf2f((unsigned short)(pp[e] >> 16)) * cf[2 * e + 1] + bf2f((unsigned short)(qq[e] >> 16)) * cbv[2 * e + 1];
            oo[e] = pk2(h0 * gelu_tanh(bf2f((unsigned short)(yy[e] & 0xffffu))), h1 * gelu_tanh(bf2f((unsigned short)(yy[e] >> 16)))); }
        v4u o; o.x = oo[0]; o.y = oo[1]; o.z = oo[2]; o.w = oo[3];
        *(GAS v4u*)(MIX + (size_t)m * D + 1536 + c8) = o;
    }
}
__device__ __forceinline__ void lru_carry_phase(const Frame& F, const float* __restrict__ CAR_A, const float* __restrict__ CAR_H, float* __restrict__ CIN) {
    const int id = F.bx * NTHREADS + F.tid;
    if (id < 2 * BATCH * 512) {
        const int s = id >> 11, b = (id >> 9) & 3, ch = id & 511;
        const size_t base = ((size_t)((s * BATCH + b) * 32)) * 512 + ch;
        float av[32], hv[32];
#pragma unroll
        for (int n = 0; n < 32; ++n) { av[n] = CAR_A[base + (size_t)n * 512]; hv[n] = CAR_H[base + (size_t)n * 512]; }
        float h = 0.f;
        if (s == 0) {
#pragma unroll
            for (int n = 0; n < 32; ++n) { const float t = hv[n]; hv[n] = h; h = av[n] * h + t; }
        } else {
#pragma unroll
            for (int n = 31; n >= 0; --n) { const float t = hv[n]; hv[n] = h; h = av[n] * h + t; }
        }
#pragma unroll
        for (int n = 0; n < 32; ++n) CIN[base + (size_t)n * 512] = hv[n];
    }
}
#define WA_LOAD(colbase, u_) do { const int b_ = (u_) >> 6, hkv_ = ((u_) >> 5) & 1, q0_ = ((u_) & 31) * 64; \
    _Pragma("unroll") for (int i_ = 0; i_ < 10; ++i_) { const int ch_ = tl + NTHREADS * i_, r_ = ch_ >> 4, col_ = ch_ & 15; int j_ = q0_ - 128 + r_; j_ = j_ < 0 ? 0 : (j_ > SEQ - 1 ? SEQ - 1 : j_); \
        kreg[i_] = *(const GAS v4u*)(PB + (size_t)(b_ * SEQ + j_) * NPB + (colbase) + hkv_ * 128 + col_ * 8); } } while (0)
#define WA_STORE(stride_) do { _Pragma("unroll") for (int i_ = 0; i_ < 10; ++i_) { const int ch_ = tl + NTHREADS * i_, r_ = ch_ >> 4, col_ = ch_ & 15; \
        *(LAS v4u*)(KS + r_ * (stride_) + col_ * 16) = kreg[i_]; } } while (0)
__device__ __forceinline__ void wattn_phase(const Frame& F, const bf16* __restrict__ PB, const float* __restrict__ rel_bias, const float* __restrict__ sink, bf16* __restrict__ MIX) {
    LAS unsigned char* KS = F.lds;
    LAS float* rb = (LAS float*)(F.lds + 320 * 288 + 4 * 304 * 4);
    LAS float* btab = (LAS float*)(F.lds + 320 * 288);
    const int lane = F.lane, g = lane >> 4, c = lane & 15, w = F.wave, tid = F.tid, rt = w >> 1, hp = w & 1;
    constexpr int NUNITS = BATCH * 2 * (SEQ / 64);
    v4u kreg[10];
    int unit = F.bx, bias_hkv = -1; float snk[2] = {0.f, 0.f};
    int tl = tid;
    if (unit < NUNITS) WA_LOAD(O_AK, unit);
    while (unit < NUNITS) {
        asm volatile("" : "+v"(tl));
        const int b = unit >> 6, hkv = (unit >> 5) & 1, qb = unit & 31;
        const int q0 = qb * 64;
        LBAR();
        WA_STORE(272);
        if (tid < 336) { const int pos = q0 - 128 + tid; rb[tid] = (pos >= 0 && pos < SEQ && tid < 320) ? 0.f : -1e30f; }
        if (hkv != bias_hkv) {
            for (int e = tid; e < 4 * 304; e += NTHREADS) { const int hh = e / 304, rel = e % 304 - 143; btab[e] = (rel >= -128 && rel <= 128) ? rel_bias[t5_bucket(rel) * 8 + hkv * 4 + hh] : -1e30f; }
            snk[0] = sink[hkv * 4 + hp * 2]; snk[1] = sink[hkv * 4 + hp * 2 + 1]; bias_hkv = hkv; }
        LBAR();
        const size_t qoff = (size_t)(b * SEQ + q0 + 16 * rt + c) * NPB + O_AQ + (hkv * 4 + hp * 2) * 128 + g * 8;
        bf16x8 qfr[4];
#pragma unroll
        for (int ks = 0; ks < 4; ++ks) qfr[ks] = *(const GAS bf16x8*)(PB + qoff + ks * 32);
        WA_LOAD(O_AV, unit);
        bf16x8 pf0[9], pf1[9];
#pragma unroll 1
        for (int hh = 0; hh < 2; ++hh) {
            f32x4 S[17];
#pragma unroll
            for (int kt = 0; kt < 17; ++kt) S[kt] = (f32x4){0.f, 0.f, 0.f, 0.f};
#pragma unroll
            for (int ks = 0; ks < 4; ++ks) {
                const bf16x8 qf = qfr[ks];
#pragma unroll
                for (int kt = 0; kt < 17; ++kt) { const bf16x8 kf = *(const LAS bf16x8*)(KS + (16 * rt + 16 * kt + c) * 272 + ks * 64 + g * 16); S[kt] = __builtin_amdgcn_mfma_f32_16x16x32_bf16(kf, qf, S[kt], 0, 0, 0);
                    if (kt == 5 || kt == 11 || kt == 16) __builtin_amdgcn_sched_barrier(0); }
            }
            if (hh == 0) {
#pragma unroll
                for (int ks = 0; ks < 4; ++ks) qfr[ks] = *(const GAS bf16x8*)(PB + qoff + 128 + ks * 32); }
            const LAS float* bt = btab + (hp * 2 + hh) * 304;
#pragma unroll
            for (int kt = 0; kt < 17; ++kt)
#pragma unroll
                for (int r = 0; r < 4; ++r) {
                    S[kt][r] = S[kt][r] * 0.08838834764831845f + (bt[(4 * g - c + 15) + 16 * kt + r] + rb[(16 * rt + 4 * g) + 16 * kt + r]);
                    if (r == 3 && (kt & 1)) __builtin_amdgcn_sched_barrier(0);
                }
            const float sk = hh ? snk[1] : snk[0];
            float mx = sk;
#pragma unroll
            for (int kt = 0; kt < 17; ++kt)
#pragma unroll
                for (int r = 0; r < 4; ++r) mx = fmaxf(mx, S[kt][r]);
            mx = fmaxf(mx, lane_xor_f(mx, 16, lane)); mx = fmaxf(mx, lane_xor_f(mx, 32, lane));
            float sum = 0.f;
#pragma unroll
            for (int kt = 0; kt < 17; ++kt)
#pragma unroll
                for (int r = 0; r < 4; ++r) { const float p = __builtin_amdgcn_exp2f((S[kt][r] - mx) * 1.4426950408889634f); S[kt][r] = p; sum += p; }
            sum += lane_xor_f(sum, 16, lane); sum += lane_xor_f(sum, 32, lane);
            sum += __builtin_amdgcn_exp2f((sk - mx) * 1.4426950408889634f);
            const float inv = 1.f / sum;
            bf16x8 pfc[9];
#pragma unroll
            for (int s = 0; s < 9; ++s) { v4u t; t.x = pk2(S[2 * s][0] * inv, S[2 * s][1] * inv); t.y = pk2(S[2 * s][2] * inv, S[2 * s][3] * inv);
                if (s < 8) { t.z = pk2(S[2 * s + 1][0] * inv, S[2 * s + 1][1] * inv); t.w = pk2(S[2 * s + 1][2] * inv, S[2 * s + 1][3] * inv); } else { t.z = 0u; t.w = 0u; }
                pfc[s] = __builtin_bit_cast(bf16x8, t); }
            if (hh == 0) {
#pragma unroll
                for (int s = 0; s < 9; ++s) pf0[s] = pfc[s];
            } else {
#pragma unroll
                for (int s = 0; s < 9; ++s) pf1[s] = pfc[s]; }
        }
        LBAR();
        WA_STORE(288);
        LBAR();
        const int nxt = unit + F.G;
        if (nxt < NUNITS) WA_LOAD(O_AK, nxt);
        for (int dt = 0; dt < 8; ++dt) {
            f32x4 acc0 = {0.f, 0.f, 0.f, 0.f}, acc1 = {0.f, 0.f, 0.f, 0.f};
#pragma unroll
            for (int s = 0; s < 9; ++s) {
                LAS unsigned char* vp = KS + (16 * rt + 32 * s + 4 * g + (c >> 2)) * 288 + (16 * dt + 4 * (c & 3)) * 2;
                const s16x4 lo = __builtin_amdgcn_ds_read_tr16_b64_v4i16((LAS s16x4*)vp);
                const s16x4 hi = __builtin_amdgcn_ds_read_tr16_b64_v4i16((LAS s16x4*)(vp + (s < 8 ? 16 * 288 : 0)));
                const bf16x8 vf = __builtin_shufflevector(lo, hi, 0, 1, 2, 3, 4, 5, 6, 7);
                acc0 = __builtin_amdgcn_mfma_f32_16x16x32_bf16(vf, pf0[s], acc0, 0, 0, 0);
                acc1 = __builtin_amdgcn_mfma_f32_16x16x32_bf16(vf, pf1[s], acc1, 0, 0, 0);
            }
            bf16* op = MIX + (size_t)(b * SEQ + q0 + 16 * rt + c) * D + (hkv * 4 + hp * 2) * 128 + dt * 16 + 4 * g;
            v2u o; o.x = pk2(acc0[0], acc0[1]); o.y = pk2(acc0[2], acc0[3]); *(GAS v2u*)op = o;
            o.x = pk2(acc1[0], acc1[1]); o.y = pk2(acc1[2], acc1[3]); *(GAS v2u*)(op + 128) = o;
        }
        unit = nxt;
    }
}
#undef WA_LOAD
#undef WA_STORE
__device__ __forceinline__ void xsoftmax_phase(const Frame& F, const float* __restrict__ SC, bf16* __restrict__ P) {
    const int lane = F.lane, gw = F.bx * NWAVES + F.wave, NGW = F.G * NWAVES;
    for (int m0 = gw; m0 < M; m0 += 4 * NGW) {
        f32x4 s[4][4];
#pragma unroll
        for (int i = 0; i < 4; ++i) { const int m = m0 + i * NGW; const bool ok = m < M; const size_t mm = ok ? m : m0;
#pragma unroll
            for (int h = 0; h < 4; ++h) { const f32x4 a = *(const GAS f32x4*)(SC + mm * 1024 + h * 256 + 4 * lane), b2 = *(const GAS f32x4*)(SC + ((size_t)M + mm) * 1024 + h * 256 + 4 * lane); s[i][h] = a + b2; } }
#pragma unroll
        for (int i = 0; i < 4; ++i) { const int m = m0 + i * NGW; if (m >= M) break;
#pragma unroll
            for (int h = 0; h < 4; ++h) { const f32x4 v = s[i][h];
                const float mx = wave_max(fmaxf(fmaxf(v.x, v.y), fmaxf(v.z, v.w)), lane);
                const float e0 = __builtin_amdgcn_exp2f((v.x - mx) * 1.4426950408889634f), e1 = __builtin_amdgcn_exp2f((v.y - mx) * 1.4426950408889634f), e2 = __builtin_amdgcn_exp2f((v.z - mx) * 1.4426950408889634f), e3 = __builtin_amdgcn_exp2f((v.w - mx) * 1.4426950408889634f);
                const float inv = 1.f / wave_sum((e0 + e1) + (e2 + e3), lane);
                v2u o; o.x = pk2(e0 * inv, e1 * inv); o.y = pk2(e2 * inv, e3 * inv);
                *(GAS v2u*)(P + (size_t)m * 1024 + h * 256 + 4 * lane) = o; } }
    }
}
constexpr int NPL = 15;
enum Phase { PH_CONV = 0, PH_KV, PH_IN, PH_X1, PH_X2, PH_X3, PH_OUT, PH_RN1  , PH_Q  , PH_XA  , PH_O, PH_RN2  , PH_UP, PH_DOWN, PH_RN3   };
struct Args { const float* in[31]; float* out; unsigned char* ws; int ph_lo, ph_hi, li, pad; };

__global__ void __launch_bounds__(NTHREADS, 2) fwd(Args args) {
    extern __shared__ __attribute__((aligned(16))) unsigned char lds[];
    Frame F;
    F.lds = (LAS unsigned char*)lds;
    const int wave_s = __builtin_amdgcn_readfirstlane(threadIdx.x >> 6);
    F.tid = threadIdx.x; F.lane = F.tid & 63; F.wave = wave_s;
    F.G = gridDim.x; F.bx = blockIdx.x;
    unsigned char* ws_top = args.ws;
    const int lo = args.ph_lo, hi = args.ph_hi;
    for (int u = F.tid; u < (LDS_BYTES - LDSCTL_OFF) / 4; u += NTHREADS) ((LAS unsigned*)(F.lds + LDSCTL_OFF))[u] = 0u;
    __syncthreads();
    XcdBarrier bar; bar.bar = (unsigned*)(ws_top + WS_CTL) + CW_BAR; bar.x = 0; bar.st = nullptr;
    const bool one_launch = (hi - lo) > 1;
    if (one_launch) bar = xcd_barrier_post((unsigned*)(ws_top + WS_CTL) + CW_BAR, (volatile LAS unsigned*)(F.lds + MISC_OFF) + 8);
#define IN(k) (lo <= (k) && (k) < hi)
#define AMP_T0() const unsigned long long at0_ = (PROBE_AMP != 0) ? __builtin_amdgcn_s_memrealtime() : 0ull
#define AMP_END(bit) do { if (PROBE_AMP & (1u << (bit))) { __syncthreads(); const unsigned long long at1_ = __builtin_amdgcn_s_memrealtime(), tgt_ = at1_ + AMP_K * (at1_ - at0_); \
        while (__builtin_amdgcn_s_memrealtime() < tgt_) __builtin_amdgcn_s_sleep(16); } } while (0)
#define SEAM(k) do { if (one_launch && (k) + 1 < hi) { AMP_T0(); xcd_barrier(bar); if (PROBE_AMP & (1u << 16)) xcd_barrier(bar); AMP_END(17); } } while (0)
#define PHASE_BEGIN() const CAS Args* ka_ = (const CAS Args*)__builtin_amdgcn_kernarg_segment_ptr(); asm volatile("" : "+s"(ka_)); \
    unsigned mk_ = ~0u; int l = l_it, bx_ = (int)blockIdx.x, G_ = (int)gridDim.x; asm volatile("" : "+s"(mk_), "+s"(l), "+s"(bx_), "+s"(G_)); F.bx = bx_; F.G = G_;     \
    int tz_ = (wave_s << 6) + (int)__builtin_amdgcn_mbcnt_hi(mk_, __builtin_amdgcn_mbcnt_lo(mk_, 0u)); asm volatile("" : "+v"(tz_)); F.tid = tz_; F.lane = tz_ & 63; F.wave = __builtin_amdgcn_readfirstlane(tz_ >> 6); \
    unsigned char* ws = ka_->ws; float* X = ka_->out; bf16* XN = (bf16*)(ws + WS_XN); float* RS = (float*)(ws + WS_MISC + MISC_RS); unsigned char* wl = ws + WS_W + (size_t)(l % NWL) * WL_BYTES; \
    const int gw = F.bx * NWAVES + F.wave, NGW = F.G * NWAVES; (void)gw; (void)NGW; (void)X; (void)XN; (void)wl; (void)RS

    for (int l_it = 0; l_it < DEPTH; ++l_it) {
        const int pb = l_it * NPL;
        if (IN(pb + PH_CONV)) { PHASE_BEGIN(); AMP_T0();
            LAS float* scr = (LAS float*)(F.lds + RING_OFF + F.wave * 16384);
            const int lc0 = (NWL == 1) ? l : (l == 0 ? 0 : DEPTH), lc1 = (NWL == 1) ? l + 1 : DEPTH;
            if (lc1 > lc0) conv_weights_phase(F, ka_->in, ws, SEGA, SEGA_START, 2, SEGA_ITEMS, 0, DEPTH * SEGA_ITEMS, scr, gw, NGW);
            for (int lc = lc0; lc < lc1; ++lc)
                for (int m = gw; m < MM; m += NGW) norm_row(F.lane, ka_->in[1] + (size_t)m * D, ka_->in[26] + (size_t)lc * D, (bf16*)(ws + WS_MEMN) + ((size_t)lc * MM + m) * D, nullptr); AMP_END(0);
        }
        if (l_it == 0 || NWL == 1) SEAM(pb + PH_CONV);
        if (IN(pb + PH_KV)) { PHASE_BEGIN(); AMP_T0();
            const int lc0 = (NWL == 1) ? l : (l == 0 ? 0 : DEPTH), lc1 = (NWL == 1) ? l + 1 : DEPTH;
            if (lc1 > lc0) {
                const int GA = F.G >> 1;
                if (F.bx < GA) {
                    const bf16* base = (const bf16*)(ws + WS_W);
                    pg8::Gemm g{base, base, 0, 0, D, 0, 0};
                    pg8::KvOrder S; S.G = GA; S.c = F.bx; S.NL = lc1 - lc0; S.l0 = lc0;
                    S.memn_p0 = (int)((WS_MEMN - WS_W) / MiB) + 4 * lc0; S.memn_ps = 4;
                    S.xk_p0 = (int)(((size_t)(lc0 % NWL) * WL_BYTES + WL_XK) / MiB); S.xv_p0 = (int)(((size_t)(lc0 % NWL) * WL_BYTES + WL_XV) / MiB); S.w_ps = (int)(WL_BYTES / MiB);
                    pg8::EpiBf16<0> E{(bf16*)(ws + WS_KX), D, (bf16*)(ws + WS_VT), D, nullptr, 0, 0.f, 0.f, nullptr};
                    pg8::gemm_phase<pg8::EpiBf16<0>, pg8::KvOrder, true, true>(F.lds + RING_OFF, g, S, E, F.tid);
                } else {
                    LAS float* scrB = (LAS float*)(F.lds + RING_OFF + F.wave * 16384); const int gwB = (F.bx - GA) * NWAVES + F.wave, NGWB = (F.G - GA) * NWAVES;
                    conv_weights_phase(F, ka_->in, ws, SEGO, SEGO_START, 1, SEGO_ITEMS, 0, DEPTH * SEGO_ITEMS, scrB, gwB, NGWB);
                    for (int r = gwB; r < DEPTH * D; r += NGWB) { const int lc = r / D, k = r % D;
                        scale_row_bf16(F.lane, ka_->in[18] + ((size_t)lc * D + k) * D, ka_->in[27][(size_t)lc * D + k], (bf16*)(ws + WS_W + (size_t)(lc % NWL) * WL_BYTES + WL_XQ) + (size_t)k * D); }
                    conv_weights_phase(F, ka_->in, ws, SEGB, SEGB_START, 6, SEGB_ITEMS, 0, SEGB_SPLIT, scrB, gwB, NGWB);
                }
            }
            AMP_END(1);
        }
        if (l_it == 0 || NWL == 1) SEAM(pb + PH_KV);
        if (l_it == 0 && IN(PH_RN1)) { PHASE_BEGIN(); AMP_T0();
            const int GA = F.G >> 1;
            if (F.bx < GA) {
                const bf16* base = (const bf16*)(ws + WS_W);
                pg8::Gemm g{base, base, 0, 0, 512, D, D};
                pg8::ProdOrder S; S.G = GA; S.c = F.bx; S.NL = DEPTH; S.kx_p0 = (int)((WS_KX - WS_W) / MiB); S.vx_p0 = (int)((WS_VT - WS_W) / MiB); S.xq_p0 = (int)(WL_XQ / MiB); S.xo_p0 = (int)(WL_XO / MiB); S.w_ps = (int)(WL_BYTES / MiB);
                pg8::EpiBf16<0> E{(bf16*)(ws + WS_MQK), D, (bf16*)(ws + WS_VWO), 1024, nullptr, 0, 0.f, 0.f, nullptr};
                pg8::gemm_phase<pg8::EpiBf16<0>, pg8::ProdOrder, true, true>(F.lds + RING_OFF, g, S, E, F.tid);
            } else {
                LAS float* scrB = (LAS float*)(F.lds + RING_OFF + F.wave * 16384); const int gwB = (F.bx - GA) * NWAVES + F.wave, NGWB = (F.G - GA) * NWAVES;
                conv_weights_phase(F, ka_->in, ws, SEGB, SEGB_START, 6, SEGB_ITEMS, SEGB_SPLIT, DEPTH * SEGB_ITEMS, scrB, gwB, NGWB);
                for (int it = gwB; it < DEPTH * 16 * 8; it += NGWB) { const int lc = it >> 7, mi = (it >> 3) & 15, gate = mi >> 3, s = (mi >> 2) & 1, gg = mi & 3;
                    p0_transpose_item(ka_->in[gate ? 15 : 13] + ((size_t)lc * 8 + s * 4 + gg) * 16384, 128, 128, 0, (bf16*)(ws + WS_W + (size_t)(lc % NWL) * WL_BYTES + WL_LRUG) + (size_t)((s * 2 + gate) * 4 + gg) * 16384, 0, 4, nullptr, scrB, it & 7, F.lane); }
                if (NGWB * 8 == M) { init_rows<4>(F.lane, ka_->in[0] + (size_t)gwB * D, XN + (size_t)gwB * D, RS + gwB, (size_t)NGWB);
                    init_rows<4>(F.lane, ka_->in[0] + (size_t)(gwB + 4 * NGWB) * D, XN + (size_t)(gwB + 4 * NGWB) * D, RS + gwB + 4 * NGWB, (size_t)NGWB); }
                else for (int m = gwB; m < M; m += NGWB) init_row(F.lane, ka_->in[0] + (size_t)m * D, XN + (size_t)m * D, RS + m);
            }
            AMP_END(19);
        }
        if (l_it == 0) SEAM(PH_RN1);
        if (IN(pb + PH_IN)) { PHASE_BEGIN(); AMP_T0();
            pg8::Gemm g{XN, (const bf16*)(wl + WL_IN), M, NPB, D, 0, 0}; pg8::StaticOrder S; S.init(M, NPB, F.G, F.bx);
            pg8::EpiBf16<0> E{(bf16*)(ws + WS_PB), NPB, nullptr, 0, RS, M, 1.f / D, EPS, (LAS float*)(F.lds + RING_BYTES)};
            pg8::gemm_phase<pg8::EpiBf16<0>, pg8::StaticOrder, true, true>(F.lds + RING_OFF, g, S, E, F.tid);
            zgemm(F, XN, (const bf16*)(wl + WL_Z), RS, (float*)(ws + WS_Z)); AMP_END(2);
        }
        SEAM(pb + PH_IN);
        if (IN(pb + PH_X1)) { PHASE_BEGIN();
            { AMP_T0(); gla_u_phase(F, (const bf16*)(ws + WS_PB), (const float*)(ws + WS_Z), ka_->in[6] + (size_t)l * 4096, ka_->in[7] + (size_t)l * 256, ka_->in[8] + (size_t)l * 4096, ka_->in[9] + (size_t)l * 256,
                        (bf16*)(ws + WS_GLAU), (float*)(ws + WS_MISC + MISC_DEC)); AMP_END(3); }
            { AMP_T0(); lru_phase(F, (const bf16*)(ws + WS_PB), (const bf16*)(wl + WL_LRUG), ka_->in[11] + (size_t)l * 2048, ka_->in[12] + (size_t)l * 512, ka_->in[14] + (size_t)l * 1024, ka_->in[16] + (size_t)l * 1024, ka_->in[17] + (size_t)l * 1024,
                             (float*)(ws + WS_MISC + MISC_CAR_A), (float*)(ws + WS_MISC + MISC_CAR_H), (bf16*)(ws + WS_LRU), (bf16*)(ws + WS_LRU) + (size_t)M * 512, (bf16*)(ws + WS_LRU) + (size_t)2 * M * 512); AMP_END(5); } }
        SEAM(pb + PH_X1);
        if (IN(pb + PH_X2)) { PHASE_BEGIN();
            { AMP_T0();
            gla_state_phase(F, (bf16*)(ws + WS_GLAU), (const float*)(ws + WS_MISC + MISC_DEC));
            lru_carry_phase(F, (const float*)(ws + WS_MISC + MISC_CAR_A), (const float*)(ws + WS_MISC + MISC_CAR_H), (float*)(ws + WS_MISC + MISC_CIN));
            AMP_END(14); }
            { AMP_T0(); wattn_phase(F, (const bf16*)(ws + WS_PB), ka_->in[2], ka_->in[5] + l * 8, (bf16*)(ws + WS_MIX)); AMP_END(6); } }
        SEAM(pb + PH_X2);
        if (IN(pb + PH_X3)) { PHASE_BEGIN();
            { AMP_T0(); gla_o_phase(F, (const bf16*)(ws + WS_PB), (const float*)(ws + WS_Z), ka_->in[6] + (size_t)l * 4096, ka_->in[7] + (size_t)l * 256, ka_->in[8] + (size_t)l * 4096, ka_->in[9] + (size_t)l * 256,
                        (const bf16*)(ws + WS_GLAU), ka_->in[10] + (size_t)l * 512, (bf16*)(ws + WS_MIX)); AMP_END(7); }
            { AMP_T0(); lru_out_phase(F, (const bf16*)(ws + WS_PB), (const bf16*)(ws + WS_LRU), (const bf16*)(ws + WS_LRU) + (size_t)M * 512, (const bf16*)(ws + WS_LRU) + (size_t)2 * M * 512, (const float*)(ws + WS_MISC + MISC_CIN), (bf16*)(ws + WS_MIX)); AMP_END(8); } }
        SEAM(pb + PH_X3);
        if (IN(pb + PH_OUT)) { PHASE_BEGIN(); AMP_T0();
            pg8::Gemm g{(const bf16*)(ws + WS_MIX), (const bf16*)(wl + WL_OUT), M, D, D, 0, 0}; pg8::StaticOrder S; S.init(M, D, F.G, F.bx);
            pg8::EpiResid E{XN, ka_->in[25] + (size_t)l * D, RS, M, nullptr, (float*)(ws + WS_SLOT) + (size_t)(l * 3 + 0) * 32 * 8 * 256, (unsigned*)(ws + WS_CTL) + CW_RCNT + (l * 3 + 0) * 32 * 64, 1.f / D, EPS};
            pg8::gemm_phase<pg8::EpiResid, pg8::StaticOrder, false, true>(F.lds + RING_OFF, g, S, E, F.tid); AMP_END(9);
        }
        SEAM(pb + PH_RN1);
        if (IN(pb + PH_Q)) { PHASE_BEGIN(); AMP_T0();
            pg8::Gemm g{XN, (const bf16*)(ws + WS_MQK), M, 2048, 1024, D, D}; pg8::BatchBOrder<2> S; S.init(M, 2048, F.G, F.bx); S.bp0 = l * 16; S.per_b = 4; S.khalf_bytes = 2048;
            pg8::EpiF32s E{(float*)(ws + WS_SC), 1024, RS, M, 1.f / D, EPS, 0.044194173824159216f, 32, (LAS float*)(F.lds + RING_BYTES)};
            pg8::gemm_phase<pg8::EpiF32s, pg8::BatchBOrder<2>, true, true>(F.lds + RING_OFF, g, S, E, F.tid); AMP_END(10);
        }
        SEAM(pb + PH_Q);
        if (IN(pb + PH_XA)) { PHASE_BEGIN(); AMP_T0(); xsoftmax_phase(F, (const float*)(ws + WS_SC), (bf16*)(ws + WS_PR)); AMP_END(4); }
        SEAM(pb + PH_XA);
        if (IN(pb + PH_O)) { PHASE_BEGIN(); AMP_T0();
            pg8::Gemm g{(const bf16*)(ws + WS_PR), (const bf16*)(ws + WS_VWO), M, D, 1024, 1024, 1024}; pg8::BatchBOrder<1> S; S.init(M, D, F.G, F.bx); S.bp0 = l * 32; S.per_b = 8; S.khalf_bytes = 0;
            pg8::EpiResid E{XN, ka_->in[28] + (size_t)l * D, RS, M, nullptr, (float*)(ws + WS_SLOT) + (size_t)(l * 3 + 1) * 32 * 8 * 256, (unsigned*)(ws + WS_CTL) + CW_RCNT + (l * 3 + 1) * 32 * 64, 1.f / D, EPS, K8U[l] ? ws + WS_X8 : nullptr};
            pg8::gemm_phase<pg8::EpiResid, pg8::BatchBOrder<1>, false, true>(F.lds + RING_OFF, g, S, E, F.tid); AMP_END(11);
        }
        SEAM(pb + PH_RN2);
        if (IN(pb + PH_UP)) { PHASE_BEGIN(); AMP_T0();
            const int k8u = K8U[l]; const bf16* A0 = k8u ? (const bf16*)(ws + WS_X8) : XN;
            pg8::Gemm g{A0, (const bf16*)(wl + WL_UP), M, DFF, D, 0, 0}; pg8::MixedOrder S; S.init(M, DFF, F.G, F.bx); S.nt8 = k8u / 128; S.ntb = (D - k8u) / 64;
            S.jumpA = k8u ? (long long)((const char*)XN - (const char*)A0) + k8u : 0; S.jumpB = k8u; S.sclA = 0x7b7b7b7b; S.sclB = 0x78787878;
            pg8::EpiBf16<1> E{(bf16*)(ws + WS_H), DFF, nullptr, 0, RS, M, 1.f / D, EPS, (LAS float*)(F.lds + RING_BYTES), K8L[l] / 256};
            if (PROBE_AMP & (1u << 18)) {
                for (int rr = 0; rr < 4; ++rr) { S.r0 = rr; S.nr = 1; pg8::gemm_phase<pg8::EpiBf16<1>, pg8::MixedOrder, true, true>(F.lds + RING_OFF, g, S, E, F.tid); if (rr < 3) xcd_barrier(bar); }
            } else
            pg8::gemm_phase<pg8::EpiBf16<1>, pg8::MixedOrder, true, true>(F.lds + RING_OFF, g, S, E, F.tid); AMP_END(12);
        }
        SEAM(pb + PH_UP);
        if (IN(pb + PH_DOWN)) { PHASE_BEGIN(); AMP_T0();
            pg8::Gemm g{(const bf16*)(ws + WS_H), (const bf16*)(wl + WL_DOWN), M, D, DFF, 0, 0}; pg8::MixedOrder S; S.init(M, D, F.G, F.bx); const int k8 = K8L[l]; S.nt8 = k8 / 128; S.ntb = (DFF - k8) / 64; S.jumpA = k8; S.jumpB = k8; S.sclA = 0x7b7b7b7b; S.sclB = 0x77777777;
            pg8::EpiResid E{XN, ka_->in[30] + (size_t)l * D, RS, M, (l + 1 < DEPTH) ? nullptr : X, (float*)(ws + WS_SLOT) + (size_t)(l * 3 + 2) * 32 * 8 * 256, (unsigned*)(ws + WS_CTL) + CW_RCNT + (l * 3 + 2) * 32 * 64, 1.f / D, EPS};
            pg8::gemm_phase<pg8::EpiResid, pg8::MixedOrder, false, true>(F.lds + RING_OFF, g, S, E, F.tid); AMP_END(13);
        }
        SEAM(pb + PH_RN3);
    }
#undef IN
#undef SEAM
}
extern "C" void kernel_launch(void* const* d_in, const int* in_sizes, int n_in, void* d_out, int out_size, void* d_ws, size_t ws_size, hipStream_t stream) {
    static int grid = 0;
    if (grid == 0) {
        int dev = 0, cus = 0;
        if (n_in != 31 || out_size != M * D || ws_size < WS_END) { fprintf(stderr, "kernel_launch: built for 31 inputs, %d outputs, >= %zu bytes of workspace; got %d, %d, %zu\n", M * D, (size_t)WS_END, n_in, out_size, ws_size); grid = -1; return; }
        if (hipGetDevice(&dev) != hipSuccess || hipDeviceGetAttribute(&cus, hipDeviceAttributeMultiprocessorCount, dev) != hipSuccess) { fprintf(stderr, "kernel_launch: device query failed\n"); grid = -1; return; }
        if (hipFuncSetAttribute((const void*)fwd, hipFuncAttributeMaxDynamicSharedMemorySize, LDS_BYTES) != hipSuccess) { fprintf(stderr, "kernel_launch: hipFuncSetAttribute failed\n"); grid = -1; return; }
        int per_cu = 0;
        if (hipOccupancyMaxActiveBlocksPerMultiprocessor(&per_cu, (const void*)fwd, NTHREADS, LDS_BYTES) != hipSuccess || per_cu < 1) { fprintf(stderr, "kernel_launch: occupancy query reports %d workgroups per CU\n", per_cu); (void)hipGetLastError(); }
        if (cus != 256) { fprintf(stderr, "kernel_launch: built for a 256-CU device (one 256x256 GEMM unit per workgroup in the fused-epilogue phases); found %d CUs\n", cus); grid = -1; return; }
        grid = cus;
    }
    if (grid < 0) return;
    unsigned char* ws = (unsigned char*)d_ws;
    (void)hipMemsetAsync(ws + WS_CTL, 0, CTL_ZERO_BYTES, stream);
    Args a{};
    for (int i = 0; i < 31; ++i) a.in[i] = (const float*)d_in[i];
    a.out = (float*)d_out; a.ws = ws;
#if defined(MK_PER_PHASE) && MK_PER_PHASE
    for (int p = 0; p < DEPTH * NPL; ++p) { if (NWL == 4 && p >= NPL && (p % NPL) < 2) continue; if ((p % NPL) == PH_RN1 || (p % NPL) == PH_RN2 || (p % NPL) == PH_RN3) continue; a.ph_lo = p; a.ph_hi = p + 1; hipLaunchKernelGGL(fwd, dim3(grid), dim3(NTHREADS), LDS_BYTES, stream, a); }
#else
    a.ph_lo = 0; a.ph_hi = DEPTH * NPL;
    hipLaunchKernelGGL(fwd, dim3(grid), dim3(NTHREADS), LDS_BYTES, stream, a);
    const hipError_t le = hipPeekAtLastError();
    if (le != hipSuccess) fprintf(stderr, "kernel_launch: launch failed: %s\n", hipGetErrorName(le));
#endif
}
```
